# Optimizing an MI355X kernel written in HIP

```python
import functools
import jax
import jax.numpy as jnp
from jax import lax
import numpy as np

D_MODEL = 1024
BATCH = 2
SEQ = 8192
DEPTH = 1
DEC_BATCH = 128
DEC_SEQ = 1
PAST_LEN = 8192
PAGE_SIZE = 128

D_RNN = 1280
RNN_BLOCKS = 16
RNN_BLOCK = D_RNN // RNN_BLOCKS
CONV_W = 4
LRU_C = 8.0
N_HEADS = 16
QK_NOPE = 64
QK_ROPE = 32
V_HEAD = 64
Q_LORA = 384
KV_LORA = 256
ROPE_THETA = 10000.0
SM_SCALE = (QK_NOPE + QK_ROPE) ** -0.5
Q_BLOCK = 128
D_FF = 2816
D_PLE = 256
EPS = 1e-6
O_XR = D_RNN
O_YR = O_XR + D_RNN
O_Q = O_YR + Q_LORA
O_KV = O_Q + KV_LORA
O_KR = O_KV + QK_ROPE
O_GA = O_KR + D_MODEL
D_IN = O_GA + D_MODEL

kernel_name = 'hybrid_rglru_mla_macaron_step'


def rmsnorm(x, g):
    xf = x.astype(jnp.float32)
    y = xf * lax.rsqrt(jnp.mean(xf * xf, axis=-1, keepdims=True) + EPS)
    return (y * g.astype(jnp.float32)).astype(x.dtype)


def swiglu(u, w_gate, w_up, w_down):
    return (jax.nn.silu(u @ w_gate) * (u @ w_up)) @ w_down


def rope(x, pos):
    half = QK_ROPE // 2
    freqs = ROPE_THETA ** (-jnp.arange(half, dtype=jnp.float32) / half)
    ang = pos.astype(jnp.float32)[:, None] * freqs[None, :]
    cos = jnp.cos(ang)[:, None, :]
    sin = jnp.sin(ang)[:, None, :]
    xf = x.astype(jnp.float32)
    x1, x2 = xf[..., :half], xf[..., half:]
    return jnp.concatenate([x1 * cos - x2 * sin, x1 * sin + x2 * cos], axis=-1).astype(x.dtype)


def causal_conv(x, buf, w, b):
    s = x.shape[1]
    xe = jnp.concatenate([buf.astype(x.dtype), x], axis=1)
    y = b + xe[:, 0:s] * w[0]
    for k in range(1, CONV_W):
        y = y + xe[:, k:k + s] * w[k]
    return y, xe[:, -(CONV_W - 1):]


def rg_lru(x, h0, w_a, b_a, w_i, b_i, lam):
    bsz, s, _ = x.shape
    xb = x.reshape(bsz, s, RNN_BLOCKS, RNN_BLOCK)
    r = jax.nn.sigmoid(jnp.einsum('bsnc,ncd->bsnd', xb, w_a) + b_a).reshape(bsz, s, D_RNN)
    gi = jax.nn.sigmoid(jnp.einsum('bsnc,ncd->bsnd', xb, w_i) + b_i).reshape(bsz, s, D_RNN)
    log_a = -LRU_C * r.astype(jnp.float32) * jax.nn.softplus(-lam.astype(jnp.float32))
    a = jnp.exp(log_a)
    mult = jnp.sqrt(-jnp.expm1(2.0 * log_a))
    bt = mult * (gi * x).astype(jnp.float32)
    bt = bt.at[:, 0].add(a[:, 0] * h0.astype(jnp.float32))

    def combine(left, right):
        a1, b1 = left
        a2, b2 = right
        return a1 * a2, a2 * b1 + b2

    _, h = lax.associative_scan(combine, (a, bt), axis=1)
    return h.astype(x.dtype), h[:, -1].astype(h0.dtype)


def mla_project(cq_in, kv_in, kr_in, pos, q_norm, w_uq, w_qr, kv_norm, w_uk):
    cq = rmsnorm(cq_in, q_norm)
    q_nope = jnp.einsum('bsr,rhd->bshd', cq, w_uq)
    q_rope = rope(jnp.einsum('bsr,rhd->bshd', cq, w_qr), pos)
    ckv = rmsnorm(kv_in, kv_norm)
    k_rope = rope(kr_in[:, :, None, :], pos)[:, :, 0]
    q_abs = jnp.einsum('bshd,rhd->bshr', q_nope, w_uk)
    return q_abs, q_rope, ckv, k_rope


def mla_scores(q_abs, q_rope, ckv, krope):
    s = jnp.einsum('bqhr,bkr->bhqk', q_abs, ckv) + jnp.einsum('bqhd,bkd->bhqk', q_rope, krope)
    return s.astype(jnp.float32) * SM_SCALE


def mla_attend_prompt(q_abs, q_rope, ckv, krope):
    bsz, s = q_abs.shape[0], q_abs.shape[1]
    nb = s // Q_BLOCK
    qa = q_abs.reshape(bsz, nb, Q_BLOCK, N_HEADS, KV_LORA).transpose(1, 0, 2, 3, 4)
    qr = q_rope.reshape(bsz, nb, Q_BLOCK, N_HEADS, QK_ROPE).transpose(1, 0, 2, 3, 4)
    kpos = jnp.arange(s)

    def block(args):
        qa_b, qr_b, start = args
        sc = mla_scores(qa_b, qr_b, ckv, krope)
        qpos = start + jnp.arange(Q_BLOCK)
        sc = jnp.where(kpos[None, :] <= qpos[:, None], sc, -jnp.inf)
        p = jax.nn.softmax(sc, axis=-1).astype(ckv.dtype)
        return jnp.einsum('bhqk,bkr->bqhr', p, ckv)

    o = lax.map(block, (qa, qr, jnp.arange(nb) * Q_BLOCK))
    return o.transpose(1, 0, 2, 3, 4).reshape(bsz, s, N_HEADS, KV_LORA)


def mla_attend_sample(q_abs, q_rope, ckv_new, kr_new, ckv_pool, kr_pool, page_table):
    bd, q = q_abs.shape[0], q_abs.shape[1]
    ckv_past = ckv_pool[page_table].reshape(bd, -1, KV_LORA).astype(ckv_new.dtype)
    kr_past = kr_pool[page_table].reshape(bd, -1, QK_ROPE).astype(kr_new.dtype)
    s_past = mla_scores(q_abs, q_rope, ckv_past, kr_past)
    s_new = mla_scores(q_abs, q_rope, ckv_new, kr_new)
    s_new = jnp.where(jnp.tril(jnp.ones((q, q), dtype=bool)), s_new, -jnp.inf)
    n_past = s_past.shape[-1]
    p = jax.nn.softmax(jnp.concatenate([s_past, s_new], axis=-1), axis=-1).astype(ckv_new.dtype)
    return (jnp.einsum('bhqk,bkr->bqhr', p[..., :n_past], ckv_past)
            + jnp.einsum('bhqk,bkr->bqhr', p[..., n_past:], ckv_new))


def decoder_layer(x, p, pos, h0, conv_buf, attend, lw):
    u = rmsnorm(x, lw['ffn1_pre'])
    x = x + 0.5 * rmsnorm(swiglu(u, lw['ffn1_w_gate'], lw['ffn1_w_up'], lw['ffn1_w_down']), lw['ffn1_post'])
    u = rmsnorm(x, lw['mix_pre'])
    z = u @ lw['w_in']
    xr, yr, cq_in, kv_in, kr_in = z[..., :O_XR], z[..., O_XR:O_YR], z[..., O_YR:O_Q], z[..., O_Q:O_KV], z[..., O_KV:O_KR]
    g_a, g_b = z[..., O_KR:O_GA], z[..., O_GA:D_IN]
    xc, conv_new = causal_conv(xr, conv_buf, lw['conv_w'], lw['conv_b'])
    hseq, h_last = rg_lru(xc, h0, lw['lru_w_a'], lw['lru_b_a'], lw['lru_w_i'], lw['lru_b_i'], lw['lru_lambda'])
    y_a = (hseq * jax.nn.gelu(yr)) @ lw['w_branch_rnn']
    q_abs, q_rope, ckv, krope = mla_project(cq_in, kv_in, kr_in, pos, lw['q_norm'], lw['w_uq'], lw['w_qr'], lw['kv_norm'], lw['w_uk'])
    o_lat = attend(q_abs, q_rope, ckv, krope)
    o = jnp.einsum('bshr,rhv->bshv', o_lat, lw['w_uv'])
    y_b = o.reshape(o.shape[0], o.shape[1], N_HEADS * V_HEAD) @ lw['w_branch_attn']
    m = jax.nn.sigmoid(g_a) * y_a + jax.nn.sigmoid(g_b) * y_b
    x = x + rmsnorm(m @ lw['w_out'], lw['mix_post'])
    u = rmsnorm(x, lw['ffn2_pre'])
    x = x + 0.5 * rmsnorm(swiglu(u, lw['ffn2_w_gate'], lw['ffn2_w_up'], lw['ffn2_w_down']), lw['ffn2_post'])
    e = jax.nn.sigmoid(x @ lw['ple_gate']) * (p @ lw['ple_proj'])
    x = x + rmsnorm(e, lw['ple_post'])
    return x, (ckv, krope, h_last, conv_new)


def setup_inputs(seed: int = 0) -> dict:
    key = jax.random.key(seed)
    ks = list(jax.random.split(key, 64))
    f32 = jnp.float32

    def nrm(shape, scale):
        return jax.random.normal(ks.pop(), shape, f32) * scale

    def gain(n):
        return 1.0 + nrm((DEPTH, n), 0.05)

    n_pages = PAST_LEN // PAGE_SIZE
    n_used = DEC_BATCH * n_pages
    n_pool = (n_used * 5) // 4
    page_table = jax.random.permutation(ks.pop(), n_pool)[:n_used].reshape(DEC_BATCH, n_pages).astype(jnp.int32)
    a0 = jax.random.uniform(ks.pop(), (DEPTH, D_RNN), f32, 0.9, 0.999)
    lru_lambda = jnp.log(a0) - jnp.log1p(-a0)
    return {
        'x_prompt': nrm((BATCH, SEQ, D_MODEL), 1.0),
        'x_sample': nrm((DEC_BATCH, DEC_SEQ, D_MODEL), 1.0),
        'p_prompt': nrm((DEPTH, BATCH, SEQ, D_PLE), 1.0),
        'p_sample': nrm((DEPTH, DEC_BATCH, DEC_SEQ, D_PLE), 1.0),
        'cache_ckv': nrm((DEPTH, n_pool, PAGE_SIZE, KV_LORA), 1.0),
        'cache_krope': nrm((DEPTH, n_pool, PAGE_SIZE, QK_ROPE), 1.0),
        'state_h': nrm((DEPTH, DEC_BATCH, D_RNN), 0.5),
        'state_conv': nrm((DEPTH, DEC_BATCH, CONV_W - 1, D_RNN), 1.0),
        'page_table': page_table,
        'ffn1_pre': gain(D_MODEL),
        'ffn1_w_gate': nrm((DEPTH, D_MODEL, D_FF), D_MODEL ** -0.5),
        'ffn1_w_up': nrm((DEPTH, D_MODEL, D_FF), D_MODEL ** -0.5),
        'ffn1_w_down': nrm((DEPTH, D_FF, D_MODEL), D_FF ** -0.5),
        'ffn1_post': gain(D_MODEL),
        'mix_pre': gain(D_MODEL),
        'w_in': nrm((DEPTH, D_MODEL, D_IN), D_MODEL ** -0.5),
        'conv_w': nrm((DEPTH, CONV_W, D_RNN), CONV_W ** -0.5),
        'conv_b': nrm((DEPTH, D_RNN), 0.02),
        'lru_w_a': nrm((DEPTH, RNN_BLOCKS, RNN_BLOCK, RNN_BLOCK), RNN_BLOCK ** -0.5),
        'lru_b_a': nrm((DEPTH, RNN_BLOCKS, RNN_BLOCK), 0.02),
        'lru_w_i': nrm((DEPTH, RNN_BLOCKS, RNN_BLOCK, RNN_BLOCK), RNN_BLOCK ** -0.5),
        'lru_b_i': nrm((DEPTH, RNN_BLOCKS, RNN_BLOCK), 0.02),
        'lru_lambda': lru_lambda,
        'w_branch_rnn': nrm((DEPTH, D_RNN, D_MODEL), D_RNN ** -0.5),
        'q_norm': gain(Q_LORA),
        'w_uq': nrm((DEPTH, Q_LORA, N_HEADS, QK_NOPE), Q_LORA ** -0.5),
        'w_qr': nrm((DEPTH, Q_LORA, N_HEADS, QK_ROPE), Q_LORA ** -0.5),
        'kv_norm': gain(KV_LORA),
        'w_uk': nrm((DEPTH, KV_LORA, N_HEADS, QK_NOPE), KV_LORA ** -0.5),
        'w_uv': nrm((DEPTH, KV_LORA, N_HEADS, V_HEAD), KV_LORA ** -0.5),
        'w_branch_attn': nrm((DEPTH, N_HEADS * V_HEAD, D_MODEL), (N_HEADS * V_HEAD) ** -0.5),
        'w_out': nrm((DEPTH, D_MODEL, D_MODEL), D_MODEL ** -0.5),
        'mix_post': gain(D_MODEL),
        'ffn2_pre': gain(D_MODEL),
        'ffn2_w_gate': nrm((DEPTH, D_MODEL, D_FF), D_MODEL ** -0.5),
        'ffn2_w_up': nrm((DEPTH, D_MODEL, D_FF), D_MODEL ** -0.5),
        'ffn2_w_down': nrm((DEPTH, D_FF, D_MODEL), D_FF ** -0.5),
        'ffn2_post': gain(D_MODEL),
        'ple_gate': nrm((DEPTH, D_MODEL, D_MODEL), D_MODEL ** -0.5),
        'ple_proj': nrm((DEPTH, D_PLE, D_MODEL), D_PLE ** -0.5),
        'ple_post': gain(D_MODEL),
    }


def reference(x_prompt, x_sample, p_prompt, p_sample, cache_ckv, cache_krope, state_h, state_conv, page_table,
              ffn1_pre, ffn1_w_gate, ffn1_w_up, ffn1_w_down, ffn1_post,
              mix_pre, w_in, conv_w, conv_b, lru_w_a, lru_b_a, lru_w_i, lru_b_i, lru_lambda, w_branch_rnn,
              q_norm, w_uq, w_qr, kv_norm, w_uk, w_uv, w_branch_attn, w_out, mix_post,
              ffn2_pre, ffn2_w_gate, ffn2_w_up, ffn2_w_down, ffn2_post,
              ple_gate, ple_proj, ple_post):
    bsz = x_prompt.shape[0]
    pos_prompt = jnp.arange(x_prompt.shape[1], dtype=jnp.int32)
    past_len = page_table.shape[1] * PAGE_SIZE
    pos_sample = past_len + jnp.arange(x_sample.shape[1], dtype=jnp.int32)
    h0_prompt = jnp.zeros((bsz, D_RNN), state_h.dtype)
    conv0_prompt = jnp.zeros((bsz, CONV_W - 1, D_RNN), x_prompt.dtype)
    hp, hs = x_prompt, x_sample
    st_p_all, st_s_all = [], []
    for i in range(DEPTH):
        lw = dict(
            ffn1_pre=ffn1_pre[i], ffn1_w_gate=ffn1_w_gate[i], ffn1_w_up=ffn1_w_up[i], ffn1_w_down=ffn1_w_down[i], ffn1_post=ffn1_post[i],
            mix_pre=mix_pre[i], w_in=w_in[i], conv_w=conv_w[i], conv_b=conv_b[i],
            lru_w_a=lru_w_a[i], lru_b_a=lru_b_a[i], lru_w_i=lru_w_i[i], lru_b_i=lru_b_i[i], lru_lambda=lru_lambda[i],
            w_branch_rnn=w_branch_rnn[i], q_norm=q_norm[i], w_uq=w_uq[i], w_qr=w_qr[i], kv_norm=kv_norm[i],
            w_uk=w_uk[i], w_uv=w_uv[i], w_branch_attn=w_branch_attn[i], w_out=w_out[i], mix_post=mix_post[i],
            ffn2_pre=ffn2_pre[i], ffn2_w_gate=ffn2_w_gate[i], ffn2_w_up=ffn2_w_up[i], ffn2_w_down=ffn2_w_down[i], ffn2_post=ffn2_post[i],
            ple_gate=ple_gate[i], ple_proj=ple_proj[i], ple_post=ple_post[i])
        hp, st_p = decoder_layer(hp, p_prompt[i], pos_prompt, h0_prompt, conv0_prompt, mla_attend_prompt, lw)
        attend_s = functools.partial(mla_attend_sample, ckv_pool=cache_ckv[i], kr_pool=cache_krope[i], page_table=page_table)
        hs, st_s = decoder_layer(hs, p_sample[i], pos_sample, state_h[i], state_conv[i], attend_s, lw)
        st_p_all.append(st_p)
        st_s_all.append(st_s)
    new_ckv_prompt = jnp.stack([s[0] for s in st_p_all])
    new_krope_prompt = jnp.stack([s[1] for s in st_p_all])
    new_h_prompt = jnp.stack([s[2] for s in st_p_all])
    new_conv_prompt = jnp.stack([s[3] for s in st_p_all])
    new_ckv_sample = jnp.stack([s[0] for s in st_s_all])
    new_krope_sample = jnp.stack([s[1] for s in st_s_all])
    new_h_sample = jnp.stack([s[2] for s in st_s_all])
    new_conv_sample = jnp.stack([s[3] for s in st_s_all])
    return (hp, hs, new_ckv_prompt, new_krope_prompt, new_h_prompt, new_conv_prompt,
            new_ckv_sample, new_krope_sample, new_h_sample, new_conv_sample)
```

```cpp
#include <hip/hip_runtime.h>
#include <cstdio>
#include <cstdint>

#define GAS __attribute__((address_space(1)))
#define LAS __attribute__((address_space(3)))
typedef unsigned short bf16;
typedef short bf16x8 __attribute__((ext_vector_type(8)));
typedef short s16x4 __attribute__((ext_vector_type(4)));
typedef float f32x2 __attribute__((ext_vector_type(2)));
typedef float f32x4 __attribute__((ext_vector_type(4)));
typedef float f32x16 __attribute__((ext_vector_type(16)));
typedef unsigned u32x2 __attribute__((ext_vector_type(2)));
typedef unsigned u32x4 __attribute__((ext_vector_type(4)));
typedef __bf16 bf16x2_t __attribute__((ext_vector_type(2)));

constexpr int DM = 1024, SEQ = 8192, NBATCH = 2, MP = NBATCH * SEQ, NS = 128, MT = 16640, NMT = MT / 256;
constexpr int DFF = 2816, DRNN = 1280, NBLK = 16, BLK = 80, QL = 384, KVL = 256, ROPE = 32, NH = 16;
constexpr int DPLE = 256, DIN = 5280, ZW = 5376;
constexpr int Z_XR = 0, Z_YR = 1280, Z_CQ = 2560, Z_KV = 2944, Z_KR = 3200, Z_GA = 3328, Z_GB = 4352;
constexpr int QW = 1536, KVW = 2048;
constexpr int PAGE = 128, NPAGES = 64;
constexpr float EPS = 1e-6f;
constexpr float C2 = 0.10206207261596577f * 1.4426950408889634f;
constexpr size_t O_Y = 0, O_CKV_P = 16908288, O_KR_P = 21102592, O_H_P = 21626880, O_CONV_P = 21629440, O_CKV_S = 21637120, O_KR_S = 21669888, O_H_S = 21673984, O_CONV_S = 21837824, O_END = 22329344;
enum { I_XP = 0, I_XS, I_PP, I_PS, I_CCKV, I_CKR, I_SH, I_SCONV, I_PT, I_F1PRE, I_F1G, I_F1U, I_F1D, I_F1POST, I_MIXPRE, I_WIN, I_CONVW, I_CONVB, I_LWA, I_LBA, I_LWI, I_LBI, I_LAM,
       I_WRNN, I_QNORM, I_WUQ, I_WQR, I_KVNORM, I_WUK, I_WUV, I_WATT, I_WOUT, I_MIXPOST, I_F2PRE, I_F2G, I_F2U, I_F2D, I_F2POST, I_PG, I_PPJ, I_PPOST, N_IN, I_OUT = N_IN, I_WS, N_PTR };

constexpr size_t MiB = 1u << 20;
constexpr size_t WS_CTL = 0, CTL_ZERO_BYTES = 256 * 1024;
constexpr size_t WS_BUP1 = 2 * MiB, WS_BDN1 = 13 * MiB, WS_BIN = 19 * MiB, WS_BRNN = 30 * MiB, WS_BQ = 33 * MiB, WS_BKV = 35 * MiB, WS_BATT = 36 * MiB, WS_BOUT = 38 * MiB,
                 WS_BUP2 = 40 * MiB, WS_BDN2 = 51 * MiB, WS_BPG = 57 * MiB, WS_BPP = 59 * MiB, WS_LW = 60 * MiB, WS_ROPE = 61 * MiB, WS_SUM = 63 * MiB;
constexpr size_t WS_XN = 64 * MiB, WS_F = 97 * MiB, WS_H = 130 * MiB, WS_XR = 220 * MiB, WS_Z = 285 * MiB, WS_CQ = 456 * MiB, WS_CKV = 469 * MiB, WS_KR = 478 * MiB, WS_Q = 480 * MiB,
                 WS_KVB = 529 * MiB, WS_PB = 593 * MiB, WS_PPB = 602 * MiB, WS_HG = 635 * MiB, WS_YAG = 676 * MiB, WS_OB = 709 * MiB, WS_MX = 742 * MiB, WS_PART = 775 * MiB, WS_NSLOT = 808 * MiB, WS_END = 810 * MiB;
constexpr int ROPE_TAB = 8193 * 16;
constexpr int PART_STRIDE = 16 * 256 + 32;
constexpr int CW_BAR = 4096;
constexpr int CW_PN = 8192;
constexpr int CW_SN = 49152;
constexpr int CW_QUE = 2048;
#ifndef EARLY_DEC
#define EARLY_DEC 0
#endif
#ifndef NDEC
#define NDEC 64
#endif

__device__ __forceinline__ float bflo(unsigned w) { return __uint_as_float(w << 16); }
__device__ __forceinline__ float bfhi(unsigned w) { return __uint_as_float(w & 0xffff0000u); }
__device__ __forceinline__ float bf2f(bf16 v) { return __uint_as_float((unsigned)v << 16); }
__device__ __forceinline__ unsigned pk2(float lo, float hi) { f32x2 v = {lo, hi}; bf16x2_t b = __builtin_convertvector(v, bf16x2_t); return __builtin_bit_cast(unsigned, b); }
__device__ __forceinline__ bf16 f2bf(float f) { return (bf16)(pk2(f, 0.f) & 0xffffu); }
__device__ __forceinline__ float sigmoid_f(float x) { return __builtin_amdgcn_rcpf(1.f + __builtin_amdgcn_exp2f(-1.4426950408889634f * x)); }
__device__ __forceinline__ float silu_f(float x) { return x * sigmoid_f(x); }
__device__ __forceinline__ float gelu_tanh_f(float x) { const float u = 0.7978845608028654f * (x + 0.044715f * x * x * x); return x * sigmoid_f(2.f * u); }
__device__ __forceinline__ float wave_sum(float v) {
#define WS_DPP(ctrl) v += __uint_as_float((unsigned)__builtin_amdgcn_update_dpp(0, (int)__float_as_uint(v), ctrl, 0xf, 0xf, false))
    WS_DPP(0xB1); WS_DPP(0x4E); WS_DPP(0x141); WS_DPP(0x140);
#undef WS_DPP
    { const unsigned u = __float_as_uint(v); const auto r = __builtin_amdgcn_permlane16_swap(u, u, false, false); v = __uint_as_float(r[0]) + __uint_as_float(r[1]); }
    { const unsigned u = __float_as_uint(v); const auto r = __builtin_amdgcn_permlane32_swap(u, u, false, false); v = __uint_as_float(r[0]) + __uint_as_float(r[1]); }
    return v;
}
__device__ __forceinline__ int lane_id() { return (int)__builtin_amdgcn_mbcnt_hi(~0u, __builtin_amdgcn_mbcnt_lo(~0u, 0u)); }
#define TIDW(wv) ((wv) * 64 + lane_id())
#define LDS_WAIT() asm volatile("s_waitcnt lgkmcnt(0)" ::: "memory")
#define VM_WAIT() asm volatile("s_waitcnt vmcnt(0)" ::: "memory")

namespace pg8 {
typedef unsigned short bf16_t;
constexpr int BM = 256, BK = 64, HALF = 128, HTB = HALF * BK * 2, STAGE_BYTES = 8 * HTB, NXCD = 8, WGM = 8;
__host__ __device__ __forceinline__ int lds_byte(int r, int c) { const int st = (r >> 4) * 2 + (c >> 5), rr = r & 15, cc = c & 31, ob = rr * 64 + cc * 2; return st * 1024 + (ob ^ (((ob >> 9) & 1) << 5)); }
__host__ __device__ __forceinline__ void stage_rc(int b, int& R, int& C) { const int st = b / 1024, sb = b % 1024, swz = sb ^ (((sb >> 9) & 1) << 5); R = (st >> 1) * 16 + swz / 64; C = (st & 1) * 32 + (swz % 64) / 2; }
__host__ __device__ __forceinline__ int perm32(int rho) { const int n = rho >> 4, i = rho & 15; return 8 * (i >> 2) + 4 * n + (i & 3); }
struct Unit { int pm, pn; };
struct Gemm { const bf16_t* A; const bf16_t* Bt; int M, N, K; };
struct StaticOrder {
    int nM, nN, nwg, G, c;
    __host__ __device__ void init(int M, int N, int G_, int c_) { nM = M / BM; nN = N / BM; nwg = nM * nN; G = G_; c = c_; }
    __host__ __device__ bool next(int i, Unit& u) const {
        const long L = (long)i * G + c; if (L >= nwg) return false;
        int wgid = (int)L; { const int q = nwg / NXCD, r = nwg % NXCD, xcd = wgid % NXCD, off = wgid / NXCD; wgid = (xcd < r ? xcd * (q + 1) : r * (q + 1) + (xcd - r) * q) + off; }
        const int nig = WGM * nN, gid = wgid / nig, fm = gid * WGM, gsz = (nM - fm) < WGM ? (nM - fm) : WGM;
        u.pm = fm + ((wgid % nig) % gsz); u.pn = (wgid % nig) / gsz; return true;
    }
    __device__ __forceinline__ void a_ready(const Unit&) const {}
    __device__ __forceinline__ void done(const Unit&) const {}
};
enum { EM_PLAIN = 0, EM_SWIGLU, EM_WIN, EM_SCALE, EM_MULZ, EM_FMAZ, EM_SIGMUL };
template <int MODE> struct Epi {
    static constexpr bool PERM = true, AFTER_DRAIN = false;
    bf16_t* O; int ldc;
    const bf16_t* aux; int ldaux;
    const bf16_t* add; int ldadd;
    float scale;
    __device__ __forceinline__ void operator()(const f32x4 (&acc)[2][2][4][2], const Unit& u, int wr, int wc, int fr, int fq) const {
        const int row0 = u.pm * BM + wr * 64 + fr;
        if constexpr (MODE == EM_SWIGLU) {
            const int col = u.pn * HALF + wc * 32 + 8 * fq;
#pragma unroll
            for (int ai = 0; ai < 2; ++ai)
#pragma unroll
                for (int m = 0; m < 4; ++m) {
                    const f32x4 g0 = acc[ai][0][m][0], g1 = acc[ai][0][m][1], u0 = acc[ai][1][m][0], u1 = acc[ai][1][m][1];
                    u32x4 w; w.x = pk2(silu_f(g0[0]) * u0[0], silu_f(g0[1]) * u0[1]); w.y = pk2(silu_f(g0[2]) * u0[2], silu_f(g0[3]) * u0[3]);
                    w.z = pk2(silu_f(g1[0]) * u1[0], silu_f(g1[1]) * u1[1]); w.w = pk2(silu_f(g1[2]) * u1[2], silu_f(g1[3]) * u1[3]);
                    *(u32x4*)(O + (size_t)(row0 + ai * HALF + m * 16) * ldc + col) = w;
                }
        } else {
            int act = 0;
            if constexpr (MODE == EM_WIN) act = (u.pn >= 5 && u.pn < 10) ? 1 : (u.pn >= 13 ? 2 : 0);
#pragma unroll
            for (int ai = 0; ai < 2; ++ai)
#pragma unroll
                for (int m = 0; m < 4; ++m) {
                    const int row = row0 + ai * HALF + m * 16;
#pragma unroll
                    for (int bj = 0; bj < 2; ++bj) {
                        const int col = u.pn * BM + bj * HALF + wc * 32 + 8 * fq;
                        f32x4 v0 = acc[ai][bj][m][0], v1 = acc[ai][bj][m][1];
                        if constexpr (MODE == EM_WIN) {
                            if (act == 1) { for (int j = 0; j < 4; ++j) { v0[j] = gelu_tanh_f(v0[j]); v1[j] = gelu_tanh_f(v1[j]); } }
                            else if (act == 2) { for (int j = 0; j < 4; ++j) { v0[j] = sigmoid_f(v0[j]); v1[j] = sigmoid_f(v1[j]); } }
                        }
                        if constexpr (MODE == EM_SCALE) { v0 = v0 * scale; v1 = v1 * scale; }
                        if constexpr (MODE == EM_MULZ || MODE == EM_FMAZ || MODE == EM_SIGMUL) {
                            const u32x4 z = *(const u32x4*)(aux + (size_t)row * ldaux + col);
                            f32x4 z0 = {bflo(z.x), bfhi(z.x), bflo(z.y), bfhi(z.y)}, z1 = {bflo(z.z), bfhi(z.z), bflo(z.w), bfhi(z.w)};
                            if constexpr (MODE == EM_SIGMUL) { for (int j = 0; j < 4; ++j) { v0[j] = sigmoid_f(v0[j]); v1[j] = sigmoid_f(v1[j]); } }
                            v0 = v0 * z0; v1 = v1 * z1;
                            if constexpr (MODE == EM_FMAZ) {
                                const u32x4 y = *(const u32x4*)(add + (size_t)row * ldadd + col);
                                v0 += (f32x4){bflo(y.x), bfhi(y.x), bflo(y.y), bfhi(y.y)}; v1 += (f32x4){bflo(y.z), bfhi(y.z), bflo(y.w), bfhi(y.w)};
                            }
                        }
                        u32x4 w; w.x = pk2(v0[0], v0[1]); w.y = pk2(v0[2], v0[3]); w.z = pk2(v1[0], v1[1]); w.w = pk2(v1[2], v1[3]);
                        *(u32x4*)(O + (size_t)row * ldc + col) = w;
                    }
                }
        }
    }
};

struct OneUnit { Unit u; __device__ __forceinline__ bool next(int i, Unit& o) const { if (i != 0) return false; o = u; return true; }
    __device__ __forceinline__ void a_ready(const Unit&) const {} __device__ __forceinline__ void done(const Unit&) const {} };
template <int NEXT, int SRC, int PRE = 0> struct EpiNorm {
    static constexpr bool PERM = true, AFTER_DRAIN = true;
    const float* xin; bf16_t* XR; bf16_t* XN; float* Y; const float* gpost; const float* gpre; float coef; float* slots; unsigned* cnt; const bf16_t* aux;
    __device__ __forceinline__ void operator()(const f32x4 (&)[2][2][4][2], const Unit&, int, int, int, int) const {}
    __device__ __forceinline__ void stats(const f32x4 (&v)[2][2][4][2], const Unit& u, int wr, int wc, int fr, int fq, LAS unsigned char* lds, int wid, int lane, int which, float c) const {
        LAS float* P = (LAS float*)lds; LAS float* S = (LAS float*)(lds + 4096);
#pragma unroll
        for (int ai = 0; ai < 2; ++ai)
#pragma unroll
            for (int m = 0; m < 4; ++m) { float q = 0.f;
#pragma unroll
                for (int bj = 0; bj < 2; ++bj)
#pragma unroll
                    for (int n = 0; n < 2; ++n) { const f32x4 x = v[ai][bj][m][n]; q += (x[0] * x[0] + x[1] * x[1]) + (x[2] * x[2] + x[3] * x[3]); }
                { const unsigned uq = __float_as_uint(q); const auto r_ = __builtin_amdgcn_permlane16_swap(uq, uq, false, false); q = __uint_as_float(r_[0]) + __uint_as_float(r_[1]); }
                { const unsigned uq = __float_as_uint(q); const auto r_ = __builtin_amdgcn_permlane32_swap(uq, uq, false, false); q = __uint_as_float(r_[0]) + __uint_as_float(r_[1]); }
                if (fq == 0) P[(ai * HALF + wr * 64 + m * 16 + fr) * 4 + wc] = q; }
        asm volatile("s_waitcnt lgkmcnt(0)" ::: "memory"); __builtin_amdgcn_s_barrier(); asm volatile("" ::: "memory");
        const int row = wid * 32 + (lane & 31);
        float* slot = slots + ((size_t)(which * 64 + u.pm) * BM + row) * 4;
        unsigned* c0 = cnt + (size_t)(which * 64 + u.pm) * 64;
        if (lane < 32) { const f32x4 p4 = *(const LAS f32x4*)(P + row * 4); __hip_atomic_store(slot + u.pn, (p4[0] + p4[1]) + (p4[2] + p4[3]), __ATOMIC_RELAXED, __HIP_MEMORY_SCOPE_AGENT); }
        asm volatile("s_waitcnt vmcnt(0)" ::: "memory");
        if (lane == 0) (void)__hip_atomic_fetch_add(c0, 1u, __ATOMIC_RELAXED, __HIP_MEMORY_SCOPE_AGENT);
        if (wid == 0) { unsigned sp = 0u;
            while ((unsigned)__builtin_amdgcn_readfirstlane(__hip_atomic_load(c0, __ATOMIC_RELAXED, __HIP_MEMORY_SCOPE_AGENT)) < 32u) { __builtin_amdgcn_s_sleep(1); if (++sp > (1u << 20)) break; }
            __builtin_amdgcn_fence(__ATOMIC_ACQUIRE, "agent"); }
        asm volatile("s_waitcnt vmcnt(0) lgkmcnt(0)" ::: "memory"); __builtin_amdgcn_s_barrier(); asm volatile("" ::: "memory");
        if (lane < 32) { float t = 0.f;
#pragma unroll
            for (int k = 0; k < 4; ++k) t += __hip_atomic_load(slot + k, __ATOMIC_RELAXED, __HIP_MEMORY_SCOPE_AGENT);
            S[row] = c / sqrtf(t * (1.f / 1024.f) + 1e-6f); }
        asm volatile("s_waitcnt vmcnt(0) lgkmcnt(0)" ::: "memory"); __builtin_amdgcn_s_barrier(); asm volatile("" ::: "memory");
    }
    __device__ __forceinline__ void fused(f32x4 (&acc)[2][2][4][2], const Unit& u, int wr, int wc, int fr, int fq, LAS unsigned char* lds, int wid, int lane) const {
        const LAS float* S = (const LAS float*)(lds + 4096);
        if constexpr (PRE == 1) {
#pragma unroll
            for (int bj = 0; bj < 2; ++bj)
#pragma unroll
                for (int ai = 0; ai < 2; ++ai)
#pragma unroll
                    for (int m = 0; m < 4; ++m) { const size_t off = (size_t)(u.pm * BM + ai * HALF + wr * 64 + m * 16 + fr) * 1024 + u.pn * BM + bj * HALF + wc * 32 + 8 * fq;
                        const u32x4 zq = *(const u32x4*)(aux + off); f32x4 v0 = acc[ai][bj][m][0], v1 = acc[ai][bj][m][1];
#pragma unroll
                        for (int j = 0; j < 4; ++j) { v0[j] = sigmoid_f(v0[j]); v1[j] = sigmoid_f(v1[j]); }
                        acc[ai][bj][m][0] = v0 * (f32x4){bflo(zq.x), bfhi(zq.x), bflo(zq.y), bfhi(zq.y)}; acc[ai][bj][m][1] = v1 * (f32x4){bflo(zq.z), bfhi(zq.z), bflo(zq.w), bfhi(zq.w)}; }
        }
        stats(acc, u, wr, wc, fr, fq, lds, wid, lane, 0, coef);
#pragma unroll
        for (int bj = 0; bj < 2; ++bj) {
            const int col = u.pn * BM + bj * HALF + wc * 32 + 8 * fq;
            const f32x4 g0 = *(const f32x4*)(gpost + col), g1 = *(const f32x4*)(gpost + col + 4);
#pragma unroll
            for (int ai = 0; ai < 2; ++ai)
#pragma unroll
                for (int m = 0; m < 4; ++m) {
                    const int rl = ai * HALF + wr * 64 + m * 16 + fr; const size_t off = (size_t)(u.pm * BM + rl) * 1024 + col; const float r = S[rl];
                    f32x4 x0, x1;
                    if constexpr (SRC == 0) { x0 = *(const f32x4*)(xin + off); x1 = *(const f32x4*)(xin + off + 4); }
                    else { const u32x4 w = *(const u32x4*)((SRC == 1 ? XR : XN) + off); x0 = (f32x4){bflo(w.x), bfhi(w.x), bflo(w.y), bfhi(w.y)}; x1 = (f32x4){bflo(w.z), bfhi(w.z), bflo(w.w), bfhi(w.w)}; }
                    x0 = x0 + acc[ai][bj][m][0] * g0 * r; x1 = x1 + acc[ai][bj][m][1] * g1 * r;
                    acc[ai][bj][m][0] = x0; acc[ai][bj][m][1] = x1;
                    if constexpr (NEXT == 0) { *(f32x4*)(Y + off) = x0; *(f32x4*)(Y + off + 4) = x1; }
                    else { u32x4 w; w.x = pk2(x0[0], x0[1]); w.y = pk2(x0[2], x0[3]); w.z = pk2(x1[0], x1[1]); w.w = pk2(x1[2], x1[3]); *(u32x4*)((NEXT == 1 ? XR : XN) + off) = w; }
                }
        }
        if constexpr (NEXT == 1) {
            stats(acc, u, wr, wc, fr, fq, lds, wid, lane, 1, 1.f);
#pragma unroll
            for (int bj = 0; bj < 2; ++bj) {
                const int col = u.pn * BM + bj * HALF + wc * 32 + 8 * fq;
                const f32x4 g0 = *(const f32x4*)(gpre + col), g1 = *(const f32x4*)(gpre + col + 4);
#pragma unroll
                for (int ai = 0; ai < 2; ++ai)
#pragma unroll
                    for (int m = 0; m < 4; ++m) {
                        const int rl = ai * HALF + wr * 64 + m * 16 + fr; const size_t off = (size_t)(u.pm * BM + rl) * 1024 + col; const float r = S[rl];
                        const f32x4 x0 = acc[ai][bj][m][0] * g0 * r, x1 = acc[ai][bj][m][1] * g1 * r;
                        u32x4 w; w.x = pk2(x0[0], x0[1]); w.y = pk2(x0[2], x0[3]); w.z = pk2(x1[0], x1[1]); w.w = pk2(x1[2], x1[3]); *(u32x4*)(XN + off) = w;
                    }
            }
        }
    }
};
template <class EpiT, class Sched, bool ALIGN_EPI = false, bool SP2 = false>
__device__ __forceinline__ void gemm_phase(LAS unsigned char* lds, const Gemm g, const Sched& S, const EpiT& E, int wv) {
    int tid_ = TIDW(wv); asm volatile("" : "+v"(tid_));
    const int tid = tid_, wid = __builtin_amdgcn_readfirstlane(tid >> 6), lane = tid & 63, wr = wid >> 2, wc = wid & 3, fr = lane & 15, fq = lane >> 4;
    const int K = g.K, nt = K / BK;
    unsigned voffA[2], voffB[2];
#pragma unroll
    for (int i = 0; i < 2; ++i) { int R, C; stage_rc(tid * 16 + i * 8192, R, C); const int Rb = EpiT::PERM ? ((R & ~31) + perm32(R & 31)) : R;
        voffA[i] = (unsigned)(R * K + C) * 2u; voffB[i] = (unsigned)(Rb * K + C) * 2u; }
    const size_t kstep = (size_t)(BK * 2);
    const size_t hstep = (size_t)HALF * K * 2;
    const size_t tstep = 2 * hstep;
    const unsigned ldsw = (unsigned)wid * 1024u;
    const int aoff = lds_byte(wr * 64 + fr, fq * 8), boff = lds_byte(wc * 32 + fr, fq * 8);
#define PG8_SA(b, h) (((b) * 2 + (h)) * HTB)
#define PG8_SB(b, h) ((4 + (b) * 2 + (h)) * HTB)
#define PG8_STAGE(bufoff, gbase, voff) do { _Pragma("unroll") for (int _i = 0; _i < 2; ++_i) \
        __builtin_amdgcn_global_load_lds((const unsigned*)((const char*)(gbase) + (voff)[_i]), (LAS unsigned*)(lds + (bufoff) + ldsw + _i * 8192), 16, 0, 0); } while (0)
#define PG8_LDA(dst, b, h) do { _Pragma("unroll") for (int m = 0; m < 4; ++m) _Pragma("unroll") for (int k = 0; k < 2; ++k) dst[m][k] = *(const LAS bf16x8*)(lds + PG8_SA(b, h) + aoff + m * 2048 + k * 1024); } while (0)
#define PG8_LDB(dst, b, h) do { _Pragma("unroll") for (int n = 0; n < 2; ++n) _Pragma("unroll") for (int k = 0; k < 2; ++k) dst[n][k] = *(const LAS bf16x8*)(lds + PG8_SB(b, h) + boff + n * 2048 + k * 1024); } while (0)
#define PG8_MMA(ai, bj, At, Bt) do { __builtin_amdgcn_s_setprio(1); _Pragma("unroll") for (int m = 0; m < 4; ++m) _Pragma("unroll") for (int n = 0; n < 2; ++n) _Pragma("unroll") for (int k = 0; k < 2; ++k) \
        acc[ai][bj][m][n] = __builtin_amdgcn_mfma_f32_16x16x32_bf16(Bt[n][k], At[m][k], acc[ai][bj][m][n], 0, 0, 0); __builtin_amdgcn_s_setprio(0); } while (0)
#define PG8_WAIT_V(n) asm volatile("s_waitcnt vmcnt(" #n ")" ::: "memory")
#define PG8_WAIT_L(n) asm volatile("s_waitcnt lgkmcnt(" #n ")" ::: "memory")
#define PG8_BAR __builtin_amdgcn_s_barrier()
#define PG8_SCHED __builtin_amdgcn_sched_barrier(0)
    Unit cur, nxt; int ui = 0;
    if (!S.next(0, cur)) return;
    f32x4 acc[2][2][4][2];
#pragma unroll
    for (int a = 0; a < 2; ++a)
#pragma unroll
        for (int b = 0; b < 2; ++b)
#pragma unroll
            for (int m = 0; m < 4; ++m)
#pragma unroll
                for (int n = 0; n < 2; ++n) acc[a][b][m][n] = (f32x4){0.f, 0.f, 0.f, 0.f};
    bf16x8 At[4][2], B0[2][2], B1[2][2];
    const char* cA = (const char*)g.A + (size_t)cur.pm * tstep; const char* cB = (const char*)g.Bt + (size_t)cur.pn * tstep;
    S.a_ready(cur);
    if constexpr (SP2) {
        PG8_STAGE(PG8_SB(0, 0), cB, voffB); PG8_STAGE(PG8_SB(0, 1), cB + hstep, voffB); PG8_STAGE(PG8_SA(0, 0), cA, voffA); PG8_STAGE(PG8_SA(0, 1), cA + hstep, voffA);
        if (wr == 1) PG8_BAR;
        PG8_WAIT_V(2); PG8_BAR;
        PG8_STAGE(PG8_SB(1, 0), cB + kstep, voffB); PG8_STAGE(PG8_SA(1, 0), cA + kstep, voffA); PG8_STAGE(PG8_SB(1, 1), cB + hstep + kstep, voffB);
        PG8_WAIT_V(6); PG8_BAR;
    } else {
        PG8_STAGE(PG8_SB(0, 0), cB, voffB); PG8_STAGE(PG8_SA(0, 0), cA, voffA); PG8_STAGE(PG8_SB(0, 1), cB + hstep, voffB); PG8_STAGE(PG8_SA(0, 1), cA + hstep, voffA);
        if (wr == 1) PG8_BAR;
        PG8_WAIT_V(4); PG8_BAR;
        PG8_STAGE(PG8_SB(1, 0), cB + kstep, voffB); PG8_STAGE(PG8_SA(1, 0), cA + kstep, voffA); PG8_STAGE(PG8_SB(1, 1), cB + hstep + kstep, voffB);
        PG8_WAIT_V(6); PG8_BAR;
    }
    for (;;) {
        const bool has_next = S.next(ui + 1, nxt);
        const char* nA = has_next ? (const char*)g.A + (size_t)nxt.pm * tstep : cA; const char* nB = has_next ? (const char*)g.Bt + (size_t)nxt.pn * tstep : cB;
        for (int t = 0; t < nt; t += 2) {
            const bool last = (t == nt - 2);
            const char* a1 = cA + (size_t)(t + 1) * kstep;
            const char* a2 = last ? nA : cA + (size_t)(t + 2) * kstep; const char* b2 = last ? nB : cB + (size_t)(t + 2) * kstep;
            const char* a3 = a2 + kstep; const char* b3 = b2 + kstep;
            if (last && has_next) S.a_ready(nxt);
            if constexpr (SP2) {
            PG8_LDB(B0, 0, 0); PG8_LDB(B1, 0, 1); PG8_SCHED; PG8_LDA(At, 0, 0); PG8_STAGE(PG8_SA(1, 1), a1 + hstep, voffA);
            PG8_WAIT_V(8); PG8_WAIT_L(0); PG8_BAR; PG8_MMA(0, 0, At, B0); PG8_MMA(0, 1, At, B1); PG8_BAR; PG8_SCHED;
            PG8_LDA(At, 0, 1); PG8_STAGE(PG8_SB(0, 0), b2, voffB); PG8_STAGE(PG8_SB(0, 1), b2 + hstep, voffB); PG8_STAGE(PG8_SA(0, 0), a2, voffA);
            PG8_WAIT_V(8); PG8_WAIT_L(0); PG8_BAR; PG8_MMA(1, 0, At, B0); PG8_MMA(1, 1, At, B1); PG8_BAR; PG8_SCHED;
            PG8_LDB(B0, 1, 0); PG8_LDB(B1, 1, 1); PG8_SCHED; PG8_LDA(At, 1, 0); PG8_STAGE(PG8_SA(0, 1), a2 + hstep, voffA);
            PG8_WAIT_V(8); PG8_WAIT_L(0); PG8_BAR; PG8_MMA(0, 0, At, B0); PG8_MMA(0, 1, At, B1); PG8_BAR; PG8_SCHED;
            PG8_LDA(At, 1, 1); PG8_STAGE(PG8_SB(1, 0), b3, voffB); PG8_STAGE(PG8_SB(1, 1), b3 + hstep, voffB); PG8_STAGE(PG8_SA(1, 0), a3, voffA);
            PG8_WAIT_V(8); PG8_WAIT_L(0); PG8_BAR; PG8_MMA(1, 0, At, B0); PG8_MMA(1, 1, At, B1); PG8_BAR; PG8_SCHED;
            } else {
            PG8_LDB(B0, 0, 0); PG8_SCHED; PG8_LDA(At, 0, 0); PG8_STAGE(PG8_SA(1, 1), a1 + hstep, voffA);
            PG8_WAIT_L(8); PG8_BAR; PG8_WAIT_L(0); PG8_MMA(0, 0, At, B0); PG8_BAR; PG8_SCHED;
            PG8_LDB(B1, 0, 1); PG8_STAGE(PG8_SB(0, 0), b2, voffB);
            PG8_BAR; PG8_WAIT_L(0); PG8_MMA(0, 1, At, B1); PG8_BAR;
            PG8_LDA(At, 0, 1); PG8_STAGE(PG8_SA(0, 0), a2, voffA);
            PG8_BAR; PG8_WAIT_L(0); PG8_MMA(1, 0, At, B0); PG8_BAR; PG8_SCHED;
            PG8_STAGE(PG8_SB(0, 1), b2 + hstep, voffB);
            PG8_WAIT_V(6); PG8_BAR; PG8_MMA(1, 1, At, B1); PG8_BAR;
            PG8_LDB(B0, 1, 0); PG8_SCHED; PG8_LDA(At, 1, 0); PG8_STAGE(PG8_SA(0, 1), a2 + hstep, voffA);
            PG8_WAIT_L(8); PG8_BAR; PG8_WAIT_L(0); PG8_MMA(0, 0, At, B0); PG8_BAR; PG8_SCHED;
            PG8_LDB(B1, 1, 1); PG8_STAGE(PG8_SB(1, 0), b3, voffB);
            PG8_BAR; PG8_WAIT_L(0); PG8_MMA(0, 1, At, B1); PG8_BAR;
            PG8_LDA(At, 1, 1); PG8_STAGE(PG8_SA(1, 0), a3, voffA);
            PG8_BAR; PG8_WAIT_L(0); PG8_MMA(1, 0, At, B0); PG8_BAR; PG8_SCHED;
            PG8_STAGE(PG8_SB(1, 1), b3 + hstep, voffB);
            PG8_WAIT_V(6); PG8_BAR; PG8_MMA(1, 1, At, B1); PG8_BAR;
            }
        }
        if constexpr (ALIGN_EPI) { if (wr == 0) PG8_BAR; }
        if constexpr (!EpiT::AFTER_DRAIN) { E(acc, cur, wr, wc, fr, fq); S.done(cur); }
        if (!has_next) break;
#pragma unroll
        for (int a = 0; a < 2; ++a)
#pragma unroll
            for (int b = 0; b < 2; ++b)
#pragma unroll
                for (int m = 0; m < 4; ++m)
#pragma unroll
                    for (int n = 0; n < 2; ++n) acc[a][b][m][n] = (f32x4){0.f, 0.f, 0.f, 0.f};
        cur = nxt; cA = nA; cB = nB; ++ui;
        if constexpr (ALIGN_EPI) { if (wr == 1) PG8_BAR; }
    }
    PG8_WAIT_V(0);
    if constexpr (!ALIGN_EPI) { if (wr == 0) PG8_BAR; }
    PG8_BAR;
    if constexpr (EpiT::AFTER_DRAIN) E.fused(acc, cur, wr, wc, fr, fq, lds, wid, lane);
#undef PG8_SA
#undef PG8_SB
#undef PG8_STAGE
#undef PG8_LDA
#undef PG8_LDB
#undef PG8_MMA
#undef PG8_WAIT_V
#undef PG8_WAIT_L
#undef PG8_BAR
#undef PG8_SCHED
}
}

template <int MODE, int K> __device__ __forceinline__ void sgemm_sample(LAS unsigned char* lds, const bf16* A, const bf16* Bt, int N, bf16* O, int ldc, const bf16* aux, int ldaux, const bf16* add, int ldadd, int vcu, int G, int wv,
                                                                 unsigned* sig = nullptr) {
    int tid = TIDW(wv); asm volatile("" : "+v"(tid));
    const int lane = tid & 63, wave = __builtin_amdgcn_readfirstlane(tid >> 6), l15 = lane & 15, g4 = lane >> 4, tsel = wave & 1, kq = wave >> 1;
    constexpr int kn = K >> 2, KQ = kn / 32;
    const int npair = N >> 5, nitem = 8 * npair;
    LAS f32x4* red = (LAS f32x4*)lds;
    for (int item = vcu; item < nitem; item += G) {
        const int tr = item / npair, ct = 2 * (item - tr * npair) + tsel;
        const int row = MP + tr * 16 + l15;
        const bf16* ap = A + (size_t)row * K + kq * kn + 8 * g4;
        const bf16* bp = Bt + (size_t)(ct * 16 + l15) * K + kq * kn + 8 * g4;
        f32x4 acc = {0.f, 0.f, 0.f, 0.f};
        bf16x8 av[KQ], bv[KQ];
#pragma unroll
        for (int k = 0; k < KQ; ++k) { av[k] = *(const bf16x8*)(ap + 32 * k); bv[k] = *(const bf16x8*)(bp + 32 * k); }
        u32x2 zz = {0u, 0u}, yy = {0u, 0u};
        if constexpr (MODE == pg8::EM_MULZ || MODE == pg8::EM_FMAZ || MODE == pg8::EM_SIGMUL) { if (kq == 0) zz = *(const u32x2*)(aux + (size_t)row * ldaux + ct * 16 + 4 * g4); }
        if constexpr (MODE == pg8::EM_FMAZ) { if (kq == 0) yy = *(const u32x2*)(add + (size_t)row * ldadd + ct * 16 + 4 * g4); }
#pragma unroll
        for (int k = 0; k < KQ; ++k) acc = __builtin_amdgcn_mfma_f32_16x16x32_bf16(bv[k], av[k], acc, 0, 0, 0);
        __syncthreads();
        if (kq > 0) red[(tsel * 3 + (kq - 1)) * 64 + lane] = acc;
        __syncthreads();
        if (kq == 0) {
            acc = acc + red[(tsel * 3 + 0) * 64 + lane] + red[(tsel * 3 + 1) * 64 + lane] + red[(tsel * 3 + 2) * 64 + lane];
            const int col = ct * 16 + 4 * g4;
            f32x4 v = acc;
            if constexpr (MODE == pg8::EM_MULZ || MODE == pg8::EM_FMAZ || MODE == pg8::EM_SIGMUL) {
                const f32x4 zf = {bflo(zz.x), bfhi(zz.x), bflo(zz.y), bfhi(zz.y)};
                if constexpr (MODE == pg8::EM_SIGMUL) { for (int j = 0; j < 4; ++j) v[j] = sigmoid_f(v[j]); }
                v = v * zf;
                if constexpr (MODE == pg8::EM_FMAZ) { v += (f32x4){bflo(yy.x), bfhi(yy.x), bflo(yy.y), bfhi(yy.y)}; }
            }
            u32x2 w; w.x = pk2(v[0], v[1]); w.y = pk2(v[2], v[3]);
            if (sig) __hip_atomic_store((unsigned long long*)(O + (size_t)row * ldc + col), ((unsigned long long)w.y << 32) | w.x, __ATOMIC_RELAXED, __HIP_MEMORY_SCOPE_AGENT);
            else *(u32x2*)(O + (size_t)row * ldc + col) = w;
        }
    }
    if (sig) asm volatile("s_waitcnt vmcnt(0)" ::: "memory");
    __syncthreads();
    if (sig && wv == 0 && lane == 0) { for (int item = vcu; item < nitem; item += G) (void)__hip_atomic_fetch_add(sig + 64 * (item / npair), 1u, __ATOMIC_RELAXED, __HIP_MEMORY_SCOPE_AGENT); }
}

constexpr int RING_OFF = 0, RING_BYTES = 131072;
constexpr int LDSCTL_OFF = RING_BYTES, MISC_OFF = LDSCTL_OFF + 320;
constexpr int LDS_BYTES = 147456;
constexpr int NWAVES = 8;

#define XB_TMO      128
#define XB_XCNT(j)  (256  + 64 * (j))
#define XB_XSUB(j)  (1280 + 64 * (j))
#define XB_XGEN(j)  (2304 + 64 * (j))
#define XB_TOP      3328
#define XB_TOPGEN   3392
#define XCD_BAR_WORDS 3456
#define XB_SPIN_CAP (1u << 18)
__device__ __forceinline__ unsigned xb_ld(unsigned* p)              { return __hip_atomic_load(p, __ATOMIC_RELAXED, __HIP_MEMORY_SCOPE_AGENT); }
__device__ __forceinline__ unsigned xb_add(unsigned* p, unsigned v) { return __hip_atomic_fetch_add(p, v, __ATOMIC_RELAXED, __HIP_MEMORY_SCOPE_AGENT); }
__device__ __forceinline__ unsigned xb_xcc_id() { return (unsigned)__builtin_amdgcn_s_getreg((3 << 11) | 20) & 0xFu; }
#define XB_SPIN(cond, bar) do { unsigned _sp = 0; while (cond) { __builtin_amdgcn_s_sleep(1); \
    if ((++_sp & 255u) == 0u) { if (xb_ld(&(bar)[XB_TMO])) break; if (_sp > XB_SPIN_CAP) { atomicAdd(&(bar)[XB_TMO], 1u); break; } } } } while (0)
struct XcdBarrier { unsigned* bar; unsigned x; volatile LAS unsigned* st; bool t0; };
__device__ __forceinline__ XcdBarrier xcd_barrier_post(unsigned* bar, volatile LAS unsigned* st) {
    XcdBarrier b; b.bar = bar; b.x = xb_xcc_id(); b.st = st;
    if (threadIdx.x == 0) (void)xb_add(&bar[XB_XCNT(b.x)], 1u);
    return b;
}
__device__ __forceinline__ void xcd_barrier_complete(unsigned* bar, unsigned x, unsigned& nloc, unsigned& nx) {
    const unsigned G = gridDim.x * gridDim.y * gridDim.z;
    unsigned sum, cnt, mine, sp = 0u;
    for (;;) {
        sum = 0u; cnt = 0u; mine = 0u;
#pragma unroll
        for (unsigned j = 0; j < 16; ++j) { const unsigned c = xb_ld(&bar[XB_XCNT(j)]); sum += c; cnt += (c > 0u) ? 1u : 0u; mine = (j == x) ? c : mine; }
        if (sum == G) break;
        __builtin_amdgcn_s_sleep(1);
        if ((++sp & 255u) == 0u) { if (xb_ld(&bar[XB_TMO])) break; if (sp > XB_SPIN_CAP) { atomicAdd(&bar[XB_TMO], 1u); break; } }
    }
    nloc = mine > 0u ? mine : 1u; nx = cnt > 0u ? cnt : 1u;
}
__device__ __forceinline__ void xcd_barrier(const XcdBarrier& b) {
    asm volatile("s_waitcnt vmcnt(0)" ::: "memory");
    __syncthreads();
    if (b.t0) {
        unsigned* bar = b.bar;
        __builtin_amdgcn_s_waitcnt(0);
        unsigned nloc = b.st[0], nx = b.st[1];
        if (nloc == 0u) { xcd_barrier_complete(bar, b.x, nloc, nx); b.st[0] = nloc; b.st[1] = nx; }
        const unsigned old = xb_add(&bar[XB_XSUB(b.x)], 1u);
        const unsigned gen = old / nloc;
        if (old + 1u == (gen + 1u) * nloc) {
            __builtin_amdgcn_fence(__ATOMIC_RELEASE, "agent");
            asm volatile("s_waitcnt vmcnt(0)" ::: "memory");
            const unsigned og = xb_add(&bar[XB_TOP], 1u);
            const unsigned tg = og / nx;
            if (og + 1u == (tg + 1u) * nx) xb_add(&bar[XB_TOPGEN], 1u);
            else XB_SPIN(xb_ld(&bar[XB_TOPGEN]) == tg, bar);
            __builtin_amdgcn_fence(__ATOMIC_ACQUIRE, "agent");
            xb_add(&bar[XB_XGEN(b.x)], 1u);
            asm volatile("s_waitcnt vmcnt(0)" ::: "memory");
        } else {
            XB_SPIN(xb_ld(&bar[XB_XGEN(b.x)]) == gen, bar);
            __builtin_amdgcn_fence(__ATOMIC_ACQUIRE, "agent");
            asm volatile("s_waitcnt vmcnt(0)" ::: "memory");
        }
    }
    __syncthreads();
}
__device__ __forceinline__ void xcd_barrier_arrive(const XcdBarrier& b) {
    asm volatile("s_waitcnt vmcnt(0)" ::: "memory");
    __syncthreads();
    if (b.t0) {
        unsigned* bar = b.bar;
        __builtin_amdgcn_s_waitcnt(0);
        unsigned nloc = b.st[0], nx = b.st[1];
        if (nloc == 0u) { xcd_barrier_complete(bar, b.x, nloc, nx); b.st[0] = nloc; b.st[1] = nx; }
        const unsigned old = xb_add(&bar[XB_XSUB(b.x)], 1u);
        const unsigned gen = old / nloc;
        if (old + 1u == (gen + 1u) * nloc) {
            __builtin_amdgcn_fence(__ATOMIC_RELEASE, "agent");
            asm volatile("s_waitcnt vmcnt(0)" ::: "memory");
            const unsigned og = xb_add(&bar[XB_TOP], 1u);
            const unsigned tg = og / nx;
            if (og + 1u == (tg + 1u) * nx) xb_add(&bar[XB_TOPGEN], 1u);
            else XB_SPIN(xb_ld(&bar[XB_TOPGEN]) == tg, bar);
            __builtin_amdgcn_fence(__ATOMIC_ACQUIRE, "agent");
            xb_add(&bar[XB_XGEN(b.x)], 1u);
            asm volatile("s_waitcnt vmcnt(0)" ::: "memory");
            b.st[3] = 1u;
        } else { b.st[2] = gen; b.st[3] = 0u; }
    }
    __syncthreads();
}
__device__ __forceinline__ void xcd_barrier_finish(const XcdBarrier& b) {
    if (b.t0) {
        if (b.st[3] == 0u) { const unsigned gen = b.st[2]; XB_SPIN(xb_ld(&b.bar[XB_XGEN(b.x)]) == gen, b.bar); __builtin_amdgcn_fence(__ATOMIC_ACQUIRE, "agent"); asm volatile("s_waitcnt vmcnt(0)" ::: "memory"); }
    }
    __syncthreads();
}

struct Args { const void* in[N_PTR]; int ph_lo, ph_hi, li, pad; };

template <int MAP> __device__ __forceinline__ int rowmap(int n, int row_off) {
    if constexpr (MAP == 1) return (n >> 7) * 256 + (n & 127);
    else if constexpr (MAP == 2) return (n >> 7) * 256 + 128 + (n & 127);
    else if constexpr (MAP == 3) return n < 3232 ? n : n + 96;
    else if constexpr (MAP == 4) { const int d = n & 31; return row_off + (n & ~31) + 8 * ((d >> 2) & 3) + 4 * (d >> 4) + (d & 3); }
    else return row_off + n;
}
template <int MAP> __device__ __forceinline__ void transpose_item(const float* W, int K, int N, bf16* WT, int row_off, LAS float* scr, int item, int lane, float wscale = 1.f) {
    const int nblk = N / 32, kb = item / nblk, nb = item % nblk, k0 = 64 * kb, n0 = 32 * nb;
#pragma unroll 8
    for (int i = 0; i < 32; ++i) { const int kk = 2 * i + (lane >> 5); scr[kk * 33 + (lane & 31)] = W[(size_t)(k0 + kk) * N + n0 + (lane & 31)] * wscale; }
    LDS_WAIT(); asm volatile("" ::: "memory");
    const int c = lane & 7;
#pragma unroll
    for (int j = 0; j < 4; ++j) { const int n = (lane >> 3) + 8 * j; const LAS float* s = scr + (8 * c) * 33 + n;
        u32x4 o; o.x = pk2(s[0 * 33], s[1 * 33]); o.y = pk2(s[2 * 33], s[3 * 33]); o.z = pk2(s[4 * 33], s[5 * 33]); o.w = pk2(s[6 * 33], s[7 * 33]);
        *(u32x4*)(WT + (size_t)rowmap<MAP>(n0 + n, row_off) * K + k0 + 8 * c) = o; }
    LDS_WAIT(); asm volatile("" ::: "memory");
}
__device__ __forceinline__ const float* xrow_ptr(const Args& a, int m, int z) {
    if (m < MP) return (const float*)a.in[I_XP + z] + (size_t)m * DM;
    if (m < MP + NS) return (const float*)a.in[I_XS + z] + (size_t)(m - MP) * DM;
    return nullptr;
}
__device__ __forceinline__ void rms_row_to_bf16(const float* xrow, const float* gain, bf16* orow, int lane) {
    f32x4 v[4]; float s = 0.f;
#pragma unroll
    for (int j = 0; j < 4; ++j) { v[j] = xrow ? ((const f32x4*)xrow)[lane + 64 * j] : (f32x4){0.f, 0.f, 0.f, 0.f}; s += (v[j].x * v[j].x + v[j].y * v[j].y) + (v[j].z * v[j].z + v[j].w * v[j].w); }
    const float rstd = 1.f / sqrtf(wave_sum(s) * (1.f / DM) + EPS);
#pragma unroll
    for (int j = 0; j < 4; ++j) { const f32x4 g = ((const f32x4*)gain)[lane + 64 * j];
        u32x2 o; o.x = pk2(v[j].x * rstd * g.x, v[j].y * rstd * g.y); o.y = pk2(v[j].z * rstd * g.z, v[j].w * rstd * g.w);
        ((u32x2*)orow)[lane + 64 * j] = o; }
}
constexpr int CVI_UP = 16 * 88, CVI_DN = 44 * 32, CVI_IN = 16 * 165, CVI_RNN = 20 * 32, CVI_UQ = 6 * 32, CVI_QR = 6 * 16, CVI_UK = 4 * 32, CVI_SQ = 16 * 32, CVI_PPJ = 4 * 32;
constexpr int CV_A = 2 * CVI_UP, CV_B = CV_A + CVI_DN + CVI_IN, CV_N = CV_B + 2 * CVI_UP + CVI_DN + CVI_RNN + CVI_UQ + CVI_QR + 2 * CVI_UK + 3 * CVI_SQ + CVI_PPJ;
__device__ __forceinline__ void convert_item(const Args& a, int z, unsigned char* ws, LAS float* scr, int it, int lane) {
    int r = it;
    if (r < CVI_UP) { transpose_item<1>((const float*)a.in[I_F1G + z], DM, DFF, (bf16*)(ws + WS_BUP1), 0, scr, r, lane); return; } r -= CVI_UP;
    if (r < CVI_UP) { transpose_item<2>((const float*)a.in[I_F1U + z], DM, DFF, (bf16*)(ws + WS_BUP1), 0, scr, r, lane); return; } r -= CVI_UP;
    if (r < CVI_DN) { transpose_item<0>((const float*)a.in[I_F1D + z], DFF, DM, (bf16*)(ws + WS_BDN1), 0, scr, r, lane); return; } r -= CVI_DN;
    if (r < CVI_IN) { transpose_item<3>((const float*)a.in[I_WIN + z], DM, DIN, (bf16*)(ws + WS_BIN), 0, scr, r, lane); return; } r -= CVI_IN;
    if (r < CVI_UP) { transpose_item<1>((const float*)a.in[I_F2G + z], DM, DFF, (bf16*)(ws + WS_BUP2), 0, scr, r, lane); return; } r -= CVI_UP;
    if (r < CVI_UP) { transpose_item<2>((const float*)a.in[I_F2U + z], DM, DFF, (bf16*)(ws + WS_BUP2), 0, scr, r, lane); return; } r -= CVI_UP;
    if (r < CVI_DN) { transpose_item<0>((const float*)a.in[I_F2D + z], DFF, DM, (bf16*)(ws + WS_BDN2), 0, scr, r, lane); return; } r -= CVI_DN;
    if (r < CVI_RNN) { transpose_item<0>((const float*)a.in[I_WRNN + z], DRNN, DM, (bf16*)(ws + WS_BRNN), 0, scr, r, lane); return; } r -= CVI_RNN;
    if (r < CVI_UQ) { transpose_item<0>((const float*)a.in[I_WUQ + z], QL, 1024, (bf16*)(ws + WS_BQ), 0, scr, r, lane, C2); return; } r -= CVI_UQ;
    if (r < CVI_QR) { transpose_item<0>((const float*)a.in[I_WQR + z], QL, 512, (bf16*)(ws + WS_BQ), 1024, scr, r, lane, C2); return; } r -= CVI_QR;
    if (r < CVI_UK) { transpose_item<0>((const float*)a.in[I_WUK + z], KVL, 1024, (bf16*)(ws + WS_BKV), 0, scr, r, lane); return; } r -= CVI_UK;
    if (r < CVI_UK) { transpose_item<0>((const float*)a.in[I_WUV + z], KVL, 1024, (bf16*)(ws + WS_BKV), 1024, scr, r, lane); return; } r -= CVI_UK;
    if (r < CVI_SQ) { transpose_item<0>((const float*)a.in[I_WATT + z], DM, DM, (bf16*)(ws + WS_BATT), 0, scr, r, lane); return; } r -= CVI_SQ;
    if (r < CVI_SQ) { transpose_item<0>((const float*)a.in[I_WOUT + z], DM, DM, (bf16*)(ws + WS_BOUT), 0, scr, r, lane); return; } r -= CVI_SQ;
    if (r < CVI_SQ) { transpose_item<0>((const float*)a.in[I_PG + z], DM, DM, (bf16*)(ws + WS_BPG), 0, scr, r, lane); return; } r -= CVI_SQ;
    transpose_item<0>((const float*)a.in[I_PPJ + z], DPLE, DM, (bf16*)(ws + WS_BPP), 0, scr, r, lane);
}
__device__ __forceinline__ void convert_range(const Args& a, LAS unsigned char* lds, int lo, int hi, int w, int nw, int wv) {
    int z = 0; asm volatile("" : "+s"(z));
    int tid = TIDW(wv); asm volatile("" : "+v"(tid)); const int lane = tid & 63, wave = wv;
    unsigned char* ws = (unsigned char*)a.in[I_WS + z];
    LAS float* scr = (LAS float*)(lds + RING_OFF + wave * 16384);
    for (int it = lo + w; it < hi; it += nw) convert_item(a, z, ws, scr, it, lane);
}
__device__ __forceinline__ void convert_in_tail(const Args& a, LAS unsigned char* lds, int nwg, int G, int c, int lo, int hi, int wv) {
    const int full = (nwg + G - 1) / G, nl = full * G - nwg;
    const int wave = wv;
    if (nl == 0) { convert_range(a, lds, lo, hi, c * NWAVES + wave, G * NWAVES, wv); return; }
    if (c >= G - nl) convert_range(a, lds, lo, hi, (c - (G - nl)) * NWAVES + wave, nl * NWAVES, wv);
}
__device__ __forceinline__ void p0_prologue(const Args& a, LAS unsigned char* lds, int vcu, int G, int tid, int lane, int wave) {
    int z = 0; asm volatile("" : "+s"(z));
    unsigned char* ws = (unsigned char*)a.in[I_WS + z];
    const int gw = vcu * NWAVES + wave, NGW = G * NWAVES;
    convert_range(a, lds, 0, CV_A, gw, NGW, wave);
    const int gt = vcu * 512 + tid, NGT = G * 512;
    for (int i = gt; i < 12288; i += NGT) ((u32x4*)(ws + WS_BIN + (size_t)3232 * DM * 2))[i] = (u32x4){0u, 0u, 0u, 0u};
    for (int i = gt; i < NBLK * 160 * 104; i += NGT) {
        const int n = i / (160 * 104), r = i - n * (160 * 104), j = r / 104, k = r - j * 104;
        float v = 0.f;
        if (k < 80) v = j < 80 ? ((const float*)a.in[I_LWA + z])[(n * 80 + k) * 80 + j] : ((const float*)a.in[I_LWI + z])[(n * 80 + k) * 80 + (j - 80)];
        ((bf16*)(ws + WS_LW))[i] = f2bf(v);
    }
    for (int i = gt; i < ROPE_TAB; i += NGT) {
        const int pos = i >> 4, k = i & 15;
        const double freq = exp2(-(double)k * (13.287712379549449 / 16.0));
        double rev = (double)pos * freq * 0.15915494309189535;
        rev -= floor(rev);
        const float rf = (float)rev;
        ((float*)(ws + WS_ROPE))[i] = __builtin_amdgcn_cosf(rf);
        ((float*)(ws + WS_ROPE))[ROPE_TAB + i] = __builtin_amdgcn_sinf(rf);
    }
    for (int m0 = gw; m0 < MT; m0 += 4 * NGW) {
        f32x4 v[4][4], pv[4];
#pragma unroll
        for (int q = 0; q < 4; ++q) { const int m = m0 + q * NGW; const bool ok = m < MT;
            const float* xr = ok ? xrow_ptr(a, m, z) : nullptr;
            const float* pr = !ok ? nullptr : (m < MP ? (const float*)a.in[I_PP + z] + (size_t)m * DPLE : (m < MP + NS ? (const float*)a.in[I_PS + z] + (size_t)(m - MP) * DPLE : nullptr));
#pragma unroll
            for (int jj = 0; jj < 4; ++jj) v[q][jj] = xr ? ((const f32x4*)xr)[lane + 64 * jj] : (f32x4){0.f, 0.f, 0.f, 0.f};
            pv[q] = pr ? ((const f32x4*)pr)[lane] : (f32x4){0.f, 0.f, 0.f, 0.f}; }
#pragma unroll
        for (int q = 0; q < 4; ++q) { const int m = m0 + q * NGW; if (m >= MT) break;
            float sq = 0.f;
#pragma unroll
            for (int jj = 0; jj < 4; ++jj) sq += (v[q][jj].x * v[q][jj].x + v[q][jj].y * v[q][jj].y) + (v[q][jj].z * v[q][jj].z + v[q][jj].w * v[q][jj].w);
            const float rstd = __builtin_amdgcn_rsqf(wave_sum(sq) * (1.f / DM) + EPS);
            bf16* orow = (bf16*)(ws + WS_XN) + (size_t)m * DM;
#pragma unroll
            for (int jj = 0; jj < 4; ++jj) { const f32x4 g = ((const f32x4*)a.in[I_F1PRE + z])[lane + 64 * jj];
                u32x2 o; o.x = pk2(v[q][jj].x * rstd * g.x, v[q][jj].y * rstd * g.y); o.y = pk2(v[q][jj].z * rstd * g.z, v[q][jj].w * rstd * g.w);
                ((u32x2*)orow)[lane + 64 * jj] = o; }
            u32x2 o; o.x = pk2(pv[q].x, pv[q].y); o.y = pk2(pv[q].z, pv[q].w);
            ((u32x2*)((bf16*)(ws + WS_PB) + (size_t)m * DPLE))[lane] = o;
        }
    }
}

template <int NEXT, int SRC> __device__ __forceinline__ void norm_rows(const Args& a, const bf16* Fin, float coef, int i_post, int i_pre, int first, int NGW, int end, int lane) {
    int z = 0; asm volatile("" : "+s"(z));
    unsigned char* ws = (unsigned char*)a.in[I_WS + z];
    bf16* XR = (bf16*)(ws + WS_XR); bf16* XN = (bf16*)(ws + WS_XN);
    const float* post = (const float*)a.in[i_post + z]; const float* pre = (const float*)a.in[i_pre + z];
    for (int m0 = first; m0 < end; m0 += 2 * NGW) {
        f32x4 f[2][4], x[2][4]; float s[2] = {0.f, 0.f};
#pragma unroll
        for (int q = 0; q < 2; ++q) { const int m = m0 + q * NGW; const bool ok = m < end; const int mm = ok ? m : m0;
            const float* xr = SRC == 0 ? xrow_ptr(a, mm, z) : nullptr;
            const bf16* xb = (SRC == 1 ? XR : XN) + (size_t)mm * DM;
#pragma unroll
            for (int j = 0; j < 4; ++j) {
                const u32x2 w = ((const u32x2*)(Fin + (size_t)mm * DM))[lane + 64 * j];
                f[q][j] = (f32x4){bflo(w.x), bfhi(w.x), bflo(w.y), bfhi(w.y)};
                if constexpr (SRC == 0) x[q][j] = ((const f32x4*)xr)[lane + 64 * j];
                else { const u32x2 xw = ((const u32x2*)xb)[lane + 64 * j]; x[q][j] = (f32x4){bflo(xw.x), bfhi(xw.x), bflo(xw.y), bfhi(xw.y)}; }
                s[q] += (f[q][j].x * f[q][j].x + f[q][j].y * f[q][j].y) + (f[q][j].z * f[q][j].z + f[q][j].w * f[q][j].w);
            } }
#pragma unroll
        for (int q = 0; q < 2; ++q) { const int m = m0 + q * NGW; if (m >= end) break;
            const float rstd = coef / sqrtf(wave_sum(s[q]) * (1.f / DM) + EPS);
            float s2 = 0.f;
#pragma unroll
            for (int j = 0; j < 4; ++j) { const f32x4 g = ((const f32x4*)post)[lane + 64 * j]; x[q][j] = x[q][j] + f[q][j] * g * rstd; s2 += (x[q][j].x * x[q][j].x + x[q][j].y * x[q][j].y) + (x[q][j].z * x[q][j].z + x[q][j].w * x[q][j].w); }
            if constexpr (NEXT == 0) {
#pragma unroll
                for (int j = 0; j < 4; ++j) ((f32x4*)((float*)a.in[I_OUT + z] + O_Y + (size_t)m * DM))[lane + 64 * j] = x[q][j];
            } else {
                if constexpr (NEXT == 1) {
#pragma unroll
                    for (int j = 0; j < 4; ++j) { u32x2 o; o.x = pk2(x[q][j].x, x[q][j].y); o.y = pk2(x[q][j].z, x[q][j].w); ((u32x2*)(XR + (size_t)m * DM))[lane + 64 * j] = o; }
                }
                float r2 = 1.f;
                if constexpr (NEXT == 1) r2 = 1.f / sqrtf(wave_sum(s2) * (1.f / DM) + EPS);
#pragma unroll
                for (int j = 0; j < 4; ++j) {
                    f32x4 g = {1.f, 1.f, 1.f, 1.f};
                    if constexpr (NEXT == 1) g = ((const f32x4*)pre)[lane + 64 * j];
                    u32x2 o; o.x = pk2(x[q][j].x * r2 * g.x, x[q][j].y * r2 * g.y); o.y = pk2(x[q][j].z * r2 * g.z, x[q][j].w * r2 * g.w);
                    ((u32x2*)(XN + (size_t)m * DM))[lane + 64 * j] = o;
                }
            }
        }
    }
}
template <int NEXT, int SRC> __device__ __forceinline__ void sample_norm(const Args& a, unsigned* sig, const bf16* Fin, float coef, int i_post, int i_pre, int G, int vcu, int wv) {
    constexpr int npair = DM >> 5, nitem = 8 * npair;
    const int lane = lane_id();
    for (int item = vcu; item < nitem; item += G) {
        if (item % npair != 0) continue;
        const int tr = item / npair;
        if (wv == 0) { unsigned sp = 0u; while ((unsigned)__builtin_amdgcn_readfirstlane(__hip_atomic_load(sig + 64 * tr, __ATOMIC_RELAXED, __HIP_MEMORY_SCOPE_AGENT)) < (unsigned)npair) { __builtin_amdgcn_s_sleep(1); if (++sp > (1u << 20)) break; }
                       __builtin_amdgcn_fence(__ATOMIC_ACQUIRE, "agent"); asm volatile("s_waitcnt vmcnt(0)" ::: "memory"); }
        __syncthreads();
        norm_rows<NEXT, SRC>(a, Fin, coef, i_post, i_pre, MP + 16 * tr + wv, NWAVES, MP + 16 * tr + 16, lane);
    }
}

__device__ __forceinline__ void mla_prep(const Args& a, int vcu, int G, int lane, int wave) {
    int z = 0; asm volatile("" : "+s"(z));
    unsigned char* ws = (unsigned char*)a.in[I_WS + z];
    const int gw = vcu * NWAVES + wave, NGW = G * NWAVES;
    const bf16* Z = (const bf16*)(ws + WS_Z);
    const float* cosT = (const float*)(ws + WS_ROPE); const float* sinT = cosT + ROPE_TAB;
    const float* qn = (const float*)a.in[I_QNORM + z]; const float* kn = (const float*)a.in[I_KVNORM + z];
    for (int m0 = gw; m0 < MT; m0 += 4 * NGW) {
        unsigned qw[4][3]; u32x2 kw4[4]; float x1[4], x2[4], cs[4], sn4[4];
#pragma unroll
        for (int qq = 0; qq < 4; ++qq) { const int m = m0 + qq * NGW, mm = m < MT ? m : m0; const bf16* zr = Z + (size_t)mm * ZW;
#pragma unroll
            for (int j = 0; j < 3; ++j) qw[qq][j] = ((const unsigned*)(zr + Z_CQ))[lane + 64 * j];
            kw4[qq] = ((const u32x2*)(zr + Z_KV))[lane];
            const int pos = mm < MP ? (mm & (SEQ - 1)) : SEQ, l16 = lane & 15;
            x1[qq] = bf2f(zr[Z_KR + l16]); x2[qq] = bf2f(zr[Z_KR + 16 + l16]); cs[qq] = cosT[pos * 16 + l16]; sn4[qq] = sinT[pos * 16 + l16]; }
#pragma unroll
        for (int qq = 0; qq < 4; ++qq) { const int m = m0 + qq * NGW; if (m >= MT) break;
            float q[6]; float s = 0.f;
#pragma unroll
            for (int j = 0; j < 3; ++j) { const unsigned w = qw[qq][j]; q[2 * j] = bflo(w); q[2 * j + 1] = bfhi(w); s += q[2 * j] * q[2 * j] + q[2 * j + 1] * q[2 * j + 1]; }
            const float rq = __builtin_amdgcn_rsqf(wave_sum(s) * (1.f / QL) + EPS);
#pragma unroll
            for (int j = 0; j < 3; ++j) { const f32x2 g = ((const f32x2*)qn)[lane + 64 * j]; ((unsigned*)((bf16*)(ws + WS_CQ) + (size_t)m * QL))[lane + 64 * j] = pk2(q[2 * j] * rq * g.x, q[2 * j + 1] * rq * g.y); }
            const u32x2 kw = kw4[qq];
            f32x4 kv = {bflo(kw.x), bfhi(kw.x), bflo(kw.y), bfhi(kw.y)};
            const float rk = __builtin_amdgcn_rsqf(wave_sum((kv.x * kv.x + kv.y * kv.y) + (kv.z * kv.z + kv.w * kv.w)) * (1.f / KVL) + EPS);
            kv = kv * rk * ((const f32x4*)kn)[lane];
            { u32x2 o; o.x = pk2(kv.x, kv.y); o.y = pk2(kv.z, kv.w); ((u32x2*)((bf16*)(ws + WS_CKV) + (size_t)m * KVL))[lane] = o; }
            if (m < MP) ((f32x4*)((float*)a.in[I_OUT + z] + O_CKV_P + (size_t)m * KVL))[lane] = kv;
            else if (m < MP + NS) ((f32x4*)((float*)a.in[I_OUT + z] + O_CKV_S + (size_t)(m - MP) * KVL))[lane] = kv;
            if (lane < 16) {
                const float o1 = x1[qq] * cs[qq] - x2[qq] * sn4[qq], o2 = x1[qq] * sn4[qq] + x2[qq] * cs[qq];
                bf16* kr = (bf16*)(ws + WS_KR) + (size_t)m * ROPE;
                kr[lane] = f2bf(o1); kr[16 + lane] = f2bf(o2);
                float* ko = m < MP ? (float*)a.in[I_OUT + z] + O_KR_P + (size_t)m * ROPE : (m < MP + NS ? (float*)a.in[I_OUT + z] + O_KR_S + (size_t)(m - MP) * ROPE : nullptr);
                if (ko) { ko[lane] = o1; ko[16 + lane] = o2; }
            }
        }
    }
    { const float* scv = (const float*)a.in[I_SCONV + z]; float* co = (float*)a.in[I_OUT + z] + O_CONV_S;
      for (int it = gw; it < NS * 3 * (DRNN / 64); it += NGW) { const int sq = it / 60, r = it - 60 * sq, j = r / 20, idx = (r - 20 * j) * 64 + lane;
          co[(size_t)(sq * 3 + j) * DRNN + idx] = j < 2 ? scv[(size_t)(sq * 3 + j + 1) * DRNN + idx] : bf2f(Z[(size_t)(MP + sq) * ZW + Z_XR + idx]); } }
}


constexpr int L2_LW = 0, L2_CW = 33280, L2_TILE = 35328, L2_TPITCH = 84, L2_TBYTES = 16 * L2_TPITCH * 4, L2_WAVE = 2 * L2_TBYTES;
static_assert(L2_TILE + 8 * L2_WAVE <= RING_BYTES, "RG-LRU LDS map");
__device__ __forceinline__ float one_minus_exp(float x) {
    const float t = x * (1.f + x * (0.5f + x * (0.16666667f + x * 0.041666668f)));
    float e = 1.f - __builtin_amdgcn_exp2f(x * 1.4426950408889634f); asm volatile("" : "+v"(e));
    return x > -0.06f ? -t : e;
}
__device__ __forceinline__ void row4(float v, float (&out)[4]) {
    const unsigned u = __float_as_uint(v);
    const auto h = __builtin_amdgcn_permlane32_swap(u, u, false, false);
    const auto lo = __builtin_amdgcn_permlane16_swap(h[0], h[0], false, false);
    const auto hi = __builtin_amdgcn_permlane16_swap(h[1], h[1], false, false);
    out[0] = __uint_as_float(lo[0]); out[1] = __uint_as_float(lo[1]); out[2] = __uint_as_float(hi[0]); out[3] = __uint_as_float(hi[1]);
}
template <int PASS> __device__ __forceinline__ void lru_load(const bf16* Z, int ch0, int row0, int tib0, int l15, int g4, u32x4 (&zw)[3][5]) {
#pragma unroll
    for (int j = 0; j < 3; ++j) { const int cb = 32 * j + 8 * g4;
#pragma unroll
        for (int t = 0; t < 4; ++t) { u32x4 w = {0u, 0u, 0u, 0u}; if (tib0 + l15 + t - 3 >= 0) w = *(const u32x4*)(Z + (size_t)(row0 + l15 + t - 3) * ZW + Z_XR + ch0 + cb); zw[j][t] = w; }
        if (PASS == 2) { u32x4 w = {0u, 0u, 0u, 0u}; if (cb < 80) w = *(const u32x4*)(Z + (size_t)(row0 + l15) * ZW + Z_YR + ch0 + cb); zw[j][4] = w; }
    }
}
template <int PASS, bool SAMP> __device__ __forceinline__ void lru_tile(const Args& a, int z, unsigned char* ws, LAS unsigned char* lds, int n, int row0, int tib0, int lane, int wave,
                                                                        const float (&gba)[5], const float (&gbi)[5], const float (&gsp)[5], float (&carry)[5], float (&aprod)[5], const u32x4 (&zw)[3][5]) {
    const bf16* Z = (const bf16*)(ws + WS_Z);
    const int l15 = lane & 15, g4 = lane >> 4, ch0 = n * BLK;
    LAS float* xt = (LAS float*)(lds + L2_TILE + wave * L2_WAVE); LAS float* ht = xt + 16 * L2_TPITCH;
    const LAS float* cwl = (const LAS float*)(lds + L2_CW);
    bf16x8 af[3];
#pragma unroll
    for (int j = 0; j < 3; ++j) {
        const int cb = 32 * j + 8 * g4;
        float xc[8];
        { const f32x4 b0 = *(const LAS f32x4*)(cwl + 4 * 96 + cb), b1 = *(const LAS f32x4*)(cwl + 4 * 96 + cb + 4); xc[0] = b0.x; xc[1] = b0.y; xc[2] = b0.z; xc[3] = b0.w; xc[4] = b1.x; xc[5] = b1.y; xc[6] = b1.z; xc[7] = b1.w; }
#pragma unroll
        for (int t = 0; t < 4; ++t) {
            float xv[8];
            if (SAMP && t < 3) {
                const float* sp = (const float*)a.in[I_SCONV + z] + (size_t)((row0 - MP + l15) * 3 + t) * DRNN + ch0 + cb;
                if (cb < 80) { const f32x4 v0 = *(const f32x4*)sp, v1 = *(const f32x4*)(sp + 4); xv[0] = v0.x; xv[1] = v0.y; xv[2] = v0.z; xv[3] = v0.w; xv[4] = v1.x; xv[5] = v1.y; xv[6] = v1.z; xv[7] = v1.w; }
                else { for (int e = 0; e < 8; ++e) xv[e] = 0.f; }
            } else {
                u32x4 w;
                if constexpr (SAMP) w = *(const u32x4*)(Z + (size_t)(row0 + l15) * ZW + Z_XR + ch0 + cb); else w = zw[j][t];
                xv[0] = bflo(w.x); xv[1] = bfhi(w.x); xv[2] = bflo(w.y); xv[3] = bfhi(w.y); xv[4] = bflo(w.z); xv[5] = bfhi(w.z); xv[6] = bflo(w.w); xv[7] = bfhi(w.w);
            }
            const f32x4 w0 = *(const LAS f32x4*)(cwl + t * 96 + cb), w1 = *(const LAS f32x4*)(cwl + t * 96 + cb + 4);
            xc[0] += w0.x * xv[0]; xc[1] += w0.y * xv[1]; xc[2] += w0.z * xv[2]; xc[3] += w0.w * xv[3]; xc[4] += w1.x * xv[4]; xc[5] += w1.y * xv[5]; xc[6] += w1.z * xv[6]; xc[7] += w1.w * xv[7];
        }
        u32x4 pw; pw.x = pk2(xc[0], xc[1]); pw.y = pk2(xc[2], xc[3]); pw.z = pk2(xc[4], xc[5]); pw.w = pk2(xc[6], xc[7]);
        af[j] = __builtin_bit_cast(bf16x8, pw);
        if (cb < 80) { *(LAS f32x4*)(xt + l15 * L2_TPITCH + cb) = (f32x4){xc[0], xc[1], xc[2], xc[3]}; *(LAS f32x4*)(xt + l15 * L2_TPITCH + cb + 4) = (f32x4){xc[4], xc[5], xc[6], xc[7]}; }
    }
    LDS_WAIT();
#pragma unroll
    for (int ct = 0; ct < 5; ++ct) {
        f32x4 ar = {0.f, 0.f, 0.f, 0.f}, ai = {0.f, 0.f, 0.f, 0.f};
#pragma unroll
        for (int j = 0; j < 3; ++j) {
            const bf16x8 br = *(const LAS bf16x8*)(lds + L2_LW + (ct * 16 + l15) * 208 + (32 * j + 8 * g4) * 2);
            const bf16x8 bi = *(const LAS bf16x8*)(lds + L2_LW + (80 + ct * 16 + l15) * 208 + (32 * j + 8 * g4) * 2);
            ar = __builtin_amdgcn_mfma_f32_16x16x32_bf16(af[j], br, ar, 0, 0, 0);
            ai = __builtin_amdgcn_mfma_f32_16x16x32_bf16(af[j], bi, ai, 0, 0, 0);
        }
        const int ch = ct * 16 + l15;
        float av[4], bv[4];
#pragma unroll
        for (int i = 0; i < 4; ++i) {
            const float r = sigmoid_f(ar[i] + gba[ct]), gi = sigmoid_f(ai[i] + gbi[ct]);
            const float la = -8.f * r * gsp[ct];
            av[i] = __builtin_amdgcn_exp2f(la * 1.4426950408889634f);
            bv[i] = __builtin_amdgcn_sqrtf((1.f - av[i]) * (1.f + av[i])) * gi * xt[(4 * g4 + i) * L2_TPITCH + ch];
        }
        float hv[4];
        if constexpr (SAMP) {
            const float* sh = (const float*)a.in[I_SH + z];
#pragma unroll
            for (int i = 0; i < 4; ++i) { const int s = row0 - MP + 4 * g4 + i; hv[i] = av[i] * sh[(size_t)s * DRNN + ch0 + ch] + bv[i]; ((float*)a.in[I_OUT + z])[O_H_S + (size_t)s * DRNN + ch0 + ch] = hv[i]; }
        } else {
            float q[4]; float hl = 0.f, qq = 1.f;
#pragma unroll
            for (int i = 0; i < 4; ++i) { hl = av[i] * hl + bv[i]; qq *= av[i]; hv[i] = hl; q[i] = qq; }
            float cin = carry[ct], call = carry[ct], pall = 1.f;
            float Pq[4], Hq[4];
            row4(qq, Pq); row4(hl, Hq);
#pragma unroll
            for (int gq = 0; gq < 4; ++gq) { const float Pg = Pq[gq], Hg = Hq[gq];
                if (gq < g4) cin = Pg * cin + Hg;
                call = Pg * call + Hg; pall *= Pg; }
#pragma unroll
            for (int i = 0; i < 4; ++i) hv[i] += q[i] * cin;
            carry[ct] = call; aprod[ct] *= pall;
        }
        if constexpr (PASS == 2) {
#pragma unroll
            for (int i = 0; i < 4; ++i) ht[(4 * g4 + i) * L2_TPITCH + ch] = hv[i];
        }
    }
    if constexpr (PASS == 2) {
        LDS_WAIT();
#pragma unroll
        for (int j = 0; j < 3; ++j) { const int cb = 32 * j + 8 * g4;
            if (cb < 80) {
                const f32x4 h0 = *(const LAS f32x4*)(ht + l15 * L2_TPITCH + cb), h1 = *(const LAS f32x4*)(ht + l15 * L2_TPITCH + cb + 4);
                u32x4 y; if constexpr (SAMP) y = *(const u32x4*)(Z + (size_t)(row0 + l15) * ZW + Z_YR + ch0 + cb); else y = zw[j][4];
                u32x4 o; o.x = pk2(h0.x * bflo(y.x), h0.y * bfhi(y.x)); o.y = pk2(h0.z * bflo(y.y), h0.w * bfhi(y.y)); o.z = pk2(h1.x * bflo(y.z), h1.y * bfhi(y.z)); o.w = pk2(h1.z * bflo(y.w), h1.w * bfhi(y.w));
                *(u32x4*)((bf16*)(ws + WS_HG) + (size_t)(row0 + l15) * DRNN + ch0 + cb) = o;
            }
        }
    }
    LDS_WAIT();
}
template <int PASS> __device__ __forceinline__ void lru_cu_unit(const Args& a, LAS unsigned char* lds, int u, int wave) {
    int z = 0; asm volatile("" : "+s"(z));
    int lane_ = lane_id(); asm volatile("" : "+v"(lane_)); const int lane = lane_, l15 = lane & 15;
    unsigned char* ws = (unsigned char*)a.in[I_WS + z];
    const int n = u & 15, ch0 = n * BLK, cidx = 8 * (u >> 4) + wave;
    __syncthreads();
    { const u32x4* src = (const u32x4*)(ws + WS_LW + (size_t)n * 33280); LAS u32x4* dst = (LAS u32x4*)(lds + L2_LW);
      for (int i = TIDW(wave); i < 2080; i += 512) dst[i] = src[i]; }
    { const int tid = TIDW(wave); if (tid < 480) { const int t = tid / 96, c = tid - 96 * t; float v = 0.f;
        if (c < 80) v = t < 4 ? ((const float*)a.in[I_CONVW + z])[t * DRNN + ch0 + c] : ((const float*)a.in[I_CONVB + z])[ch0 + c];
        ((LAS float*)(lds + L2_CW))[tid] = v; } }
    float gba[5], gbi[5], gsp[5], carry[5], aprod[5];
#pragma unroll
    for (int ct = 0; ct < 5; ++ct) { const int cg = ch0 + ct * 16 + l15; gba[ct] = ((const float*)a.in[I_LBA + z])[cg]; gbi[ct] = ((const float*)a.in[I_LBI + z])[cg];
        gsp[ct] = log1pf(expf(-((const float*)a.in[I_LAM + z])[cg])); carry[ct] = 0.f; aprod[ct] = 1.f; }
    const bf16* Zp = (const bf16*)(ws + WS_Z);
    const int row_c = cidx * 128, tib_c = (cidx & 63) * 128, g4 = lane >> 4;
    u32x4 zwA[3][5], zwB[3][5];
    lru_load<PASS>(Zp, ch0, row_c, tib_c, l15, g4, zwA);
    if (PASS == 2) {
        const f32x2* SUM = (const f32x2*)(ws + WS_SUM);
        const int nprev = cidx & 63, base = cidx & ~63, qn = (nprev + 3) >> 2, lo = base + g4 * qn, hi = (lo + qn < base + nprev) ? lo + qn : base + nprev;
        float fa[5], fh[5];
#pragma unroll
        for (int ct = 0; ct < 5; ++ct) { fa[ct] = 1.f; fh[ct] = 0.f; }
        for (int jc = lo; jc < hi; jc += 4) {
            f32x2 sm[4][5];
#pragma unroll
            for (int k = 0; k < 4; ++k)
#pragma unroll
                for (int ct = 0; ct < 5; ++ct) sm[k][ct] = (jc + k < hi) ? SUM[(size_t)(jc + k) * DRNN + ch0 + ct * 16 + l15] : (f32x2){1.f, 0.f};
#pragma unroll
            for (int k = 0; k < 4; ++k)
#pragma unroll
                for (int ct = 0; ct < 5; ++ct) { fh[ct] = sm[k][ct].x * fh[ct] + sm[k][ct].y; fa[ct] = sm[k][ct].x * fa[ct]; }
        }
#pragma unroll
        for (int ct = 0; ct < 5; ++ct) { float c = 0.f;
            float Aq[4], Hq[4]; row4(fa[ct], Aq); row4(fh[ct], Hq);
#pragma unroll
            for (int gq = 0; gq < 4; ++gq) c = Aq[gq] * c + Hq[gq];
            carry[ct] = c; }
    }
    __syncthreads();
#pragma unroll 1
    for (int mt = 0; mt < 8; mt += 2) {
        lru_load<PASS>(Zp, ch0, row_c + 16 * (mt + 1), tib_c + 16 * (mt + 1), l15, g4, zwB);
        lru_tile<PASS, false>(a, z, ws, lds, n, row_c + 16 * mt, tib_c + 16 * mt, lane, wave, gba, gbi, gsp, carry, aprod, zwA);
        if (mt + 2 < 8) lru_load<PASS>(Zp, ch0, row_c + 16 * (mt + 2), tib_c + 16 * (mt + 2), l15, g4, zwA);
        lru_tile<PASS, false>(a, z, ws, lds, n, row_c + 16 * (mt + 1), tib_c + 16 * (mt + 1), lane, wave, gba, gbi, gsp, carry, aprod, zwB);
    }
    if (PASS == 1) { if (lane < 16) { for (int ct = 0; ct < 5; ++ct) ((f32x2*)(ws + WS_SUM))[(size_t)cidx * DRNN + ch0 + ct * 16 + l15] = (f32x2){aprod[ct], carry[ct]}; } }
    else {
        float* out = (float*)a.in[I_OUT + z];
        if ((cidx & 63) == 63) {
            const int bb = cidx >> 6;
            if (lane < 16) { for (int ct = 0; ct < 5; ++ct) out[O_H_P + (size_t)bb * DRNN + ch0 + ct * 16 + l15] = carry[ct]; }
            const bf16* Z = (const bf16*)(ws + WS_Z);
            for (int e = lane; e < 240; e += 64) { const int jj = e / 80, c = e - 80 * jj; out[O_CONV_P + (size_t)(bb * 3 + jj) * DRNN + ch0 + c] = bf2f(Z[(size_t)(bb * SEQ + SEQ - 3 + jj) * ZW + Z_XR + ch0 + c]); }
        }
        if (u < 16) {
            float c2[5], p2[5];
#pragma unroll
            for (int ct = 0; ct < 5; ++ct) { c2[ct] = 0.f; p2[ct] = 1.f; }
            lru_tile<PASS, true>(a, z, ws, lds, n, MP + 16 * wave, 0, lane, wave, gba, gbi, gsp, c2, p2, zwA);
        }
    }
}

constexpr int SA_QIMG = 0, SA_PITCH = 592, SA_KT = 16 * SA_PITCH;
constexpr int SA_SLOT = 66 * 64 * 4, SA_OLAT = 4 * SA_SLOT;
static_assert(SA_OLAT + 16 * 256 * 4 <= RING_BYTES, "decode attention LDS map");
__device__ __forceinline__ void sample_attn_half(const Args& a, LAS unsigned char* lds, int s, int half, int wv) {
    int z = 0; asm volatile("" : "+s"(z));
    int tid = TIDW(wv); asm volatile("" : "+v"(tid)); const int lane = tid & 63, wave = wv;
    unsigned char* ws = (unsigned char*)a.in[I_WS + z];
    const bf16* Qrow = (const bf16*)(ws + WS_Q) + (size_t)(MP + s) * QW;
    const bf16* BKV = (const bf16*)(ws + WS_BKV);
    __syncthreads();
    {
        LAS float* qs = (LAS float*)(lds + SA_KT);
        { const unsigned w = ((const unsigned*)Qrow)[tid]; qs[2 * tid] = bflo(w); qs[2 * tid + 1] = bfhi(w); }
        __syncthreads();
        const int r2 = (tid & 127) * 2, hg = tid >> 7;
#pragma unroll 1
        for (int hh = 0; hh < 4; ++hh) { const int hd = hg * 4 + hh; float a0 = 0.f, a1 = 0.f;
            unsigned wv_[64];
#pragma unroll
            for (int d = 0; d < 64; ++d) wv_[d] = *(const unsigned*)(BKV + (size_t)(hd * 64 + d) * KVL + r2);
#pragma unroll
            for (int d = 0; d < 64; ++d) { const float q = qs[hd * 64 + d]; a0 += q * bflo(wv_[d]); a1 += q * bfhi(wv_[d]); }
            *(LAS unsigned*)(lds + SA_QIMG + hd * SA_PITCH + r2 * 2) = pk2(a0, a1); }
        if ((tid & 31) < 16) { const int hd = tid >> 5, i = tid & 15;
          const float* cosT = (const float*)(ws + WS_ROPE); const float c = cosT[SEQ * 16 + i], sn = cosT[ROPE_TAB + SEQ * 16 + i];
          const float x1 = bf2f(Qrow[1024 + hd * 32 + i]), x2 = bf2f(Qrow[1024 + hd * 32 + 16 + i]);
          *(LAS bf16*)(lds + SA_QIMG + hd * SA_PITCH + (256 + i) * 2) = f2bf(x1 * c - x2 * sn);
          *(LAS bf16*)(lds + SA_QIMG + hd * SA_PITCH + (256 + 16 + i) * 2) = f2bf(x1 * sn + x2 * c); }
    }
    __syncthreads();
    const int g4 = lane >> 4, l15 = lane & 15;
    const LAS unsigned char* qfp = lds + SA_QIMG + l15 * SA_PITCH + 8 * g4 * 2;
    LAS unsigned char* kt = lds + SA_KT + wave * 9472;
    const unsigned ktb = (unsigned)(uintptr_t)kt;
    const int* pt = (const int*)a.in[I_PT + z] + s * NPAGES + half * 32 + wave * 4;
    const float* cckv = (const float*)a.in[I_CCKV + z]; const float* ckr = (const float*)a.in[I_CKR + z];
    float m_run = -1e30f, l_part = 0.f;
    f32x4 oacc[16];
#pragma unroll
    for (int i = 0; i < 16; ++i) oacc[i] = (f32x4){0.f, 0.f, 0.f, 0.f};
    f32x4 stA[18], stB[18];
#define SA_ISSUE(ST, tt) do { const int pid_ = pt[(tt) >> 3]; const float* kb_ = cckv + ((size_t)pid_ * PAGE + ((tt) & 7) * 16) * KVL; const float* rb_ = ckr + ((size_t)pid_ * PAGE + ((tt) & 7) * 16) * ROPE; \
        _Pragma("unroll") for (int i_ = 0; i_ < 16; ++i_) ST[i_] = __builtin_nontemporal_load((const f32x4*)(kb_ + i_ * KVL) + lane); \
        ST[16] = __builtin_nontemporal_load((const f32x4*)rb_ + lane); ST[17] = __builtin_nontemporal_load((const f32x4*)rb_ + 64 + lane); } while (0)
#define SA_TOLDS(ST) do { \
        _Pragma("unroll") for (int i = 0; i < 16; ++i) { u32x2 o; o.x = pk2(ST[i].x, ST[i].y); o.y = pk2(ST[i].z, ST[i].w); *(LAS u32x2*)(kt + i * SA_PITCH + lane * 8) = o; } \
        _Pragma("unroll") for (int k = 0; k < 2; ++k) { u32x2 o; o.x = pk2(ST[16 + k].x, ST[16 + k].y); o.y = pk2(ST[16 + k].z, ST[16 + k].w); *(LAS u32x2*)(kt + (8 * k + (lane >> 3)) * SA_PITCH + (256 + 4 * (lane & 7)) * 2) = o; } } while (0)
#define SA_COMPUTE(SELF) do { \
        LDS_WAIT(); \
        f32x4 sacc = {0.f, 0.f, 0.f, 0.f}; \
        _Pragma("unroll") for (int j = 0; j < 9; ++j) { const bf16x8 kf = *(const LAS bf16x8*)(kt + l15 * SA_PITCH + (32 * j + 8 * g4) * 2); const bf16x8 qfj = *(const LAS bf16x8*)(qfp + 64 * j); sacc = __builtin_amdgcn_mfma_f32_16x16x32_bf16(kf, qfj, sacc, 0, 0, 0); } \
        if (SELF) { _Pragma("unroll") for (int i = 0; i < 4; ++i) if (4 * g4 + i >= 1) sacc[i] = -__builtin_inff(); } \
        float mx = fmaxf(fmaxf(sacc[0], sacc[1]), fmaxf(sacc[2], sacc[3])); \
        mx = fmaxf(mx, __shfl_xor(mx, 16)); mx = fmaxf(mx, __shfl_xor(mx, 32)); \
        const float mn = fmaxf(m_run, mx), alpha = __builtin_amdgcn_exp2f(m_run - mn); \
        m_run = mn; \
        const float p0 = __builtin_amdgcn_exp2f(sacc[0] - mn), p1 = __builtin_amdgcn_exp2f(sacc[1] - mn), p2 = __builtin_amdgcn_exp2f(sacc[2] - mn), p3 = __builtin_amdgcn_exp2f(sacc[3] - mn); \
        l_part = l_part * alpha + ((p0 + p1) + (p2 + p3)); \
        u32x2 pw; pw.x = pk2(p0, p1); pw.y = pk2(p2, p3); \
        const s16x4 pb = __builtin_bit_cast(s16x4, pw); \
        const unsigned vaddr = ktb + (unsigned)((4 * g4 + (l15 >> 2)) * SA_PITCH + (l15 & 3) * 8); \
        _Pragma("unroll") for (int ct = 0; ct < 16; ++ct) { \
            s16x4 vf; \
            asm volatile("ds_read_b64_tr_b16 %0, %1 offset:%2" : "=v"(vf) : "v"(vaddr), "i"(ct * 32) : "memory"); \
            asm volatile("s_waitcnt lgkmcnt(0)" ::: "memory"); \
            oacc[ct] = oacc[ct] * alpha; \
            oacc[ct] = __builtin_amdgcn_mfma_f32_16x16x16bf16_1k(vf, pb, oacc[ct], 0, 0, 0); } } while (0)
    SA_ISSUE(stA, 0); SA_ISSUE(stB, 1);
#pragma unroll 1
    for (int tt = 0; tt < 32; tt += 2) {
        if (tt + 1 < 32) asm volatile("s_waitcnt vmcnt(18)" ::: "memory"); else VM_WAIT();
        asm volatile("" : "+v"(stA[0]), "+v"(stA[1]), "+v"(stA[2]), "+v"(stA[3]), "+v"(stA[4]), "+v"(stA[5]), "+v"(stA[6]), "+v"(stA[7]), "+v"(stA[8]));
        asm volatile("" : "+v"(stA[9]), "+v"(stA[10]), "+v"(stA[11]), "+v"(stA[12]), "+v"(stA[13]), "+v"(stA[14]), "+v"(stA[15]), "+v"(stA[16]), "+v"(stA[17]));
        SA_TOLDS(stA);
        if (tt + 2 < 32) SA_ISSUE(stA, tt + 2);
        SA_COMPUTE(false);
        if (tt + 2 < 32) asm volatile("s_waitcnt vmcnt(18)" ::: "memory"); else VM_WAIT();
        asm volatile("" : "+v"(stB[0]), "+v"(stB[1]), "+v"(stB[2]), "+v"(stB[3]), "+v"(stB[4]), "+v"(stB[5]), "+v"(stB[6]), "+v"(stB[7]), "+v"(stB[8]));
        asm volatile("" : "+v"(stB[9]), "+v"(stB[10]), "+v"(stB[11]), "+v"(stB[12]), "+v"(stB[13]), "+v"(stB[14]), "+v"(stB[15]), "+v"(stB[16]), "+v"(stB[17]));
        SA_TOLDS(stB);
        if (tt + 3 < 32) SA_ISSUE(stB, tt + 3);
        SA_COMPUTE(false);
    }
    if (half == 1 && wave == 7) {
        const bf16* ck = (const bf16*)(ws + WS_CKV) + (size_t)(MP + s) * KVL; const bf16* kr = (const bf16*)(ws + WS_KR) + (size_t)(MP + s) * ROPE;
#pragma unroll
        for (int i = 0; i < 16; ++i) { u32x2 o = {0u, 0u}; if (i == 0) o = ((const u32x2*)ck)[lane]; *(LAS u32x2*)(kt + i * SA_PITCH + lane * 8) = o; }
        if (lane < 32) { *(LAS bf16*)(kt + (256 + lane) * 2) = kr[lane]; }
        else { const int d = lane - 32; for (int i = 1; i < 16; ++i) *(LAS bf16*)(kt + i * SA_PITCH + (256 + d) * 2) = 0; }
        SA_COMPUTE(true);
    }
#undef SA_ISSUE
#undef SA_TOLDS
#undef SA_COMPUTE
    LAS float* slots = (LAS float*)lds;
#pragma unroll 1
    for (int half = 4; half >= 1; half >>= 1) {
        __syncthreads();
        if (wave >= half && wave < 2 * half) { LAS float* sl = slots + (size_t)(wave - half) * (SA_SLOT / 4);
#pragma unroll
            for (int ct = 0; ct < 16; ++ct) { sl[(4 * ct + 0) * 64 + lane] = oacc[ct][0]; sl[(4 * ct + 1) * 64 + lane] = oacc[ct][1]; sl[(4 * ct + 2) * 64 + lane] = oacc[ct][2]; sl[(4 * ct + 3) * 64 + lane] = oacc[ct][3]; }
            sl[64 * 64 + lane] = m_run; sl[65 * 64 + lane] = l_part; }
        __syncthreads();
        if (wave < half) { const LAS float* sl = slots + (size_t)wave * (SA_SLOT / 4);
            const float m2 = sl[64 * 64 + lane], l2 = sl[65 * 64 + lane];
            const float mn = fmaxf(m_run, m2), a1 = __builtin_amdgcn_exp2f(m_run - mn), a2 = __builtin_amdgcn_exp2f(m2 - mn);
            m_run = mn; l_part = a1 * l_part + a2 * l2;
#pragma unroll
            for (int ct = 0; ct < 16; ++ct) { oacc[ct][0] = a1 * oacc[ct][0] + a2 * sl[(4 * ct + 0) * 64 + lane]; oacc[ct][1] = a1 * oacc[ct][1] + a2 * sl[(4 * ct + 1) * 64 + lane];
                                             oacc[ct][2] = a1 * oacc[ct][2] + a2 * sl[(4 * ct + 2) * 64 + lane]; oacc[ct][3] = a1 * oacc[ct][3] + a2 * sl[(4 * ct + 3) * 64 + lane]; } }
    }
    if (wave == 0) {
        float* part = (float*)(ws + WS_PART) + (size_t)(s * 2 + half) * PART_STRIDE;
        float lsum = l_part; lsum += __shfl_xor(lsum, 16); lsum += __shfl_xor(lsum, 32);
#pragma unroll
        for (int ct = 0; ct < 16; ++ct) *(f32x4*)(part + l15 * 256 + ct * 16 + 4 * g4) = oacc[ct];
        if (g4 == 0) { part[4096 + l15] = m_run; part[4096 + 16 + l15] = lsum; }
    }
}
__device__ __forceinline__ void sample_attn_seq(const Args& a, LAS unsigned char* lds, int s, int wv) {
    int z = 0; asm volatile("" : "+s"(z));
    int tid = TIDW(wv); asm volatile("" : "+v"(tid)); const int lane = tid & 63, wave = wv;
    unsigned char* ws = (unsigned char*)a.in[I_WS + z];
    const bf16* Qrow = (const bf16*)(ws + WS_Q) + (size_t)(MP + s) * QW;
    const bf16* BKV = (const bf16*)(ws + WS_BKV);
    __syncthreads();
    {
        LAS float* qs = (LAS float*)(lds + SA_KT);
        { const unsigned w = ((const unsigned*)Qrow)[tid]; qs[2 * tid] = bflo(w); qs[2 * tid + 1] = bfhi(w); }
        __syncthreads();
        const int r2 = (tid & 127) * 2, hg = tid >> 7;
#pragma unroll 1
        for (int hh = 0; hh < 4; ++hh) { const int hd = hg * 4 + hh; float a0 = 0.f, a1 = 0.f;
            unsigned wv_[64];
#pragma unroll
            for (int d = 0; d < 64; ++d) wv_[d] = *(const unsigned*)(BKV + (size_t)(hd * 64 + d) * KVL + r2);
#pragma unroll
            for (int d = 0; d < 64; ++d) { const float q = qs[hd * 64 + d]; a0 += q * bflo(wv_[d]); a1 += q * bfhi(wv_[d]); }
            *(LAS unsigned*)(lds + SA_QIMG + hd * SA_PITCH + r2 * 2) = pk2(a0, a1); }
        if ((tid & 31) < 16) { const int hd = tid >> 5, i = tid & 15;
          const float* cosT = (const float*)(ws + WS_ROPE); const float c = cosT[SEQ * 16 + i], sn = cosT[ROPE_TAB + SEQ * 16 + i];
          const float x1 = bf2f(Qrow[1024 + hd * 32 + i]), x2 = bf2f(Qrow[1024 + hd * 32 + 16 + i]);
          *(LAS bf16*)(lds + SA_QIMG + hd * SA_PITCH + (256 + i) * 2) = f2bf(x1 * c - x2 * sn);
          *(LAS bf16*)(lds + SA_QIMG + hd * SA_PITCH + (256 + 16 + i) * 2) = f2bf(x1 * sn + x2 * c); }
    }
    __syncthreads();
    const int g4 = lane >> 4, l15 = lane & 15;
    const LAS unsigned char* qfp = lds + SA_QIMG + l15 * SA_PITCH + 8 * g4 * 2;
    LAS unsigned char* kt = lds + SA_KT + wave * 9472;
    const unsigned ktb = (unsigned)(uintptr_t)kt;
    const int* pt = (const int*)a.in[I_PT + z] + s * NPAGES + wave * 8;
    const float* cckv = (const float*)a.in[I_CCKV + z]; const float* ckr = (const float*)a.in[I_CKR + z];
    float m_run = -1e30f, l_part = 0.f;
    f32x4 oacc[16];
#pragma unroll
    for (int i = 0; i < 16; ++i) oacc[i] = (f32x4){0.f, 0.f, 0.f, 0.f};
    f32x4 stA[18], stB[18];
#define SA_ISSUE(ST, tt) do { const int pid_ = pt[(tt) >> 3]; const float* kb_ = cckv + ((size_t)pid_ * PAGE + ((tt) & 7) * 16) * KVL; const float* rb_ = ckr + ((size_t)pid_ * PAGE + ((tt) & 7) * 16) * ROPE; \
        _Pragma("unroll") for (int i_ = 0; i_ < 16; ++i_) ST[i_] = __builtin_nontemporal_load((const f32x4*)(kb_ + i_ * KVL) + lane); \
        ST[16] = __builtin_nontemporal_load((const f32x4*)rb_ + lane); ST[17] = __builtin_nontemporal_load((const f32x4*)rb_ + 64 + lane); } while (0)
#define SA_TOLDS(ST) do { \
        _Pragma("unroll") for (int i = 0; i < 16; ++i) { u32x2 o; o.x = pk2(ST[i].x, ST[i].y); o.y = pk2(ST[i].z, ST[i].w); *(LAS u32x2*)(kt + i * SA_PITCH + lane * 8) = o; } \
        _Pragma("unroll") for (int k = 0; k < 2; ++k) { u32x2 o; o.x = pk2(ST[16 + k].x, ST[16 + k].y); o.y = pk2(ST[16 + k].z, ST[16 + k].w); *(LAS u32x2*)(kt + (8 * k + (lane >> 3)) * SA_PITCH + (256 + 4 * (lane & 7)) * 2) = o; } } while (0)
#define SA_TR4(base_) do { \
        asm volatile("ds_read_b64_tr_b16 %0, %4 offset:%5\n\tds_read_b64_tr_b16 %1, %4 offset:%6\n\tds_read_b64_tr_b16 %2, %4 offset:%7\n\tds_read_b64_tr_b16 %3, %4 offset:%8\n\ts_waitcnt lgkmcnt(0)" \
                     : "=&v"(vf[0]), "=&v"(vf[1]), "=&v"(vf[2]), "=&v"(vf[3]) \
                     : "v"(vaddr), "i"(((base_) + 0) * 32), "i"(((base_) + 1) * 32), "i"(((base_) + 2) * 32), "i"(((base_) + 3) * 32) : "memory"); \
        _Pragma("unroll") for (int c_ = 0; c_ < 4; ++c_) oacc[(base_) + c_] = __builtin_amdgcn_mfma_f32_16x16x16bf16_1k(vf[c_], pb, oacc[(base_) + c_], 0, 0, 0); } while (0)
#define SA_COMPUTE(SELF) do { \
        LDS_WAIT(); \
        f32x4 sacc = {0.f, 0.f, 0.f, 0.f}; \
        _Pragma("unroll") for (int j = 0; j < 9; ++j) { const bf16x8 kf = *(const LAS bf16x8*)(kt + l15 * SA_PITCH + (32 * j + 8 * g4) * 2); const bf16x8 qfj = *(const LAS bf16x8*)(qfp + 64 * j); sacc = __builtin_amdgcn_mfma_f32_16x16x32_bf16(kf, qfj, sacc, 0, 0, 0); } \
        if (SELF) { _Pragma("unroll") for (int i = 0; i < 4; ++i) if (4 * g4 + i >= 1) sacc[i] = -__builtin_inff(); } \
        float mx = fmaxf(fmaxf(sacc[0], sacc[1]), fmaxf(sacc[2], sacc[3])); \
        { auto r_ = __builtin_amdgcn_permlane16_swap(__float_as_uint(mx), __float_as_uint(mx), false, false); mx = fmaxf(__uint_as_float(r_[0]), __uint_as_float(r_[1])); } \
        { auto r_ = __builtin_amdgcn_permlane32_swap(__float_as_uint(mx), __float_as_uint(mx), false, false); mx = fmaxf(__uint_as_float(r_[0]), __uint_as_float(r_[1])); } \
        if (__builtin_expect(__any(mx > m_run + 8.f), 0)) { const float mn = fmaxf(m_run, mx), alpha = __builtin_amdgcn_exp2f(m_run - mn); m_run = mn; l_part *= alpha; \
            _Pragma("unroll") for (int ct = 0; ct < 16; ++ct) oacc[ct] = oacc[ct] * alpha; } \
        const float p0 = __builtin_amdgcn_exp2f(sacc[0] - m_run), p1 = __builtin_amdgcn_exp2f(sacc[1] - m_run), p2 = __builtin_amdgcn_exp2f(sacc[2] - m_run), p3 = __builtin_amdgcn_exp2f(sacc[3] - m_run); \
        l_part += (p0 + p1) + (p2 + p3); \
        u32x2 pw; pw.x = pk2(p0, p1); pw.y = pk2(p2, p3); \
        const s16x4 pb = __builtin_bit_cast(s16x4, pw); \
        const unsigned vaddr = ktb + (unsigned)((4 * g4 + (l15 >> 2)) * SA_PITCH + (l15 & 3) * 8); \
        s16x4 vf[4]; SA_TR4(0); SA_TR4(4); SA_TR4(8); SA_TR4(12); } while (0)
    SA_ISSUE(stA, 0); SA_ISSUE(stB, 1);
#pragma unroll 1
    for (int tt = 0; tt < 64; tt += 2) {
        if (tt + 1 < 64) asm volatile("s_waitcnt vmcnt(18)" ::: "memory"); else VM_WAIT();
        asm volatile("" : "+v"(stA[0]), "+v"(stA[1]), "+v"(stA[2]), "+v"(stA[3]), "+v"(stA[4]), "+v"(stA[5]), "+v"(stA[6]), "+v"(stA[7]), "+v"(stA[8]));
        asm volatile("" : "+v"(stA[9]), "+v"(stA[10]), "+v"(stA[11]), "+v"(stA[12]), "+v"(stA[13]), "+v"(stA[14]), "+v"(stA[15]), "+v"(stA[16]), "+v"(stA[17]));
        SA_TOLDS(stA);
        if (tt + 2 < 64) SA_ISSUE(stA, tt + 2);
        SA_COMPUTE(false);
        if (tt + 2 < 64) asm volatile("s_waitcnt vmcnt(18)" ::: "memory"); else VM_WAIT();
        asm volatile("" : "+v"(stB[0]), "+v"(stB[1]), "+v"(stB[2]), "+v"(stB[3]), "+v"(stB[4]), "+v"(stB[5]), "+v"(stB[6]), "+v"(stB[7]), "+v"(stB[8]));
        asm volatile("" : "+v"(stB[9]), "+v"(stB[10]), "+v"(stB[11]), "+v"(stB[12]), "+v"(stB[13]), "+v"(stB[14]), "+v"(stB[15]), "+v"(stB[16]), "+v"(stB[17]));
        SA_TOLDS(stB);
        if (tt + 3 < 64) SA_ISSUE(stB, tt + 3);
        SA_COMPUTE(false);
    }
    if (wave == 7) {
        const bf16* ck = (const bf16*)(ws + WS_CKV) + (size_t)(MP + s) * KVL; const bf16* kr = (const bf16*)(ws + WS_KR) + (size_t)(MP + s) * ROPE;
#pragma unroll
        for (int i = 0; i < 16; ++i) { u32x2 o = {0u, 0u}; if (i == 0) o = ((const u32x2*)ck)[lane]; *(LAS u32x2*)(kt + i * SA_PITCH + lane * 8) = o; }
        if (lane < 32) { *(LAS bf16*)(kt + (256 + lane) * 2) = kr[lane]; }
        else { const int d = lane - 32; for (int i = 1; i < 16; ++i) *(LAS bf16*)(kt + i * SA_PITCH + (256 + d) * 2) = 0; }
        SA_COMPUTE(true);
    }
#undef SA_ISSUE
#undef SA_TOLDS
#undef SA_COMPUTE
#undef SA_TR4
    LAS float* slots = (LAS float*)lds;
#pragma unroll 1
    for (int half = 4; half >= 1; half >>= 1) {
        __syncthreads();
        if (wave >= half && wave < 2 * half) { LAS float* sl = slots + (size_t)(wave - half) * (SA_SLOT / 4);
#pragma unroll
            for (int ct = 0; ct < 16; ++ct) { sl[(4 * ct + 0) * 64 + lane] = oacc[ct][0]; sl[(4 * ct + 1) * 64 + lane] = oacc[ct][1]; sl[(4 * ct + 2) * 64 + lane] = oacc[ct][2]; sl[(4 * ct + 3) * 64 + lane] = oacc[ct][3]; }
            sl[64 * 64 + lane] = m_run; sl[65 * 64 + lane] = l_part; }
        __syncthreads();
        if (wave < half) { const LAS float* sl = slots + (size_t)wave * (SA_SLOT / 4);
            const float m2 = sl[64 * 64 + lane], l2 = sl[65 * 64 + lane];
            const float mn = fmaxf(m_run, m2), a1 = __builtin_amdgcn_exp2f(m_run - mn), a2 = __builtin_amdgcn_exp2f(m2 - mn);
            m_run = mn; l_part = a1 * l_part + a2 * l2;
#pragma unroll
            for (int ct = 0; ct < 16; ++ct) { oacc[ct][0] = a1 * oacc[ct][0] + a2 * sl[(4 * ct + 0) * 64 + lane]; oacc[ct][1] = a1 * oacc[ct][1] + a2 * sl[(4 * ct + 1) * 64 + lane];
                                             oacc[ct][2] = a1 * oacc[ct][2] + a2 * sl[(4 * ct + 2) * 64 + lane]; oacc[ct][3] = a1 * oacc[ct][3] + a2 * sl[(4 * ct + 3) * 64 + lane]; } }
    }
    LAS float* olat = (LAS float*)(lds + SA_OLAT);
    if (wave == 0) {
        float lsum = l_part; lsum += __shfl_xor(lsum, 16); lsum += __shfl_xor(lsum, 32);
        const float il = 1.f / lsum;
#pragma unroll
        for (int ct = 0; ct < 16; ++ct) *(LAS f32x4*)(olat + l15 * 256 + ct * 16 + 4 * g4) = oacc[ct] * il;
    }
    __syncthreads();
    {
        const int hd = tid >> 5, v0 = (tid & 31) * 2;
        const bf16* B = BKV + (size_t)(1024 + hd * 64 + v0) * KVL;
        float a0 = 0.f, a1 = 0.f;
#pragma unroll 8
        for (int r = 0; r < 256; r += 8) { const u32x4 w0 = *(const u32x4*)(B + r), w1 = *(const u32x4*)(B + KVL + r);
            const f32x4 x0 = *(const LAS f32x4*)(olat + hd * 256 + r), x1 = *(const LAS f32x4*)(olat + hd * 256 + r + 4);
            a0 += x0.x * bflo(w0.x) + x0.y * bfhi(w0.x) + x0.z * bflo(w0.y) + x0.w * bfhi(w0.y) + x1.x * bflo(w0.z) + x1.y * bfhi(w0.z) + x1.z * bflo(w0.w) + x1.w * bfhi(w0.w);
            a1 += x0.x * bflo(w1.x) + x0.y * bfhi(w1.x) + x0.z * bflo(w1.y) + x0.w * bfhi(w1.y) + x1.x * bflo(w1.z) + x1.y * bfhi(w1.z) + x1.z * bflo(w1.w) + x1.w * bfhi(w1.w); }
        *(unsigned*)((bf16*)(ws + WS_OB) + (size_t)(MP + s) * DM + hd * 64 + v0) = pk2(a0, a1);
    }
}
__device__ __forceinline__ void sample_combine(const Args& a, LAS unsigned char* lds, int s, int wv) {
    int z = 0; asm volatile("" : "+s"(z));
    int tid = TIDW(wv); asm volatile("" : "+v"(tid));
    unsigned char* ws = (unsigned char*)a.in[I_WS + z];
    const float* part = (const float*)(ws + WS_PART) + (size_t)s * 2 * PART_STRIDE;
    LAS float* olat = (LAS float*)lds;
    __syncthreads();
    {
        const int hd = tid >> 5, cg = (tid & 31) * 8;
        const float m0 = part[4096 + hd], m1 = part[PART_STRIDE + 4096 + hd], mmax = fmaxf(m0, m1);
        const float w0 = __builtin_amdgcn_exp2f(m0 - mmax), w1 = __builtin_amdgcn_exp2f(m1 - mmax);
        const float il = 1.f / (w0 * part[4096 + 16 + hd] + w1 * part[PART_STRIDE + 4096 + 16 + hd]);
        const f32x4 o0 = (*(const f32x4*)(part + hd * 256 + cg) * w0 + *(const f32x4*)(part + PART_STRIDE + hd * 256 + cg) * w1) * il;
        const f32x4 o1 = (*(const f32x4*)(part + hd * 256 + cg + 4) * w0 + *(const f32x4*)(part + PART_STRIDE + hd * 256 + cg + 4) * w1) * il;
        *(LAS f32x4*)(olat + hd * 256 + cg) = o0; *(LAS f32x4*)(olat + hd * 256 + cg + 4) = o1;
    }
    __syncthreads();
    {
        const int hd = tid >> 5, v0 = (tid & 31) * 2;
        const bf16* B = (const bf16*)(ws + WS_BKV) + (size_t)(1024 + hd * 64 + v0) * KVL;
        float a0 = 0.f, a1 = 0.f;
#pragma unroll 8
        for (int r = 0; r < 256; r += 8) { const u32x4 w0 = *(const u32x4*)(B + r), w1 = *(const u32x4*)(B + KVL + r);
            const f32x4 x0 = *(const LAS f32x4*)(olat + hd * 256 + r), x1 = *(const LAS f32x4*)(olat + hd * 256 + r + 4);
            a0 += x0.x * bflo(w0.x) + x0.y * bfhi(w0.x) + x0.z * bflo(w0.y) + x0.w * bfhi(w0.y) + x1.x * bflo(w0.z) + x1.y * bfhi(w0.z) + x1.z * bflo(w0.w) + x1.w * bfhi(w0.w);
            a1 += x0.x * bflo(w1.x) + x0.y * bfhi(w1.x) + x0.z * bflo(w1.y) + x0.w * bfhi(w1.y) + x1.x * bflo(w1.z) + x1.y * bfhi(w1.z) + x1.z * bflo(w1.w) + x1.w * bfhi(w1.w); }
        *(unsigned*)((bf16*)(ws + WS_OB) + (size_t)(MP + s) * DM + hd * 64 + v0) = pk2(a0, a1);
    }
}

namespace pattn4 {
constexpr int NKS = 4, NVS = 4, KSLOT = 12288, VSLOT = 8192;
constexpr int LDS_K = 0, LDS_V = NKS * KSLOT, LDS_WS = LDS_V + NVS * VSLOT, LDS_OST = LDS_WS + 8 * 256, LDS_TOTAL = LDS_OST + 8 * 4096;
static_assert(LDS_TOTAL <= RING_BYTES, "attention LDS map");
constexpr float THR = 8.f;
#define SBAR() __builtin_amdgcn_sched_barrier(0)
#define SGB(mask, n) __builtin_amdgcn_sched_group_barrier(mask, n, 0)
#define WAIT_BAR(N) do { if constexpr (VAR & 4) asm volatile("s_waitcnt vmcnt(" #N ") lgkmcnt(0)" ::: "memory"); else asm volatile("s_waitcnt vmcnt(" #N ") lgkmcnt(0)\n\ts_barrier" ::: "memory"); } while (0)
__device__ __forceinline__ int crow(int r, int hi) { return (r & 3) + 8 * (r >> 2) + 4 * hi; }
__device__ __forceinline__ void mask_tile(f32x16& p0, f32x16& p1, int dq) {
    const float NEG = -__builtin_inff();
#pragma unroll
    for (int r = 0; r < 16; ++r) { const int c = (r & 3) + 8 * (r >> 2); if (dq - c < 0) p0[r] = NEG; if (dq - c - 32 < 0) p1[r] = NEG; }
}
template <int VAR> __device__ __forceinline__ void block(const bf16* Q, const bf16* KVB, const bf16* KR, const float* cosT, bf16* OB, LAS unsigned char* lds, int b, int h, int qb, int t0, int wv,
                                                   bool primed, bool has_next, int nb_, int nh_, int nqb_, bf16x8 (&qr)[6]) {
    int tid = TIDW(wv); asm volatile("" : "+v"(tid));
    const int wid = wv, lane = tid & 63, r32 = lane & 31, hi = lane >> 5;
    const int NT = 4 * (qb + 1);
    const int P0 = qb * 256, qlo = P0 + wid * 32, qm = qlo + r32 - 4 * hi;
    LAS float* wsf = (LAS float*)(lds + LDS_WS) + wid * 64; LAS float* li_l = wsf; LAS float* al_l = wsf + 32;
    const size_t rowbase = (size_t)b * SEQ;
    const bf16* ksrc = KVB + (rowbase + (wid & 3) * 16 + (lane & 15)) * KVW + h * 64 + ((wid >> 2) * 4 + (lane >> 4)) * 8;
    const bf16* rsrc = KR + (rowbase + (wid & 3) * 16 + (lane & 15)) * ROPE + (lane >> 4) * 8;
    const bf16* vsrc = KVB + (rowbase + 16 * (wid & 3) + (lane >> 2)) * KVW + 1024 + h * 64 + (wid >> 2) * 32 + (lane & 3) * 8;
    LAS unsigned char* kdst = lds + LDS_K + (wid & 3) * 3072 + (wid >> 2) * 1024; LAS unsigned char* rdst = lds + LDS_K + (wid & 3) * 3072 + 2048; LAS unsigned char* vdst = lds + LDS_V + wid * 1024;
#define TT(i_) (((i_) + t0 < NT) ? (i_) + t0 : (i_) + t0 - NT)
#define DMA_K(t, slot) do { if constexpr ((VAR & 16) != 0) break; __builtin_amdgcn_global_load_lds((const unsigned*)(ksrc + (size_t)TT(t) * 64 * KVW), (LAS unsigned*)(kdst + (slot) * KSLOT), 16, 0, 0); \
                            __builtin_amdgcn_global_load_lds((const unsigned*)(rsrc + (size_t)TT(t) * 64 * ROPE), (LAS unsigned*)(rdst + (slot) * KSLOT), 16, 0, 0); } while (0)
#define DMA_V(t, slot) do { if constexpr ((VAR & 16) == 0) __builtin_amdgcn_global_load_lds((const unsigned*)(vsrc + (size_t)TT(t) * 64 * KVW), (LAS unsigned*)(vdst + (slot) * VSLOT), 16, 0, 0); } while (0)
    const LAS unsigned char* kb0 = lds + LDS_K + (r32 >> 4) * 3072 + (r32 & 15) * 16 + hi * 256;
    const int vb0 = (int)(uintptr_t)(lds + LDS_V) + ((lane >> 4) & 1) * 32 + (lane & 3) * 8 + (4 * hi + ((lane & 15) >> 2)) * 64;
    float m_reg = 0.f, l_reg = 0.f; f32x16 o[2] = {}; f32x16 negm = f32x16{};
#define PRIME(bb_, hh_, qq_) do { const size_t rb_ = (size_t)(bb_) * SEQ; \
        const bf16* ks_ = KVB + (rb_ + (wid & 3) * 16 + (lane & 15)) * KVW + (hh_) * 64 + ((wid >> 2) * 4 + (lane >> 4)) * 8; \
        const bf16* rs_ = KR + (rb_ + (wid & 3) * 16 + (lane & 15)) * ROPE + (lane >> 4) * 8; \
        const bf16* vs_ = KVB + (rb_ + 16 * (wid & 3) + (lane >> 2)) * KVW + 1024 + (hh_) * 64 + (wid >> 2) * 32 + (lane & 3) * 8; \
        if constexpr ((VAR & 16) == 0) { _Pragma("unroll") for (int t_ = 0; t_ < 3; ++t_) { \
            __builtin_amdgcn_global_load_lds((const unsigned*)(ks_ + (size_t)t_ * 64 * KVW), (LAS unsigned*)(kdst + t_ * KSLOT), 16, 0, 0); \
            __builtin_amdgcn_global_load_lds((const unsigned*)(rs_ + (size_t)t_ * 64 * ROPE), (LAS unsigned*)(rdst + t_ * KSLOT), 16, 0, 0); \
            if (t_ < 2) __builtin_amdgcn_global_load_lds((const unsigned*)(vs_ + (size_t)t_ * 64 * KVW), (LAS unsigned*)(vdst + t_ * VSLOT), 16, 0, 0); } } \
        const bf16* qrow_ = Q + (rb_ + (qq_) * 256 + wid * 32 + r32) * QW; \
        _Pragma("unroll") for (int d0 = 0; d0 < 4; ++d0) qr[d0] = *(const bf16x8*)(qrow_ + (hh_) * 64 + d0 * 16 + hi * 8); \
        _Pragma("unroll") for (int d0 = 4; d0 < 6; ++d0) qr[d0] = *(const bf16x8*)(qrow_ + 1024 + (hh_) * 32 + (d0 - 4) * 16 + hi * 8); } while (0)
    if (!primed) PRIME(b, h, qb);
    bf16x8 kf[12];
#define KLOAD(slot) do { const LAS unsigned char* kb_ = kb0 + (slot) * KSLOT; _Pragma("unroll") for (int d0 = 0; d0 < 6; ++d0) { kf[2 * d0] = *(const LAS bf16x8*)(kb_ + d0 * 512); kf[2 * d0 + 1] = *(const LAS bf16x8*)(kb_ + d0 * 512 + 6144); } } while (0)
#define QK(P0_, P1_) do { if constexpr ((VAR & 32) != 0) { P0_ = negm; P1_ = negm; P0_[0] += __builtin_bit_cast(float, (int)kf[0][0] + (int)kf[11][1]); } else if constexpr ((VAR & 2) != 0) { P0_ = negm; P1_ = negm; _Pragma("unroll") for (int d0 = 0; d0 < 12; ++d0) { P0_[d0] += (float)kf[d0][0]; P1_[d0] += (float)kf[d0][1]; } } else { P0_ = __builtin_amdgcn_mfma_f32_32x32x16_bf16(kf[0], qr[0], negm, 0, 0, 0); P1_ = __builtin_amdgcn_mfma_f32_32x32x16_bf16(kf[1], qr[0], negm, 0, 0, 0); \
        _Pragma("unroll") for (int d0 = 1; d0 < 6; ++d0) { P0_ = __builtin_amdgcn_mfma_f32_32x32x16_bf16(kf[2 * d0], qr[d0], P0_, 0, 0, 0); P1_ = __builtin_amdgcn_mfma_f32_32x32x16_bf16(kf[2 * d0 + 1], qr[d0], P1_, 0, 0, 0); } } } while (0)
#define RESC(al) do { if (__any((al) < 1.f)) { if (hi == 0) al_l[r32] = (al); asm volatile("s_waitcnt lgkmcnt(0)" ::: "memory"); \
        _Pragma("unroll") for (int d_ = 0; d_ < 2; ++d_) _Pragma("unroll") for (int r = 0; r < 16; ++r) o[d_][r] *= al_l[crow(r, hi)]; } } while (0)
#define MASKT(P0_, P1_, t) do { const int kbm_ = TT(t) * 64; if (kbm_ + 63 > qlo) mask_tile(P0_, P1_, qm - kbm_); } while (0)
#define ROWMAX(P0_, P1_, pm_) do { float m0_ = fmaxf(P0_[0], P1_[0]), m1_ = fmaxf(P0_[1], P1_[1]), m2_ = fmaxf(P0_[2], P1_[2]), m3_ = fmaxf(P0_[3], P1_[3]); \
        _Pragma("unroll") for (int r = 4; r < 16; r += 4) { m0_ = fmaxf(fmaxf(m0_, P0_[r]), P1_[r]); m1_ = fmaxf(fmaxf(m1_, P0_[r + 1]), P1_[r + 1]); m2_ = fmaxf(fmaxf(m2_, P0_[r + 2]), P1_[r + 2]); m3_ = fmaxf(fmaxf(m3_, P0_[r + 3]), P1_[r + 3]); } \
        pm_ = fmaxf(fmaxf(m0_, m1_), fmaxf(m2_, m3_)); \
        auto rr_ = __builtin_amdgcn_permlane32_swap(__float_as_uint(pm_), __float_as_uint(pm_), false, false); pm_ = fmaxf(__uint_as_float(rr_[0]), __uint_as_float(rr_[1])); } while (0)
#define SHIFT(P0_, P1_, dl_) do { m_reg += (dl_); _Pragma("unroll") for (int r = 0; r < 16; ++r) { P0_[r] -= (dl_); P1_[r] -= (dl_); } _Pragma("unroll") for (int r = 0; r < 16; ++r) negm[r] = -m_reg; } while (0)
#define EXP16(P_) do { if constexpr ((VAR & 1) == 0) { _Pragma("unroll") for (int r = 0; r < 16; ++r) P_[r] = __builtin_amdgcn_exp2f(P_[r]); } } while (0)
#define PACKP(P0_, P1_) do { \
        { u32x4 w_ = {pk2(P0_[0], P0_[1]), pk2(P0_[2], P0_[3]), pk2(P0_[4], P0_[5]), pk2(P0_[6], P0_[7])}; pa0 = __builtin_bit_cast(bf16x8, w_); } \
        { u32x4 w_ = {pk2(P0_[8], P0_[9]), pk2(P0_[10], P0_[11]), pk2(P0_[12], P0_[13]), pk2(P0_[14], P0_[15])}; pa1 = __builtin_bit_cast(bf16x8, w_); } \
        { u32x4 w_ = {pk2(P1_[0], P1_[1]), pk2(P1_[2], P1_[3]), pk2(P1_[4], P1_[5]), pk2(P1_[6], P1_[7])}; pa2 = __builtin_bit_cast(bf16x8, w_); } \
        { u32x4 w_ = {pk2(P1_[8], P1_[9]), pk2(P1_[10], P1_[11]), pk2(P1_[12], P1_[13]), pk2(P1_[14], P1_[15])}; pa3 = __builtin_bit_cast(bf16x8, w_); } } while (0)
#define SOFTMAX2(P0_, P1_, al_) do { EXP16(P1_); float ps_ = 0.f; _Pragma("unroll") for (int r = 0; r < 16; ++r) ps_ += P0_[r] + P1_[r]; \
        auto rr_ = __builtin_amdgcn_permlane32_swap(__float_as_uint(ps_), __float_as_uint(ps_), false, false); ps_ = __uint_as_float(rr_[0]) + __uint_as_float(rr_[1]); \
        l_reg = l_reg * (al_) + ps_; PACKP(P0_, P1_); } while (0)
    s16x4 vl[8], vh[8];
#define TRRD(dst, off) asm volatile("ds_read_b64_tr_b16 %0, %1 offset:%2" : "=&v"(dst) : "v"(vb_), "i"(off) : "memory")
#define VREAD(slot) do { const int vb_ = vb0 + (slot) * VSLOT; \
        TRRD(vl[0], 0); TRRD(vh[0], 512); TRRD(vl[1], 1024); TRRD(vh[1], 1536); TRRD(vl[2], 2048); TRRD(vh[2], 2560); TRRD(vl[3], 3072); TRRD(vh[3], 3584); \
        TRRD(vl[4], 4096); TRRD(vh[4], 4608); TRRD(vl[5], 5120); TRRD(vh[5], 5632); TRRD(vl[6], 6144); TRRD(vh[6], 6656); TRRD(vl[7], 7168); TRRD(vh[7], 7680); } while (0)
#define VF(i) (bf16x8){vl[i][0], vl[i][1], vl[i][2], vl[i][3], vh[i][0], vh[i][1], vh[i][2], vh[i][3]}
#define PVALL() do { if constexpr ((VAR & 32) != 0) { o[0][0] += (float)vl[0][0] + (float)vh[7][1] + (float)pa0[0] + (float)pa3[1]; } else if constexpr ((VAR & 8) != 0) { PVH(0); PVH(1); } else { \
        o[0] = __builtin_amdgcn_mfma_f32_32x32x16_bf16(pa0, VF(0), o[0], 0, 0, 0); o[1] = __builtin_amdgcn_mfma_f32_32x32x16_bf16(pa0, VF(4), o[1], 0, 0, 0); \
        o[0] = __builtin_amdgcn_mfma_f32_32x32x16_bf16(pa1, VF(1), o[0], 0, 0, 0); o[1] = __builtin_amdgcn_mfma_f32_32x32x16_bf16(pa1, VF(5), o[1], 0, 0, 0); \
        o[0] = __builtin_amdgcn_mfma_f32_32x32x16_bf16(pa2, VF(2), o[0], 0, 0, 0); o[1] = __builtin_amdgcn_mfma_f32_32x32x16_bf16(pa2, VF(6), o[1], 0, 0, 0); \
        o[0] = __builtin_amdgcn_mfma_f32_32x32x16_bf16(pa3, VF(3), o[0], 0, 0, 0); o[1] = __builtin_amdgcn_mfma_f32_32x32x16_bf16(pa3, VF(7), o[1], 0, 0, 0); } } while (0)
#define PVH(d0) do { if constexpr ((VAR & 8) != 0) { _Pragma("unroll") for (int e_ = 0; e_ < 4; ++e_) { o[d0][e_] += (float)vl[4 * (d0) + e_][0] + (float)vh[4 * (d0) + e_][1] + (float)pa0[e_] + (float)pa1[e_] + (float)pa2[e_] + (float)pa3[e_]; } } else { o[d0] = __builtin_amdgcn_mfma_f32_32x32x16_bf16(pa0, VF(4 * (d0) + 0), o[d0], 0, 0, 0); o[d0] = __builtin_amdgcn_mfma_f32_32x32x16_bf16(pa1, VF(4 * (d0) + 1), o[d0], 0, 0, 0); \
        o[d0] = __builtin_amdgcn_mfma_f32_32x32x16_bf16(pa2, VF(4 * (d0) + 2), o[d0], 0, 0, 0); o[d0] = __builtin_amdgcn_mfma_f32_32x32x16_bf16(pa3, VF(4 * (d0) + 3), o[d0], 0, 0, 0); } } while (0)
    f32x16 px0, px1; bf16x8 pa0, pa1, pa2, pa3;
#define TILE_VALU(al_) bf16x8 pn0, pn1, pn2, pn3; do { EXP16(px0); EXP16(px1); float s0_ = px0[0] + px1[0], s1_ = px0[1] + px1[1], s2_ = px0[2] + px1[2], s3_ = px0[3] + px1[3]; \
        _Pragma("unroll") for (int r = 4; r < 16; r += 4) { s0_ += px0[r] + px1[r]; s1_ += px0[r + 1] + px1[r + 1]; s2_ += px0[r + 2] + px1[r + 2]; s3_ += px0[r + 3] + px1[r + 3]; } \
        float ps_ = (s0_ + s1_) + (s2_ + s3_); \
        auto rr_ = __builtin_amdgcn_permlane32_swap(__float_as_uint(ps_), __float_as_uint(ps_), false, false); ps_ = __uint_as_float(rr_[0]) + __uint_as_float(rr_[1]); \
        l_reg = l_reg * (al_) + ps_; \
        { u32x4 w_ = {pk2(px0[0], px0[1]), pk2(px0[2], px0[3]), pk2(px0[4], px0[5]), pk2(px0[6], px0[7])}; pn0 = __builtin_bit_cast(bf16x8, w_); } \
        { u32x4 w_ = {pk2(px0[8], px0[9]), pk2(px0[10], px0[11]), pk2(px0[12], px0[13]), pk2(px0[14], px0[15])}; pn1 = __builtin_bit_cast(bf16x8, w_); } \
        { u32x4 w_ = {pk2(px1[0], px1[1]), pk2(px1[2], px1[3]), pk2(px1[4], px1[5]), pk2(px1[6], px1[7])}; pn2 = __builtin_bit_cast(bf16x8, w_); } \
        { u32x4 w_ = {pk2(px1[8], px1[9]), pk2(px1[10], px1[11]), pk2(px1[12], px1[13]), pk2(px1[14], px1[15])}; pn3 = __builtin_bit_cast(bf16x8, w_); } } while (0)
    if (primed) { WAIT_BAR(4); } else { WAIT_BAR(0); }
    asm volatile("" : "+v"(qr[0]), "+v"(qr[1]), "+v"(qr[2]), "+v"(qr[3]), "+v"(qr[4]), "+v"(qr[5]));
    {
        const float* ct_ = cosT + (size_t)(P0 + wid * 32 + r32) * 16 + 8 * hi; const float* st_ = ct_ + ROPE_TAB;
        const f32x4 c0 = *(const f32x4*)ct_, c1 = *(const f32x4*)(ct_ + 4), s0 = *(const f32x4*)st_, s1 = *(const f32x4*)(st_ + 4);
        const u32x4 w1 = __builtin_bit_cast(u32x4, qr[4]), w2 = __builtin_bit_cast(u32x4, qr[5]);
        const f32x4 x1a = {bflo(w1.x), bfhi(w1.x), bflo(w1.y), bfhi(w1.y)}, x1b = {bflo(w1.z), bfhi(w1.z), bflo(w1.w), bfhi(w1.w)};
        const f32x4 x2a = {bflo(w2.x), bfhi(w2.x), bflo(w2.y), bfhi(w2.y)}, x2b = {bflo(w2.z), bfhi(w2.z), bflo(w2.w), bfhi(w2.w)};
        const f32x4 o1a = x1a * c0 - x2a * s0, o1b = x1b * c1 - x2b * s1, o2a = x1a * s0 + x2a * c0, o2b = x1b * s1 + x2b * c1;
        u32x4 r1 = {pk2(o1a.x, o1a.y), pk2(o1a.z, o1a.w), pk2(o1b.x, o1b.y), pk2(o1b.z, o1b.w)}, r2 = {pk2(o2a.x, o2a.y), pk2(o2a.z, o2a.w), pk2(o2b.x, o2b.y), pk2(o2b.z, o2b.w)};
        qr[4] = __builtin_bit_cast(bf16x8, r1); qr[5] = __builtin_bit_cast(bf16x8, r2); }
    const bool trail = wid >= 4;
#define PBAR_M(t) do { if ((t) + 3 < NT) { WAIT_BAR(6); } else { WAIT_BAR(0); } } while (0)
#define PBAR_V(t) do { if ((t) + 3 < NT) { WAIT_BAR(6); } else { WAIT_BAR(0); } } while (0)
    if (trail) WAIT_BAR(0);
    DMA_K(3, 3); DMA_V(2, 2);
    KLOAD(0); QK(px0, px1);
    PBAR_V(0);
    MASKT(px0, px1, 0);
    { float pm; ROWMAX(px0, px1, pm); SHIFT(px0, px1, pm); TILE_VALU(1.f); pa0 = pn0; pa1 = pn1; pa2 = pn2; pa3 = pn3; }
    int sk = 1, sv = 0;
#pragma unroll 1
    for (int t = 1; t < NT; ++t) {
        PBAR_M(t);
        { if (t + 3 < NT) DMA_K(t + 3, (sk + 3) & 3); if (t + 2 < NT) DMA_V(t + 2, (sk + 2) & 3); }
        SBAR();
        KLOAD(sk); VREAD(sv);
        SBAR();
        QK(px0, px1);
        SBAR(); asm volatile("s_waitcnt lgkmcnt(0)" ::: "memory"); SBAR();
        PVALL();
        PBAR_V(t);
        MASKT(px0, px1, t);
        float pm_, alX = 1.f; ROWMAX(px0, px1, pm_);
        if (__builtin_expect(__any(pm_ > THR), 0)) { const float dl_ = fmaxf(pm_, 0.f); SHIFT(px0, px1, dl_); alX = __builtin_amdgcn_exp2f(-dl_); }
        TILE_VALU(alX);
        pa0 = pn0; pa1 = pn1; pa2 = pn2; pa3 = pn3;
        RESC(alX);
        sk = (sk + 1) & 3; sv = (sv + 1) & 3;
    }
    WAIT_BAR(0);
    VREAD(sv); asm volatile("s_waitcnt lgkmcnt(0)" ::: "memory"); SBAR(); PVALL();
    if (!trail) WAIT_BAR(0);
    if (has_next) PRIME(nb_, nh_, nqb_);
#undef PBAR_M
#undef PBAR_V
    if (hi == 0) li_l[r32] = l_reg; asm volatile("s_waitcnt lgkmcnt(0)" ::: "memory");
    bf16* Ow = OB + (rowbase + P0 + wid * 32) * DM + h * 64;
    {
        LAS bf16* stg = (LAS bf16*)(lds + LDS_OST) + wid * 2048;
#pragma unroll
        for (int r = 0; r < 16; ++r) { const int orow = crow(r, hi); const float rl = __builtin_amdgcn_rcpf(li_l[orow]);
#pragma unroll
            for (int d0 = 0; d0 < 2; ++d0) stg[orow * 64 + d0 * 32 + r32] = f2bf(o[d0][r] * rl); }
        asm volatile("s_waitcnt lgkmcnt(0)" ::: "memory");
#pragma unroll
        for (int i4 = 0; i4 < 4; ++i4) { const int row = i4 * 8 + (lane >> 3), ch = lane & 7; const u32x4 v = *(const LAS u32x4*)(stg + row * 64 + ch * 8); *(u32x4*)(Ow + (size_t)row * DM + ch * 8) = v; }
    }
    if (!has_next) WAIT_BAR(0);
#undef PRIME
#undef TT
#undef DMA_K
#undef DMA_V
#undef KLOAD
#undef QK
#undef RESC
#undef MASKT
#undef ROWMAX
#undef SHIFT
#undef EXP16
#undef PACKP
#undef SOFTMAX2
#undef TILE_VALU
#undef TRRD
#undef VREAD
#undef VF
#undef PVH
#undef PVALL
#undef STEP
}
#undef SBAR
#undef SGB
#undef WAIT_BAR
}

#ifndef MK_PER_PHASE
#define MK_PER_PHASE 0
#endif
#ifndef REPEAT_MASK
#define REPEAT_MASK 0
#endif
#ifndef ATT_SHADOW
#define ATT_SHADOW -1
#endif
#ifndef P7_ONLY
#define P7_ONLY 0
#endif
__device__ __forceinline__ int q_grab(unsigned* que, LAS int* slot, int wv) {
    if (wv == 0) { if (lane_id() == 0) *slot = (int)__hip_atomic_fetch_add(que, 1u, __ATOMIC_RELAXED, __HIP_MEMORY_SCOPE_AGENT); }
    __syncthreads();
    const int r = __builtin_amdgcn_readfirstlane(*slot);
    __syncthreads();
    return r;
}
constexpr int N_PHASES = 17;
__global__ void __launch_bounds__(NWAVES * 64, 2) hybrid_fwd(Args args) {
    extern __shared__ __attribute__((aligned(16))) unsigned char lds_raw[];
    LAS unsigned char* lds = (LAS unsigned char*)lds_raw;
    const int wv0 = __builtin_amdgcn_readfirstlane(threadIdx.x >> 6);
    for (int u = threadIdx.x; u < (LDS_BYTES - LDSCTL_OFF) / 4; u += NWAVES * 64) ((LAS unsigned*)(lds + LDSCTL_OFF))[u] = 0u;
    __syncthreads();
    if (!MK_PER_PHASE) (void)xcd_barrier_post((unsigned*)((unsigned char*)args.in[I_WS] + WS_CTL) + CW_BAR, (volatile LAS unsigned*)(lds + MISC_OFF) + 8);
    const int lo = args.ph_lo, hi = args.ph_hi;
#define IN(k) (lo <= (k) && (k) < hi)
#define PH_BEGIN int z = 0; asm volatile("" : "+s"(z)); int tid = TIDW(wv0); asm volatile("" : "+v"(tid)); const int lane = tid & 63, wave = wv0; \
    const int G = gridDim.x; const int bx = blockIdx.x; const int vcu = (G % 8 == 0) ? (bx % 8) * (G / 8) + bx / 8 : bx; unsigned char* ws = (unsigned char*)args.in[I_WS + z]; \
    LAS unsigned char* ring = lds + RING_OFF; (void)lane; (void)wave; (void)vcu; (void)ws; (void)ring; (void)tid;
#define SEAM(k) do { if (IN(k) && IN((k) + 1)) { int zb = 0; asm volatile("" : "+s"(zb)); XcdBarrier bar; bar.bar = (unsigned*)((unsigned char*)args.in[I_WS + zb] + WS_CTL) + CW_BAR; bar.x = xb_xcc_id(); \
        bar.st = (volatile LAS unsigned*)(lds + MISC_OFF) + 8; bar.t0 = (TIDW(wv0) == 0); xcd_barrier(bar); } } while (0)
    typedef pg8::StaticOrder SO;
#define GBAR() do { int zb = 0; asm volatile("" : "+s"(zb)); XcdBarrier bar; bar.bar = (unsigned*)((unsigned char*)args.in[I_WS + zb] + WS_CTL) + CW_BAR; bar.x = xb_xcc_id(); \
        bar.st = (volatile LAS unsigned*)(lds + MISC_OFF) + 8; bar.t0 = (TIDW(wv0) == 0); xcd_barrier(bar); } while (0)
#define BAR_ARRIVE() do { int zb = 0; asm volatile("" : "+s"(zb)); XcdBarrier bar; bar.bar = (unsigned*)((unsigned char*)args.in[I_WS + zb] + WS_CTL) + CW_BAR; bar.x = xb_xcc_id(); \
        bar.st = (volatile LAS unsigned*)(lds + MISC_OFF) + 8; bar.t0 = (TIDW(wv0) == 0); xcd_barrier_arrive(bar); } while (0)
#define BAR_FINISH() do { int zb = 0; asm volatile("" : "+s"(zb)); XcdBarrier bar; bar.bar = (unsigned*)((unsigned char*)args.in[I_WS + zb] + WS_CTL) + CW_BAR; bar.x = xb_xcc_id(); \
        bar.st = (volatile LAS unsigned*)(lds + MISC_OFF) + 8; bar.t0 = (TIDW(wv0) == 0); xcd_barrier_finish(bar); } while (0)
#define PHASE(k, ...) if (IN(k)) { { constexpr int rep = 0; (void)rep; __VA_ARGS__ } if constexpr (((REPEAT_MASK) >> (k)) & 1) { GBAR(); { constexpr int rep = 1; (void)rep; __VA_ARGS__ } } }

    PHASE(0, { PH_BEGIN p0_prologue(args, lds, vcu, G, tid, lane, wave); })
    SEAM(0);
    PHASE(1, { PH_BEGIN pg8::Gemm g{(const bf16*)(ws + WS_XN), (const bf16*)(ws + WS_BUP1), MT, 2 * DFF, DM}; SO S; S.init(MT, 2 * DFF, G, bx);
        pg8::Epi<pg8::EM_SWIGLU> E{(bf16*)(ws + WS_H), DFF, nullptr, 0, nullptr, 0, 1.f};
        pg8::gemm_phase<pg8::Epi<pg8::EM_SWIGLU>, SO, true, true>(ring, g, S, E, wv0);
        if (rep == 0) convert_in_tail(args, lds, S.nwg, G, bx, CV_A, CV_B, wv0); })
    SEAM(1);
    PHASE(2, { PH_BEGIN sgemm_sample<pg8::EM_PLAIN, DFF>(lds, (const bf16*)(ws + WS_H), (const bf16*)(ws + WS_BDN1), DM, (bf16*)(ws + WS_F), DM, nullptr, 0, nullptr, 0, vcu, G, wv0, (unsigned*)(ws + WS_CTL) + CW_SN + 0 * 8 * 64);
        pg8::Gemm g{(const bf16*)(ws + WS_H), (const bf16*)(ws + WS_BDN1), MP, DM, DFF}; SO S; S.init(MP, DM, G, bx);
        pg8::EpiNorm<1, 0> E{(const float*)args.in[I_XP + z], (bf16*)(ws + WS_XR), (bf16*)(ws + WS_XN), nullptr, (const float*)args.in[I_F1POST + z], (const float*)args.in[I_MIXPRE + z], 0.5f, (float*)(ws + WS_NSLOT) + (size_t)0 * 2 * 64 * 256 * 4, (unsigned*)(ws + WS_CTL) + CW_PN + 0 * 2 * 64 * 64, nullptr};
        pg8::gemm_phase<pg8::EpiNorm<1, 0>, SO, true, true>(ring, g, S, E, wv0);
        sample_norm<1, 0>(args, (unsigned*)(ws + WS_CTL) + CW_SN + 0 * 8 * 64, (const bf16*)(ws + WS_F), 0.5f, I_F1POST, I_MIXPRE, G, vcu, wv0); })
    SEAM(3);
    PHASE(4, { PH_BEGIN pg8::Gemm g{(const bf16*)(ws + WS_XN), (const bf16*)(ws + WS_BIN), MT, ZW, DM}; SO S; S.init(MT, ZW, G, bx);
        pg8::Epi<pg8::EM_WIN> E{(bf16*)(ws + WS_Z), ZW, nullptr, 0, nullptr, 0, 1.f};
        pg8::gemm_phase<pg8::Epi<pg8::EM_WIN>, SO, true, true>(ring, g, S, E, wv0);
        if (rep == 0) convert_in_tail(args, lds, S.nwg, G, bx, CV_B, CV_N, wv0); })
    SEAM(4);
    PHASE(5, { PH_BEGIN
        for (int u = vcu; u < 256; u += G) lru_cu_unit<1>(args, lds, u, wv0);
        mla_prep(args, vcu, G, lane, wave);
    })
    SEAM(5);
    PHASE(6, {
        { PH_BEGIN for (int u = vcu; u < 256; u += G) lru_cu_unit<2>(args, lds, u, wv0); }
        __syncthreads();
        { PH_BEGIN sgemm_sample<pg8::EM_PLAIN, QL>(lds, (const bf16*)(ws + WS_CQ), (const bf16*)(ws + WS_BQ), QW, (bf16*)(ws + WS_Q), QW, nullptr, 0, nullptr, 0, vcu, G, wv0);
          sgemm_sample<pg8::EM_PLAIN, DPLE>(lds, (const bf16*)(ws + WS_PB), (const bf16*)(ws + WS_BPP), DM, (bf16*)(ws + WS_PPB), DM, nullptr, 0, nullptr, 0, vcu, G, wv0); }
    })
    SEAM(6);
    PHASE(7, {
        bool dec7;
        { PH_BEGIN const int nq = (G % 8 == 0) ? 8 : 1, q = (nq == 8) ? (bx & 7) : 0, ci = (nq == 8) ? (bx >> 3) : bx, cpq = G / nq, ndq = (NDEC / nq < cpq) ? NDEC / nq : cpq;
          const bool early = EARLY_DEC && (G == 256); dec7 = early && ci < ndq;
          if (!dec7) {
            const int Gp = early ? G - ndq * nq : G, cp = early ? (ci - ndq) * 8 + q : bx, vcup = early ? q * (cpq - ndq) + (ci - ndq) : vcu;
            sgemm_sample<pg8::EM_MULZ, DRNN>(lds, (const bf16*)(ws + WS_HG), (const bf16*)(ws + WS_BRNN), DM, (bf16*)(ws + WS_YAG), DM, (const bf16*)(ws + WS_Z) + Z_GA, ZW, nullptr, 0, vcup, Gp, wv0);
            { pg8::Gemm g{(const bf16*)(ws + WS_CQ), (const bf16*)(ws + WS_BQ), MP, QW, QL}; SO S; S.init(MP, QW, Gp, cp);
              pg8::Epi<pg8::EM_PLAIN> E{(bf16*)(ws + WS_Q), QW, nullptr, 0, nullptr, 0, 1.f};
              pg8::gemm_phase<pg8::Epi<pg8::EM_PLAIN>, SO, true, true>(ring, g, S, E, wv0); } } }
        if (!dec7) { PH_BEGIN const int nq = (G % 8 == 0) ? 8 : 1, q = (nq == 8) ? (bx & 7) : 0, ci = (nq == 8) ? (bx >> 3) : bx, cpq = G / nq, ndq = (NDEC / nq < cpq) ? NDEC / nq : cpq;
          const bool early = EARLY_DEC && (G == 256); const int Gp = early ? G - ndq * nq : G, cp = early ? (ci - ndq) * 8 + q : bx;
          pg8::Gemm g{(const bf16*)(ws + WS_CKV), (const bf16*)(ws + WS_BKV), MP, KVW, KVL}; SO S; S.init(MP, KVW, Gp, cp);
          pg8::Epi<pg8::EM_PLAIN> E{(bf16*)(ws + WS_KVB), KVW, nullptr, 0, nullptr, 0, 1.f};
          pg8::gemm_phase<pg8::Epi<pg8::EM_PLAIN>, SO, true, true>(ring, g, S, E, wv0); }
        BAR_ARRIVE();
        if (!dec7) BAR_FINISH();
    })
    PHASE(8, { PH_BEGIN
        const int nq = (G % 8 == 0) ? 8 : 1, q = (nq == 8) ? (bx & 7) : 0, ci = (nq == 8) ? (bx >> 3) : bx, cpq = G / nq;
        {
            const int ndq = (NDEC / nq < cpq) ? NDEC / nq : cpq, nd = ndq * nq;
            if (ci < ndq) {
                _Pragma("unroll 1") for (int sq = q * ndq + ci; sq < NS; sq += nd) {
                    sample_attn_seq(args, lds, sq, wv0);
                }
                __syncthreads();
                if (EARLY_DEC && G == 256) BAR_FINISH();
            }
        }
        {
            unsigned* que = (unsigned*)(ws + WS_CTL) + CW_QUE + 64 * q;
            LAS int* slot = (LAS int*)(lds + MISC_OFF) + 64;
            const int hq = 32 / nq, nblk = 32 * hq, npq = 64 / nq, ny = 4 * npq, ya0 = nblk - 10, nitem = nblk + ny;
            int cur = q_grab(que, slot, wv0), nxt = nitem; if (cur < nitem) nxt = q_grab(que, slot, wv0);
            _Pragma("unroll 1") while (cur < nitem) {
                if (cur >= ya0 && cur < ya0 + ny) {
                    const int t = cur - ya0;
                    pg8::Gemm g{(const bf16*)(ws + WS_HG), (const bf16*)(ws + WS_BRNN), MP, DM, DRNN}; pg8::OneUnit T; T.u.pm = q * npq + (t % npq); T.u.pn = t / npq;
                    pg8::Epi<pg8::EM_MULZ> E{(bf16*)(ws + WS_YAG), DM, (const bf16*)(ws + WS_Z) + Z_GA, ZW, nullptr, 0, 1.f};
                    pg8::gemm_phase<pg8::Epi<pg8::EM_MULZ>, pg8::OneUnit, true, true>(ring, g, T, E, wv0);
                    cur = nxt; if (cur < nitem) nxt = q_grab(que, slot, wv0);
                    continue;
                }
                bf16x8 qr[6]; bool primed = false, more;
                do {
                    const int kc = cur < ya0 ? cur : cur - ny, bh = hq * q + 2 * (kc >> 6) + (kc & 1), qb = 31 - ((kc & 63) >> 1);
                    more = nxt < nitem && !(nxt >= ya0 && nxt < ya0 + ny);
                    const int kn = more ? (nxt < ya0 ? nxt : nxt - ny) : 0, bhn = hq * q + 2 * (kn >> 6) + (kn & 1), qbn = 31 - ((kn & 63) >> 1);
                    pattn4::block<0>((const bf16*)(ws + WS_Q), (const bf16*)(ws + WS_KVB), (const bf16*)(ws + WS_KR), (const float*)(ws + WS_ROPE), (bf16*)(ws + WS_OB), lds, bh >> 4, bh & 15, qb, 0, wv0,
                                     primed, more, bhn >> 4, bhn & 15, qbn, qr);
                    primed = true; cur = nxt; if (cur < nitem) nxt = q_grab(que, slot, wv0);
                } while (more);
            }
        }
        __syncthreads();
#if ATT_SHADOW >= 0
        GBAR();
        { int z2 = 0; asm volatile("" : "+s"(z2)); unsigned char* ws2 = (unsigned char*)args.in[I_WS + z2];
          const int G2 = gridDim.x, bx2 = blockIdx.x, vcu2 = (G2 % 8 == 0) ? (bx2 % 8) * (G2 / 8) + bx2 / 8 : bx2;
          bf16x8 qrs[6];
          for (int L = vcu2; L < 512; L += G2) { const int bh = L >> 4, x = L & 15;
            pattn4::block<ATT_SHADOW>((const bf16*)(ws2 + WS_Q), (const bf16*)(ws2 + WS_KVB), (const bf16*)(ws2 + WS_KR), (const float*)(ws2 + WS_ROPE), (bf16*)(ws2 + WS_END), lds, bh >> 4, bh & 15, x, 0, wv0, false, false, 0, 0, 0, qrs);
            pattn4::block<ATT_SHADOW>((const bf16*)(ws2 + WS_Q), (const bf16*)(ws2 + WS_KVB), (const bf16*)(ws2 + WS_KR), (const float*)(ws2 + WS_ROPE), (bf16*)(ws2 + WS_END), lds, bh >> 4, bh & 15, 31 - x, 0, wv0, false, false, 0, 0, 0, qrs); } }
        __syncthreads();
#endif
    })
    SEAM(8);
    PHASE(9, { PH_BEGIN sgemm_sample<pg8::EM_FMAZ, DM>(lds, (const bf16*)(ws + WS_OB), (const bf16*)(ws + WS_BATT), DM, (bf16*)(ws + WS_MX), DM, (const bf16*)(ws + WS_Z) + Z_GB, ZW, (const bf16*)(ws + WS_YAG), DM, vcu, G, wv0);
        pg8::Gemm g{(const bf16*)(ws + WS_OB), (const bf16*)(ws + WS_BATT), MP, DM, DM}; SO S; S.init(MP, DM, G, bx);
        pg8::Epi<pg8::EM_FMAZ> E{(bf16*)(ws + WS_MX), DM, (const bf16*)(ws + WS_Z) + Z_GB, ZW, (const bf16*)(ws + WS_YAG), DM, 1.f};
        pg8::gemm_phase<pg8::Epi<pg8::EM_FMAZ>, SO, true, true>(ring, g, S, E, wv0); })
    SEAM(9);
    PHASE(10, { PH_BEGIN sgemm_sample<pg8::EM_PLAIN, DM>(lds, (const bf16*)(ws + WS_MX), (const bf16*)(ws + WS_BOUT), DM, (bf16*)(ws + WS_F), DM, nullptr, 0, nullptr, 0, vcu, G, wv0, (unsigned*)(ws + WS_CTL) + CW_SN + 1 * 8 * 64);
        pg8::Gemm g{(const bf16*)(ws + WS_MX), (const bf16*)(ws + WS_BOUT), MP, DM, DM}; SO S; S.init(MP, DM, G, bx);
        pg8::EpiNorm<1, 1> E{nullptr, (bf16*)(ws + WS_XR), (bf16*)(ws + WS_XN), nullptr, (const float*)args.in[I_MIXPOST + z], (const float*)args.in[I_F2PRE + z], 1.0f, (float*)(ws + WS_NSLOT) + (size_t)1 * 2 * 64 * 256 * 4, (unsigned*)(ws + WS_CTL) + CW_PN + 1 * 2 * 64 * 64, nullptr};
        pg8::gemm_phase<pg8::EpiNorm<1, 1>, SO, true, true>(ring, g, S, E, wv0);
        sample_norm<1, 1>(args, (unsigned*)(ws + WS_CTL) + CW_SN + 1 * 8 * 64, (const bf16*)(ws + WS_F), 1.0f, I_MIXPOST, I_F2PRE, G, vcu, wv0); })
    SEAM(11);
    PHASE(12, { PH_BEGIN pg8::Gemm g{(const bf16*)(ws + WS_XN), (const bf16*)(ws + WS_BUP2), MT, 2 * DFF, DM}; SO S; S.init(MT, 2 * DFF, G, bx);
        pg8::Epi<pg8::EM_SWIGLU> E{(bf16*)(ws + WS_H), DFF, nullptr, 0, nullptr, 0, 1.f};
        pg8::gemm_phase<pg8::Epi<pg8::EM_SWIGLU>, SO, true, true>(ring, g, S, E, wv0); }
        { PH_BEGIN const int nwg0 = (MT / 256) * (2 * DFF / 256), full = (nwg0 + G - 1) / G, nl = full * G - nwg0;
          if (nl == 0 || bx >= G - nl) { pg8::Gemm g2{(const bf16*)(ws + WS_PB), (const bf16*)(ws + WS_BPP), MP, DM, DPLE}; SO T; T.init(MP, DM, nl == 0 ? G : nl, nl == 0 ? bx : bx - (G - nl));
            pg8::Epi<pg8::EM_PLAIN> E2{(bf16*)(ws + WS_PPB), DM, nullptr, 0, nullptr, 0, 1.f};
            pg8::gemm_phase<pg8::Epi<pg8::EM_PLAIN>, SO, true, true>(ring, g2, T, E2, wv0); } } )
    SEAM(12);
    PHASE(13, { PH_BEGIN sgemm_sample<pg8::EM_PLAIN, DFF>(lds, (const bf16*)(ws + WS_H), (const bf16*)(ws + WS_BDN2), DM, (bf16*)(ws + WS_F), DM, nullptr, 0, nullptr, 0, vcu, G, wv0, (unsigned*)(ws + WS_CTL) + CW_SN + 2 * 8 * 64);
        pg8::Gemm g{(const bf16*)(ws + WS_H), (const bf16*)(ws + WS_BDN2), MP, DM, DFF}; SO S; S.init(MP, DM, G, bx);
        pg8::EpiNorm<2, 1> E{nullptr, (bf16*)(ws + WS_XR), (bf16*)(ws + WS_XN), nullptr, (const float*)args.in[I_F2POST + z], nullptr, 0.5f, (float*)(ws + WS_NSLOT) + (size_t)2 * 2 * 64 * 256 * 4, (unsigned*)(ws + WS_CTL) + CW_PN + 2 * 2 * 64 * 64, nullptr};
        pg8::gemm_phase<pg8::EpiNorm<2, 1>, SO, true, true>(ring, g, S, E, wv0);
        sample_norm<2, 1>(args, (unsigned*)(ws + WS_CTL) + CW_SN + 2 * 8 * 64, (const bf16*)(ws + WS_F), 0.5f, I_F2POST, I_F2POST, G, vcu, wv0); })
    SEAM(14);
    PHASE(15, { PH_BEGIN sgemm_sample<pg8::EM_SIGMUL, DM>(lds, (const bf16*)(ws + WS_XN), (const bf16*)(ws + WS_BPG), DM, (bf16*)(ws + WS_F), DM, (const bf16*)(ws + WS_PPB), DM, nullptr, 0, vcu, G, wv0, (unsigned*)(ws + WS_CTL) + CW_SN + 3 * 8 * 64);
        pg8::Gemm g{(const bf16*)(ws + WS_XN), (const bf16*)(ws + WS_BPG), MP, DM, DM}; SO S; S.init(MP, DM, G, bx);
        pg8::EpiNorm<0, 2, 1> E{nullptr, nullptr, (bf16*)(ws + WS_XN), (float*)args.in[I_OUT + z] + O_Y, (const float*)args.in[I_PPOST + z], nullptr, 1.0f, (float*)(ws + WS_NSLOT) + (size_t)3 * 2 * 64 * 256 * 4, (unsigned*)(ws + WS_CTL) + CW_PN + 3 * 2 * 64 * 64, (const bf16*)(ws + WS_PPB)};
        pg8::gemm_phase<pg8::EpiNorm<0, 2, 1>, SO, true, true>(ring, g, S, E, wv0);
        sample_norm<0, 2>(args, (unsigned*)(ws + WS_CTL) + CW_SN + 3 * 8 * 64, (const bf16*)(ws + WS_F), 1.0f, I_PPOST, I_PPOST, G, vcu, wv0); })
#undef IN
#undef SEAM
#undef PHASE
#undef GBAR
#undef PH_BEGIN
}

extern "C" void kernel_launch(void* const* d_in, const int* in_sizes, int n_in, void* d_out, int out_size, void* d_ws, size_t ws_size, hipStream_t stream) {
    static int grid = 0;
    if (grid == 0) {
        if (n_in != N_IN || (size_t)out_size != O_END || ws_size < WS_END) { fprintf(stderr, "kernel_launch: unexpected shapes (n_in %d, out %d, ws %zu)\n", n_in, out_size, ws_size); grid = -1; return; }
        int dev = 0, cus = 0, per_cu = 0;
        if (hipGetDevice(&dev) != hipSuccess || hipDeviceGetAttribute(&cus, hipDeviceAttributeMultiprocessorCount, dev) != hipSuccess) { grid = -1; return; }
        if (hipFuncSetAttribute((const void*)hybrid_fwd, hipFuncAttributeMaxDynamicSharedMemorySize, LDS_BYTES) != hipSuccess) { fprintf(stderr, "kernel_launch: hipFuncSetAttribute failed\n"); grid = -1; return; }
        if (hipOccupancyMaxActiveBlocksPerMultiprocessor(&per_cu, (const void*)hybrid_fwd, NWAVES * 64, LDS_BYTES) != hipSuccess || per_cu < 1) { fprintf(stderr, "kernel_launch: occupancy query says %d\n", per_cu); }
        (void)hipGetLastError();
        grid = cus;
    }
    if (grid < 0) return;
    (void)hipMemsetAsync((char*)d_ws + WS_CTL, 0, CTL_ZERO_BYTES, stream);
    Args a{};
    for (int i = 0; i < N_IN; ++i) a.in[i] = d_in[i];
    a.in[I_OUT] = d_out; a.in[I_WS] = d_ws; a.pad = 0;
#if MK_PER_PHASE
    for (int p = 0; p < N_PHASES; ++p) { a.ph_lo = p; a.ph_hi = p + 1; a.li = p; hipLaunchKernelGGL(hybrid_fwd, dim3(grid), dim3(NWAVES * 64), LDS_BYTES, stream, a); }
#else
    a.ph_lo = 0; a.ph_hi = N_PHASES; a.li = 0;
    hipLaunchKernelGGL(hybrid_fwd, dim3(grid), dim3(NWAVES * 64), LDS_BYTES, stream, a);
#endif
    const hipError_t le = hipPeekAtLastError();
    if (le != hipSuccess) fprintf(stderr, "kernel_launch: launch failed: %s\n", hipGetErrorName(le));
}
```

```cpp
#include <hip/hip_runtime.h>
#include <cstdio>
#include <cstdint>

#define GAS __attribute__((address_space(1)))
#define LAS __attribute__((address_space(3)))
typedef unsigned short bf16;
typedef short bf16x8 __attribute__((ext_vector_type(8)));
typedef short s16x4 __attribute__((ext_vector_type(4)));
typedef float f32x2 __attribute__((ext_vector_type(2)));
typedef float f32x4 __attribute__((ext_vector_type(4)));
typedef float f32x16 __attribute__((ext_vector_type(16)));
typedef unsigned u32x2 __attribute__((ext_vector_type(2)));
typedef unsigned u32x4 __attribute__((ext_vector_type(4)));
typedef __bf16 bf16x2_t __attribute__((ext_vector_type(2)));

constexpr int DM = 1024, SEQ = 8192, NBATCH = 2, MP = NBATCH * SEQ, NS = 128, MT = 16640, NMT = MT / 256;
constexpr int DFF = 2816, DRNN = 1280, NBLK = 16, BLK = 80, QL = 384, KVL = 256, ROPE = 32, NH = 16;
constexpr int DPLE = 256, DIN = 5280, ZW = 5376;
constexpr int Z_XR = 0, Z_YR = 1280, Z_CQ = 2560, Z_KV = 2944, Z_KR = 3200, Z_GA = 3328, Z_GB = 4352;
constexpr int QW = 1536, KVW = 2048;
constexpr int PAGE = 128, NPAGES = 64;
constexpr float EPS = 1e-6f;
constexpr float C2 = 0.10206207261596577f * 1.4426950408889634f;
constexpr size_t O_Y = 0, O_CKV_P = 16908288, O_KR_P = 21102592, O_H_P = 21626880, O_CONV_P = 21629440, O_CKV_S = 21637120, O_KR_S = 21669888, O_H_S = 21673984, O_CONV_S = 21837824, O_END = 22329344;
enum { I_XP = 0, I_XS, I_PP, I_PS, I_CCKV, I_CKR, I_SH, I_SCONV, I_PT, I_F1PRE, I_F1G, I_F1U, I_F1D, I_F1POST, I_MIXPRE, I_WIN, I_CONVW, I_CONVB, I_LWA, I_LBA, I_LWI, I_LBI, I_LAM,
       I_WRNN, I_QNORM, I_WUQ, I_WQR, I_KVNORM, I_WUK, I_WUV, I_WATT, I_WOUT, I_MIXPOST, I_F2PRE, I_F2G, I_F2U, I_F2D, I_F2POST, I_PG, I_PPJ, I_PPOST, N_IN, I_OUT = N_IN, I_WS, N_PTR };

constexpr size_t MiB = 1u << 20;
constexpr size_t WS_CTL = 0, CTL_ZERO_BYTES = 256 * 1024;
constexpr size_t WS_BUP1 = 2 * MiB, WS_BDN1 = 13 * MiB, WS_BIN = 19 * MiB, WS_BRNN = 30 * MiB, WS_BQ = 33 * MiB, WS_BKV = 35 * MiB, WS_BATT = 36 * MiB, WS_BOUT = 38 * MiB,
                 WS_BUP2 = 40 * MiB, WS_BDN2 = 51 * MiB, WS_BPG = 57 * MiB, WS_BPP = 59 * MiB, WS_LW = 60 * MiB, WS_ROPE = 61 * MiB, WS_SUM = 63 * MiB;
constexpr size_t WS_XN = 64 * MiB, WS_F = 97 * MiB, WS_H = 130 * MiB, WS_XR = 220 * MiB, WS_Z = 285 * MiB, WS_CQ = 456 * MiB, WS_CKV = 469 * MiB, WS_KR = 478 * MiB, WS_Q = 480 * MiB,
                 WS_KVB = 529 * MiB, WS_PB = 593 * MiB, WS_PPB = 602 * MiB, WS_HG = 635 * MiB, WS_YAG = 676 * MiB, WS_OB = 709 * MiB, WS_MX = 742 * MiB, WS_PART = 775 * MiB, WS_NSLOT = 808 * MiB, WS_END = 810 * MiB;
constexpr int ROPE_TAB = 8193 * 16;
constexpr int PART_STRIDE = 16 * 256 + 32;
constexpr int CW_BAR = 4096;
constexpr int CW_PN = 8192;
constexpr int CW_SN = 49152;
constexpr int CW_QUE = 2048;
#ifndef EARLY_DEC
#define EARLY_DEC 0
#endif
#ifndef NDEC
#define NDEC 64
#endif

__device__ __forceinline__ float bflo(unsigned w) { return __uint_as_float(w << 16); }
__device__ __forceinline__ float bfhi(unsigned w) { return __uint_as_float(w & 0xffff0000u); }
__device__ __forceinline__ float bf2f(bf16 v) { return __uint_as_float((unsigned)v << 16); }
__device__ __forceinline__ unsigned pk2(float lo, float hi) { f32x2 v = {lo, hi}; bf16x2_t b = __builtin_convertvector(v, bf16x2_t); return __builtin_bit_cast(unsigned, b); }
__device__ __forceinline__ bf16 f2bf(float f) { return (bf16)(pk2(f, 0.f) & 0xffffu); }
__device__ __forceinline__ float sigmoid_f(float x) { return __builtin_amdgcn_rcpf(1.f + __builtin_amdgcn_exp2f(-1.4426950408889634f * x)); }
__device__ __forceinline__ float silu_f(float x) { return x * sigmoid_f(x); }
__device__ __forceinline__ float gelu_tanh_f(float x) { const float u = 0.7978845608028654f * (x + 0.044715f * x * x * x); return x * sigmoid_f(2.f * u); }
__device__ __forceinline__ float wave_sum(float v) {
#define WS_DPP(ctrl) v += __uint_as_float((unsigned)__builtin_amdgcn_update_dpp(0, (int)__float_as_uint(v), ctrl, 0xf, 0xf, false))
    WS_DPP(0xB1); WS_DPP(0x4E); WS_DPP(0x141); WS_DPP(0x140);
#undef WS_DPP
    { const unsigned u = __float_as_uint(v); const auto r = __builtin_amdgcn_permlane16_swap(u, u, false, false); v = __uint_as_float(r[0]) + __uint_as_float(r[1]); }
    { const unsigned u = __float_as_uint(v); const auto r = __builtin_amdgcn_permlane32_swap(u, u, false, false); v = __uint_as_float(r[0]) + __uint_as_float(r[1]); }
    return v;
}
__device__ __forceinline__ int lane_id() { return (int)__builtin_amdgcn_mbcnt_hi(~0u, __builtin_amdgcn_mbcnt_lo(~0u, 0u)); }
#define TIDW(wv) ((wv) * 64 + lane_id())
#define LDS_WAIT() asm volatile("s_waitcnt lgkmcnt(0)" ::: "memory")
#define VM_WAIT() asm volatile("s_waitcnt vmcnt(0)" ::: "memory")

namespace pg8 {
typedef unsigned short bf16_t;
constexpr int BM = 256, BK = 64, HALF = 128, HTB = HALF * BK * 2, STAGE_BYTES = 8 * HTB, NXCD = 8, WGM = 8;
__host__ __device__ __forceinline__ int lds_byte(int r, int c) { const int st = (r >> 4) * 2 + (c >> 5), rr = r & 15, cc = c & 31, ob = rr * 64 + cc * 2; return st * 1024 + (ob ^ (((ob >> 9) & 1) << 5)); }
__host__ __device__ __forceinline__ void stage_rc(int b, int& R, int& C) { const int st = b / 1024, sb = b % 1024, swz = sb ^ (((sb >> 9) & 1) << 5); R = (st >> 1) * 16 + swz / 64; C = (st & 1) * 32 + (swz % 64) / 2; }
__host__ __device__ __forceinline__ int perm32(int rho) { const int n = rho >> 4, i = rho & 15; return 8 * (i >> 2) + 4 * n + (i & 3); }
struct Unit { int pm, pn; };
struct Gemm { const bf16_t* A; const bf16_t* Bt; int M, N, K; };
struct StaticOrder {
    int nM, nN, nwg, G, c;
    __host__ __device__ void init(int M, int N, int G_, int c_) { nM = M / BM; nN = N / BM; nwg = nM * nN; G = G_; c = c_; }
    __host__ __device__ bool next(int i, Unit& u) const {
        const long L = (long)i * G + c; if (L >= nwg) return false;
        int wgid = (int)L; { const int q = nwg / NXCD, r = nwg % NXCD, xcd = wgid % NXCD, off = wgid / NXCD; wgid = (xcd < r ? xcd * (q + 1) : r * (q + 1) + (xcd - r) * q) + off; }
        const int nig = WGM * nN, gid = wgid / nig, fm = gid * WGM, gsz = (nM - fm) < WGM ? (nM - fm) : WGM;
        u.pm = fm + ((wgid % nig) % gsz); u.pn = (wgid % nig) / gsz; return true;
    }
    __device__ __forceinline__ void a_ready(const Unit&) const {}
    __device__ __forceinline__ void done(const Unit&) const {}
};
enum { EM_PLAIN = 0, EM_SWIGLU, EM_WIN, EM_SCALE, EM_MULZ, EM_FMAZ, EM_SIGMUL };
template <int MODE> struct Epi {
    static constexpr bool PERM = true, AFTER_DRAIN = false;
    bf16_t* O; int ldc;
    const bf16_t* aux; int ldaux;
    const bf16_t* add; int ldadd;
    float scale;
    __device__ __forceinline__ void operator()(const f32x4 (&acc)[2][2][4][2], const Unit& u, int wr, int wc, int fr, int fq) const {
        const int row0 = u.pm * BM + wr * 64 + fr;
        if constexpr (MODE == EM_SWIGLU) {
            const int col = u.pn * HALF + wc * 32 + 8 * fq;
#pragma unroll
            for (int ai = 0; ai < 2; ++ai)
#pragma unroll
                for (int m = 0; m < 4; ++m) {
                    const f32x4 g0 = acc[ai][0][m][0], g1 = acc[ai][0][m][1], u0 = acc[ai][1][m][0], u1 = acc[ai][1][m][1];
                    u32x4 w; w.x = pk2(silu_f(g0[0]) * u0[0], silu_f(g0[1]) * u0[1]); w.y = pk2(silu_f(g0[2]) * u0[2], silu_f(g0[3]) * u0[3]);
                    w.z = pk2(silu_f(g1[0]) * u1[0], silu_f(g1[1]) * u1[1]); w.w = pk2(silu_f(g1[2]) * u1[2], silu_f(g1[3]) * u1[3]);
                    *(u32x4*)(O + (size_t)(row0 + ai * HALF + m * 16) * ldc + col) = w;
                }
        } else {
            int act = 0;
            if constexpr (MODE == EM_WIN) act = (u.pn >= 5 && u.pn < 10) ? 1 : (u.pn >= 13 ? 2 : 0);
#pragma unroll
            for (int ai = 0; ai < 2; ++ai)
#pragma unroll
                for (int m = 0; m < 4; ++m) {
                    const int row = row0 + ai * HALF + m * 16;
#pragma unroll
                    for (int bj = 0; bj < 2; ++bj) {
                        const int col = u.pn * BM + bj * HALF + wc * 32 + 8 * fq;
                        f32x4 v0 = acc[ai][bj][m][0], v1 = acc[ai][bj][m][1];
                        if constexpr (MODE == EM_WIN) {
                            if (act == 1) { for (int j = 0; j < 4; ++j) { v0[j] = gelu_tanh_f(v0[j]); v1[j] = gelu_tanh_f(v1[j]); } }
                            else if (act == 2) { for (int j = 0; j < 4; ++j) { v0[j] = sigmoid_f(v0[j]); v1[j] = sigmoid_f(v1[j]); } }
                        }
                        if constexpr (MODE == EM_SCALE) { v0 = v0 * scale; v1 = v1 * scale; }
                        if constexpr (MODE == EM_MULZ || MODE == EM_FMAZ || MODE == EM_SIGMUL) {
                            const u32x4 z = *(const u32x4*)(aux + (size_t)row * ldaux + col);
                            f32x4 z0 = {bflo(z.x), bfhi(z.x), bflo(z.y), bfhi(z.y)}, z1 = {bflo(z.z), bfhi(z.z), bflo(z.w), bfhi(z.w)};
                            if constexpr (MODE == EM_SIGMUL) { for (int j = 0; j < 4; ++j) { v0[j] = sigmoid_f(v0[j]); v1[j] = sigmoid_f(v1[j]); } }
                            v0 = v0 * z0; v1 = v1 * z1;
                            if constexpr (MODE == EM_FMAZ) {
                                const u32x4 y = *(const u32x4*)(add + (size_t)row * ldadd + col);
                                v0 += (f32x4){bflo(y.x), bfhi(y.x), bflo(y.y), bfhi(y.y)}; v1 += (f32x4){bflo(y.z), bfhi(y.z), bflo(y.w), bfhi(y.w)};
                            }
                        }
                        u32x4 w; w.x = pk2(v0[0], v0[1]); w.y = pk2(v0[2], v0[3]); w.z = pk2(v1[0], v1[1]); w.w = pk2(v1[2], v1[3]);
                        *(u32x4*)(O + (size_t)row * ldc + col) = w;
                    }
                }
        }
    }
};

struct OneUnit { Unit u; __device__ __forceinline__ bool next(int i, Unit& o) const { if (i != 0) return false; o = u; return true; }
    __device__ __forceinline__ void a_ready(const Unit&) const {} __device__ __forceinline__ void done(const Unit&) const {} };
template <int NEXT, int SRC, int PRE = 0> struct EpiNorm {
    static constexpr bool PERM = true, AFTER_DRAIN = true;
    const float* xin; bf16_t* XR; bf16_t* XN; float* Y; const float* gpost; const float* gpre; float coef; float* slots; unsigned* cnt; const bf16_t* aux;
    __device__ __forceinline__ void operator()(const f32x4 (&)[2][2][4][2], const Unit&, int, int, int, int) const {}
    __device__ __forceinline__ void stats(const f32x4 (&v)[2][2][4][2], const Unit& u, int wr, int wc, int fr, int fq, LAS unsigned char* lds, int wid, int lane, int which, float c) const {
        LAS float* P = (LAS float*)lds; LAS float* S = (LAS float*)(lds + 4096);
#pragma unroll
        for (int ai = 0; ai < 2; ++ai)
#pragma unroll
            for (int m = 0; m < 4; ++m) { float q = 0.f;
#pragma unroll
                for (int bj = 0; bj < 2; ++bj)
#pragma unroll
                    for (int n = 0; n < 2; ++n) { const f32x4 x = v[ai][bj][m][n]; q += (x[0] * x[0] + x[1] * x[1]) + (x[2] * x[2] + x[3] * x[3]); }
                { const unsigned uq = __float_as_uint(q); const auto r_ = __builtin_amdgcn_permlane16_swap(uq, uq, false, false); q = __uint_as_float(r_[0]) + __uint_as_float(r_[1]); }
                { const unsigned uq = __float_as_uint(q); const auto r_ = __builtin_amdgcn_permlane32_swap(uq, uq, false, false); q = __uint_as_float(r_[0]) + __uint_as_float(r_[1]); }
                if (fq == 0) P[(ai * HALF + wr * 64 + m * 16 + fr) * 4 + wc] = q; }
        asm volatile("s_waitcnt lgkmcnt(0)" ::: "memory"); __builtin_amdgcn_s_barrier(); asm volatile("" ::: "memory");
        const int row = wid * 32 + (lane & 31);
        float* slot = slots + ((size_t)(which * 64 + u.pm) * BM + row) * 4;
        unsigned* c0 = cnt + (size_t)(which * 64 + u.pm) * 64;
        if (lane < 32) { const f32x4 p4 = *(const LAS f32x4*)(P + row * 4); __hip_atomic_store(slot + u.pn, (p4[0] + p4[1]) + (p4[2] + p4[3]), __ATOMIC_RELAXED, __HIP_MEMORY_SCOPE_AGENT); }
        asm volatile("s_waitcnt vmcnt(0)" ::: "memory");
        if (lane == 0) (void)__hip_atomic_fetch_add(c0, 1u, __ATOMIC_RELAXED, __HIP_MEMORY_SCOPE_AGENT);
        if (wid == 0) { unsigned sp = 0u;
            while ((unsigned)__builtin_amdgcn_readfirstlane(__hip_atomic_load(c0, __ATOMIC_RELAXED, __HIP_MEMORY_SCOPE_AGENT)) < 32u) { __builtin_amdgcn_s_sleep(1); if (++sp > (1u << 20)) break; }
            __builtin_amdgcn_fence(__ATOMIC_ACQUIRE, "agent"); }
        asm volatile("s_waitcnt vmcnt(0) lgkmcnt(0)" ::: "memory"); __builtin_amdgcn_s_barrier(); asm volatile("" ::: "memory");
        if (lane < 32) { float t = 0.f;
#pragma unroll
            for (int k = 0; k < 4; ++k) t += __hip_atomic_load(slot + k, __ATOMIC_RELAXED, __HIP_MEMORY_SCOPE_AGENT);
            S[row] = c / sqrtf(t * (1.f / 1024.f) + 1e-6f); }
        asm volatile("s_waitcnt vmcnt(0) lgkmcnt(0)" ::: "memory"); __builtin_amdgcn_s_barrier(); asm volatile("" ::: "memory");
    }
    __device__ __forceinline__ void fused(f32x4 (&acc)[2][2][4][2], const Unit& u, int wr, int wc, int fr, int fq, LAS unsigned char* lds, int wid, int lane) const {
        const LAS float* S = (const LAS float*)(lds + 4096);
        if constexpr (PRE == 1) {
#pragma unroll
            for (int bj = 0; bj < 2; ++bj)
#pragma unroll
                for (int ai = 0; ai < 2; ++ai)
#pragma unroll
                    for (int m = 0; m < 4; ++m) { const size_t off = (size_t)(u.pm * BM + ai * HALF + wr * 64 + m * 16 + fr) * 1024 + u.pn * BM + bj * HALF + wc * 32 + 8 * fq;
                        const u32x4 zq = *(const u32x4*)(aux + off); f32x4 v0 = acc[ai][bj][m][0], v1 = acc[ai][bj][m][1];
#pragma unroll
                        for (int j = 0; j < 4; ++j) { v0[j] = sigmoid_f(v0[j]); v1[j] = sigmoid_f(v1[j]); }
                        acc[ai][bj][m][0] = v0 * (f32x4){bflo(zq.x), bfhi(zq.x), bflo(zq.y), bfhi(zq.y)}; acc[ai][bj][m][1] = v1 * (f32x4){bflo(zq.z), bfhi(zq.z), bflo(zq.w), bfhi(zq.w)}; }
        }
        u32x4 xres[1][2][4];
        if constexpr (SRC != 0) {
#pragma unroll
            for (int bj = 0; bj < 1; ++bj)
#pragma unroll
                for (int ai = 0; ai < 2; ++ai)
#pragma unroll
                    for (int m = 0; m < 4; ++m) xres[bj][ai][m] = *(const u32x4*)((SRC == 1 ? XR : XN) + (size_t)(u.pm * BM + ai * HALF + wr * 64 + m * 16 + fr) * 1024 + u.pn * BM + bj * HALF + wc * 32 + 8 * fq);
        }
        stats(acc, u, wr, wc, fr, fq, lds, wid, lane, 0, coef);
#pragma unroll
        for (int bj = 0; bj < 2; ++bj) {
            const int col = u.pn * BM + bj * HALF + wc * 32 + 8 * fq;
            const f32x4 g0 = *(const f32x4*)(gpost + col), g1 = *(const f32x4*)(gpost + col + 4);
#pragma unroll
            for (int ai = 0; ai < 2; ++ai)
#pragma unroll
                for (int m = 0; m < 4; ++m) {
                    const int rl = ai * HALF + wr * 64 + m * 16 + fr; const size_t off = (size_t)(u.pm * BM + rl) * 1024 + col; const float r = S[rl];
                    f32x4 x0, x1;
                    if constexpr (SRC == 0) { x0 = *(const f32x4*)(xin + off); x1 = *(const f32x4*)(xin + off + 4); }
                    else { const u32x4 w = bj == 0 ? xres[0][ai][m] : *(const u32x4*)((SRC == 1 ? XR : XN) + off); x0 = (f32x4){bflo(w.x), bfhi(w.x), bflo(w.y), bfhi(w.y)}; x1 = (f32x4){bflo(w.z), bfhi(w.z), bflo(w.w), bfhi(w.w)}; }
                    x0 = x0 + acc[ai][bj][m][0] * g0 * r; x1 = x1 + acc[ai][bj][m][1] * g1 * r;
                    acc[ai][bj][m][0] = x0; acc[ai][bj][m][1] = x1;
                    if constexpr (NEXT == 0) { *(f32x4*)(Y + off) = x0; *(f32x4*)(Y + off + 4) = x1; }
                    else { u32x4 w; w.x = pk2(x0[0], x0[1]); w.y = pk2(x0[2], x0[3]); w.z = pk2(x1[0], x1[1]); w.w = pk2(x1[2], x1[3]); *(u32x4*)((NEXT == 1 ? XR : XN) + off) = w; }
                }
        }
        if constexpr (NEXT == 1) {
            stats(acc, u, wr, wc, fr, fq, lds, wid, lane, 1, 1.f);
#pragma unroll
            for (int bj = 0; bj < 2; ++bj) {
                const int col = u.pn * BM + bj * HALF + wc * 32 + 8 * fq;
                const f32x4 g0 = *(const f32x4*)(gpre + col), g1 = *(const f32x4*)(gpre + col + 4);
#pragma unroll
                for (int ai = 0; ai < 2; ++ai)
#pragma unroll
                    for (int m = 0; m < 4; ++m) {
                        const int rl = ai * HALF + wr * 64 + m * 16 + fr; const size_t off = (size_t)(u.pm * BM + rl) * 1024 + col; const float r = S[rl];
                        const f32x4 x0 = acc[ai][bj][m][0] * g0 * r, x1 = acc[ai][bj][m][1] * g1 * r;
                        u32x4 w; w.x = pk2(x0[0], x0[1]); w.y = pk2(x0[2], x0[3]); w.z = pk2(x1[0], x1[1]); w.w = pk2(x1[2], x1[3]); *(u32x4*)(XN + off) = w;
                    }
            }
        }
    }
};
template <class EpiT, class Sched, bool ALIGN_EPI = false, bool SP2 = false>
__device__ __forceinline__ void gemm_phase(LAS unsigned char* lds, const Gemm g, const Sched& S, const EpiT& E, int wv) {
    int tid_ = TIDW(wv); asm volatile("" : "+v"(tid_));
    const int tid = tid_, wid = __builtin_amdgcn_readfirstlane(tid >> 6), lane = tid & 63, wr = wid >> 2, wc = wid & 3, fr = lane & 15, fq = lane >> 4;
    const int K = g.K, nt = K / BK;
    unsigned voffA[2], voffB[2];
#pragma unroll
    for (int i = 0; i < 2; ++i) { int R, C; stage_rc(tid * 16 + i * 8192, R, C); const int Rb = EpiT::PERM ? ((R & ~31) + perm32(R & 31)) : R;
        voffA[i] = (unsigned)(R * K + C) * 2u; voffB[i] = (unsigned)(Rb * K + C) * 2u; }
    const size_t kstep = (size_t)(BK * 2);
    const size_t hstep = (size_t)HALF * K * 2;
    const size_t tstep = 2 * hstep;
    const unsigned ldsw = (unsigned)wid * 1024u;
    const int aoff = lds_byte(wr * 64 + fr, fq * 8), boff = lds_byte(wc * 32 + fr, fq * 8);
#define PG8_SA(b, h) (((b) * 2 + (h)) * HTB)
#define PG8_SB(b, h) ((4 + (b) * 2 + (h)) * HTB)
#define PG8_STAGE(bufoff, gbase, voff) do { _Pragma("unroll") for (int _i = 0; _i < 2; ++_i) \
        __builtin_amdgcn_global_load_lds((const unsigned*)((const char*)(gbase) + (voff)[_i]), (LAS unsigned*)(lds + (bufoff) + ldsw + _i * 8192), 16, 0, 0); } while (0)
#define PG8_LDA(dst, b, h) do { _Pragma("unroll") for (int m = 0; m < 4; ++m) _Pragma("unroll") for (int k = 0; k < 2; ++k) dst[m][k] = *(const LAS bf16x8*)(lds + PG8_SA(b, h) + aoff + m * 2048 + k * 1024); } while (0)
#define PG8_LDB(dst, b, h) do { _Pragma("unroll") for (int n = 0; n < 2; ++n) _Pragma("unroll") for (int k = 0; k < 2; ++k) dst[n][k] = *(const LAS bf16x8*)(lds + PG8_SB(b, h) + boff + n * 2048 + k * 1024); } while (0)
#define PG8_MMA(ai, bj, At, Bt) do { __builtin_amdgcn_s_setprio(1); _Pragma("unroll") for (int m = 0; m < 4; ++m) _Pragma("unroll") for (int n = 0; n < 2; ++n) _Pragma("unroll") for (int k = 0; k < 2; ++k) \
        acc[ai][bj][m][n] = __builtin_amdgcn_mfma_f32_16x16x32_bf16(Bt[n][k], At[m][k], acc[ai][bj][m][n], 0, 0, 0); __builtin_amdgcn_s_setprio(0); } while (0)
#define PG8_WAIT_V(n) asm volatile("s_waitcnt vmcnt(" #n ")" ::: "memory")
#define PG8_WAIT_L(n) asm volatile("s_waitcnt lgkmcnt(" #n ")" ::: "memory")
#define PG8_BAR __builtin_amdgcn_s_barrier()
#define PG8_SCHED __builtin_amdgcn_sched_barrier(0)
    Unit cur, nxt; int ui = 0;
    if (!S.next(0, cur)) return;
    f32x4 acc[2][2][4][2];
#pragma unroll
    for (int a = 0; a < 2; ++a)
#pragma unroll
        for (int b = 0; b < 2; ++b)
#pragma unroll
            for (int m = 0; m < 4; ++m)
#pragma unroll
                for (int n = 0; n < 2; ++n) acc[a][b][m][n] = (f32x4){0.f, 0.f, 0.f, 0.f};
    bf16x8 At[4][2], B0[2][2], B1[2][2];
    const char* cA = (const char*)g.A + (size_t)cur.pm * tstep; const char* cB = (const char*)g.Bt + (size_t)cur.pn * tstep;
    S.a_ready(cur);
    if constexpr (SP2) {
        PG8_STAGE(PG8_SB(0, 0), cB, voffB); PG8_STAGE(PG8_SB(0, 1), cB + hstep, voffB); PG8_STAGE(PG8_SA(0, 0), cA, voffA); PG8_STAGE(PG8_SA(0, 1), cA + hstep, voffA);
        if (wr == 1) PG8_BAR;
        PG8_WAIT_V(2); PG8_BAR;
        PG8_STAGE(PG8_SB(1, 0), cB + kstep, voffB); PG8_STAGE(PG8_SA(1, 0), cA + kstep, voffA); PG8_STAGE(PG8_SB(1, 1), cB + hstep + kstep, voffB);
        PG8_WAIT_V(6); PG8_BAR;
    } else {
        PG8_STAGE(PG8_SB(0, 0), cB, voffB); PG8_STAGE(PG8_SA(0, 0), cA, voffA); PG8_STAGE(PG8_SB(0, 1), cB + hstep, voffB); PG8_STAGE(PG8_SA(0, 1), cA + hstep, voffA);
        if (wr == 1) PG8_BAR;
        PG8_WAIT_V(4); PG8_BAR;
        PG8_STAGE(PG8_SB(1, 0), cB + kstep, voffB); PG8_STAGE(PG8_SA(1, 0), cA + kstep, voffA); PG8_STAGE(PG8_SB(1, 1), cB + hstep + kstep, voffB);
        PG8_WAIT_V(6); PG8_BAR;
    }
    for (;;) {
        const bool has_next = S.next(ui + 1, nxt);
        const char* nA = has_next ? (const char*)g.A + (size_t)nxt.pm * tstep : cA; const char* nB = has_next ? (const char*)g.Bt + (size_t)nxt.pn * tstep : cB;
        for (int t = 0; t < nt; t += 2) {
            const bool last = (t == nt - 2);
            const char* a1 = cA + (size_t)(t + 1) * kstep;
            const char* a2 = last ? nA : cA + (size_t)(t + 2) * kstep; const char* b2 = last ? nB : cB + (size_t)(t + 2) * kstep;
            const char* a3 = a2 + kstep; const char* b3 = b2 + kstep;
            if (last && has_next) S.a_ready(nxt);
            if constexpr (SP2) {
            PG8_LDB(B0, 0, 0); PG8_LDB(B1, 0, 1); PG8_SCHED; PG8_LDA(At, 0, 0); PG8_STAGE(PG8_SA(1, 1), a1 + hstep, voffA);
            PG8_WAIT_V(8); PG8_WAIT_L(0); PG8_BAR; PG8_MMA(0, 0, At, B0); PG8_MMA(0, 1, At, B1); PG8_BAR; PG8_SCHED;
            PG8_LDA(At, 0, 1); PG8_STAGE(PG8_SB(0, 0), b2, voffB); PG8_STAGE(PG8_SB(0, 1), b2 + hstep, voffB); PG8_STAGE(PG8_SA(0, 0), a2, voffA);
            PG8_WAIT_V(8); PG8_WAIT_L(0); PG8_BAR; PG8_MMA(1, 0, At, B0); PG8_MMA(1, 1, At, B1); PG8_BAR; PG8_SCHED;
            PG8_LDB(B0, 1, 0); PG8_LDB(B1, 1, 1); PG8_SCHED; PG8_LDA(At, 1, 0); PG8_STAGE(PG8_SA(0, 1), a2 + hstep, voffA);
            PG8_WAIT_V(8); PG8_WAIT_L(0); PG8_BAR; PG8_MMA(0, 0, At, B0); PG8_MMA(0, 1, At, B1); PG8_BAR; PG8_SCHED;
            PG8_LDA(At, 1, 1); PG8_STAGE(PG8_SB(1, 0), b3, voffB); PG8_STAGE(PG8_SB(1, 1), b3 + hstep, voffB); PG8_STAGE(PG8_SA(1, 0), a3, voffA);
            PG8_WAIT_V(8); PG8_WAIT_L(0); PG8_BAR; PG8_MMA(1, 0, At, B0); PG8_MMA(1, 1, At, B1); PG8_BAR; PG8_SCHED;
            } else {
            PG8_LDB(B0, 0, 0); PG8_SCHED; PG8_LDA(At, 0, 0); PG8_STAGE(PG8_SA(1, 1), a1 + hstep, voffA);
            PG8_WAIT_L(8); PG8_BAR; PG8_WAIT_L(0); PG8_MMA(0, 0, At, B0); PG8_BAR; PG8_SCHED;
            PG8_LDB(B1, 0, 1); PG8_STAGE(PG8_SB(0, 0), b2, voffB);
            PG8_BAR; PG8_WAIT_L(0); PG8_MMA(0, 1, At, B1); PG8_BAR;
            PG8_LDA(At, 0, 1); PG8_STAGE(PG8_SA(0, 0), a2, voffA);
            PG8_BAR; PG8_WAIT_L(0); PG8_MMA(1, 0, At, B0); PG8_BAR; PG8_SCHED;
            PG8_STAGE(PG8_SB(0, 1), b2 + hstep, voffB);
            PG8_WAIT_V(6); PG8_BAR; PG8_MMA(1, 1, At, B1); PG8_BAR;
            PG8_LDB(B0, 1, 0); PG8_SCHED; PG8_LDA(At, 1, 0); PG8_STAGE(PG8_SA(0, 1), a2 + hstep, voffA);
            PG8_WAIT_L(8); PG8_BAR; PG8_WAIT_L(0); PG8_MMA(0, 0, At, B0); PG8_BAR; PG8_SCHED;
            PG8_LDB(B1, 1, 1); PG8_STAGE(PG8_SB(1, 0), b3, voffB);
            PG8_BAR; PG8_WAIT_L(0); PG8_MMA(0, 1, At, B1); PG8_BAR;
            PG8_LDA(At, 1, 1); PG8_STAGE(PG8_SA(1, 0), a3, voffA);
            PG8_BAR; PG8_WAIT_L(0); PG8_MMA(1, 0, At, B0); PG8_BAR; PG8_SCHED;
            PG8_STAGE(PG8_SB(1, 1), b3 + hstep, voffB);
            PG8_WAIT_V(6); PG8_BAR; PG8_MMA(1, 1, At, B1); PG8_BAR;
            }
        }
        if constexpr (ALIGN_EPI) { if (wr == 0) PG8_BAR; }
        if constexpr (!EpiT::AFTER_DRAIN) { E(acc, cur, wr, wc, fr, fq); S.done(cur); }
        if (!has_next) break;
#pragma unroll
        for (int a = 0; a < 2; ++a)
#pragma unroll
            for (int b = 0; b < 2; ++b)
#pragma unroll
                for (int m = 0; m < 4; ++m)
#pragma unroll
                    for (int n = 0; n < 2; ++n) acc[a][b][m][n] = (f32x4){0.f, 0.f, 0.f, 0.f};
        cur = nxt; cA = nA; cB = nB; ++ui;
        if constexpr (ALIGN_EPI) { if (wr == 1) PG8_BAR; }
    }
    PG8_WAIT_V(0);
    if constexpr (!ALIGN_EPI) { if (wr == 0) PG8_BAR; }
    PG8_BAR;
    if constexpr (EpiT::AFTER_DRAIN) E.fused(acc, cur, wr, wc, fr, fq, lds, wid, lane);
#undef PG8_SA
#undef PG8_SB
#undef PG8_STAGE
#undef PG8_LDA
#undef PG8_LDB
#undef PG8_MMA
#undef PG8_WAIT_V
#undef PG8_WAIT_L
#undef PG8_BAR
#undef PG8_SCHED
}
}

template <int MODE, int K> __device__ __forceinline__ void sgemm_sample(LAS unsigned char* lds, const bf16* A, const bf16* Bt, int N, bf16* O, int ldc, const bf16* aux, int ldaux, const bf16* add, int ldadd, int vcu, int G, int wv,
                                                                 unsigned* sig = nullptr) {
    int tid = TIDW(wv); asm volatile("" : "+v"(tid));
    const int lane = tid & 63, wave = __builtin_amdgcn_readfirstlane(tid >> 6), l15 = lane & 15, g4 = lane >> 4, tsel = wave & 1, kq = wave >> 1;
    constexpr int kn = K >> 2, KQ = kn / 32;
    const int npair = N >> 5, nitem = 8 * npair;
    LAS f32x4* red = (LAS f32x4*)lds;
    for (int item = vcu; item < nitem; item += G) {
        const int tr = item / npair, ct = 2 * (item - tr * npair) + tsel;
        const int row = MP + tr * 16 + l15;
        const bf16* ap = A + (size_t)row * K + kq * kn + 8 * g4;
        const bf16* bp = Bt + (size_t)(ct * 16 + l15) * K + kq * kn + 8 * g4;
        f32x4 acc = {0.f, 0.f, 0.f, 0.f};
        bf16x8 av[KQ], bv[KQ];
#pragma unroll
        for (int k = 0; k < KQ; ++k) { av[k] = *(const bf16x8*)(ap + 32 * k); bv[k] = *(const bf16x8*)(bp + 32 * k); }
        u32x2 zz = {0u, 0u}, yy = {0u, 0u};
        if constexpr (MODE == pg8::EM_MULZ || MODE == pg8::EM_FMAZ || MODE == pg8::EM_SIGMUL) { if (kq == 0) zz = *(const u32x2*)(aux + (size_t)row * ldaux + ct * 16 + 4 * g4); }
        if constexpr (MODE == pg8::EM_FMAZ) { if (kq == 0) yy = *(const u32x2*)(add + (size_t)row * ldadd + ct * 16 + 4 * g4); }
#pragma unroll
        for (int k = 0; k < KQ; ++k) acc = __builtin_amdgcn_mfma_f32_16x16x32_bf16(bv[k], av[k], acc, 0, 0, 0);
        __syncthreads();
        if (kq > 0) red[(tsel * 3 + (kq - 1)) * 64 + lane] = acc;
        __syncthreads();
        if (kq == 0) {
            acc = acc + red[(tsel * 3 + 0) * 64 + lane] + red[(tsel * 3 + 1) * 64 + lane] + red[(tsel * 3 + 2) * 64 + lane];
            const int col = ct * 16 + 4 * g4;
            f32x4 v = acc;
            if constexpr (MODE == pg8::EM_MULZ || MODE == pg8::EM_FMAZ || MODE == pg8::EM_SIGMUL) {
                const f32x4 zf = {bflo(zz.x), bfhi(zz.x), bflo(zz.y), bfhi(zz.y)};
                if constexpr (MODE == pg8::EM_SIGMUL) { for (int j = 0; j < 4; ++j) v[j] = sigmoid_f(v[j]); }
                v = v * zf;
                if constexpr (MODE == pg8::EM_FMAZ) { v += (f32x4){bflo(yy.x), bfhi(yy.x), bflo(yy.y), bfhi(yy.y)}; }
            }
            u32x2 w; w.x = pk2(v[0], v[1]); w.y = pk2(v[2], v[3]);
            if (sig) __hip_atomic_store((unsigned long long*)(O + (size_t)row * ldc + col), ((unsigned long long)w.y << 32) | w.x, __ATOMIC_RELAXED, __HIP_MEMORY_SCOPE_AGENT);
            else *(u32x2*)(O + (size_t)row * ldc + col) = w;
        }
    }
    if (sig) asm volatile("s_waitcnt vmcnt(0)" ::: "memory");
    __syncthreads();
    if (sig && wv == 0 && lane == 0) { for (int item = vcu; item < nitem; item += G) (void)__hip_atomic_fetch_add(sig + 64 * (item / npair), 1u, __ATOMIC_RELAXED, __HIP_MEMORY_SCOPE_AGENT); }
}

constexpr int RING_OFF = 0, RING_BYTES = 131072;
constexpr int LDSCTL_OFF = RING_BYTES, MISC_OFF = LDSCTL_OFF + 320;
constexpr int LDS_BYTES = 147456;
constexpr int NWAVES = 8;

#define XB_TMO      128
#define XB_XCNT(j)  (256  + 64 * (j))
#define XB_XSUB(j)  (1280 + 64 * (j))
#define XB_XGEN(j)  (2304 + 64 * (j))
#define XB_TOP      3328
#define XB_TOPGEN   3392
#define XCD_BAR_WORDS 3456
#define XB_SPIN_CAP (1u << 18)
__device__ __forceinline__ unsigned xb_ld(unsigned* p)              { return __hip_atomic_load(p, __ATOMIC_RELAXED, __HIP_MEMORY_SCOPE_AGENT); }
__device__ __forceinline__ unsigned xb_add(unsigned* p, unsigned v) { return __hip_atomic_fetch_add(p, v, __ATOMIC_RELAXED, __HIP_MEMORY_SCOPE_AGENT); }
__device__ __forceinline__ unsigned xb_xcc_id() { return (unsigned)__builtin_amdgcn_s_getreg((3 << 11) | 20) & 0xFu; }
#define XB_SPIN(cond, bar) do { unsigned _sp = 0; while (cond) { __builtin_amdgcn_s_sleep(1); \
    if ((++_sp & 255u) == 0u) { if (xb_ld(&(bar)[XB_TMO])) break; if (_sp > XB_SPIN_CAP) { atomicAdd(&(bar)[XB_TMO], 1u); break; } } } } while (0)
struct XcdBarrier { unsigned* bar; unsigned x; volatile LAS unsigned* st; bool t0; };
__device__ __forceinline__ XcdBarrier xcd_barrier_post(unsigned* bar, volatile LAS unsigned* st) {
    XcdBarrier b; b.bar = bar; b.x = xb_xcc_id(); b.st = st;
    if (threadIdx.x == 0) (void)xb_add(&bar[XB_XCNT(b.x)], 1u);
    return b;
}
__device__ __forceinline__ void xcd_barrier_complete(unsigned* bar, unsigned x, unsigned& nloc, unsigned& nx) {
    const unsigned G = gridDim.x * gridDim.y * gridDim.z;
    unsigned sum, cnt, mine, sp = 0u;
    for (;;) {
        sum = 0u; cnt = 0u; mine = 0u;
#pragma unroll
        for (unsigned j = 0; j < 16; ++j) { const unsigned c = xb_ld(&bar[XB_XCNT(j)]); sum += c; cnt += (c > 0u) ? 1u : 0u; mine = (j == x) ? c : mine; }
        if (sum == G) break;
        __builtin_amdgcn_s_sleep(1);
        if ((++sp & 255u) == 0u) { if (xb_ld(&bar[XB_TMO])) break; if (sp > XB_SPIN_CAP) { atomicAdd(&bar[XB_TMO], 1u); break; } }
    }
    nloc = mine > 0u ? mine : 1u; nx = cnt > 0u ? cnt : 1u;
}
__device__ __forceinline__ void xcd_barrier(const XcdBarrier& b) {
    asm volatile("s_waitcnt vmcnt(0)" ::: "memory");
    __syncthreads();
    if (b.t0) {
        unsigned* bar = b.bar;
        __builtin_amdgcn_s_waitcnt(0);
        unsigned nloc = b.st[0], nx = b.st[1];
        if (nloc == 0u) { xcd_barrier_complete(bar, b.x, nloc, nx); b.st[0] = nloc; b.st[1] = nx; }
        const unsigned old = xb_add(&bar[XB_XSUB(b.x)], 1u);
        const unsigned gen = old / nloc;
        if (old + 1u == (gen + 1u) * nloc) {
            __builtin_amdgcn_fence(__ATOMIC_RELEASE, "agent");
            asm volatile("s_waitcnt vmcnt(0)" ::: "memory");
            const unsigned og = xb_add(&bar[XB_TOP], 1u);
            const unsigned tg = og / nx;
            if (og + 1u == (tg + 1u) * nx) xb_add(&bar[XB_TOPGEN], 1u);
            else XB_SPIN(xb_ld(&bar[XB_TOPGEN]) == tg, bar);
            __builtin_amdgcn_fence(__ATOMIC_ACQUIRE, "agent");
            xb_add(&bar[XB_XGEN(b.x)], 1u);
            asm volatile("s_waitcnt vmcnt(0)" ::: "memory");
        } else {
            XB_SPIN(xb_ld(&bar[XB_XGEN(b.x)]) == gen, bar);
            __builtin_amdgcn_fence(__ATOMIC_ACQUIRE, "agent");
            asm volatile("s_waitcnt vmcnt(0)" ::: "memory");
        }
    }
    __syncthreads();
}
__device__ __forceinline__ void xcd_barrier_arrive(const XcdBarrier& b) {
    asm volatile("s_waitcnt vmcnt(0)" ::: "memory");
    __syncthreads();
    if (b.t0) {
        unsigned* bar = b.bar;
        __builtin_amdgcn_s_waitcnt(0);
        unsigned nloc = b.st[0], nx = b.st[1];
        if (nloc == 0u) { xcd_barrier_complete(bar, b.x, nloc, nx); b.st[0] = nloc; b.st[1] = nx; }
        const unsigned old = xb_add(&bar[XB_XSUB(b.x)], 1u);
        const unsigned gen = old / nloc;
        if (old + 1u == (gen + 1u) * nloc) {
            __builtin_amdgcn_fence(__ATOMIC_RELEASE, "agent");
            asm volatile("s_waitcnt vmcnt(0)" ::: "memory");
            const unsigned og = xb_add(&bar[XB_TOP], 1u);
            const unsigned tg = og / nx;
            if (og + 1u == (tg + 1u) * nx) xb_add(&bar[XB_TOPGEN], 1u);
            else XB_SPIN(xb_ld(&bar[XB_TOPGEN]) == tg, bar);
            __builtin_amdgcn_fence(__ATOMIC_ACQUIRE, "agent");
            xb_add(&bar[XB_XGEN(b.x)], 1u);
            asm volatile("s_waitcnt vmcnt(0)" ::: "memory");
            b.st[3] = 1u;
        } else { b.st[2] = gen; b.st[3] = 0u; }
    }
    __syncthreads();
}
__device__ __forceinline__ void xcd_barrier_finish(const XcdBarrier& b) {
    if (b.t0) {
        if (b.st[3] == 0u) { const unsigned gen = b.st[2]; XB_SPIN(xb_ld(&b.bar[XB_XGEN(b.x)]) == gen, b.bar); __builtin_amdgcn_fence(__ATOMIC_ACQUIRE, "agent"); asm volatile("s_waitcnt vmcnt(0)" ::: "memory"); }
    }
    __syncthreads();
}

struct Args { const void* in[N_PTR]; int ph_lo, ph_hi, li, pad; };

template <int MAP> __device__ __forceinline__ int rowmap(int n, int row_off) {
    if constexpr (MAP == 1) return (n >> 7) * 256 + (n & 127);
    else if constexpr (MAP == 2) return (n >> 7) * 256 + 128 + (n & 127);
    else if constexpr (MAP == 3) return n < 3232 ? n : n + 96;
    else if constexpr (MAP == 4) { const int d = n & 31; return row_off + (n & ~31) + 8 * ((d >> 2) & 3) + 4 * (d >> 4) + (d & 3); }
    else return row_off + n;
}
template <int MAP> __device__ __forceinline__ void transpose_item(const float* W, int K, int N, bf16* WT, int row_off, LAS float* scr, int item, int lane, float wscale = 1.f) {
    const int nblk = N / 32, kb = item / nblk, nb = item % nblk, k0 = 64 * kb, n0 = 32 * nb;
#pragma unroll 8
    for (int i = 0; i < 32; ++i) { const int kk = 2 * i + (lane >> 5); scr[kk * 33 + (lane & 31)] = W[(size_t)(k0 + kk) * N + n0 + (lane & 31)] * wscale; }
    LDS_WAIT(); asm volatile("" ::: "memory");
    const int c = lane & 7;
#pragma unroll
    for (int j = 0; j < 4; ++j) { const int n = (lane >> 3) + 8 * j; const LAS float* s = scr + (8 * c) * 33 + n;
        u32x4 o; o.x = pk2(s[0 * 33], s[1 * 33]); o.y = pk2(s[2 * 33], s[3 * 33]); o.z = pk2(s[4 * 33], s[5 * 33]); o.w = pk2(s[6 * 33], s[7 * 33]);
        *(u32x4*)(WT + (size_t)rowmap<MAP>(n0 + n, row_off) * K + k0 + 8 * c) = o; }
    LDS_WAIT(); asm volatile("" ::: "memory");
}
__device__ __forceinline__ const float* xrow_ptr(const Args& a, int m, int z) {
    if (m < MP) return (const float*)a.in[I_XP + z] + (size_t)m * DM;
    if (m < MP + NS) return (const float*)a.in[I_XS + z] + (size_t)(m - MP) * DM;
    return nullptr;
}
__device__ __forceinline__ void rms_row_to_bf16(const float* xrow, const float* gain, bf16* orow, int lane) {
    f32x4 v[4]; float s = 0.f;
#pragma unroll
    for (int j = 0; j < 4; ++j) { v[j] = xrow ? ((const f32x4*)xrow)[lane + 64 * j] : (f32x4){0.f, 0.f, 0.f, 0.f}; s += (v[j].x * v[j].x + v[j].y * v[j].y) + (v[j].z * v[j].z + v[j].w * v[j].w); }
    const float rstd = 1.f / sqrtf(wave_sum(s) * (1.f / DM) + EPS);
#pragma unroll
    for (int j = 0; j < 4; ++j) { const f32x4 g = ((const f32x4*)gain)[lane + 64 * j];
        u32x2 o; o.x = pk2(v[j].x * rstd * g.x, v[j].y * rstd * g.y); o.y = pk2(v[j].z * rstd * g.z, v[j].w * rstd * g.w);
        ((u32x2*)orow)[lane + 64 * j] = o; }
}
constexpr int CVI_UP = 16 * 88, CVI_DN = 44 * 32, CVI_IN = 16 * 165, CVI_RNN = 20 * 32, CVI_UQ = 6 * 32, CVI_QR = 6 * 16, CVI_UK = 4 * 32, CVI_SQ = 16 * 32, CVI_PPJ = 4 * 32;
constexpr int CV_A = 2 * CVI_UP, CV_B = CV_A + CVI_DN + CVI_IN, CV_N = CV_B + 2 * CVI_UP + CVI_DN + CVI_RNN + CVI_UQ + CVI_QR + 2 * CVI_UK + 3 * CVI_SQ + CVI_PPJ;
__device__ __forceinline__ void convert_item(const Args& a, int z, unsigned char* ws, LAS float* scr, int it, int lane) {
    int r = it;
    if (r < CVI_UP) { transpose_item<1>((const float*)a.in[I_F1G + z], DM, DFF, (bf16*)(ws + WS_BUP1), 0, scr, r, lane); return; } r -= CVI_UP;
    if (r < CVI_UP) { transpose_item<2>((const float*)a.in[I_F1U + z], DM, DFF, (bf16*)(ws + WS_BUP1), 0, scr, r, lane); return; } r -= CVI_UP;
    if (r < CVI_DN) { transpose_item<0>((const float*)a.in[I_F1D + z], DFF, DM, (bf16*)(ws + WS_BDN1), 0, scr, r, lane); return; } r -= CVI_DN;
    if (r < CVI_IN) { transpose_item<3>((const float*)a.in[I_WIN + z], DM, DIN, (bf16*)(ws + WS_BIN), 0, scr, r, lane); return; } r -= CVI_IN;
    if (r < CVI_UP) { transpose_item<1>((const float*)a.in[I_F2G + z], DM, DFF, (bf16*)(ws + WS_BUP2), 0, scr, r, lane); return; } r -= CVI_UP;
    if (r < CVI_UP) { transpose_item<2>((const float*)a.in[I_F2U + z], DM, DFF, (bf16*)(ws + WS_BUP2), 0, scr, r, lane); return; } r -= CVI_UP;
    if (r < CVI_DN) { transpose_item<0>((const float*)a.in[I_F2D + z], DFF, DM, (bf16*)(ws + WS_BDN2), 0, scr, r, lane); return; } r -= CVI_DN;
    if (r < CVI_RNN) { transpose_item<0>((const float*)a.in[I_WRNN + z], DRNN, DM, (bf16*)(ws + WS_BRNN), 0, scr, r, lane); return; } r -= CVI_RNN;
    if (r < CVI_UQ) { transpose_item<0>((const float*)a.in[I_WUQ + z], QL, 1024, (bf16*)(ws + WS_BQ), 0, scr, r, lane, C2); return; } r -= CVI_UQ;
    if (r < CVI_QR) { transpose_item<0>((const float*)a.in[I_WQR + z], QL, 512, (bf16*)(ws + WS_BQ), 1024, scr, r, lane, C2); return; } r -= CVI_QR;
    if (r < CVI_UK) { transpose_item<0>((const float*)a.in[I_WUK + z], KVL, 1024, (bf16*)(ws + WS_BKV), 0, scr, r, lane); return; } r -= CVI_UK;
    if (r < CVI_UK) { transpose_item<0>((const float*)a.in[I_WUV + z], KVL, 1024, (bf16*)(ws + WS_BKV), 1024, scr, r, lane); return; } r -= CVI_UK;
    if (r < CVI_SQ) { transpose_item<0>((const float*)a.in[I_WATT + z], DM, DM, (bf16*)(ws + WS_BATT), 0, scr, r, lane); return; } r -= CVI_SQ;
    if (r < CVI_SQ) { transpose_item<0>((const float*)a.in[I_WOUT + z], DM, DM, (bf16*)(ws + WS_BOUT), 0, scr, r, lane); return; } r -= CVI_SQ;
    if (r < CVI_SQ) { transpose_item<0>((const float*)a.in[I_PG + z], DM, DM, (bf16*)(ws + WS_BPG), 0, scr, r, lane); return; } r -= CVI_SQ;
    transpose_item<0>((const float*)a.in[I_PPJ + z], DPLE, DM, (bf16*)(ws + WS_BPP), 0, scr, r, lane);
}
__device__ __forceinline__ void convert_range(const Args& a, LAS unsigned char* lds, int lo, int hi, int w, int nw, int wv) {
    int z = 0; asm volatile("" : "+s"(z));
    int tid = TIDW(wv); asm volatile("" : "+v"(tid)); const int lane = tid & 63, wave = wv;
    unsigned char* ws = (unsigned char*)a.in[I_WS + z];
    LAS float* scr = (LAS float*)(lds + RING_OFF + wave * 16384);
    for (int it = lo + w; it < hi; it += nw) convert_item(a, z, ws, scr, it, lane);
}
__device__ __forceinline__ void convert_in_tail(const Args& a, LAS unsigned char* lds, int nwg, int G, int c, int lo, int hi, int wv) {
    const int full = (nwg + G - 1) / G, nl = full * G - nwg;
    const int wave = wv;
    if (nl == 0) { convert_range(a, lds, lo, hi, c * NWAVES + wave, G * NWAVES, wv); return; }
    if (c >= G - nl) convert_range(a, lds, lo, hi, (c - (G - nl)) * NWAVES + wave, nl * NWAVES, wv);
}
__device__ __forceinline__ void p0_prologue(const Args& a, LAS unsigned char* lds, int vcu, int G, int tid, int lane, int wave) {
    int z = 0; asm volatile("" : "+s"(z));
    unsigned char* ws = (unsigned char*)a.in[I_WS + z];
    const int gw = vcu * NWAVES + wave, NGW = G * NWAVES;
    convert_range(a, lds, 0, CV_A, gw, NGW, wave);
    const int gt = vcu * 512 + tid, NGT = G * 512;
    for (int i = gt; i < 12288; i += NGT) ((u32x4*)(ws + WS_BIN + (size_t)3232 * DM * 2))[i] = (u32x4){0u, 0u, 0u, 0u};
    for (int i = gt; i < NBLK * 160 * 104; i += NGT) {
        const int n = i / (160 * 104), r = i - n * (160 * 104), j = r / 104, k = r - j * 104;
        float v = 0.f;
        if (k < 80) v = j < 80 ? ((const float*)a.in[I_LWA + z])[(n * 80 + k) * 80 + j] : ((const float*)a.in[I_LWI + z])[(n * 80 + k) * 80 + (j - 80)];
        ((bf16*)(ws + WS_LW))[i] = f2bf(v);
    }
    for (int i = gt; i < ROPE_TAB; i += NGT) {
        const int pos = i >> 4, k = i & 15;
        const double freq = exp2(-(double)k * (13.287712379549449 / 16.0));
        double rev = (double)pos * freq * 0.15915494309189535;
        rev -= floor(rev);
        const float rf = (float)rev;
        ((float*)(ws + WS_ROPE))[i] = __builtin_amdgcn_cosf(rf);
        ((float*)(ws + WS_ROPE))[ROPE_TAB + i] = __builtin_amdgcn_sinf(rf);
    }
    for (int m0 = gw; m0 < MT; m0 += 2 * NGW)
#pragma unroll
    for (int qq = 0; qq < 2; ++qq) { const int m = m0 + qq * NGW; if (m >= MT) break;
        rms_row_to_bf16(xrow_ptr(a, m, z), (const float*)a.in[I_F1PRE + z], (bf16*)(ws + WS_XN) + (size_t)m * DM, lane);
        const float* pr = m < MP ? (const float*)a.in[I_PP + z] + (size_t)m * DPLE : (m < MP + NS ? (const float*)a.in[I_PS + z] + (size_t)(m - MP) * DPLE : nullptr);
        const f32x4 v = pr ? ((const f32x4*)pr)[lane] : (f32x4){0.f, 0.f, 0.f, 0.f};
        u32x2 o; o.x = pk2(v.x, v.y); o.y = pk2(v.z, v.w);
        ((u32x2*)((bf16*)(ws + WS_PB) + (size_t)m * DPLE))[lane] = o;
    }
}

template <int NEXT, int SRC> __device__ __forceinline__ void norm_rows(const Args& a, const bf16* Fin, float coef, int i_post, int i_pre, int first, int NGW, int end, int lane) {
    int z = 0; asm volatile("" : "+s"(z));
    unsigned char* ws = (unsigned char*)a.in[I_WS + z];
    bf16* XR = (bf16*)(ws + WS_XR); bf16* XN = (bf16*)(ws + WS_XN);
    const float* post = (const float*)a.in[i_post + z]; const float* pre = (const float*)a.in[i_pre + z];
    for (int m0 = first; m0 < end; m0 += 2 * NGW) {
        f32x4 f[2][4], x[2][4]; float s[2] = {0.f, 0.f};
#pragma unroll
        for (int q = 0; q < 2; ++q) { const int m = m0 + q * NGW; const bool ok = m < end; const int mm = ok ? m : m0;
            const float* xr = SRC == 0 ? xrow_ptr(a, mm, z) : nullptr;
            const bf16* xb = (SRC == 1 ? XR : XN) + (size_t)mm * DM;
#pragma unroll
            for (int j = 0; j < 4; ++j) {
                const u32x2 w = ((const u32x2*)(Fin + (size_t)mm * DM))[lane + 64 * j];
                f[q][j] = (f32x4){bflo(w.x), bfhi(w.x), bflo(w.y), bfhi(w.y)};
                if constexpr (SRC == 0) x[q][j] = ((const f32x4*)xr)[lane + 64 * j];
                else { const u32x2 xw = ((const u32x2*)xb)[lane + 64 * j]; x[q][j] = (f32x4){bflo(xw.x), bfhi(xw.x), bflo(xw.y), bfhi(xw.y)}; }
                s[q] += (f[q][j].x * f[q][j].x + f[q][j].y * f[q][j].y) + (f[q][j].z * f[q][j].z + f[q][j].w * f[q][j].w);
            } }
#pragma unroll
        for (int q = 0; q < 2; ++q) { const int m = m0 + q * NGW; if (m >= end) break;
            const float rstd = coef / sqrtf(wave_sum(s[q]) * (1.f / DM) + EPS);
            float s2 = 0.f;
#pragma unroll
            for (int j = 0; j < 4; ++j) { const f32x4 g = ((const f32x4*)post)[lane + 64 * j]; x[q][j] = x[q][j] + f[q][j] * g * rstd; s2 += (x[q][j].x * x[q][j].x + x[q][j].y * x[q][j].y) + (x[q][j].z * x[q][j].z + x[q][j].w * x[q][j].w); }
            if constexpr (NEXT == 0) {
#pragma unroll
                for (int j = 0; j < 4; ++j) ((f32x4*)((float*)a.in[I_OUT + z] + O_Y + (size_t)m * DM))[lane + 64 * j] = x[q][j];
            } else {
                if constexpr (NEXT == 1) {
#pragma unroll
                    for (int j = 0; j < 4; ++j) { u32x2 o; o.x = pk2(x[q][j].x, x[q][j].y); o.y = pk2(x[q][j].z, x[q][j].w); ((u32x2*)(XR + (size_t)m * DM))[lane + 64 * j] = o; }
                }
                float r2 = 1.f;
                if constexpr (NEXT == 1) r2 = 1.f / sqrtf(wave_sum(s2) * (1.f / DM) + EPS);
#pragma unroll
                for (int j = 0; j < 4; ++j) {
                    f32x4 g = {1.f, 1.f, 1.f, 1.f};
                    if constexpr (NEXT == 1) g = ((const f32x4*)pre)[lane + 64 * j];
                    u32x2 o; o.x = pk2(x[q][j].x * r2 * g.x, x[q][j].y * r2 * g.y); o.y = pk2(x[q][j].z * r2 * g.z, x[q][j].w * r2 * g.w);
                    ((u32x2*)(XN + (size_t)m * DM))[lane + 64 * j] = o;
                }
            }
        }
    }
}
template <int NEXT, int SRC> __device__ __forceinline__ void sample_norm(const Args& a, unsigned* sig, const bf16* Fin, float coef, int i_post, int i_pre, int G, int vcu, int wv) {
    constexpr int npair = DM >> 5, nitem = 8 * npair;
    const int lane = lane_id();
    for (int item = vcu; item < nitem; item += G) {
        if (item % npair != 0) continue;
        const int tr = item / npair;
        if (wv == 0) { unsigned sp = 0u; while ((unsigned)__builtin_amdgcn_readfirstlane(__hip_atomic_load(sig + 64 * tr, __ATOMIC_RELAXED, __HIP_MEMORY_SCOPE_AGENT)) < (unsigned)npair) { __builtin_amdgcn_s_sleep(1); if (++sp > (1u << 20)) break; }
                       __builtin_amdgcn_fence(__ATOMIC_ACQUIRE, "agent"); asm volatile("s_waitcnt vmcnt(0)" ::: "memory"); }
        __syncthreads();
        norm_rows<NEXT, SRC>(a, Fin, coef, i_post, i_pre, MP + 16 * tr + wv, NWAVES, MP + 16 * tr + 16, lane);
    }
}

__device__ __forceinline__ void mla_prep(const Args& a, int vcu, int G, int lane, int wave) {
    int z = 0; asm volatile("" : "+s"(z));
    unsigned char* ws = (unsigned char*)a.in[I_WS + z];
    const int gw = vcu * NWAVES + wave, NGW = G * NWAVES;
    const bf16* Z = (const bf16*)(ws + WS_Z);
    const float* cosT = (const float*)(ws + WS_ROPE); const float* sinT = cosT + ROPE_TAB;
    const float* qn = (const float*)a.in[I_QNORM + z]; const float* kn = (const float*)a.in[I_KVNORM + z];
    for (int m0 = gw; m0 < MT; m0 += 4 * NGW) {
        unsigned qw[4][3]; u32x2 kw4[4]; float x1[4], x2[4], cs[4], sn4[4];
#pragma unroll
        for (int qq = 0; qq < 4; ++qq) { const int m = m0 + qq * NGW, mm = m < MT ? m : m0; const bf16* zr = Z + (size_t)mm * ZW;
#pragma unroll
            for (int j = 0; j < 3; ++j) qw[qq][j] = ((const unsigned*)(zr + Z_CQ))[lane + 64 * j];
            kw4[qq] = ((const u32x2*)(zr + Z_KV))[lane];
            const int pos = mm < MP ? (mm & (SEQ - 1)) : SEQ, l16 = lane & 15;
            x1[qq] = bf2f(zr[Z_KR + l16]); x2[qq] = bf2f(zr[Z_KR + 16 + l16]); cs[qq] = cosT[pos * 16 + l16]; sn4[qq] = sinT[pos * 16 + l16]; }
#pragma unroll
        for (int qq = 0; qq < 4; ++qq) { const int m = m0 + qq * NGW; if (m >= MT) break;
            float q[6]; float s = 0.f;
#pragma unroll
            for (int j = 0; j < 3; ++j) { const unsigned w = qw[qq][j]; q[2 * j] = bflo(w); q[2 * j + 1] = bfhi(w); s += q[2 * j] * q[2 * j] + q[2 * j + 1] * q[2 * j + 1]; }
            const float rq = __builtin_amdgcn_rsqf(wave_sum(s) * (1.f / QL) + EPS);
#pragma unroll
            for (int j = 0; j < 3; ++j) { const f32x2 g = ((const f32x2*)qn)[lane + 64 * j]; ((unsigned*)((bf16*)(ws + WS_CQ) + (size_t)m * QL))[lane + 64 * j] = pk2(q[2 * j] * rq * g.x, q[2 * j + 1] * rq * g.y); }
            const u32x2 kw = kw4[qq];
            f32x4 kv = {bflo(kw.x), bfhi(kw.x), bflo(kw.y), bfhi(kw.y)};
            const float rk = __builtin_amdgcn_rsqf(wave_sum((kv.x * kv.x + kv.y * kv.y) + (kv.z * kv.z + kv.w * kv.w)) * (1.f / KVL) + EPS);
            kv = kv * rk * ((const f32x4*)kn)[lane];
            { u32x2 o; o.x = pk2(kv.x, kv.y); o.y = pk2(kv.z, kv.w); ((u32x2*)((bf16*)(ws + WS_CKV) + (size_t)m * KVL))[lane] = o; }
            if (m < MP) ((f32x4*)((float*)a.in[I_OUT + z] + O_CKV_P + (size_t)m * KVL))[lane] = kv;
            else if (m < MP + NS) ((f32x4*)((float*)a.in[I_OUT + z] + O_CKV_S + (size_t)(m - MP) * KVL))[lane] = kv;
            if (lane < 16) {
                const float o1 = x1[qq] * cs[qq] - x2[qq] * sn4[qq], o2 = x1[qq] * sn4[qq] + x2[qq] * cs[qq];
                bf16* kr = (bf16*)(ws + WS_KR) + (size_t)m * ROPE;
                kr[lane] = f2bf(o1); kr[16 + lane] = f2bf(o2);
                float* ko = m < MP ? (float*)a.in[I_OUT + z] + O_KR_P + (size_t)m * ROPE : (m < MP + NS ? (float*)a.in[I_OUT + z] + O_KR_S + (size_t)(m - MP) * ROPE : nullptr);
                if (ko) { ko[lane] = o1; ko[16 + lane] = o2; }
            }
        }
    }
    { const float* scv = (const float*)a.in[I_SCONV + z]; float* co = (float*)a.in[I_OUT + z] + O_CONV_S;
      for (int it = gw; it < NS * 3 * (DRNN / 64); it += NGW) { const int sq = it / 60, r = it - 60 * sq, j = r / 20, idx = (r - 20 * j) * 64 + lane;
          co[(size_t)(sq * 3 + j) * DRNN + idx] = j < 2 ? scv[(size_t)(sq * 3 + j + 1) * DRNN + idx] : bf2f(Z[(size_t)(MP + sq) * ZW + Z_XR + idx]); } }
}


constexpr int L2_LW = 0, L2_CW = 33280, L2_TILE = 35328, L2_TPITCH = 84, L2_TBYTES = 16 * L2_TPITCH * 4, L2_WAVE = 2 * L2_TBYTES;
static_assert(L2_TILE + 8 * L2_WAVE <= RING_BYTES, "RG-LRU LDS map");
__device__ __forceinline__ float one_minus_exp(float x) {
    const float t = x * (1.f + x * (0.5f + x * (0.16666667f + x * 0.041666668f)));
    float e = 1.f - __builtin_amdgcn_exp2f(x * 1.4426950408889634f); asm volatile("" : "+v"(e));
    return x > -0.06f ? -t : e;
}
__device__ __forceinline__ void row4(float v, float (&out)[4]) {
    const unsigned u = __float_as_uint(v);
    const auto h = __builtin_amdgcn_permlane32_swap(u, u, false, false);
    const auto lo = __builtin_amdgcn_permlane16_swap(h[0], h[0], false, false);
    const auto hi = __builtin_amdgcn_permlane16_swap(h[1], h[1], false, false);
    out[0] = __uint_as_float(lo[0]); out[1] = __uint_as_float(lo[1]); out[2] = __uint_as_float(hi[0]); out[3] = __uint_as_float(hi[1]);
}
template <int PASS> __device__ __forceinline__ void lru_load(const bf16* Z, int ch0, int row0, int tib0, int l15, int g4, u32x4 (&zw)[3][5]) {
#pragma unroll
    for (int j = 0; j < 3; ++j) { const int cb = 32 * j + 8 * g4;
#pragma unroll
        for (int t = 0; t < 4; ++t) { u32x4 w = {0u, 0u, 0u, 0u}; if (tib0 + l15 + t - 3 >= 0) w = *(const u32x4*)(Z + (size_t)(row0 + l15 + t - 3) * ZW + Z_XR + ch0 + cb); zw[j][t] = w; }
        if (PASS == 2) { u32x4 w = {0u, 0u, 0u, 0u}; if (cb < 80) w = *(const u32x4*)(Z + (size_t)(row0 + l15) * ZW + Z_YR + ch0 + cb); zw[j][4] = w; }
    }
}
template <int PASS, bool SAMP> __device__ __forceinline__ void lru_tile(const Args& a, int z, unsigned char* ws, LAS unsigned char* lds, int n, int row0, int tib0, int lane, int wave,
                                                                        const float (&gba)[5], const float (&gbi)[5], const float (&gsp)[5], float (&carry)[5], float (&aprod)[5], const u32x4 (&zw)[3][5]) {
    const bf16* Z = (const bf16*)(ws + WS_Z);
    const int l15 = lane & 15, g4 = lane >> 4, ch0 = n * BLK;
    LAS float* xt = (LAS float*)(lds + L2_TILE + wave * L2_WAVE); LAS float* ht = xt + 16 * L2_TPITCH;
    const LAS float* cwl = (const LAS float*)(lds + L2_CW);
    bf16x8 af[3];
#pragma unroll
    for (int j = 0; j < 3; ++j) {
        const int cb = 32 * j + 8 * g4;
        float xc[8];
        { const f32x4 b0 = *(const LAS f32x4*)(cwl + 4 * 96 + cb), b1 = *(const LAS f32x4*)(cwl + 4 * 96 + cb + 4); xc[0] = b0.x; xc[1] = b0.y; xc[2] = b0.z; xc[3] = b0.w; xc[4] = b1.x; xc[5] = b1.y; xc[6] = b1.z; xc[7] = b1.w; }
#pragma unroll
        for (int t = 0; t < 4; ++t) {
            float xv[8];
            if (SAMP && t < 3) {
                const float* sp = (const float*)a.in[I_SCONV + z] + (size_t)((row0 - MP + l15) * 3 + t) * DRNN + ch0 + cb;
                if (cb < 80) { const f32x4 v0 = *(const f32x4*)sp, v1 = *(const f32x4*)(sp + 4); xv[0] = v0.x; xv[1] = v0.y; xv[2] = v0.z; xv[3] = v0.w; xv[4] = v1.x; xv[5] = v1.y; xv[6] = v1.z; xv[7] = v1.w; }
                else { for (int e = 0; e < 8; ++e) xv[e] = 0.f; }
            } else {
                u32x4 w;
                if constexpr (SAMP) w = *(const u32x4*)(Z + (size_t)(row0 + l15) * ZW + Z_XR + ch0 + cb); else w = zw[j][t];
                xv[0] = bflo(w.x); xv[1] = bfhi(w.x); xv[2] = bflo(w.y); xv[3] = bfhi(w.y); xv[4] = bflo(w.z); xv[5] = bfhi(w.z); xv[6] = bflo(w.w); xv[7] = bfhi(w.w);
            }
            const f32x4 w0 = *(const LAS f32x4*)(cwl + t * 96 + cb), w1 = *(const LAS f32x4*)(cwl + t * 96 + cb + 4);
            xc[0] += w0.x * xv[0]; xc[1] += w0.y * xv[1]; xc[2] += w0.z * xv[2]; xc[3] += w0.w * xv[3]; xc[4] += w1.x * xv[4]; xc[5] += w1.y * xv[5]; xc[6] += w1.z * xv[6]; xc[7] += w1.w * xv[7];
        }
        u32x4 pw; pw.x = pk2(xc[0], xc[1]); pw.y = pk2(xc[2], xc[3]); pw.z = pk2(xc[4], xc[5]); pw.w = pk2(xc[6], xc[7]);
        af[j] = __builtin_bit_cast(bf16x8, pw);
        if (cb < 80) { *(LAS f32x4*)(xt + l15 * L2_TPITCH + cb) = (f32x4){xc[0], xc[1], xc[2], xc[3]}; *(LAS f32x4*)(xt + l15 * L2_TPITCH + cb + 4) = (f32x4){xc[4], xc[5], xc[6], xc[7]}; }
    }
    LDS_WAIT();
#pragma unroll
    for (int ct = 0; ct < 5; ++ct) {
        f32x4 ar = {0.f, 0.f, 0.f, 0.f}, ai = {0.f, 0.f, 0.f, 0.f};
#pragma unroll
        for (int j = 0; j < 3; ++j) {
            const bf16x8 br = *(const LAS bf16x8*)(lds + L2_LW + (ct * 16 + l15) * 208 + (32 * j + 8 * g4) * 2);
            const bf16x8 bi = *(const LAS bf16x8*)(lds + L2_LW + (80 + ct * 16 + l15) * 208 + (32 * j + 8 * g4) * 2);
            ar = __builtin_amdgcn_mfma_f32_16x16x32_bf16(af[j], br, ar, 0, 0, 0);
            ai = __builtin_amdgcn_mfma_f32_16x16x32_bf16(af[j], bi, ai, 0, 0, 0);
        }
        const int ch = ct * 16 + l15;
        float av[4], bv[4];
#pragma unroll
        for (int i = 0; i < 4; ++i) {
            const float r = sigmoid_f(ar[i] + gba[ct]), gi = sigmoid_f(ai[i] + gbi[ct]);
            const float la = -8.f * r * gsp[ct];
            av[i] = __builtin_amdgcn_exp2f(la * 1.4426950408889634f);
            bv[i] = __builtin_amdgcn_sqrtf((1.f - av[i]) * (1.f + av[i])) * gi * xt[(4 * g4 + i) * L2_TPITCH + ch];
        }
        float hv[4];
        if constexpr (SAMP) {
            const float* sh = (const float*)a.in[I_SH + z];
#pragma unroll
            for (int i = 0; i < 4; ++i) { const int s = row0 - MP + 4 * g4 + i; hv[i] = av[i] * sh[(size_t)s * DRNN + ch0 + ch] + bv[i]; ((float*)a.in[I_OUT + z])[O_H_S + (size_t)s * DRNN + ch0 + ch] = hv[i]; }
        } else {
            float q[4]; float hl = 0.f, qq = 1.f;
#pragma unroll
            for (int i = 0; i < 4; ++i) { hl = av[i] * hl + bv[i]; qq *= av[i]; hv[i] = hl; q[i] = qq; }
            float cin = carry[ct], call = carry[ct], pall = 1.f;
            float Pq[4], Hq[4];
            row4(qq, Pq); row4(hl, Hq);
#pragma unroll
            for (int gq = 0; gq < 4; ++gq) { const float Pg = Pq[gq], Hg = Hq[gq];
                if (gq < g4) cin = Pg * cin + Hg;
                call = Pg * call + Hg; pall *= Pg; }
#pragma unroll
            for (int i = 0; i < 4; ++i) hv[i] += q[i] * cin;
            carry[ct] = call; aprod[ct] *= pall;
        }
        if constexpr (PASS == 2) {
#pragma unroll
            for (int i = 0; i < 4; ++i) ht[(4 * g4 + i) * L2_TPITCH + ch] = hv[i];
        }
    }
    if constexpr (PASS == 2) {
        LDS_WAIT();
#pragma unroll
        for (int j = 0; j < 3; ++j) { const int cb = 32 * j + 8 * g4;
            if (cb < 80) {
                const f32x4 h0 = *(const LAS f32x4*)(ht + l15 * L2_TPITCH + cb), h1 = *(const LAS f32x4*)(ht + l15 * L2_TPITCH + cb + 4);
                u32x4 y; if constexpr (SAMP) y = *(const u32x4*)(Z + (size_t)(row0 + l15) * ZW + Z_YR + ch0 + cb); else y = zw[j][4];
                u32x4 o; o.x = pk2(h0.x * bflo(y.x), h0.y * bfhi(y.x)); o.y = pk2(h0.z * bflo(y.y), h0.w * bfhi(y.y)); o.z = pk2(h1.x * bflo(y.z), h1.y * bfhi(y.z)); o.w = pk2(h1.z * bflo(y.w), h1.w * bfhi(y.w));
                *(u32x4*)((bf16*)(ws + WS_HG) + (size_t)(row0 + l15) * DRNN + ch0 + cb) = o;
            }
        }
    }
    LDS_WAIT();
}
template <int PASS> __device__ __forceinline__ void lru_cu_unit(const Args& a, LAS unsigned char* lds, int u, int wave) {
    int z = 0; asm volatile("" : "+s"(z));
    int lane_ = lane_id(); asm volatile("" : "+v"(lane_)); const int lane = lane_, l15 = lane & 15;
    unsigned char* ws = (unsigned char*)a.in[I_WS + z];
    const int n = u & 15, ch0 = n * BLK, cidx = 8 * (u >> 4) + wave;
    __syncthreads();
    { const u32x4* src = (const u32x4*)(ws + WS_LW + (size_t)n * 33280); LAS u32x4* dst = (LAS u32x4*)(lds + L2_LW);
      for (int i = TIDW(wave); i < 2080; i += 512) dst[i] = src[i]; }
    { const int tid = TIDW(wave); if (tid < 480) { const int t = tid / 96, c = tid - 96 * t; float v = 0.f;
        if (c < 80) v = t < 4 ? ((const float*)a.in[I_CONVW + z])[t * DRNN + ch0 + c] : ((const float*)a.in[I_CONVB + z])[ch0 + c];
        ((LAS float*)(lds + L2_CW))[tid] = v; } }
    float gba[5], gbi[5], gsp[5], carry[5], aprod[5];
#pragma unroll
    for (int ct = 0; ct < 5; ++ct) { const int cg = ch0 + ct * 16 + l15; gba[ct] = ((const float*)a.in[I_LBA + z])[cg]; gbi[ct] = ((const float*)a.in[I_LBI + z])[cg];
        gsp[ct] = log1pf(expf(-((const float*)a.in[I_LAM + z])[cg])); carry[ct] = 0.f; aprod[ct] = 1.f; }
    const bf16* Zp = (const bf16*)(ws + WS_Z);
    const int row_c = cidx * 128, tib_c = (cidx & 63) * 128, g4 = lane >> 4;
    u32x4 zwA[3][5], zwB[3][5];
    lru_load<PASS>(Zp, ch0, row_c, tib_c, l15, g4, zwA);
    if (PASS == 2) {
        const f32x2* SUM = (const f32x2*)(ws + WS_SUM);
        const int nprev = cidx & 63, base = cidx & ~63, qn = (nprev + 3) >> 2, lo = base + g4 * qn, hi = (lo + qn < base + nprev) ? lo + qn : base + nprev;
        float fa[5], fh[5];
#pragma unroll
        for (int ct = 0; ct < 5; ++ct) { fa[ct] = 1.f; fh[ct] = 0.f; }
        for (int jc = lo; jc < hi; jc += 8) {
            f32x2 sm[8][5];
#pragma unroll
            for (int k = 0; k < 8; ++k)
#pragma unroll
                for (int ct = 0; ct < 5; ++ct) sm[k][ct] = (jc + k < hi) ? SUM[(size_t)(jc + k) * DRNN + ch0 + ct * 16 + l15] : (f32x2){1.f, 0.f};
#pragma unroll
            for (int k = 0; k < 8; ++k)
#pragma unroll
                for (int ct = 0; ct < 5; ++ct) { fh[ct] = sm[k][ct].x * fh[ct] + sm[k][ct].y; fa[ct] = sm[k][ct].x * fa[ct]; }
        }
#pragma unroll
        for (int ct = 0; ct < 5; ++ct) { float c = 0.f;
            float Aq[4], Hq[4]; row4(fa[ct], Aq); row4(fh[ct], Hq);
#pragma unroll
            for (int gq = 0; gq < 4; ++gq) c = Aq[gq] * c + Hq[gq];
            carry[ct] = c; }
    }
    __syncthreads();
#pragma unroll 1
    for (int mt = 0; mt < 8; mt += 2) {
        lru_load<PASS>(Zp, ch0, row_c + 16 * (mt + 1), tib_c + 16 * (mt + 1), l15, g4, zwB);
        lru_tile<PASS, false>(a, z, ws, lds, n, row_c + 16 * mt, tib_c + 16 * mt, lane, wave, gba, gbi, gsp, carry, aprod, zwA);
        if (mt + 2 < 8) lru_load<PASS>(Zp, ch0, row_c + 16 * (mt + 2), tib_c + 16 * (mt + 2), l15, g4, zwA);
        lru_tile<PASS, false>(a, z, ws, lds, n, row_c + 16 * (mt + 1), tib_c + 16 * (mt + 1), lane, wave, gba, gbi, gsp, carry, aprod, zwB);
    }
    if (PASS == 1) { if (lane < 16) { for (int ct = 0; ct < 5; ++ct) ((f32x2*)(ws + WS_SUM))[(size_t)cidx * DRNN + ch0 + ct * 16 + l15] = (f32x2){aprod[ct], carry[ct]}; } }
    else {
        float* out = (float*)a.in[I_OUT + z];
        if ((cidx & 63) == 63) {
            const int bb = cidx >> 6;
            if (lane < 16) { for (int ct = 0; ct < 5; ++ct) out[O_H_P + (size_t)bb * DRNN + ch0 + ct * 16 + l15] = carry[ct]; }
            const bf16* Z = (const bf16*)(ws + WS_Z);
            for (int e = lane; e < 240; e += 64) { const int jj = e / 80, c = e - 80 * jj; out[O_CONV_P + (size_t)(bb * 3 + jj) * DRNN + ch0 + c] = bf2f(Z[(size_t)(bb * SEQ + SEQ - 3 + jj) * ZW + Z_XR + ch0 + c]); }
        }
        if (u < 16) {
            float c2[5], p2[5];
#pragma unroll
            for (int ct = 0; ct < 5; ++ct) { c2[ct] = 0.f; p2[ct] = 1.f; }
            lru_tile<PASS, true>(a, z, ws, lds, n, MP + 16 * wave, 0, lane, wave, gba, gbi, gsp, c2, p2, zwA);
        }
    }
}

constexpr int SA_QIMG = 0, SA_PITCH = 592, SA_KT = 16 * SA_PITCH;
constexpr int SA_SLOT = 66 * 64 * 4, SA_OLAT = 4 * SA_SLOT;
static_assert(SA_OLAT + 16 * 256 * 4 <= RING_BYTES, "decode attention LDS map");
__device__ __forceinline__ void sample_attn_half(const Args& a, LAS unsigned char* lds, int s, int half, int wv) {
    int z = 0; asm volatile("" : "+s"(z));
    int tid = TIDW(wv); asm volatile("" : "+v"(tid)); const int lane = tid & 63, wave = wv;
    unsigned char* ws = (unsigned char*)a.in[I_WS + z];
    const bf16* Qrow = (const bf16*)(ws + WS_Q) + (size_t)(MP + s) * QW;
    const bf16* BKV = (const bf16*)(ws + WS_BKV);
    __syncthreads();
    {
        LAS float* qs = (LAS float*)(lds + SA_KT);
        { const unsigned w = ((const unsigned*)Qrow)[tid]; qs[2 * tid] = bflo(w); qs[2 * tid + 1] = bfhi(w); }
        __syncthreads();
        const int r2 = (tid & 127) * 2, hg = tid >> 7;
#pragma unroll 1
        for (int hh = 0; hh < 4; ++hh) { const int hd = hg * 4 + hh; float a0 = 0.f, a1 = 0.f;
            unsigned wv_[64];
#pragma unroll
            for (int d = 0; d < 64; ++d) wv_[d] = *(const unsigned*)(BKV + (size_t)(hd * 64 + d) * KVL + r2);
#pragma unroll
            for (int d = 0; d < 64; ++d) { const float q = qs[hd * 64 + d]; a0 += q * bflo(wv_[d]); a1 += q * bfhi(wv_[d]); }
            *(LAS unsigned*)(lds + SA_QIMG + hd * SA_PITCH + r2 * 2) = pk2(a0, a1); }
        if ((tid & 31) < 16) { const int hd = tid >> 5, i = tid & 15;
          const float* cosT = (const float*)(ws + WS_ROPE); const float c = cosT[SEQ * 16 + i], sn = cosT[ROPE_TAB + SEQ * 16 + i];
          const float x1 = bf2f(Qrow[1024 + hd * 32 + i]), x2 = bf2f(Qrow[1024 + hd * 32 + 16 + i]);
          *(LAS bf16*)(lds + SA_QIMG + hd * SA_PITCH + (256 + i) * 2) = f2bf(x1 * c - x2 * sn);
          *(LAS bf16*)(lds + SA_QIMG + hd * SA_PITCH + (256 + 16 + i) * 2) = f2bf(x1 * sn + x2 * c); }
    }
    __syncthreads();
    const int g4 = lane >> 4, l15 = lane & 15;
    const LAS unsigned char* qfp = lds + SA_QIMG + l15 * SA_PITCH + 8 * g4 * 2;
    LAS unsigned char* kt = lds + SA_KT + wave * 9472;
    const unsigned ktb = (unsigned)(uintptr_t)kt;
    const int* pt = (const int*)a.in[I_PT + z] + s * NPAGES + half * 32 + wave * 4;
    const float* cckv = (const float*)a.in[I_CCKV + z]; const float* ckr = (const float*)a.in[I_CKR + z];
    float m_run = -1e30f, l_part = 0.f;
    f32x4 oacc[16];
#pragma unroll
    for (int i = 0; i < 16; ++i) oacc[i] = (f32x4){0.f, 0.f, 0.f, 0.f};
    f32x4 stA[18], stB[18];
#define SA_ISSUE(ST, tt) do { const int pid_ = pt[(tt) >> 3]; const float* kb_ = cckv + ((size_t)pid_ * PAGE + ((tt) & 7) * 16) * KVL; const float* rb_ = ckr + ((size_t)pid_ * PAGE + ((tt) & 7) * 16) * ROPE; \
        _Pragma("unroll") for (int i_ = 0; i_ < 16; ++i_) ST[i_] = __builtin_nontemporal_load((const f32x4*)(kb_ + i_ * KVL) + lane); \
        ST[16] = __builtin_nontemporal_load((const f32x4*)rb_ + lane); ST[17] = __builtin_nontemporal_load((const f32x4*)rb_ + 64 + lane); } while (0)
#define SA_TOLDS(ST) do { \
        _Pragma("unroll") for (int i = 0; i < 16; ++i) { u32x2 o; o.x = pk2(ST[i].x, ST[i].y); o.y = pk2(ST[i].z, ST[i].w); *(LAS u32x2*)(kt + i * SA_PITCH + lane * 8) = o; } \
        _Pragma("unroll") for (int k = 0; k < 2; ++k) { u32x2 o; o.x = pk2(ST[16 + k].x, ST[16 + k].y); o.y = pk2(ST[16 + k].z, ST[16 + k].w); *(LAS u32x2*)(kt + (8 * k + (lane >> 3)) * SA_PITCH + (256 + 4 * (lane & 7)) * 2) = o; } } while (0)
#define SA_COMPUTE(SELF) do { \
        LDS_WAIT(); \
        f32x4 sacc = {0.f, 0.f, 0.f, 0.f}; \
        _Pragma("unroll") for (int j = 0; j < 9; ++j) { const bf16x8 kf = *(const LAS bf16x8*)(kt + l15 * SA_PITCH + (32 * j + 8 * g4) * 2); const bf16x8 qfj = *(const LAS bf16x8*)(qfp + 64 * j); sacc = __builtin_amdgcn_mfma_f32_16x16x32_bf16(kf, qfj, sacc, 0, 0, 0); } \
        if (SELF) { _Pragma("unroll") for (int i = 0; i < 4; ++i) if (4 * g4 + i >= 1) sacc[i] = -__builtin_inff(); } \
        float mx = fmaxf(fmaxf(sacc[0], sacc[1]), fmaxf(sacc[2], sacc[3])); \
        mx = fmaxf(mx, __shfl_xor(mx, 16)); mx = fmaxf(mx, __shfl_xor(mx, 32)); \
        const float mn = fmaxf(m_run, mx), alpha = __builtin_amdgcn_exp2f(m_run - mn); \
        m_run = mn; \
        const float p0 = __builtin_amdgcn_exp2f(sacc[0] - mn), p1 = __builtin_amdgcn_exp2f(sacc[1] - mn), p2 = __builtin_amdgcn_exp2f(sacc[2] - mn), p3 = __builtin_amdgcn_exp2f(sacc[3] - mn); \
        l_part = l_part * alpha + ((p0 + p1) + (p2 + p3)); \
        u32x2 pw; pw.x = pk2(p0, p1); pw.y = pk2(p2, p3); \
        const s16x4 pb = __builtin_bit_cast(s16x4, pw); \
        const unsigned vaddr = ktb + (unsigned)((4 * g4 + (l15 >> 2)) * SA_PITCH + (l15 & 3) * 8); \
        _Pragma("unroll") for (int ct = 0; ct < 16; ++ct) { \
            s16x4 vf; \
            asm volatile("ds_read_b64_tr_b16 %0, %1 offset:%2" : "=v"(vf) : "v"(vaddr), "i"(ct * 32) : "memory"); \
            asm volatile("s_waitcnt lgkmcnt(0)" ::: "memory"); \
            oacc[ct] = oacc[ct] * alpha; \
            oacc[ct] = __builtin_amdgcn_mfma_f32_16x16x16bf16_1k(vf, pb, oacc[ct], 0, 0, 0); } } while (0)
    SA_ISSUE(stA, 0); SA_ISSUE(stB, 1);
#pragma unroll 1
    for (int tt = 0; tt < 32; tt += 2) {
        if (tt + 1 < 32) asm volatile("s_waitcnt vmcnt(18)" ::: "memory"); else VM_WAIT();
        asm volatile("" : "+v"(stA[0]), "+v"(stA[1]), "+v"(stA[2]), "+v"(stA[3]), "+v"(stA[4]), "+v"(stA[5]), "+v"(stA[6]), "+v"(stA[7]), "+v"(stA[8]));
        asm volatile("" : "+v"(stA[9]), "+v"(stA[10]), "+v"(stA[11]), "+v"(stA[12]), "+v"(stA[13]), "+v"(stA[14]), "+v"(stA[15]), "+v"(stA[16]), "+v"(stA[17]));
        SA_TOLDS(stA);
        if (tt + 2 < 32) SA_ISSUE(stA, tt + 2);
        SA_COMPUTE(false);
        if (tt + 2 < 32) asm volatile("s_waitcnt vmcnt(18)" ::: "memory"); else VM_WAIT();
        asm volatile("" : "+v"(stB[0]), "+v"(stB[1]), "+v"(stB[2]), "+v"(stB[3]), "+v"(stB[4]), "+v"(stB[5]), "+v"(stB[6]), "+v"(stB[7]), "+v"(stB[8]));
        asm volatile("" : "+v"(stB[9]), "+v"(stB[10]), "+v"(stB[11]), "+v"(stB[12]), "+v"(stB[13]), "+v"(stB[14]), "+v"(stB[15]), "+v"(stB[16]), "+v"(stB[17]));
        SA_TOLDS(stB);
        if (tt + 3 < 32) SA_ISSUE(stB, tt + 3);
        SA_COMPUTE(false);
    }
    if (half == 1 && wave == 7) {
        const bf16* ck = (const bf16*)(ws + WS_CKV) + (size_t)(MP + s) * KVL; const bf16* kr = (const bf16*)(ws + WS_KR) + (size_t)(MP + s) * ROPE;
#pragma unroll
        for (int i = 0; i < 16; ++i) { u32x2 o = {0u, 0u}; if (i == 0) o = ((const u32x2*)ck)[lane]; *(LAS u32x2*)(kt + i * SA_PITCH + lane * 8) = o; }
        if (lane < 32) { *(LAS bf16*)(kt + (256 + lane) * 2) = kr[lane]; }
        else { const int d = lane - 32; for (int i = 1; i < 16; ++i) *(LAS bf16*)(kt + i * SA_PITCH + (256 + d) * 2) = 0; }
        SA_COMPUTE(true);
    }
#undef SA_ISSUE
#undef SA_TOLDS
#undef SA_COMPUTE
    LAS float* slots = (LAS float*)lds;
#pragma unroll 1
    for (int half = 4; half >= 1; half >>= 1) {
        __syncthreads();
        if (wave >= half && wave < 2 * half) { LAS float* sl = slots + (size_t)(wave - half) * (SA_SLOT / 4);
#pragma unroll
            for (int ct = 0; ct < 16; ++ct) { sl[(4 * ct + 0) * 64 + lane] = oacc[ct][0]; sl[(4 * ct + 1) * 64 + lane] = oacc[ct][1]; sl[(4 * ct + 2) * 64 + lane] = oacc[ct][2]; sl[(4 * ct + 3) * 64 + lane] = oacc[ct][3]; }
            sl[64 * 64 + lane] = m_run; sl[65 * 64 + lane] = l_part; }
        __syncthreads();
        if (wave < half) { const LAS float* sl = slots + (size_t)wave * (SA_SLOT / 4);
            const float m2 = sl[64 * 64 + lane], l2 = sl[65 * 64 + lane];
            const float mn = fmaxf(m_run, m2), a1 = __builtin_amdgcn_exp2f(m_run - mn), a2 = __builtin_amdgcn_exp2f(m2 - mn);
            m_run = mn; l_part = a1 * l_part + a2 * l2;
#pragma unroll
            for (int ct = 0; ct < 16; ++ct) { oacc[ct][0] = a1 * oacc[ct][0] + a2 * sl[(4 * ct + 0) * 64 + lane]; oacc[ct][1] = a1 * oacc[ct][1] + a2 * sl[(4 * ct + 1) * 64 + lane];
                                             oacc[ct][2] = a1 * oacc[ct][2] + a2 * sl[(4 * ct + 2) * 64 + lane]; oacc[ct][3] = a1 * oacc[ct][3] + a2 * sl[(4 * ct + 3) * 64 + lane]; } }
    }
    if (wave == 0) {
        float* part = (float*)(ws + WS_PART) + (size_t)(s * 2 + half) * PART_STRIDE;
        float lsum = l_part; lsum += __shfl_xor(lsum, 16); lsum += __shfl_xor(lsum, 32);
#pragma unroll
        for (int ct = 0; ct < 16; ++ct) *(f32x4*)(part + l15 * 256 + ct * 16 + 4 * g4) = oacc[ct];
        if (g4 == 0) { part[4096 + l15] = m_run; part[4096 + 16 + l15] = lsum; }
    }
}
__device__ __forceinline__ void sample_attn_seq(const Args& a, LAS unsigned char* lds, int s, int wv) {
    int z = 0; asm volatile("" : "+s"(z));
    int tid = TIDW(wv); asm volatile("" : "+v"(tid)); const int lane = tid & 63, wave = wv;
    unsigned char* ws = (unsigned char*)a.in[I_WS + z];
    const bf16* Qrow = (const bf16*)(ws + WS_Q) + (size_t)(MP + s) * QW;
    const bf16* BKV = (const bf16*)(ws + WS_BKV);
    __syncthreads();
    {
        LAS float* qs = (LAS float*)(lds + SA_KT);
        { const unsigned w = ((const unsigned*)Qrow)[tid]; qs[2 * tid] = bflo(w); qs[2 * tid + 1] = bfhi(w); }
        __syncthreads();
        const int r2 = (tid & 127) * 2, hg = tid >> 7;
#pragma unroll 1
        for (int hh = 0; hh < 4; ++hh) { const int hd = hg * 4 + hh; float a0 = 0.f, a1 = 0.f;
            unsigned wv_[64];
#pragma unroll
            for (int d = 0; d < 64; ++d) wv_[d] = *(const unsigned*)(BKV + (size_t)(hd * 64 + d) * KVL + r2);
#pragma unroll
            for (int d = 0; d < 64; ++d) { const float q = qs[hd * 64 + d]; a0 += q * bflo(wv_[d]); a1 += q * bfhi(wv_[d]); }
            *(LAS unsigned*)(lds + SA_QIMG + hd * SA_PITCH + r2 * 2) = pk2(a0, a1); }
        if ((tid & 31) < 16) { const int hd = tid >> 5, i = tid & 15;
          const float* cosT = (const float*)(ws + WS_ROPE); const float c = cosT[SEQ * 16 + i], sn = cosT[ROPE_TAB + SEQ * 16 + i];
          const float x1 = bf2f(Qrow[1024 + hd * 32 + i]), x2 = bf2f(Qrow[1024 + hd * 32 + 16 + i]);
          *(LAS bf16*)(lds + SA_QIMG + hd * SA_PITCH + (256 + i) * 2) = f2bf(x1 * c - x2 * sn);
          *(LAS bf16*)(lds + SA_QIMG + hd * SA_PITCH + (256 + 16 + i) * 2) = f2bf(x1 * sn + x2 * c); }
    }
    __syncthreads();
    const int g4 = lane >> 4, l15 = lane & 15;
    const LAS unsigned char* qfp = lds + SA_QIMG + l15 * SA_PITCH + 8 * g4 * 2;
    LAS unsigned char* kt = lds + SA_KT + wave * 9472;
    const unsigned ktb = (unsigned)(uintptr_t)kt;
    const int* pt = (const int*)a.in[I_PT + z] + s * NPAGES + wave * 8;
    const float* cckv = (const float*)a.in[I_CCKV + z]; const float* ckr = (const float*)a.in[I_CKR + z];
    float m_run = -1e30f, l_part = 0.f;
    f32x4 oacc[16];
#pragma unroll
    for (int i = 0; i < 16; ++i) oacc[i] = (f32x4){0.f, 0.f, 0.f, 0.f};
    f32x4 stA[18], stB[18];
#define SA_ISSUE(ST, tt) do { const int pid_ = pt[(tt) >> 3]; const float* kb_ = cckv + ((size_t)pid_ * PAGE + ((tt) & 7) * 16) * KVL; const float* rb_ = ckr + ((size_t)pid_ * PAGE + ((tt) & 7) * 16) * ROPE; \
        _Pragma("unroll") for (int i_ = 0; i_ < 16; ++i_) ST[i_] = __builtin_nontemporal_load((const f32x4*)(kb_ + i_ * KVL) + lane); \
        ST[16] = __builtin_nontemporal_load((const f32x4*)rb_ + lane); ST[17] = __builtin_nontemporal_load((const f32x4*)rb_ + 64 + lane); } while (0)
#define SA_TOLDS(ST) do { \
        _Pragma("unroll") for (int i = 0; i < 16; ++i) { u32x2 o; o.x = pk2(ST[i].x, ST[i].y); o.y = pk2(ST[i].z, ST[i].w); *(LAS u32x2*)(kt + i * SA_PITCH + lane * 8) = o; } \
        _Pragma("unroll") for (int k = 0; k < 2; ++k) { u32x2 o; o.x = pk2(ST[16 + k].x, ST[16 + k].y); o.y = pk2(ST[16 + k].z, ST[16 + k].w); *(LAS u32x2*)(kt + (8 * k + (lane >> 3)) * SA_PITCH + (256 + 4 * (lane & 7)) * 2) = o; } } while (0)
#define SA_TR4(base_) do { \
        asm volatile("ds_read_b64_tr_b16 %0, %4 offset:%5\n\tds_read_b64_tr_b16 %1, %4 offset:%6\n\tds_read_b64_tr_b16 %2, %4 offset:%7\n\tds_read_b64_tr_b16 %3, %4 offset:%8\n\ts_waitcnt lgkmcnt(0)" \
                     : "=&v"(vf[0]), "=&v"(vf[1]), "=&v"(vf[2]), "=&v"(vf[3]) \
                     : "v"(vaddr), "i"(((base_) + 0) * 32), "i"(((base_) + 1) * 32), "i"(((base_) + 2) * 32), "i"(((base_) + 3) * 32) : "memory"); \
        _Pragma("unroll") for (int c_ = 0; c_ < 4; ++c_) oacc[(base_) + c_] = __builtin_amdgcn_mfma_f32_16x16x16bf16_1k(vf[c_], pb, oacc[(base_) + c_], 0, 0, 0); } while (0)
#define SA_COMPUTE(SELF) do { \
        LDS_WAIT(); \
        f32x4 sacc = {0.f, 0.f, 0.f, 0.f}; \
        _Pragma("unroll") for (int j = 0; j < 9; ++j) { const bf16x8 kf = *(const LAS bf16x8*)(kt + l15 * SA_PITCH + (32 * j + 8 * g4) * 2); const bf16x8 qfj = *(const LAS bf16x8*)(qfp + 64 * j); sacc = __builtin_amdgcn_mfma_f32_16x16x32_bf16(kf, qfj, sacc, 0, 0, 0); } \
        if (SELF) { _Pragma("unroll") for (int i = 0; i < 4; ++i) if (4 * g4 + i >= 1) sacc[i] = -__builtin_inff(); } \
        float mx = fmaxf(fmaxf(sacc[0], sacc[1]), fmaxf(sacc[2], sacc[3])); \
        { auto r_ = __builtin_amdgcn_permlane16_swap(__float_as_uint(mx), __float_as_uint(mx), false, false); mx = fmaxf(__uint_as_float(r_[0]), __uint_as_float(r_[1])); } \
        { auto r_ = __builtin_amdgcn_permlane32_swap(__float_as_uint(mx), __float_as_uint(mx), false, false); mx = fmaxf(__uint_as_float(r_[0]), __uint_as_float(r_[1])); } \
        if (__builtin_expect(__any(mx > m_run + 8.f), 0)) { const float mn = fmaxf(m_run, mx), alpha = __builtin_amdgcn_exp2f(m_run - mn); m_run = mn; l_part *= alpha; \
            _Pragma("unroll") for (int ct = 0; ct < 16; ++ct) oacc[ct] = oacc[ct] * alpha; } \
        const float p0 = __builtin_amdgcn_exp2f(sacc[0] - m_run), p1 = __builtin_amdgcn_exp2f(sacc[1] - m_run), p2 = __builtin_amdgcn_exp2f(sacc[2] - m_run), p3 = __builtin_amdgcn_exp2f(sacc[3] - m_run); \
        l_part += (p0 + p1) + (p2 + p3); \
        u32x2 pw; pw.x = pk2(p0, p1); pw.y = pk2(p2, p3); \
        const s16x4 pb = __builtin_bit_cast(s16x4, pw); \
        const unsigned vaddr = ktb + (unsigned)((4 * g4 + (l15 >> 2)) * SA_PITCH + (l15 & 3) * 8); \
        s16x4 vf[4]; SA_TR4(0); SA_TR4(4); SA_TR4(8); SA_TR4(12); } while (0)
    SA_ISSUE(stA, 0); SA_ISSUE(stB, 1);
#pragma unroll 1
    for (int tt = 0; tt < 64; tt += 2) {
        if (tt + 1 < 64) asm volatile("s_waitcnt vmcnt(18)" ::: "memory"); else VM_WAIT();
        asm volatile("" : "+v"(stA[0]), "+v"(stA[1]), "+v"(stA[2]), "+v"(stA[3]), "+v"(stA[4]), "+v"(stA[5]), "+v"(stA[6]), "+v"(stA[7]), "+v"(stA[8]));
        asm volatile("" : "+v"(stA[9]), "+v"(stA[10]), "+v"(stA[11]), "+v"(stA[12]), "+v"(stA[13]), "+v"(stA[14]), "+v"(stA[15]), "+v"(stA[16]), "+v"(stA[17]));
        SA_TOLDS(stA);
        if (tt + 2 < 64) SA_ISSUE(stA, tt + 2);
        SA_COMPUTE(false);
        if (tt + 2 < 64) asm volatile("s_waitcnt vmcnt(18)" ::: "memory"); else VM_WAIT();
        asm volatile("" : "+v"(stB[0]), "+v"(stB[1]), "+v"(stB[2]), "+v"(stB[3]), "+v"(stB[4]), "+v"(stB[5]), "+v"(stB[6]), "+v"(stB[7]), "+v"(stB[8]));
        asm volatile("" : "+v"(stB[9]), "+v"(stB[10]), "+v"(stB[11]), "+v"(stB[12]), "+v"(stB[13]), "+v"(stB[14]), "+v"(stB[15]), "+v"(stB[16]), "+v"(stB[17]));
        SA_TOLDS(stB);
        if (tt + 3 < 64) SA_ISSUE(stB, tt + 3);
        SA_COMPUTE(false);
    }
    if (wave == 7) {
        const bf16* ck = (const bf16*)(ws + WS_CKV) + (size_t)(MP + s) * KVL; const bf16* kr = (const bf16*)(ws + WS_KR) + (size_t)(MP + s) * ROPE;
#pragma unroll
        for (int i = 0; i < 16; ++i) { u32x2 o = {0u, 0u}; if (i == 0) o = ((const u32x2*)ck)[lane]; *(LAS u32x2*)(kt + i * SA_PITCH + lane * 8) = o; }
        if (lane < 32) { *(LAS bf16*)(kt + (256 + lane) * 2) = kr[lane]; }
        else { const int d = lane - 32; for (int i = 1; i < 16; ++i) *(LAS bf16*)(kt + i * SA_PITCH + (256 + d) * 2) = 0; }
        SA_COMPUTE(true);
    }
#undef SA_ISSUE
#undef SA_TOLDS
#undef SA_COMPUTE
#undef SA_TR4
    LAS float* slots = (LAS float*)lds;
#pragma unroll 1
    for (int half = 4; half >= 1; half >>= 1) {
        __syncthreads();
        if (wave >= half && wave < 2 * half) { LAS float* sl = slots + (size_t)(wave - half) * (SA_SLOT / 4);
#pragma unroll
            for (int ct = 0; ct < 16; ++ct) { sl[(4 * ct + 0) * 64 + lane] = oacc[ct][0]; sl[(4 * ct + 1) * 64 + lane] = oacc[ct][1]; sl[(4 * ct + 2) * 64 + lane] = oacc[ct][2]; sl[(4 * ct + 3) * 64 + lane] = oacc[ct][3]; }
            sl[64 * 64 + lane] = m_run; sl[65 * 64 + lane] = l_part; }
        __syncthreads();
        if (wave < half) { const LAS float* sl = slots + (size_t)wave * (SA_SLOT / 4);
            const float m2 = sl[64 * 64 + lane], l2 = sl[65 * 64 + lane];
            const float mn = fmaxf(m_run, m2), a1 = __builtin_amdgcn_exp2f(m_run - mn), a2 = __builtin_amdgcn_exp2f(m2 - mn);
            m_run = mn; l_part = a1 * l_part + a2 * l2;
#pragma unroll
            for (int ct = 0; ct < 16; ++ct) { oacc[ct][0] = a1 * oacc[ct][0] + a2 * sl[(4 * ct + 0) * 64 + lane]; oacc[ct][1] = a1 * oacc[ct][1] + a2 * sl[(4 * ct + 1) * 64 + lane];
                                             oacc[ct][2] = a1 * oacc[ct][2] + a2 * sl[(4 * ct + 2) * 64 + lane]; oacc[ct][3] = a1 * oacc[ct][3] + a2 * sl[(4 * ct + 3) * 64 + lane]; } }
    }
    LAS float* olat = (LAS float*)(lds + SA_OLAT);
    if (wave == 0) {
        float lsum = l_part; lsum += __shfl_xor(lsum, 16); lsum += __shfl_xor(lsum, 32);
        const float il = 1.f / lsum;
#pragma unroll
        for (int ct = 0; ct < 16; ++ct) *(LAS f32x4*)(olat + l15 * 256 + ct * 16 + 4 * g4) = oacc[ct] * il;
    }
    __syncthreads();
    {
        const int hd = tid >> 5, v0 = (tid & 31) * 2;
        const bf16* B = BKV + (size_t)(1024 + hd * 64 + v0) * KVL;
        float a0 = 0.f, a1 = 0.f;
#pragma unroll 8
        for (int r = 0; r < 256; r += 8) { const u32x4 w0 = *(const u32x4*)(B + r), w1 = *(const u32x4*)(B + KVL + r);
            const f32x4 x0 = *(const LAS f32x4*)(olat + hd * 256 + r), x1 = *(const LAS f32x4*)(olat + hd * 256 + r + 4);
            a0 += x0.x * bflo(w0.x) + x0.y * bfhi(w0.x) + x0.z * bflo(w0.y) + x0.w * bfhi(w0.y) + x1.x * bflo(w0.z) + x1.y * bfhi(w0.z) + x1.z * bflo(w0.w) + x1.w * bfhi(w0.w);
            a1 += x0.x * bflo(w1.x) + x0.y * bfhi(w1.x) + x0.z * bflo(w1.y) + x0.w * bfhi(w1.y) + x1.x * bflo(w1.z) + x1.y * bfhi(w1.z) + x1.z * bflo(w1.w) + x1.w * bfhi(w1.w); }
        *(unsigned*)((bf16*)(ws + WS_OB) + (size_t)(MP + s) * DM + hd * 64 + v0) = pk2(a0, a1);
    }
}
__device__ __forceinline__ void sample_combine(const Args& a, LAS unsigned char* lds, int s, int wv) {
    int z = 0; asm volatile("" : "+s"(z));
    int tid = TIDW(wv); asm volatile("" : "+v"(tid));
    unsigned char* ws = (unsigned char*)a.in[I_WS + z];
    const float* part = (const float*)(ws + WS_PART) + (size_t)s * 2 * PART_STRIDE;
    LAS float* olat = (LAS float*)lds;
    __syncthreads();
    {
        const int hd = tid >> 5, cg = (tid & 31) * 8;
        const float m0 = part[4096 + hd], m1 = part[PART_STRIDE + 4096 + hd], mmax = fmaxf(m0, m1);
        const float w0 = __builtin_amdgcn_exp2f(m0 - mmax), w1 = __builtin_amdgcn_exp2f(m1 - mmax);
        const float il = 1.f / (w0 * part[4096 + 16 + hd] + w1 * part[PART_STRIDE + 4096 + 16 + hd]);
        const f32x4 o0 = (*(const f32x4*)(part + hd * 256 + cg) * w0 + *(const f32x4*)(part + PART_STRIDE + hd * 256 + cg) * w1) * il;
        const f32x4 o1 = (*(const f32x4*)(part + hd * 256 + cg + 4) * w0 + *(const f32x4*)(part + PART_STRIDE + hd * 256 + cg + 4) * w1) * il;
        *(LAS f32x4*)(olat + hd * 256 + cg) = o0; *(LAS f32x4*)(olat + hd * 256 + cg + 4) = o1;
    }
    __syncthreads();
    {
        const int hd = tid >> 5, v0 = (tid & 31) * 2;
        const bf16* B = (const bf16*)(ws + WS_BKV) + (size_t)(1024 + hd * 64 + v0) * KVL;
        float a0 = 0.f, a1 = 0.f;
#pragma unroll 8
        for (int r = 0; r < 256; r += 8) { const u32x4 w0 = *(const u32x4*)(B + r), w1 = *(const u32x4*)(B + KVL + r);
            const f32x4 x0 = *(const LAS f32x4*)(olat + hd * 256 + r), x1 = *(const LAS f32x4*)(olat + hd * 256 + r + 4);
            a0 += x0.x * bflo(w0.x) + x0.y * bfhi(w0.x) + x0.z * bflo(w0.y) + x0.w * bfhi(w0.y) + x1.x * bflo(w0.z) + x1.y * bfhi(w0.z) + x1.z * bflo(w0.w) + x1.w * bfhi(w0.w);
            a1 += x0.x * bflo(w1.x) + x0.y * bfhi(w1.x) + x0.z * bflo(w1.y) + x0.w * bfhi(w1.y) + x1.x * bflo(w1.z) + x1.y * bfhi(w1.z) + x1.z * bflo(w1.w) + x1.w * bfhi(w1.w); }
        *(unsigned*)((bf16*)(ws + WS_OB) + (size_t)(MP + s) * DM + hd * 64 + v0) = pk2(a0, a1);
    }
}

namespace pattn4 {
constexpr int NKS = 4, NVS = 4, KSLOT = 12288, VSLOT = 8192;
constexpr int LDS_K = 0, LDS_V = NKS * KSLOT, LDS_WS = LDS_V + NVS * VSLOT, LDS_OST = LDS_WS + 8 * 256, LDS_TOTAL = LDS_OST + 8 * 4096;
static_assert(LDS_TOTAL <= RING_BYTES, "attention LDS map");
constexpr float THR = 8.f;
#define SBAR() __builtin_amdgcn_sched_barrier(0)
#define SGB(mask, n) __builtin_amdgcn_sched_group_barrier(mask, n, 0)
#define WAIT_BAR(N) do { if constexpr (VAR & 4) asm volatile("s_waitcnt vmcnt(" #N ") lgkmcnt(0)" ::: "memory"); else asm volatile("s_waitcnt vmcnt(" #N ") lgkmcnt(0)\n\ts_barrier" ::: "memory"); } while (0)
__device__ __forceinline__ int crow(int r, int hi) { return (r & 3) + 8 * (r >> 2) + 4 * hi; }
__device__ __forceinline__ void mask_tile(f32x16& p0, f32x16& p1, int dq) {
    const float NEG = -__builtin_inff();
#pragma unroll
    for (int r = 0; r < 16; ++r) { const int c = (r & 3) + 8 * (r >> 2); if (dq - c < 0) p0[r] = NEG; if (dq - c - 32 < 0) p1[r] = NEG; }
}
template <int VAR> __device__ __forceinline__ void block(const bf16* Q, const bf16* KVB, const bf16* KR, const float* cosT, bf16* OB, LAS unsigned char* lds, int b, int h, int qb, int t0, int wv,
                                                   bool primed, bool has_next, int nb_, int nh_, int nqb_, bf16x8 (&qr)[6]) {
    int tid = TIDW(wv); asm volatile("" : "+v"(tid));
    const int wid = wv, lane = tid & 63, r32 = lane & 31, hi = lane >> 5;
    const int NT = 4 * (qb + 1);
    const int P0 = qb * 256, qlo = P0 + wid * 32, qm = qlo + r32 - 4 * hi;
    LAS float* wsf = (LAS float*)(lds + LDS_WS) + wid * 64; LAS float* li_l = wsf; LAS float* al_l = wsf + 32;
    const size_t rowbase = (size_t)b * SEQ;
    const bf16* ksrc = KVB + (rowbase + (wid & 3) * 16 + (lane & 15)) * KVW + h * 64 + ((wid >> 2) * 4 + (lane >> 4)) * 8;
    const bf16* rsrc = KR + (rowbase + (wid & 3) * 16 + (lane & 15)) * ROPE + (lane >> 4) * 8;
    const bf16* vsrc = KVB + (rowbase + 16 * (wid & 3) + (lane >> 2)) * KVW + 1024 + h * 64 + (wid >> 2) * 32 + (lane & 3) * 8;
    LAS unsigned char* kdst = lds + LDS_K + (wid & 3) * 3072 + (wid >> 2) * 1024; LAS unsigned char* rdst = lds + LDS_K + (wid & 3) * 3072 + 2048; LAS unsigned char* vdst = lds + LDS_V + wid * 1024;
#define TT(i_) (((i_) + t0 < NT) ? (i_) + t0 : (i_) + t0 - NT)
#define DMA_K(t, slot) do { if constexpr ((VAR & 16) != 0) break; __builtin_amdgcn_global_load_lds((const unsigned*)(ksrc + (size_t)TT(t) * 64 * KVW), (LAS unsigned*)(kdst + (slot) * KSLOT), 16, 0, 0); \
                            __builtin_amdgcn_global_load_lds((const unsigned*)(rsrc + (size_t)TT(t) * 64 * ROPE), (LAS unsigned*)(rdst + (slot) * KSLOT), 16, 0, 0); } while (0)
#define DMA_V(t, slot) do { if constexpr ((VAR & 16) == 0) __builtin_amdgcn_global_load_lds((const unsigned*)(vsrc + (size_t)TT(t) * 64 * KVW), (LAS unsigned*)(vdst + (slot) * VSLOT), 16, 0, 0); } while (0)
    const LAS unsigned char* kb0 = lds + LDS_K + (r32 >> 4) * 3072 + (r32 & 15) * 16 + hi * 256;
    const int vb0 = (int)(uintptr_t)(lds + LDS_V) + ((lane >> 4) & 1) * 32 + (lane & 3) * 8 + (4 * hi + ((lane & 15) >> 2)) * 64;
    float m_reg = 0.f, l_reg = 0.f; f32x16 o[2] = {}; f32x16 negm = f32x16{};
#define PRIME(bb_, hh_, qq_) do { const size_t rb_ = (size_t)(bb_) * SEQ; \
        const bf16* ks_ = KVB + (rb_ + (wid & 3) * 16 + (lane & 15)) * KVW + (hh_) * 64 + ((wid >> 2) * 4 + (lane >> 4)) * 8; \
        const bf16* rs_ = KR + (rb_ + (wid & 3) * 16 + (lane & 15)) * ROPE + (lane >> 4) * 8; \
        const bf16* vs_ = KVB + (rb_ + 16 * (wid & 3) + (lane >> 2)) * KVW + 1024 + (hh_) * 64 + (wid >> 2) * 32 + (lane & 3) * 8; \
        if constexpr ((VAR & 16) == 0) { _Pragma("unroll") for (int t_ = 0; t_ < 3; ++t_) { \
            __builtin_amdgcn_global_load_lds((const unsigned*)(ks_ + (size_t)t_ * 64 * KVW), (LAS unsigned*)(kdst + t_ * KSLOT), 16, 0, 0); \
            __builtin_amdgcn_global_load_lds((const unsigned*)(rs_ + (size_t)t_ * 64 * ROPE), (LAS unsigned*)(rdst + t_ * KSLOT), 16, 0, 0); \
            if (t_ < 2) __builtin_amdgcn_global_load_lds((const unsigned*)(vs_ + (size_t)t_ * 64 * KVW), (LAS unsigned*)(vdst + t_ * VSLOT), 16, 0, 0); } } \
        const bf16* qrow_ = Q + (rb_ + (qq_) * 256 + wid * 32 + r32) * QW; \
        _Pragma("unroll") for (int d0 = 0; d0 < 4; ++d0) qr[d0] = *(const bf16x8*)(qrow_ + (hh_) * 64 + d0 * 16 + hi * 8); \
        _Pragma("unroll") for (int d0 = 4; d0 < 6; ++d0) qr[d0] = *(const bf16x8*)(qrow_ + 1024 + (hh_) * 32 + (d0 - 4) * 16 + hi * 8); } while (0)
    if (!primed) PRIME(b, h, qb);
    bf16x8 kf[12];
#define KLOAD(slot) do { const LAS unsigned char* kb_ = kb0 + (slot) * KSLOT; _Pragma("unroll") for (int d0 = 0; d0 < 6; ++d0) { kf[2 * d0] = *(const LAS bf16x8*)(kb_ + d0 * 512); kf[2 * d0 + 1] = *(const LAS bf16x8*)(kb_ + d0 * 512 + 6144); } } while (0)
#define QK(P0_, P1_) do { if constexpr ((VAR & 32) != 0) { P0_ = negm; P1_ = negm; P0_[0] += __builtin_bit_cast(float, (int)kf[0][0] + (int)kf[11][1]); } else if constexpr ((VAR & 2) != 0) { P0_ = negm; P1_ = negm; _Pragma("unroll") for (int d0 = 0; d0 < 12; ++d0) { P0_[d0] += (float)kf[d0][0]; P1_[d0] += (float)kf[d0][1]; } } else { P0_ = __builtin_amdgcn_mfma_f32_32x32x16_bf16(kf[0], qr[0], negm, 0, 0, 0); P1_ = __builtin_amdgcn_mfma_f32_32x32x16_bf16(kf[1], qr[0], negm, 0, 0, 0); \
        _Pragma("unroll") for (int d0 = 1; d0 < 6; ++d0) { P0_ = __builtin_amdgcn_mfma_f32_32x32x16_bf16(kf[2 * d0], qr[d0], P0_, 0, 0, 0); P1_ = __builtin_amdgcn_mfma_f32_32x32x16_bf16(kf[2 * d0 + 1], qr[d0], P1_, 0, 0, 0); } } } while (0)
#define RESC(al) do { if (__any((al) < 1.f)) { if (hi == 0) al_l[r32] = (al); asm volatile("s_waitcnt lgkmcnt(0)" ::: "memory"); \
        _Pragma("unroll") for (int d_ = 0; d_ < 2; ++d_) _Pragma("unroll") for (int r = 0; r < 16; ++r) o[d_][r] *= al_l[crow(r, hi)]; } } while (0)
#define MASKT(P0_, P1_, t) do { const int kbm_ = TT(t) * 64; if (kbm_ + 63 > qlo) mask_tile(P0_, P1_, qm - kbm_); } while (0)
#define ROWMAX(P0_, P1_, pm_) do { float m0_ = fmaxf(P0_[0], P1_[0]), m1_ = fmaxf(P0_[1], P1_[1]), m2_ = fmaxf(P0_[2], P1_[2]), m3_ = fmaxf(P0_[3], P1_[3]); \
        _Pragma("unroll") for (int r = 4; r < 16; r += 4) { m0_ = fmaxf(fmaxf(m0_, P0_[r]), P1_[r]); m1_ = fmaxf(fmaxf(m1_, P0_[r + 1]), P1_[r + 1]); m2_ = fmaxf(fmaxf(m2_, P0_[r + 2]), P1_[r + 2]); m3_ = fmaxf(fmaxf(m3_, P0_[r + 3]), P1_[r + 3]); } \
        pm_ = fmaxf(fmaxf(m0_, m1_), fmaxf(m2_, m3_)); \
        auto rr_ = __builtin_amdgcn_permlane32_swap(__float_as_uint(pm_), __float_as_uint(pm_), false, false); pm_ = fmaxf(__uint_as_float(rr_[0]), __uint_as_float(rr_[1])); } while (0)
#define SHIFT(P0_, P1_, dl_) do { m_reg += (dl_); _Pragma("unroll") for (int r = 0; r < 16; ++r) { P0_[r] -= (dl_); P1_[r] -= (dl_); } _Pragma("unroll") for (int r = 0; r < 16; ++r) negm[r] = -m_reg; } while (0)
#define EXP16(P_) do { if constexpr ((VAR & 1) == 0) { _Pragma("unroll") for (int r = 0; r < 16; ++r) P_[r] = __builtin_amdgcn_exp2f(P_[r]); } } while (0)
#define PACKP(P0_, P1_) do { \
        { u32x4 w_ = {pk2(P0_[0], P0_[1]), pk2(P0_[2], P0_[3]), pk2(P0_[4], P0_[5]), pk2(P0_[6], P0_[7])}; pa0 = __builtin_bit_cast(bf16x8, w_); } \
        { u32x4 w_ = {pk2(P0_[8], P0_[9]), pk2(P0_[10], P0_[11]), pk2(P0_[12], P0_[13]), pk2(P0_[14], P0_[15])}; pa1 = __builtin_bit_cast(bf16x8, w_); } \
        { u32x4 w_ = {pk2(P1_[0], P1_[1]), pk2(P1_[2], P1_[3]), pk2(P1_[4], P1_[5]), pk2(P1_[6], P1_[7])}; pa2 = __builtin_bit_cast(bf16x8, w_); } \
        { u32x4 w_ = {pk2(P1_[8], P1_[9]), pk2(P1_[10], P1_[11]), pk2(P1_[12], P1_[13]), pk2(P1_[14], P1_[15])}; pa3 = __builtin_bit_cast(bf16x8, w_); } } while (0)
#define SOFTMAX2(P0_, P1_, al_) do { EXP16(P1_); float ps_ = 0.f; _Pragma("unroll") for (int r = 0; r < 16; ++r) ps_ += P0_[r] + P1_[r]; \
        auto rr_ = __builtin_amdgcn_permlane32_swap(__float_as_uint(ps_), __float_as_uint(ps_), false, false); ps_ = __uint_as_float(rr_[0]) + __uint_as_float(rr_[1]); \
        l_reg = l_reg * (al_) + ps_; PACKP(P0_, P1_); } while (0)
    s16x4 vl[8], vh[8];
#define TRRD(dst, off) asm volatile("ds_read_b64_tr_b16 %0, %1 offset:%2" : "=&v"(dst) : "v"(vb_), "i"(off) : "memory")
#define VREAD(slot) do { const int vb_ = vb0 + (slot) * VSLOT; \
        TRRD(vl[0], 0); TRRD(vh[0], 512); TRRD(vl[1], 1024); TRRD(vh[1], 1536); TRRD(vl[2], 2048); TRRD(vh[2], 2560); TRRD(vl[3], 3072); TRRD(vh[3], 3584); \
        TRRD(vl[4], 4096); TRRD(vh[4], 4608); TRRD(vl[5], 5120); TRRD(vh[5], 5632); TRRD(vl[6], 6144); TRRD(vh[6], 6656); TRRD(vl[7], 7168); TRRD(vh[7], 7680); } while (0)
#define VF(i) (bf16x8){vl[i][0], vl[i][1], vl[i][2], vl[i][3], vh[i][0], vh[i][1], vh[i][2], vh[i][3]}
#define PVALL() do { if constexpr ((VAR & 32) != 0) { o[0][0] += (float)vl[0][0] + (float)vh[7][1] + (float)pa0[0] + (float)pa3[1]; } else if constexpr ((VAR & 8) != 0) { PVH(0); PVH(1); } else { \
        o[0] = __builtin_amdgcn_mfma_f32_32x32x16_bf16(pa0, VF(0), o[0], 0, 0, 0); o[1] = __builtin_amdgcn_mfma_f32_32x32x16_bf16(pa0, VF(4), o[1], 0, 0, 0); \
        o[0] = __builtin_amdgcn_mfma_f32_32x32x16_bf16(pa1, VF(1), o[0], 0, 0, 0); o[1] = __builtin_amdgcn_mfma_f32_32x32x16_bf16(pa1, VF(5), o[1], 0, 0, 0); \
        o[0] = __builtin_amdgcn_mfma_f32_32x32x16_bf16(pa2, VF(2), o[0], 0, 0, 0); o[1] = __builtin_amdgcn_mfma_f32_32x32x16_bf16(pa2, VF(6), o[1], 0, 0, 0); \
        o[0] = __builtin_amdgcn_mfma_f32_32x32x16_bf16(pa3, VF(3), o[0], 0, 0, 0); o[1] = __builtin_amdgcn_mfma_f32_32x32x16_bf16(pa3, VF(7), o[1], 0, 0, 0); } } while (0)
#define PVH(d0) do { if constexpr ((VAR & 8) != 0) { _Pragma("unroll") for (int e_ = 0; e_ < 4; ++e_) { o[d0][e_] += (float)vl[4 * (d0) + e_][0] + (float)vh[4 * (d0) + e_][1] + (float)pa0[e_] + (float)pa1[e_] + (float)pa2[e_] + (float)pa3[e_]; } } else { o[d0] = __builtin_amdgcn_mfma_f32_32x32x16_bf16(pa0, VF(4 * (d0) + 0), o[d0], 0, 0, 0); o[d0] = __builtin_amdgcn_mfma_f32_32x32x16_bf16(pa1, VF(4 * (d0) + 1), o[d0], 0, 0, 0); \
        o[d0] = __builtin_amdgcn_mfma_f32_32x32x16_bf16(pa2, VF(4 * (d0) + 2), o[d0], 0, 0, 0); o[d0] = __builtin_amdgcn_mfma_f32_32x32x16_bf16(pa3, VF(4 * (d0) + 3), o[d0], 0, 0, 0); } } while (0)
    f32x16 px0, px1; bf16x8 pa0, pa1, pa2, pa3;
#define TILE_VALU(al_) bf16x8 pn0, pn1, pn2, pn3; do { EXP16(px0); EXP16(px1); float s0_ = px0[0] + px1[0], s1_ = px0[1] + px1[1], s2_ = px0[2] + px1[2], s3_ = px0[3] + px1[3]; \
        _Pragma("unroll") for (int r = 4; r < 16; r += 4) { s0_ += px0[r] + px1[r]; s1_ += px0[r + 1] + px1[r + 1]; s2_ += px0[r + 2] + px1[r + 2]; s3_ += px0[r + 3] + px1[r + 3]; } \
        float ps_ = (s0_ + s1_) + (s2_ + s3_); \
        auto rr_ = __builtin_amdgcn_permlane32_swap(__float_as_uint(ps_), __float_as_uint(ps_), false, false); ps_ = __uint_as_float(rr_[0]) + __uint_as_float(rr_[1]); \
        l_reg = l_reg * (al_) + ps_; \
        { u32x4 w_ = {pk2(px0[0], px0[1]), pk2(px0[2], px0[3]), pk2(px0[4], px0[5]), pk2(px0[6], px0[7])}; pn0 = __builtin_bit_cast(bf16x8, w_); } \
        { u32x4 w_ = {pk2(px0[8], px0[9]), pk2(px0[10], px0[11]), pk2(px0[12], px0[13]), pk2(px0[14], px0[15])}; pn1 = __builtin_bit_cast(bf16x8, w_); } \
        { u32x4 w_ = {pk2(px1[0], px1[1]), pk2(px1[2], px1[3]), pk2(px1[4], px1[5]), pk2(px1[6], px1[7])}; pn2 = __builtin_bit_cast(bf16x8, w_); } \
        { u32x4 w_ = {pk2(px1[8], px1[9]), pk2(px1[10], px1[11]), pk2(px1[12], px1[13]), pk2(px1[14], px1[15])}; pn3 = __builtin_bit_cast(bf16x8, w_); } } while (0)
    if (primed) { WAIT_BAR(4); } else { WAIT_BAR(0); }
    asm volatile("" : "+v"(qr[0]), "+v"(qr[1]), "+v"(qr[2]), "+v"(qr[3]), "+v"(qr[4]), "+v"(qr[5]));
    {
        const float* ct_ = cosT + (size_t)(P0 + wid * 32 + r32) * 16 + 8 * hi; const float* st_ = ct_ + ROPE_TAB;
        const f32x4 c0 = *(const f32x4*)ct_, c1 = *(const f32x4*)(ct_ + 4), s0 = *(const f32x4*)st_, s1 = *(const f32x4*)(st_ + 4);
        const u32x4 w1 = __builtin_bit_cast(u32x4, qr[4]), w2 = __builtin_bit_cast(u32x4, qr[5]);
        const f32x4 x1a = {bflo(w1.x), bfhi(w1.x), bflo(w1.y), bfhi(w1.y)}, x1b = {bflo(w1.z), bfhi(w1.z), bflo(w1.w), bfhi(w1.w)};
        const f32x4 x2a = {bflo(w2.x), bfhi(w2.x), bflo(w2.y), bfhi(w2.y)}, x2b = {bflo(w2.z), bfhi(w2.z), bflo(w2.w), bfhi(w2.w)};
        const f32x4 o1a = x1a * c0 - x2a * s0, o1b = x1b * c1 - x2b * s1, o2a = x1a * s0 + x2a * c0, o2b = x1b * s1 + x2b * c1;
        u32x4 r1 = {pk2(o1a.x, o1a.y), pk2(o1a.z, o1a.w), pk2(o1b.x, o1b.y), pk2(o1b.z, o1b.w)}, r2 = {pk2(o2a.x, o2a.y), pk2(o2a.z, o2a.w), pk2(o2b.x, o2b.y), pk2(o2b.z, o2b.w)};
        qr[4] = __builtin_bit_cast(bf16x8, r1); qr[5] = __builtin_bit_cast(bf16x8, r2); }
    const bool trail = wid >= 4;
#define PBAR_M(t) do { if ((t) + 3 < NT) { WAIT_BAR(6); } else { WAIT_BAR(0); } } while (0)
#define PBAR_V(t) do { if ((t) + 3 < NT) { WAIT_BAR(6); } else { WAIT_BAR(0); } } while (0)
    if (trail) WAIT_BAR(0);
    DMA_K(3, 3); DMA_V(2, 2);
    KLOAD(0); QK(px0, px1);
    PBAR_V(0);
    MASKT(px0, px1, 0);
    { float pm; ROWMAX(px0, px1, pm); SHIFT(px0, px1, pm); TILE_VALU(1.f); pa0 = pn0; pa1 = pn1; pa2 = pn2; pa3 = pn3; }
    int sk = 1, sv = 0;
#pragma unroll 1
    for (int t = 1; t < NT; ++t) {
        PBAR_M(t);
        { if (t + 3 < NT) DMA_K(t + 3, (sk + 3) & 3); if (t + 2 < NT) DMA_V(t + 2, (sk + 2) & 3); }
        SBAR();
        KLOAD(sk); VREAD(sv);
        SBAR();
        QK(px0, px1);
        SBAR(); asm volatile("s_waitcnt lgkmcnt(0)" ::: "memory"); SBAR();
        PVALL();
        PBAR_V(t);
        MASKT(px0, px1, t);
        float pm_, alX = 1.f; ROWMAX(px0, px1, pm_);
        if (__builtin_expect(__any(pm_ > THR), 0)) { const float dl_ = fmaxf(pm_, 0.f); SHIFT(px0, px1, dl_); alX = __builtin_amdgcn_exp2f(-dl_); }
        TILE_VALU(alX);
        pa0 = pn0; pa1 = pn1; pa2 = pn2; pa3 = pn3;
        RESC(alX);
        sk = (sk + 1) & 3; sv = (sv + 1) & 3;
    }
    WAIT_BAR(0);
    VREAD(sv); asm volatile("s_waitcnt lgkmcnt(0)" ::: "memory"); SBAR(); PVALL();
    if (!trail) WAIT_BAR(0);
    if (has_next) PRIME(nb_, nh_, nqb_);
#undef PBAR_M
#undef PBAR_V
    if (hi == 0) li_l[r32] = l_reg; asm volatile("s_waitcnt lgkmcnt(0)" ::: "memory");
    bf16* Ow = OB + (rowbase + P0 + wid * 32) * DM + h * 64;
    {
        LAS bf16* stg = (LAS bf16*)(lds + LDS_OST) + wid * 2048;
#pragma unroll
        for (int r = 0; r < 16; ++r) { const int orow = crow(r, hi); const float rl = __builtin_amdgcn_rcpf(li_l[orow]);
#pragma unroll
            for (int d0 = 0; d0 < 2; ++d0) stg[orow * 64 + d0 * 32 + r32] = f2bf(o[d0][r] * rl); }
        asm volatile("s_waitcnt lgkmcnt(0)" ::: "memory");
#pragma unroll
        for (int i4 = 0; i4 < 4; ++i4) { const int row = i4 * 8 + (lane >> 3), ch = lane & 7; const u32x4 v = *(const LAS u32x4*)(stg + row * 64 + ch * 8); *(u32x4*)(Ow + (size_t)row * DM + ch * 8) = v; }
    }
    if (!has_next) WAIT_BAR(0);
#undef PRIME
#undef TT
#undef DMA_K
#undef DMA_V
#undef KLOAD
#undef QK
#undef RESC
#undef MASKT
#undef ROWMAX
#undef SHIFT
#undef EXP16
#undef PACKP
#undef SOFTMAX2
#undef TILE_VALU
#undef TRRD
#undef VREAD
#undef VF
#undef PVH
#undef PVALL
#undef STEP
}
#undef SBAR
#undef SGB
#undef WAIT_BAR
}

#ifndef MK_PER_PHASE
#define MK_PER_PHASE 0
#endif
#ifndef REPEAT_MASK
#define REPEAT_MASK 0
#endif
#ifndef ATT_SHADOW
#define ATT_SHADOW -1
#endif
#ifndef P7_ONLY
#define P7_ONLY 0
#endif
__device__ __forceinline__ int q_grab(unsigned* que, LAS int* slot, int wv) {
    if (wv == 0) { if (lane_id() == 0) *slot = (int)__hip_atomic_fetch_add(que, 1u, __ATOMIC_RELAXED, __HIP_MEMORY_SCOPE_AGENT); }
    __syncthreads();
    const int r = __builtin_amdgcn_readfirstlane(*slot);
    __syncthreads();
    return r;
}
constexpr int N_PHASES = 17;
__global__ void __launch_bounds__(NWAVES * 64, 2) hybrid_fwd(Args args) {
    extern __shared__ __attribute__((aligned(16))) unsigned char lds_raw[];
    LAS unsigned char* lds = (LAS unsigned char*)lds_raw;
    const int wv0 = __builtin_amdgcn_readfirstlane(threadIdx.x >> 6);
    for (int u = threadIdx.x; u < (LDS_BYTES - LDSCTL_OFF) / 4; u += NWAVES * 64) ((LAS unsigned*)(lds + LDSCTL_OFF))[u] = 0u;
    __syncthreads();
    if (!MK_PER_PHASE) (void)xcd_barrier_post((unsigned*)((unsigned char*)args.in[I_WS] + WS_CTL) + CW_BAR, (volatile LAS unsigned*)(lds + MISC_OFF) + 8);
    const int lo = args.ph_lo, hi = args.ph_hi;
#define IN(k) (lo <= (k) && (k) < hi)
#define PH_BEGIN int z = 0; asm volatile("" : "+s"(z)); int tid = TIDW(wv0); asm volatile("" : "+v"(tid)); const int lane = tid & 63, wave = wv0; \
    const int G = gridDim.x; const int bx = blockIdx.x; const int vcu = (G % 8 == 0) ? (bx % 8) * (G / 8) + bx / 8 : bx; unsigned char* ws = (unsigned char*)args.in[I_WS + z]; \
    LAS unsigned char* ring = lds + RING_OFF; (void)lane; (void)wave; (void)vcu; (void)ws; (void)ring; (void)tid;
#define SEAM(k) do { if (IN(k) && IN((k) + 1)) { int zb = 0; asm volatile("" : "+s"(zb)); XcdBarrier bar; bar.bar = (unsigned*)((unsigned char*)args.in[I_WS + zb] + WS_CTL) + CW_BAR; bar.x = xb_xcc_id(); \
        bar.st = (volatile LAS unsigned*)(lds + MISC_OFF) + 8; bar.t0 = (TIDW(wv0) == 0); xcd_barrier(bar); } } while (0)
    typedef pg8::StaticOrder SO;
#define GBAR() do { int zb = 0; asm volatile("" : "+s"(zb)); XcdBarrier bar; bar.bar = (unsigned*)((unsigned char*)args.in[I_WS + zb] + WS_CTL) + CW_BAR; bar.x = xb_xcc_id(); \
        bar.st = (volatile LAS unsigned*)(lds + MISC_OFF) + 8; bar.t0 = (TIDW(wv0) == 0); xcd_barrier(bar); } while (0)
#define BAR_ARRIVE() do { int zb = 0; asm volatile("" : "+s"(zb)); XcdBarrier bar; bar.bar = (unsigned*)((unsigned char*)args.in[I_WS + zb] + WS_CTL) + CW_BAR; bar.x = xb_xcc_id(); \
        bar.st = (volatile LAS unsigned*)(lds + MISC_OFF) + 8; bar.t0 = (TIDW(wv0) == 0); xcd_barrier_arrive(bar); } while (0)
#define BAR_FINISH() do { int zb = 0; asm volatile("" : "+s"(zb)); XcdBarrier bar; bar.bar = (unsigned*)((unsigned char*)args.in[I_WS + zb] + WS_CTL) + CW_BAR; bar.x = xb_xcc_id(); \
        bar.st = (volatile LAS unsigned*)(lds + MISC_OFF) + 8; bar.t0 = (TIDW(wv0) == 0); xcd_barrier_finish(bar); } while (0)
#define PHASE(k, ...) if (IN(k)) { { constexpr int rep = 0; (void)rep; __VA_ARGS__ } if constexpr (((REPEAT_MASK) >> (k)) & 1) { GBAR(); { constexpr int rep = 1; (void)rep; __VA_ARGS__ } } }

    PHASE(0, { PH_BEGIN p0_prologue(args, lds, vcu, G, tid, lane, wave); })
    SEAM(0);
    PHASE(1, { PH_BEGIN pg8::Gemm g{(const bf16*)(ws + WS_XN), (const bf16*)(ws + WS_BUP1), MT, 2 * DFF, DM}; SO S; S.init(MT, 2 * DFF, G, bx);
        pg8::Epi<pg8::EM_SWIGLU> E{(bf16*)(ws + WS_H), DFF, nullptr, 0, nullptr, 0, 1.f};
        pg8::gemm_phase<pg8::Epi<pg8::EM_SWIGLU>, SO, true, true>(ring, g, S, E, wv0);
        if (rep == 0) convert_in_tail(args, lds, S.nwg, G, bx, CV_A, CV_B, wv0); })
    SEAM(1);
    PHASE(2, { PH_BEGIN sgemm_sample<pg8::EM_PLAIN, DFF>(lds, (const bf16*)(ws + WS_H), (const bf16*)(ws + WS_BDN1), DM, (bf16*)(ws + WS_F), DM, nullptr, 0, nullptr, 0, vcu, G, wv0, (unsigned*)(ws + WS_CTL) + CW_SN + 0 * 8 * 64);
        pg8::Gemm g{(const bf16*)(ws + WS_H), (const bf16*)(ws + WS_BDN1), MP, DM, DFF}; SO S; S.init(MP, DM, G, bx);
        pg8::EpiNorm<1, 0> E{(const float*)args.in[I_XP + z], (bf16*)(ws + WS_XR), (bf16*)(ws + WS_XN), nullptr, (const float*)args.in[I_F1POST + z], (const float*)args.in[I_MIXPRE + z], 0.5f, (float*)(ws + WS_NSLOT) + (size_t)0 * 2 * 64 * 256 * 4, (unsigned*)(ws + WS_CTL) + CW_PN + 0 * 2 * 64 * 64, nullptr};
        pg8::gemm_phase<pg8::EpiNorm<1, 0>, SO, true, true>(ring, g, S, E, wv0);
        sample_norm<1, 0>(args, (unsigned*)(ws + WS_CTL) + CW_SN + 0 * 8 * 64, (const bf16*)(ws + WS_F), 0.5f, I_F1POST, I_MIXPRE, G, vcu, wv0); })
    SEAM(3);
    PHASE(4, { PH_BEGIN pg8::Gemm g{(const bf16*)(ws + WS_XN), (const bf16*)(ws + WS_BIN), MT, ZW, DM}; SO S; S.init(MT, ZW, G, bx);
        pg8::Epi<pg8::EM_WIN> E{(bf16*)(ws + WS_Z), ZW, nullptr, 0, nullptr, 0, 1.f};
        pg8::gemm_phase<pg8::Epi<pg8::EM_WIN>, SO, true, true>(ring, g, S, E, wv0);
        if (rep == 0) convert_in_tail(args, lds, S.nwg, G, bx, CV_B, CV_N, wv0); })
    SEAM(4);
    PHASE(5, { PH_BEGIN
        for (int u = vcu; u < 256; u += G) lru_cu_unit<1>(args, lds, u, wv0);
        mla_prep(args, vcu, G, lane, wave);
    })
    SEAM(5);
    PHASE(6, {
        { PH_BEGIN for (int u = vcu; u < 256; u += G) lru_cu_unit<2>(args, lds, u, wv0); }
        __syncthreads();
        { PH_BEGIN sgemm_sample<pg8::EM_PLAIN, QL>(lds, (const bf16*)(ws + WS_CQ), (const bf16*)(ws + WS_BQ), QW, (bf16*)(ws + WS_Q), QW, nullptr, 0, nullptr, 0, vcu, G, wv0);
          sgemm_sample<pg8::EM_PLAIN, DPLE>(lds, (const bf16*)(ws + WS_PB), (const bf16*)(ws + WS_BPP), DM, (bf16*)(ws + WS_PPB), DM, nullptr, 0, nullptr, 0, vcu, G, wv0); }
    })
    SEAM(6);
    PHASE(7, {
        bool dec7;
        { PH_BEGIN const int nq = (G % 8 == 0) ? 8 : 1, q = (nq == 8) ? (bx & 7) : 0, ci = (nq == 8) ? (bx >> 3) : bx, cpq = G / nq, ndq = (NDEC / nq < cpq) ? NDEC / nq : cpq;
          const bool early = EARLY_DEC && (G == 256); dec7 = early && ci < ndq;
          if (!dec7) {
            const int Gp = early ? G - ndq * nq : G, cp = early ? (ci - ndq) * 8 + q : bx, vcup = early ? q * (cpq - ndq) + (ci - ndq) : vcu;
            sgemm_sample<pg8::EM_MULZ, DRNN>(lds, (const bf16*)(ws + WS_HG), (const bf16*)(ws + WS_BRNN), DM, (bf16*)(ws + WS_YAG), DM, (const bf16*)(ws + WS_Z) + Z_GA, ZW, nullptr, 0, vcup, Gp, wv0);
            { pg8::Gemm g{(const bf16*)(ws + WS_CQ), (const bf16*)(ws + WS_BQ), MP, QW, QL}; SO S; S.init(MP, QW, Gp, cp);
              pg8::Epi<pg8::EM_PLAIN> E{(bf16*)(ws + WS_Q), QW, nullptr, 0, nullptr, 0, 1.f};
              pg8::gemm_phase<pg8::Epi<pg8::EM_PLAIN>, SO, true, true>(ring, g, S, E, wv0); } } }
        if (!dec7) { PH_BEGIN const int nq = (G % 8 == 0) ? 8 : 1, q = (nq == 8) ? (bx & 7) : 0, ci = (nq == 8) ? (bx >> 3) : bx, cpq = G / nq, ndq = (NDEC / nq < cpq) ? NDEC / nq : cpq;
          const bool early = EARLY_DEC && (G == 256); const int Gp = early ? G - ndq * nq : G, cp = early ? (ci - ndq) * 8 + q : bx;
          pg8::Gemm g{(const bf16*)(ws + WS_CKV), (const bf16*)(ws + WS_BKV), MP, KVW, KVL}; SO S; S.init(MP, KVW, Gp, cp);
          pg8::Epi<pg8::EM_PLAIN> E{(bf16*)(ws + WS_KVB), KVW, nullptr, 0, nullptr, 0, 1.f};
          pg8::gemm_phase<pg8::Epi<pg8::EM_PLAIN>, SO, true, true>(ring, g, S, E, wv0); }
        BAR_ARRIVE();
        if (!dec7) BAR_FINISH();
    })
    PHASE(8, { PH_BEGIN
        const int nq = (G % 8 == 0) ? 8 : 1, q = (nq == 8) ? (bx & 7) : 0, ci = (nq == 8) ? (bx >> 3) : bx, cpq = G / nq;
        {
            const int ndq = (NDEC / nq < cpq) ? NDEC / nq : cpq, nd = ndq * nq;
            if (ci < ndq) {
                _Pragma("unroll 1") for (int sq = q * ndq + ci; sq < NS; sq += nd) {
                    sample_attn_seq(args, lds, sq, wv0);
                }
                __syncthreads();
                if (EARLY_DEC && G == 256) BAR_FINISH();
            }
        }
        {
            unsigned* que = (unsigned*)(ws + WS_CTL) + CW_QUE + 64 * q;
            LAS int* slot = (LAS int*)(lds + MISC_OFF) + 64;
            const int hq = 32 / nq, nblk = 32 * hq, npq = 64 / nq, ny = 4 * npq, ya0 = nblk - 10, nitem = nblk + ny;
            int cur = q_grab(que, slot, wv0), nxt = nitem; if (cur < nitem) nxt = q_grab(que, slot, wv0);
            _Pragma("unroll 1") while (cur < nitem) {
                if (cur >= ya0 && cur < ya0 + ny) {
                    const int t = cur - ya0;
                    pg8::Gemm g{(const bf16*)(ws + WS_HG), (const bf16*)(ws + WS_BRNN), MP, DM, DRNN}; pg8::OneUnit T; T.u.pm = q * npq + (t % npq); T.u.pn = t / npq;
                    pg8::Epi<pg8::EM_MULZ> E{(bf16*)(ws + WS_YAG), DM, (const bf16*)(ws + WS_Z) + Z_GA, ZW, nullptr, 0, 1.f};
                    pg8::gemm_phase<pg8::Epi<pg8::EM_MULZ>, pg8::OneUnit, true, true>(ring, g, T, E, wv0);
                    cur = nxt; if (cur < nitem) nxt = q_grab(que, slot, wv0);
                    continue;
                }
                bf16x8 qr[6]; bool primed = false, more;
                do {
                    const int kc = cur < ya0 ? cur : cur - ny, bh = hq * q + 2 * (kc >> 6) + (kc & 1), qb = 31 - ((kc & 63) >> 1);
                    more = nxt < nitem && !(nxt >= ya0 && nxt < ya0 + ny);
                    const int kn = more ? (nxt < ya0 ? nxt : nxt - ny) : 0, bhn = hq * q + 2 * (kn >> 6) + (kn & 1), qbn = 31 - ((kn & 63) >> 1);
                    pattn4::block<0>((const bf16*)(ws + WS_Q), (const bf16*)(ws + WS_KVB), (const bf16*)(ws + WS_KR), (const float*)(ws + WS_ROPE), (bf16*)(ws + WS_OB), lds, bh >> 4, bh & 15, qb, 0, wv0,
                                     primed, more, bhn >> 4, bhn & 15, qbn, qr);
                    primed = true; cur = nxt; if (cur < nitem) nxt = q_grab(que, slot, wv0);
                } while (more);
            }
        }
        __syncthreads();
#if ATT_SHADOW >= 0
        GBAR();
        { int z2 = 0; asm volatile("" : "+s"(z2)); unsigned char* ws2 = (unsigned char*)args.in[I_WS + z2];
          const int G2 = gridDim.x, bx2 = blockIdx.x, vcu2 = (G2 % 8 == 0) ? (bx2 % 8) * (G2 / 8) + bx2 / 8 : bx2;
          bf16x8 qrs[6];
          for (int L = vcu2; L < 512; L += G2) { const int bh = L >> 4, x = L & 15;
            pattn4::block<ATT_SHADOW>((const bf16*)(ws2 + WS_Q), (const bf16*)(ws2 + WS_KVB), (const bf16*)(ws2 + WS_KR), (const float*)(ws2 + WS_ROPE), (bf16*)(ws2 + WS_END), lds, bh >> 4, bh & 15, x, 0, wv0, false, false, 0, 0, 0, qrs);
            pattn4::block<ATT_SHADOW>((const bf16*)(ws2 + WS_Q), (const bf16*)(ws2 + WS_KVB), (const bf16*)(ws2 + WS_KR), (const float*)(ws2 + WS_ROPE), (bf16*)(ws2 + WS_END), lds, bh >> 4, bh & 15, 31 - x, 0, wv0, false, false, 0, 0, 0, qrs); } }
        __syncthreads();
#endif
    })
    SEAM(8);
    PHASE(9, { PH_BEGIN sgemm_sample<pg8::EM_FMAZ, DM>(lds, (const bf16*)(ws + WS_OB), (const bf16*)(ws + WS_BATT), DM, (bf16*)(ws + WS_MX), DM, (const bf16*)(ws + WS_Z) + Z_GB, ZW, (const bf16*)(ws + WS_YAG), DM, vcu, G, wv0);
        pg8::Gemm g{(const bf16*)(ws + WS_OB), (const bf16*)(ws + WS_BATT), MP, DM, DM}; SO S; S.init(MP, DM, G, bx);
        pg8::Epi<pg8::EM_FMAZ> E{(bf16*)(ws + WS_MX), DM, (const bf16*)(ws + WS_Z) + Z_GB, ZW, (const bf16*)(ws + WS_YAG), DM, 1.f};
        pg8::gemm_phase<pg8::Epi<pg8::EM_FMAZ>, SO, true, true>(ring, g, S, E, wv0); })
    SEAM(9);
    PHASE(10, { PH_BEGIN sgemm_sample<pg8::EM_PLAIN, DM>(lds, (const bf16*)(ws + WS_MX), (const bf16*)(ws + WS_BOUT), DM, (bf16*)(ws + WS_F), DM, nullptr, 0, nullptr, 0, vcu, G, wv0, (unsigned*)(ws + WS_CTL) + CW_SN + 1 * 8 * 64);
        pg8::Gemm g{(const bf16*)(ws + WS_MX), (const bf16*)(ws + WS_BOUT), MP, DM, DM}; SO S; S.init(MP, DM, G, bx);
        pg8::EpiNorm<1, 1> E{nullptr, (bf16*)(ws + WS_XR), (bf16*)(ws + WS_XN), nullptr, (const float*)args.in[I_MIXPOST + z], (const float*)args.in[I_F2PRE + z], 1.0f, (float*)(ws + WS_NSLOT) + (size_t)1 * 2 * 64 * 256 * 4, (unsigned*)(ws + WS_CTL) + CW_PN + 1 * 2 * 64 * 64, nullptr};
        pg8::gemm_phase<pg8::EpiNorm<1, 1>, SO, true, true>(ring, g, S, E, wv0);
        sample_norm<1, 1>(args, (unsigned*)(ws + WS_CTL) + CW_SN + 1 * 8 * 64, (const bf16*)(ws + WS_F), 1.0f, I_MIXPOST, I_F2PRE, G, vcu, wv0); })
    SEAM(11);
    PHASE(12, { PH_BEGIN pg8::Gemm g{(const bf16*)(ws + WS_XN), (const bf16*)(ws + WS_BUP2), MT, 2 * DFF, DM}; SO S; S.init(MT, 2 * DFF, G, bx);
        pg8::Epi<pg8::EM_SWIGLU> E{(bf16*)(ws + WS_H), DFF, nullptr, 0, nullptr, 0, 1.f};
        pg8::gemm_phase<pg8::Epi<pg8::EM_SWIGLU>, SO, true, true>(ring, g, S, E, wv0); }
        { PH_BEGIN const int nwg0 = (MT / 256) * (2 * DFF / 256), full = (nwg0 + G - 1) / G, nl = full * G - nwg0;
          if (nl == 0 || bx >= G - nl) { pg8::Gemm g2{(const bf16*)(ws + WS_PB), (const bf16*)(ws + WS_BPP), MP, DM, DPLE}; SO T; T.init(MP, DM, nl == 0 ? G : nl, nl == 0 ? bx : bx - (G - nl));
            pg8::Epi<pg8::EM_PLAIN> E2{(bf16*)(ws + WS_PPB), DM, nullptr, 0, nullptr, 0, 1.f};
            pg8::gemm_phase<pg8::Epi<pg8::EM_PLAIN>, SO, true, true>(ring, g2, T, E2, wv0); } } )
    SEAM(12);
    PHASE(13, { PH_BEGIN sgemm_sample<pg8::EM_PLAIN, DFF>(lds, (const bf16*)(ws + WS_H), (const bf16*)(ws + WS_BDN2), DM, (bf16*)(ws + WS_F), DM, nullptr, 0, nullptr, 0, vcu, G, wv0, (unsigned*)(ws + WS_CTL) + CW_SN + 2 * 8 * 64);
        pg8::Gemm g{(const bf16*)(ws + WS_H), (const bf16*)(ws + WS_BDN2), MP, DM, DFF}; SO S; S.init(MP, DM, G, bx);
        pg8::EpiNorm<2, 1> E{nullptr, (bf16*)(ws + WS_XR), (bf16*)(ws + WS_XN), nullptr, (const float*)args.in[I_F2POST + z], nullptr, 0.5f, (float*)(ws + WS_NSLOT) + (size_t)2 * 2 * 64 * 256 * 4, (unsigned*)(ws + WS_CTL) + CW_PN + 2 * 2 * 64 * 64, nullptr};
        pg8::gemm_phase<pg8::EpiNorm<2, 1>, SO, true, true>(ring, g, S, E, wv0);
        sample_norm<2, 1>(args, (unsigned*)(ws + WS_CTL) + CW_SN + 2 * 8 * 64, (const bf16*)(ws + WS_F), 0.5f, I_F2POST, I_F2POST, G, vcu, wv0); })
    SEAM(14);
    PHASE(15, { PH_BEGIN sgemm_sample<pg8::EM_SIGMUL, DM>(lds, (const bf16*)(ws + WS_XN), (const bf16*)(ws + WS_BPG), DM, (bf16*)(ws + WS_F), DM, (const bf16*)(ws + WS_PPB), DM, nullptr, 0, vcu, G, wv0, (unsigned*)(ws + WS_CTL) + CW_SN + 3 * 8 * 64);
        pg8::Gemm g{(const bf16*)(ws + WS_XN), (const bf16*)(ws + WS_BPG), MP, DM, DM}; SO S; S.init(MP, DM, G, bx);
        pg8::EpiNorm<0, 2, 1> E{nullptr, nullptr, (bf16*)(ws + WS_XN), (float*)args.in[I_OUT + z] + O_Y, (const float*)args.in[I_PPOST + z], nullptr, 1.0f, (float*)(ws + WS_NSLOT) + (size_t)3 * 2 * 64 * 256 * 4, (unsigned*)(ws + WS_CTL) + CW_PN + 3 * 2 * 64 * 64, (const bf16*)(ws + WS_PPB)};
        pg8::gemm_phase<pg8::EpiNorm<0, 2, 1>, SO, true, true>(ring, g, S, E, wv0);
        sample_norm<0, 2>(args, (unsigned*)(ws + WS_CTL) + CW_SN + 3 * 8 * 64, (const bf16*)(ws + WS_F), 1.0f, I_PPOST, I_PPOST, G, vcu, wv0); })
#undef IN
#undef SEAM
#undef PHASE
#undef GBAR
#undef PH_BEGIN
}

extern "C" void kernel_launch(void* const* d_in, const int* in_sizes, int n_in, void* d_out, int out_size, void* d_ws, size_t ws_size, hipStream_t stream) {
    static int grid = 0;
    if (grid == 0) {
        if (n_in != N_IN || (size_t)out_size != O_END || ws_size < WS_END) { fprintf(stderr, "kernel_launch: unexpected shapes (n_in %d, out %d, ws %zu)\n", n_in, out_size, ws_size); grid = -1; return; }
        int dev = 0, cus = 0, per_cu = 0;
        if (hipGetDevice(&dev) != hipSuccess || hipDeviceGetAttribute(&cus, hipDeviceAttributeMultiprocessorCount, dev) != hipSuccess) { grid = -1; return; }
        if (hipFuncSetAttribute((const void*)hybrid_fwd, hipFuncAttributeMaxDynamicSharedMemorySize, LDS_BYTES) != hipSuccess) { fprintf(stderr, "kernel_launch: hipFuncSetAttribute failed\n"); grid = -1; return; }
        if (hipOccupancyMaxActiveBlocksPerMultiprocessor(&per_cu, (const void*)hybrid_fwd, NWAVES * 64, LDS_BYTES) != hipSuccess || per_cu < 1) { fprintf(stderr, "kernel_launch: occupancy query says %d\n", per_cu); }
        (void)hipGetLastError();
        grid = cus;
    }
    if (grid < 0) return;
    (void)hipMemsetAsync((char*)d_ws + WS_CTL, 0, CTL_ZERO_BYTES, stream);
    Args a{};
    for (int i = 0; i < N_IN; ++i) a.in[i] = d_in[i];
    a.in[I_OUT] = d_out; a.in[I_WS] = d_ws; a.pad = 0;
#if MK_PER_PHASE
    for (int p = 0; p < N_PHASES; ++p) { a.ph_lo = p; a.ph_hi = p + 1; a.li = p; hipLaunchKernelGGL(hybrid_fwd, dim3(grid), dim3(NWAVES * 64), LDS_BYTES, stream, a); }
#else
    a.ph_lo = 0; a.ph_hi = N_PHASES; a.li = 0;
    hipLaunchKernelGGL(hybrid_fwd, dim3(grid), dim3(NWAVES * 64), LDS_BYTES, stream, a);
#endif
    const hipError_t le = hipPeekAtLastError();
    if (le != hipSuccess) fprintf(stderr, "kernel_launch: launch failed: %s\n", hipGetErrorName(le));
}
```

```cpp
#include <hip/hip_runtime.h>
#include <cstdio>
#include <cstdint>

#define GAS __attribute__((address_space(1)))
#define LAS __attribute__((address_space(3)))
typedef unsigned short bf16;
typedef short bf16x8 __attribute__((ext_vector_type(8)));
typedef short s16x4 __attribute__((ext_vector_type(4)));
typedef float f32x2 __attribute__((ext_vector_type(2)));
typedef float f32x4 __attribute__((ext_vector_type(4)));
typedef float f32x16 __attribute__((ext_vector_type(16)));
typedef unsigned u32x2 __attribute__((ext_vector_type(2)));
typedef unsigned u32x4 __attribute__((ext_vector_type(4)));
typedef __bf16 bf16x2_t __attribute__((ext_vector_type(2)));

constexpr int DM = 1024, SEQ = 8192, NBATCH = 2, MP = NBATCH * SEQ, NS = 128, MT = 16640, NMT = MT / 256;
constexpr int DFF = 2816, DRNN = 1280, NBLK = 16, BLK = 80, QL = 384, KVL = 256, ROPE = 32, NH = 16;
constexpr int DPLE = 256, DIN = 5280, ZW = 5376;
constexpr int Z_XR = 0, Z_YR = 1280, Z_CQ = 2560, Z_KV = 2944, Z_KR = 3200, Z_GA = 3328, Z_GB = 4352;
constexpr int QW = 1536, KVW = 2048;
constexpr int PAGE = 128, NPAGES = 64;
constexpr float EPS = 1e-6f;
constexpr float C2 = 0.10206207261596577f * 1.4426950408889634f;
constexpr size_t O_Y = 0, O_CKV_P = 16908288, O_KR_P = 21102592, O_H_P = 21626880, O_CONV_P = 21629440, O_CKV_S = 21637120, O_KR_S = 21669888, O_H_S = 21673984, O_CONV_S = 21837824, O_END = 22329344;
enum { I_XP = 0, I_XS, I_PP, I_PS, I_CCKV, I_CKR, I_SH, I_SCONV, I_PT, I_F1PRE, I_F1G, I_F1U, I_F1D, I_F1POST, I_MIXPRE, I_WIN, I_CONVW, I_CONVB, I_LWA, I_LBA, I_LWI, I_LBI, I_LAM,
       I_WRNN, I_QNORM, I_WUQ, I_WQR, I_KVNORM, I_WUK, I_WUV, I_WATT, I_WOUT, I_MIXPOST, I_F2PRE, I_F2G, I_F2U, I_F2D, I_F2POST, I_PG, I_PPJ, I_PPOST, N_IN, I_OUT = N_IN, I_WS, N_PTR };

constexpr size_t MiB = 1u << 20;
constexpr size_t WS_CTL = 0, CTL_ZERO_BYTES = 256 * 1024;
constexpr size_t WS_BUP1 = 2 * MiB, WS_BDN1 = 13 * MiB, WS_BIN = 19 * MiB, WS_BRNN = 30 * MiB, WS_BQ = 33 * MiB, WS_BKV = 35 * MiB, WS_BATT = 36 * MiB, WS_BOUT = 38 * MiB,
                 WS_BUP2 = 40 * MiB, WS_BDN2 = 51 * MiB, WS_BPG = 57 * MiB, WS_BPP = 59 * MiB, WS_LW = 60 * MiB, WS_ROPE = 61 * MiB, WS_SUM = 63 * MiB;
constexpr size_t WS_XN = 64 * MiB, WS_F = 97 * MiB, WS_H = 130 * MiB, WS_XR = 220 * MiB, WS_Z = 285 * MiB, WS_CQ = 456 * MiB, WS_CKV = 469 * MiB, WS_KR = 478 * MiB, WS_Q = 480 * MiB,
                 WS_KVB = 529 * MiB, WS_PB = 593 * MiB, WS_PPB = 602 * MiB, WS_HG = 635 * MiB, WS_YAG = 676 * MiB, WS_OB = 709 * MiB, WS_MX = 742 * MiB, WS_PART = 775 * MiB, WS_NSLOT = 808 * MiB, WS_END = 810 * MiB;
constexpr int ROPE_TAB = 8193 * 16;
constexpr int PART_STRIDE = 16 * 256 + 32;
constexpr int CW_BAR = 4096;
constexpr int CW_PN = 8192;
constexpr int CW_SN = 49152;
constexpr int CW_QUE = 2048;
#ifndef EARLY_DEC
#define EARLY_DEC 0
#endif
#ifndef NDEC
#define NDEC 64
#endif

__device__ __forceinline__ float bflo(unsigned w) { return __uint_as_float(w << 16); }
__device__ __forceinline__ float bfhi(unsigned w) { return __uint_as_float(w & 0xffff0000u); }
__device__ __forceinline__ float bf2f(bf16 v) { return __uint_as_float((unsigned)v << 16); }
__device__ __forceinline__ unsigned pk2(float lo, float hi) { f32x2 v = {lo, hi}; bf16x2_t b = __builtin_convertvector(v, bf16x2_t); return __builtin_bit_cast(unsigned, b); }
__device__ __forceinline__ bf16 f2bf(float f) { return (bf16)(pk2(f, 0.f) & 0xffffu); }
__device__ __forceinline__ float sigmoid_f(float x) { return __builtin_amdgcn_rcpf(1.f + __builtin_amdgcn_exp2f(-1.4426950408889634f * x)); }
__device__ __forceinline__ float silu_f(float x) { return x * sigmoid_f(x); }
__device__ __forceinline__ float gelu_tanh_f(float x) { const float u = 0.7978845608028654f * (x + 0.044715f * x * x * x); return x * sigmoid_f(2.f * u); }
__device__ __forceinline__ float wave_sum(float v) {
#define WS_DPP(ctrl) v += __uint_as_float((unsigned)__builtin_amdgcn_update_dpp(0, (int)__float_as_uint(v), ctrl, 0xf, 0xf, false))
    WS_DPP(0xB1); WS_DPP(0x4E); WS_DPP(0x141); WS_DPP(0x140);
#undef WS_DPP
    { const unsigned u = __float_as_uint(v); const auto r = __builtin_amdgcn_permlane16_swap(u, u, false, false); v = __uint_as_float(r[0]) + __uint_as_float(r[1]); }
    { const unsigned u = __float_as_uint(v); const auto r = __builtin_amdgcn_permlane32_swap(u, u, false, false); v = __uint_as_float(r[0]) + __uint_as_float(r[1]); }
    return v;
}
__device__ __forceinline__ int lane_id() { return (int)__builtin_amdgcn_mbcnt_hi(~0u, __builtin_amdgcn_mbcnt_lo(~0u, 0u)); }
#define TIDW(wv) ((wv) * 64 + lane_id())
#define LDS_WAIT() asm volatile("s_waitcnt lgkmcnt(0)" ::: "memory")
#define VM_WAIT() asm volatile("s_waitcnt vmcnt(0)" ::: "memory")

namespace pg8 {
typedef unsigned short bf16_t;
constexpr int BM = 256, BK = 64, HALF = 128, HTB = HALF * BK * 2, STAGE_BYTES = 8 * HTB, NXCD = 8, WGM = 8;
__host__ __device__ __forceinline__ int lds_byte(int r, int c) { const int st = (r >> 4) * 2 + (c >> 5), rr = r & 15, cc = c & 31, ob = rr * 64 + cc * 2; return st * 1024 + (ob ^ (((ob >> 9) & 1) << 5)); }
__host__ __device__ __forceinline__ void stage_rc(int b, int& R, int& C) { const int st = b / 1024, sb = b % 1024, swz = sb ^ (((sb >> 9) & 1) << 5); R = (st >> 1) * 16 + swz / 64; C = (st & 1) * 32 + (swz % 64) / 2; }
__host__ __device__ __forceinline__ int perm32(int rho) { const int n = rho >> 4, i = rho & 15; return 8 * (i >> 2) + 4 * n + (i & 3); }
struct Unit { int pm, pn; };
struct Gemm { const bf16_t* A; const bf16_t* Bt; int M, N, K; };
struct StaticOrder {
    int nM, nN, nwg, G, c;
    __host__ __device__ void init(int M, int N, int G_, int c_) { nM = M / BM; nN = N / BM; nwg = nM * nN; G = G_; c = c_; }
    __host__ __device__ bool next(int i, Unit& u) const {
        const long L = (long)i * G + c; if (L >= nwg) return false;
        int wgid = (int)L; { const int q = nwg / NXCD, r = nwg % NXCD, xcd = wgid % NXCD, off = wgid / NXCD; wgid = (xcd < r ? xcd * (q + 1) : r * (q + 1) + (xcd - r) * q) + off; }
        const int nig = WGM * nN, gid = wgid / nig, fm = gid * WGM, gsz = (nM - fm) < WGM ? (nM - fm) : WGM;
        u.pm = fm + ((wgid % nig) % gsz); u.pn = (wgid % nig) / gsz; return true;
    }
    __device__ __forceinline__ void a_ready(const Unit&) const {}
    __device__ __forceinline__ void done(const Unit&) const {}
};
enum { EM_PLAIN = 0, EM_SWIGLU, EM_WIN, EM_SCALE, EM_MULZ, EM_FMAZ, EM_SIGMUL };
template <int MODE> struct Epi {
    static constexpr bool PERM = true, AFTER_DRAIN = false;
    bf16_t* O; int ldc;
    const bf16_t* aux; int ldaux;
    const bf16_t* add; int ldadd;
    float scale;
    __device__ __forceinline__ void operator()(const f32x4 (&acc)[2][2][4][2], const Unit& u, int wr, int wc, int fr, int fq) const {
        const int row0 = u.pm * BM + wr * 64 + fr;
        if constexpr (MODE == EM_SWIGLU) {
            const int col = u.pn * HALF + wc * 32 + 8 * fq;
#pragma unroll
            for (int ai = 0; ai < 2; ++ai)
#pragma unroll
                for (int m = 0; m < 4; ++m) {
                    const f32x4 g0 = acc[ai][0][m][0], g1 = acc[ai][0][m][1], u0 = acc[ai][1][m][0], u1 = acc[ai][1][m][1];
                    u32x4 w; w.x = pk2(silu_f(g0[0]) * u0[0], silu_f(g0[1]) * u0[1]); w.y = pk2(silu_f(g0[2]) * u0[2], silu_f(g0[3]) * u0[3]);
                    w.z = pk2(silu_f(g1[0]) * u1[0], silu_f(g1[1]) * u1[1]); w.w = pk2(silu_f(g1[2]) * u1[2], silu_f(g1[3]) * u1[3]);
                    *(u32x4*)(O + (size_t)(row0 + ai * HALF + m * 16) * ldc + col) = w;
                }
        } else {
            int act = 0;
            if constexpr (MODE == EM_WIN) act = (u.pn >= 5 && u.pn < 10) ? 1 : (u.pn >= 13 ? 2 : 0);
#pragma unroll
            for (int ai = 0; ai < 2; ++ai)
#pragma unroll
                for (int m = 0; m < 4; ++m) {
                    const int row = row0 + ai * HALF + m * 16;
#pragma unroll
                    for (int bj = 0; bj < 2; ++bj) {
                        const int col = u.pn * BM + bj * HALF + wc * 32 + 8 * fq;
                        f32x4 v0 = acc[ai][bj][m][0], v1 = acc[ai][bj][m][1];
                        if constexpr (MODE == EM_WIN) {
                            if (act == 1) { for (int j = 0; j < 4; ++j) { v0[j] = gelu_tanh_f(v0[j]); v1[j] = gelu_tanh_f(v1[j]); } }
                            else if (act == 2) { for (int j = 0; j < 4; ++j) { v0[j] = sigmoid_f(v0[j]); v1[j] = sigmoid_f(v1[j]); } }
                        }
                        if constexpr (MODE == EM_SCALE) { v0 = v0 * scale; v1 = v1 * scale; }
                        if constexpr (MODE == EM_MULZ || MODE == EM_FMAZ || MODE == EM_SIGMUL) {
                            const u32x4 z = *(const u32x4*)(aux + (size_t)row * ldaux + col);
                            f32x4 z0 = {bflo(z.x), bfhi(z.x), bflo(z.y), bfhi(z.y)}, z1 = {bflo(z.z), bfhi(z.z), bflo(z.w), bfhi(z.w)};
                            if constexpr (MODE == EM_SIGMUL) { for (int j = 0; j < 4; ++j) { v0[j] = sigmoid_f(v0[j]); v1[j] = sigmoid_f(v1[j]); } }
                            v0 = v0 * z0; v1 = v1 * z1;
                            if constexpr (MODE == EM_FMAZ) {
                                const u32x4 y = *(const u32x4*)(add + (size_t)row * ldadd + col);
                                v0 += (f32x4){bflo(y.x), bfhi(y.x), bflo(y.y), bfhi(y.y)}; v1 += (f32x4){bflo(y.z), bfhi(y.z), bflo(y.w), bfhi(y.w)};
                            }
                        }
                        u32x4 w; w.x = pk2(v0[0], v0[1]); w.y = pk2(v0[2], v0[3]); w.z = pk2(v1[0], v1[1]); w.w = pk2(v1[2], v1[3]);
                        *(u32x4*)(O + (size_t)row * ldc + col) = w;
                    }
                }
        }
    }
};

struct OneUnit { Unit u; __device__ __forceinline__ bool next(int i, Unit& o) const { if (i != 0) return false; o = u; return true; }
    __device__ __forceinline__ void a_ready(const Unit&) const {} __device__ __forceinline__ void done(const Unit&) const {} };
template <int NEXT, int SRC, int PRE = 0> struct EpiNorm {
    static constexpr bool PERM = true, AFTER_DRAIN = true;
    const float* xin; bf16_t* XR; bf16_t* XN; float* Y; const float* gpost; const float* gpre; float coef; float* slots; unsigned* cnt; const bf16_t* aux;
    __device__ __forceinline__ void operator()(const f32x4 (&)[2][2][4][2], const Unit&, int, int, int, int) const {}
    __device__ __forceinline__ void stats(const f32x4 (&v)[2][2][4][2], const Unit& u, int wr, int wc, int fr, int fq, LAS unsigned char* lds, int wid, int lane, int which, float c) const {
        LAS float* P = (LAS float*)lds; LAS float* S = (LAS float*)(lds + 4096);
#pragma unroll
        for (int ai = 0; ai < 2; ++ai)
#pragma unroll
            for (int m = 0; m < 4; ++m) { float q = 0.f;
#pragma unroll
                for (int bj = 0; bj < 2; ++bj)
#pragma unroll
                    for (int n = 0; n < 2; ++n) { const f32x4 x = v[ai][bj][m][n]; q += (x[0] * x[0] + x[1] * x[1]) + (x[2] * x[2] + x[3] * x[3]); }
                { const unsigned uq = __float_as_uint(q); const auto r_ = __builtin_amdgcn_permlane16_swap(uq, uq, false, false); q = __uint_as_float(r_[0]) + __uint_as_float(r_[1]); }
                { const unsigned uq = __float_as_uint(q); const auto r_ = __builtin_amdgcn_permlane32_swap(uq, uq, false, false); q = __uint_as_float(r_[0]) + __uint_as_float(r_[1]); }
                if (fq == 0) P[(ai * HALF + wr * 64 + m * 16 + fr) * 4 + wc] = q; }
        asm volatile("s_waitcnt lgkmcnt(0)" ::: "memory"); __builtin_amdgcn_s_barrier(); asm volatile("" ::: "memory");
        const int row = wid * 32 + (lane & 31);
        float* slot = slots + ((size_t)(which * 64 + u.pm) * BM + row) * 4;
        unsigned* c0 = cnt + (size_t)(which * 64 + u.pm) * 64;
        if (lane < 32) { const f32x4 p4 = *(const LAS f32x4*)(P + row * 4); __hip_atomic_store(slot + u.pn, (p4[0] + p4[1]) + (p4[2] + p4[3]), __ATOMIC_RELAXED, __HIP_MEMORY_SCOPE_AGENT); }
        asm volatile("s_waitcnt vmcnt(0)" ::: "memory");
        if (lane == 0) (void)__hip_atomic_fetch_add(c0, 1u, __ATOMIC_RELAXED, __HIP_MEMORY_SCOPE_AGENT);
        if (wid == 0) { unsigned sp = 0u;
            while ((unsigned)__builtin_amdgcn_readfirstlane(__hip_atomic_load(c0, __ATOMIC_RELAXED, __HIP_MEMORY_SCOPE_AGENT)) < 32u) { __builtin_amdgcn_s_sleep(1); if (++sp > (1u << 20)) break; }
            __builtin_amdgcn_fence(__ATOMIC_ACQUIRE, "agent"); }
        asm volatile("s_waitcnt vmcnt(0) lgkmcnt(0)" ::: "memory"); __builtin_amdgcn_s_barrier(); asm volatile("" ::: "memory");
        if (lane < 32) { float t = 0.f;
#pragma unroll
            for (int k = 0; k < 4; ++k) t += __hip_atomic_load(slot + k, __ATOMIC_RELAXED, __HIP_MEMORY_SCOPE_AGENT);
            S[row] = c / sqrtf(t * (1.f / 1024.f) + 1e-6f); }
        asm volatile("s_waitcnt vmcnt(0) lgkmcnt(0)" ::: "memory"); __builtin_amdgcn_s_barrier(); asm volatile("" ::: "memory");
    }
    __device__ __forceinline__ void fused(f32x4 (&acc)[2][2][4][2], const Unit& u, int wr, int wc, int fr, int fq, LAS unsigned char* lds, int wid, int lane) const {
        const LAS float* S = (const LAS float*)(lds + 4096);
        if constexpr (PRE == 1) {
#pragma unroll
            for (int bj = 0; bj < 2; ++bj)
#pragma unroll
                for (int ai = 0; ai < 2; ++ai)
#pragma unroll
                    for (int m = 0; m < 4; ++m) { const size_t off = (size_t)(u.pm * BM + ai * HALF + wr * 64 + m * 16 + fr) * 1024 + u.pn * BM + bj * HALF + wc * 32 + 8 * fq;
                        const u32x4 zq = *(const u32x4*)(aux + off); f32x4 v0 = acc[ai][bj][m][0], v1 = acc[ai][bj][m][1];
#pragma unroll
                        for (int j = 0; j < 4; ++j) { v0[j] = sigmoid_f(v0[j]); v1[j] = sigmoid_f(v1[j]); }
                        acc[ai][bj][m][0] = v0 * (f32x4){bflo(zq.x), bfhi(zq.x), bflo(zq.y), bfhi(zq.y)}; acc[ai][bj][m][1] = v1 * (f32x4){bflo(zq.z), bfhi(zq.z), bflo(zq.w), bfhi(zq.w)}; }
        }
        stats(acc, u, wr, wc, fr, fq, lds, wid, lane, 0, coef);
#pragma unroll
        for (int bj = 0; bj < 2; ++bj) {
            const int col = u.pn * BM + bj * HALF + wc * 32 + 8 * fq;
            const f32x4 g0 = *(const f32x4*)(gpost + col), g1 = *(const f32x4*)(gpost + col + 4);
#pragma unroll
            for (int ai = 0; ai < 2; ++ai)
#pragma unroll
                for (int m = 0; m < 4; ++m) {
                    const int rl = ai * HALF + wr * 64 + m * 16 + fr; const size_t off = (size_t)(u.pm * BM + rl) * 1024 + col; const float r = S[rl];
                    f32x4 x0, x1;
                    if constexpr (SRC == 0) { x0 = *(const f32x4*)(xin + off); x1 = *(const f32x4*)(xin + off + 4); }
                    else { const u32x4 w = *(const u32x4*)((SRC == 1 ? XR : XN) + off); x0 = (f32x4){bflo(w.x), bfhi(w.x), bflo(w.y), bfhi(w.y)}; x1 = (f32x4){bflo(w.z), bfhi(w.z), bflo(w.w), bfhi(w.w)}; }
                    x0 = x0 + acc[ai][bj][m][0] * g0 * r; x1 = x1 + acc[ai][bj][m][1] * g1 * r;
                    acc[ai][bj][m][0] = x0; acc[ai][bj][m][1] = x1;
                    if constexpr (NEXT == 0) { *(f32x4*)(Y + off) = x0; *(f32x4*)(Y + off + 4) = x1; }
                    else { u32x4 w; w.x = pk2(x0[0], x0[1]); w.y = pk2(x0[2], x0[3]); w.z = pk2(x1[0], x1[1]); w.w = pk2(x1[2], x1[3]); *(u32x4*)((NEXT == 1 ? XR : XN) + off) = w; }
                }
        }
        if constexpr (NEXT == 1) {
            stats(acc, u, wr, wc, fr, fq, lds, wid, lane, 1, 1.f);
#pragma unroll
            for (int bj = 0; bj < 2; ++bj) {
                const int col = u.pn * BM + bj * HALF + wc * 32 + 8 * fq;
                const f32x4 g0 = *(const f32x4*)(gpre + col), g1 = *(const f32x4*)(gpre + col + 4);
#pragma unroll
                for (int ai = 0; ai < 2; ++ai)
#pragma unroll
                    for (int m = 0; m < 4; ++m) {
                        const int rl = ai * HALF + wr * 64 + m * 16 + fr; const size_t off = (size_t)(u.pm * BM + rl) * 1024 + col; const float r = S[rl];
                        const f32x4 x0 = acc[ai][bj][m][0] * g0 * r, x1 = acc[ai][bj][m][1] * g1 * r;
                        u32x4 w; w.x = pk2(x0[0], x0[1]); w.y = pk2(x0[2], x0[3]); w.z = pk2(x1[0], x1[1]); w.w = pk2(x1[2], x1[3]); *(u32x4*)(XN + off) = w;
                    }
            }
        }
    }
};
template <class EpiT, class Sched, bool ALIGN_EPI = false, bool SP2 = false>
__device__ __forceinline__ void gemm_phase(LAS unsigned char* lds, const Gemm g, const Sched& S, const EpiT& E, int wv) {
    int tid_ = TIDW(wv); asm volatile("" : "+v"(tid_));
    const int tid = tid_, wid = __builtin_amdgcn_readfirstlane(tid >> 6), lane = tid & 63, wr = wid >> 2, wc = wid & 3, fr = lane & 15, fq = lane >> 4;
    const int K = g.K, nt = K / BK;
    unsigned voffA[2], voffB[2];
#pragma unroll
    for (int i = 0; i < 2; ++i) { int R, C; stage_rc(tid * 16 + i * 8192, R, C); const int Rb = EpiT::PERM ? ((R & ~31) + perm32(R & 31)) : R;
        voffA[i] = (unsigned)(R * K + C) * 2u; voffB[i] = (unsigned)(Rb * K + C) * 2u; }
    const size_t kstep = (size_t)(BK * 2);
    const size_t hstep = (size_t)HALF * K * 2;
    const size_t tstep = 2 * hstep;
    const unsigned ldsw = (unsigned)wid * 1024u;
    const int aoff = lds_byte(wr * 64 + fr, fq * 8), boff = lds_byte(wc * 32 + fr, fq * 8);
#define PG8_SA(b, h) (((b) * 2 + (h)) * HTB)
#define PG8_SB(b, h) ((4 + (b) * 2 + (h)) * HTB)
#define PG8_STAGE(bufoff, gbase, voff) do { _Pragma("unroll") for (int _i = 0; _i < 2; ++_i) \
        __builtin_amdgcn_global_load_lds((const unsigned*)((const char*)(gbase) + (voff)[_i]), (LAS unsigned*)(lds + (bufoff) + ldsw + _i * 8192), 16, 0, 0); } while (0)
#define PG8_LDA(dst, b, h) do { _Pragma("unroll") for (int m = 0; m < 4; ++m) _Pragma("unroll") for (int k = 0; k < 2; ++k) dst[m][k] = *(const LAS bf16x8*)(lds + PG8_SA(b, h) + aoff + m * 2048 + k * 1024); } while (0)
#define PG8_LDB(dst, b, h) do { _Pragma("unroll") for (int n = 0; n < 2; ++n) _Pragma("unroll") for (int k = 0; k < 2; ++k) dst[n][k] = *(const LAS bf16x8*)(lds + PG8_SB(b, h) + boff + n * 2048 + k * 1024); } while (0)
#define PG8_MMA(ai, bj, At, Bt) do { __builtin_amdgcn_s_setprio(1); _Pragma("unroll") for (int m = 0; m < 4; ++m) _Pragma("unroll") for (int n = 0; n < 2; ++n) _Pragma("unroll") for (int k = 0; k < 2; ++k) \
        acc[ai][bj][m][n] = __builtin_amdgcn_mfma_f32_16x16x32_bf16(Bt[n][k], At[m][k], acc[ai][bj][m][n], 0, 0, 0); __builtin_amdgcn_s_setprio(0); } while (0)
#define PG8_WAIT_V(n) asm volatile("s_waitcnt vmcnt(" #n ")" ::: "memory")
#define PG8_WAIT_L(n) asm volatile("s_waitcnt lgkmcnt(" #n ")" ::: "memory")
#define PG8_BAR __builtin_amdgcn_s_barrier()
#define PG8_SCHED __builtin_amdgcn_sched_barrier(0)
    Unit cur, nxt; int ui = 0;
    if (!S.next(0, cur)) return;
    f32x4 acc[2][2][4][2];
#pragma unroll
    for (int a = 0; a < 2; ++a)
#pragma unroll
        for (int b = 0; b < 2; ++b)
#pragma unroll
            for (int m = 0; m < 4; ++m)
#pragma unroll
                for (int n = 0; n < 2; ++n) acc[a][b][m][n] = (f32x4){0.f, 0.f, 0.f, 0.f};
    bf16x8 At[4][2], B0[2][2], B1[2][2];
    const char* cA = (const char*)g.A + (size_t)cur.pm * tstep; const char* cB = (const char*)g.Bt + (size_t)cur.pn * tstep;
    S.a_ready(cur);
    if constexpr (SP2) {
        PG8_STAGE(PG8_SB(0, 0), cB, voffB); PG8_STAGE(PG8_SB(0, 1), cB + hstep, voffB); PG8_STAGE(PG8_SA(0, 0), cA, voffA); PG8_STAGE(PG8_SA(0, 1), cA + hstep, voffA);
        if (wr == 1) PG8_BAR;
        PG8_WAIT_V(2); PG8_BAR;
        PG8_STAGE(PG8_SB(1, 0), cB + kstep, voffB); PG8_STAGE(PG8_SA(1, 0), cA + kstep, voffA); PG8_STAGE(PG8_SB(1, 1), cB + hstep + kstep, voffB);
        PG8_WAIT_V(6); PG8_BAR;
    } else {
        PG8_STAGE(PG8_SB(0, 0), cB, voffB); PG8_STAGE(PG8_SA(0, 0), cA, voffA); PG8_STAGE(PG8_SB(0, 1), cB + hstep, voffB); PG8_STAGE(PG8_SA(0, 1), cA + hstep, voffA);
        if (wr == 1) PG8_BAR;
        PG8_WAIT_V(4); PG8_BAR;
        PG8_STAGE(PG8_SB(1, 0), cB + kstep, voffB); PG8_STAGE(PG8_SA(1, 0), cA + kstep, voffA); PG8_STAGE(PG8_SB(1, 1), cB + hstep + kstep, voffB);
        PG8_WAIT_V(6); PG8_BAR;
    }
    for (;;) {
        const bool has_next = S.next(ui + 1, nxt);
        const char* nA = has_next ? (const char*)g.A + (size_t)nxt.pm * tstep : cA; const char* nB = has_next ? (const char*)g.Bt + (size_t)nxt.pn * tstep : cB;
        for (int t = 0; t < nt; t += 2) {
            const bool last = (t == nt - 2);
            const char* a1 = cA + (size_t)(t + 1) * kstep;
            const char* a2 = last ? nA : cA + (size_t)(t + 2) * kstep; const char* b2 = last ? nB : cB + (size_t)(t + 2) * kstep;
            const char* a3 = a2 + kstep; const char* b3 = b2 + kstep;
            if (last && has_next) S.a_ready(nxt);
            if constexpr (SP2) {
            PG8_LDB(B0, 0, 0); PG8_LDB(B1, 0, 1); PG8_SCHED; PG8_LDA(At, 0, 0); PG8_STAGE(PG8_SA(1, 1), a1 + hstep, voffA);
            PG8_WAIT_V(8); PG8_WAIT_L(0); PG8_BAR; PG8_MMA(0, 0, At, B0); PG8_MMA(0, 1, At, B1); PG8_BAR; PG8_SCHED;
            PG8_LDA(At, 0, 1); PG8_STAGE(PG8_SB(0, 0), b2, voffB); PG8_STAGE(PG8_SB(0, 1), b2 + hstep, voffB); PG8_STAGE(PG8_SA(0, 0), a2, voffA);
            PG8_WAIT_V(8); PG8_WAIT_L(0); PG8_BAR; PG8_MMA(1, 0, At, B0); PG8_MMA(1, 1, At, B1); PG8_BAR; PG8_SCHED;
            PG8_LDB(B0, 1, 0); PG8_LDB(B1, 1, 1); PG8_SCHED; PG8_LDA(At, 1, 0); PG8_STAGE(PG8_SA(0, 1), a2 + hstep, voffA);
            PG8_WAIT_V(8); PG8_WAIT_L(0); PG8_BAR; PG8_MMA(0, 0, At, B0); PG8_MMA(0, 1, At, B1); PG8_BAR; PG8_SCHED;
            PG8_LDA(At, 1, 1); PG8_STAGE(PG8_SB(1, 0), b3, voffB); PG8_STAGE(PG8_SB(1, 1), b3 + hstep, voffB); PG8_STAGE(PG8_SA(1, 0), a3, voffA);
            PG8_WAIT_V(8); PG8_WAIT_L(0); PG8_BAR; PG8_MMA(1, 0, At, B0); PG8_MMA(1, 1, At, B1); PG8_BAR; PG8_SCHED;
            } else {
            PG8_LDB(B0, 0, 0); PG8_SCHED; PG8_LDA(At, 0, 0); PG8_STAGE(PG8_SA(1, 1), a1 + hstep, voffA);
            PG8_WAIT_L(8); PG8_BAR; PG8_WAIT_L(0); PG8_MMA(0, 0, At, B0); PG8_BAR; PG8_SCHED;
            PG8_LDB(B1, 0, 1); PG8_STAGE(PG8_SB(0, 0), b2, voffB);
            PG8_BAR; PG8_WAIT_L(0); PG8_MMA(0, 1, At, B1); PG8_BAR;
            PG8_LDA(At, 0, 1); PG8_STAGE(PG8_SA(0, 0), a2, voffA);
            PG8_BAR; PG8_WAIT_L(0); PG8_MMA(1, 0, At, B0); PG8_BAR; PG8_SCHED;
            PG8_STAGE(PG8_SB(0, 1), b2 + hstep, voffB);
            PG8_WAIT_V(6); PG8_BAR; PG8_MMA(1, 1, At, B1); PG8_BAR;
            PG8_LDB(B0, 1, 0); PG8_SCHED; PG8_LDA(At, 1, 0); PG8_STAGE(PG8_SA(0, 1), a2 + hstep, voffA);
            PG8_WAIT_L(8); PG8_BAR; PG8_WAIT_L(0); PG8_MMA(0, 0, At, B0); PG8_BAR; PG8_SCHED;
            PG8_LDB(B1, 1, 1); PG8_STAGE(PG8_SB(1, 0), b3, voffB);
            PG8_BAR; PG8_WAIT_L(0); PG8_MMA(0, 1, At, B1); PG8_BAR;
            PG8_LDA(At, 1, 1); PG8_STAGE(PG8_SA(1, 0), a3, voffA);
            PG8_BAR; PG8_WAIT_L(0); PG8_MMA(1, 0, At, B0); PG8_BAR; PG8_SCHED;
            PG8_STAGE(PG8_SB(1, 1), b3 + hstep, voffB);
            PG8_WAIT_V(6); PG8_BAR; PG8_MMA(1, 1, At, B1); PG8_BAR;
            }
        }
        if constexpr (ALIGN_EPI) { if (wr == 0) PG8_BAR; }
        if constexpr (!EpiT::AFTER_DRAIN) { E(acc, cur, wr, wc, fr, fq); S.done(cur); }
        if (!has_next) break;
#pragma unroll
        for (int a = 0; a < 2; ++a)
#pragma unroll
            for (int b = 0; b < 2; ++b)
#pragma unroll
                for (int m = 0; m < 4; ++m)
#pragma unroll
                    for (int n = 0; n < 2; ++n) acc[a][b][m][n] = (f32x4){0.f, 0.f, 0.f, 0.f};
        cur = nxt; cA = nA; cB = nB; ++ui;
        if constexpr (ALIGN_EPI) { if (wr == 1) PG8_BAR; }
    }
    PG8_WAIT_V(0);
    if constexpr (!ALIGN_EPI) { if (wr == 0) PG8_BAR; }
    PG8_BAR;
    if constexpr (EpiT::AFTER_DRAIN) E.fused(acc, cur, wr, wc, fr, fq, lds, wid, lane);
#undef PG8_SA
#undef PG8_SB
#undef PG8_STAGE
#undef PG8_LDA
#undef PG8_LDB
#undef PG8_MMA
#undef PG8_WAIT_V
#undef PG8_WAIT_L
#undef PG8_BAR
#undef PG8_SCHED
}
}

template <int MODE, int K> __device__ __forceinline__ void sgemm_sample(LAS unsigned char* lds, const bf16* A, const bf16* Bt, int N, bf16* O, int ldc, const bf16* aux, int ldaux, const bf16* add, int ldadd, int vcu, int G, int wv,
                                                                 unsigned* sig = nullptr) {
    int tid = TIDW(wv); asm volatile("" : "+v"(tid));
    const int lane = tid & 63, wave = __builtin_amdgcn_readfirstlane(tid >> 6), l15 = lane & 15, g4 = lane >> 4, tsel = wave & 1, kq = wave >> 1;
    constexpr int kn = K >> 2, KQ = kn / 32;
    const int npair = N >> 5, nitem = 8 * npair;
    LAS f32x4* red = (LAS f32x4*)lds;
    for (int item = vcu; item < nitem; item += G) {
        const int tr = item / npair, ct = 2 * (item - tr * npair) + tsel;
        const int row = MP + tr * 16 + l15;
        const bf16* ap = A + (size_t)row * K + kq * kn + 8 * g4;
        const bf16* bp = Bt + (size_t)(ct * 16 + l15) * K + kq * kn + 8 * g4;
        f32x4 acc = {0.f, 0.f, 0.f, 0.f};
        bf16x8 av[KQ], bv[KQ];
#pragma unroll
        for (int k = 0; k < KQ; ++k) { av[k] = *(const bf16x8*)(ap + 32 * k); bv[k] = *(const bf16x8*)(bp + 32 * k); }
        u32x2 zz = {0u, 0u}, yy = {0u, 0u};
        if constexpr (MODE == pg8::EM_MULZ || MODE == pg8::EM_FMAZ || MODE == pg8::EM_SIGMUL) { if (kq == 0) zz = *(const u32x2*)(aux + (size_t)row * ldaux + ct * 16 + 4 * g4); }
        if constexpr (MODE == pg8::EM_FMAZ) { if (kq == 0) yy = *(const u32x2*)(add + (size_t)row * ldadd + ct * 16 + 4 * g4); }
#pragma unroll
        for (int k = 0; k < KQ; ++k) acc = __builtin_amdgcn_mfma_f32_16x16x32_bf16(bv[k], av[k], acc, 0, 0, 0);
        __syncthreads();
        if (kq > 0) red[(tsel * 3 + (kq - 1)) * 64 + lane] = acc;
        __syncthreads();
        if (kq == 0) {
            acc = acc + red[(tsel * 3 + 0) * 64 + lane] + red[(tsel * 3 + 1) * 64 + lane] + red[(tsel * 3 + 2) * 64 + lane];
            const int col = ct * 16 + 4 * g4;
            f32x4 v = acc;
            if constexpr (MODE == pg8::EM_MULZ || MODE == pg8::EM_FMAZ || MODE == pg8::EM_SIGMUL) {
                const f32x4 zf = {bflo(zz.x), bfhi(zz.x), bflo(zz.y), bfhi(zz.y)};
                if constexpr (MODE == pg8::EM_SIGMUL) { for (int j = 0; j < 4; ++j) v[j] = sigmoid_f(v[j]); }
                v = v * zf;
                if constexpr (MODE == pg8::EM_FMAZ) { v += (f32x4){bflo(yy.x), bfhi(yy.x), bflo(yy.y), bfhi(yy.y)}; }
            }
            u32x2 w; w.x = pk2(v[0], v[1]); w.y = pk2(v[2], v[3]);
            if (sig) __hip_atomic_store((unsigned long long*)(O + (size_t)row * ldc + col), ((unsigned long long)w.y << 32) | w.x, __ATOMIC_RELAXED, __HIP_MEMORY_SCOPE_AGENT);
            else *(u32x2*)(O + (size_t)row * ldc + col) = w;
        }
    }
    if (sig) asm volatile("s_waitcnt vmcnt(0)" ::: "memory");
    __syncthreads();
    if (sig && wv == 0 && lane == 0) { for (int item = vcu; item < nitem; item += G) (void)__hip_atomic_fetch_add(sig + 64 * (item / npair), 1u, __ATOMIC_RELAXED, __HIP_MEMORY_SCOPE_AGENT); }
}

constexpr int RING_OFF = 0, RING_BYTES = 131072;
constexpr int LDSCTL_OFF = RING_BYTES, MISC_OFF = LDSCTL_OFF + 320;
constexpr int LDS_BYTES = 147456;
constexpr int NWAVES = 8;

#define XB_TMO      128
#define XB_XCNT(j)  (256  + 64 * (j))
#define XB_XSUB(j)  (1280 + 64 * (j))
#define XB_XGEN(j)  (2304 + 64 * (j))
#define XB_TOP      3328
#define XB_TOPGEN   3392
#define XCD_BAR_WORDS 3456
#define XB_SPIN_CAP (1u << 18)
__device__ __forceinline__ unsigned xb_ld(unsigned* p)              { return __hip_atomic_load(p, __ATOMIC_RELAXED, __HIP_MEMORY_SCOPE_AGENT); }
__device__ __forceinline__ unsigned xb_add(unsigned* p, unsigned v) { return __hip_atomic_fetch_add(p, v, __ATOMIC_RELAXED, __HIP_MEMORY_SCOPE_AGENT); }
__device__ __forceinline__ unsigned xb_xcc_id() { return (unsigned)__builtin_amdgcn_s_getreg((3 << 11) | 20) & 0xFu; }
#define XB_SPIN(cond, bar) do { unsigned _sp = 0; while (cond) { __builtin_amdgcn_s_sleep(1); \
    if ((++_sp & 255u) == 0u) { if (xb_ld(&(bar)[XB_TMO])) break; if (_sp > XB_SPIN_CAP) { atomicAdd(&(bar)[XB_TMO], 1u); break; } } } } while (0)
struct XcdBarrier { unsigned* bar; unsigned x; volatile LAS unsigned* st; bool t0; };
__device__ __forceinline__ XcdBarrier xcd_barrier_post(unsigned* bar, volatile LAS unsigned* st) {
    XcdBarrier b; b.bar = bar; b.x = xb_xcc_id(); b.st = st;
    if (threadIdx.x == 0) (void)xb_add(&bar[XB_XCNT(b.x)], 1u);
    return b;
}
__device__ __forceinline__ void xcd_barrier_complete(unsigned* bar, unsigned x, unsigned& nloc, unsigned& nx) {
    const unsigned G = gridDim.x * gridDim.y * gridDim.z;
    unsigned sum, cnt, mine, sp = 0u;
    for (;;) {
        sum = 0u; cnt = 0u; mine = 0u;
#pragma unroll
        for (unsigned j = 0; j < 16; ++j) { const unsigned c = xb_ld(&bar[XB_XCNT(j)]); sum += c; cnt += (c > 0u) ? 1u : 0u; mine = (j == x) ? c : mine; }
        if (sum == G) break;
        __builtin_amdgcn_s_sleep(1);
        if ((++sp & 255u) == 0u) { if (xb_ld(&bar[XB_TMO])) break; if (sp > XB_SPIN_CAP) { atomicAdd(&bar[XB_TMO], 1u); break; } }
    }
    nloc = mine > 0u ? mine : 1u; nx = cnt > 0u ? cnt : 1u;
}
__device__ __forceinline__ void xcd_barrier(const XcdBarrier& b) {
    asm volatile("s_waitcnt vmcnt(0)" ::: "memory");
    __syncthreads();
    if (b.t0) {
        unsigned* bar = b.bar;
        __builtin_amdgcn_s_waitcnt(0);
        unsigned nloc = b.st[0], nx = b.st[1];
        if (nloc == 0u) { xcd_barrier_complete(bar, b.x, nloc, nx); b.st[0] = nloc; b.st[1] = nx; }
        const unsigned old = xb_add(&bar[XB_XSUB(b.x)], 1u);
        const unsigned gen = old / nloc;
        if (old + 1u == (gen + 1u) * nloc) {
            __builtin_amdgcn_fence(__ATOMIC_RELEASE, "agent");
            asm volatile("s_waitcnt vmcnt(0)" ::: "memory");
            const unsigned og = xb_add(&bar[XB_TOP], 1u);
            const unsigned tg = og / nx;
            if (og + 1u == (tg + 1u) * nx) xb_add(&bar[XB_TOPGEN], 1u);
            else XB_SPIN(xb_ld(&bar[XB_TOPGEN]) == tg, bar);
            __builtin_amdgcn_fence(__ATOMIC_ACQUIRE, "agent");
            xb_add(&bar[XB_XGEN(b.x)], 1u);
            asm volatile("s_waitcnt vmcnt(0)" ::: "memory");
        } else {
            XB_SPIN(xb_ld(&bar[XB_XGEN(b.x)]) == gen, bar);
            __builtin_amdgcn_fence(__ATOMIC_ACQUIRE, "agent");
            asm volatile("s_waitcnt vmcnt(0)" ::: "memory");
        }
    }
    __syncthreads();
}
__device__ __forceinline__ void xcd_barrier_arrive(const XcdBarrier& b) {
    asm volatile("s_waitcnt vmcnt(0)" ::: "memory");
    __syncthreads();
    if (b.t0) {
        unsigned* bar = b.bar;
        __builtin_amdgcn_s_waitcnt(0);
        unsigned nloc = b.st[0], nx = b.st[1];
        if (nloc == 0u) { xcd_barrier_complete(bar, b.x, nloc, nx); b.st[0] = nloc; b.st[1] = nx; }
        const unsigned old = xb_add(&bar[XB_XSUB(b.x)], 1u);
        const unsigned gen = old / nloc;
        if (old + 1u == (gen + 1u) * nloc) {
            __builtin_amdgcn_fence(__ATOMIC_RELEASE, "agent");
            asm volatile("s_waitcnt vmcnt(0)" ::: "memory");
            const unsigned og = xb_add(&bar[XB_TOP], 1u);
            const unsigned tg = og / nx;
            if (og + 1u == (tg + 1u) * nx) xb_add(&bar[XB_TOPGEN], 1u);
            else XB_SPIN(xb_ld(&bar[XB_TOPGEN]) == tg, bar);
            __builtin_amdgcn_fence(__ATOMIC_ACQUIRE, "agent");
            xb_add(&bar[XB_XGEN(b.x)], 1u);
            asm volatile("s_waitcnt vmcnt(0)" ::: "memory");
            b.st[3] = 1u;
        } else { b.st[2] = gen; b.st[3] = 0u; }
    }
    __syncthreads();
}
__device__ __forceinline__ void xcd_barrier_finish(const XcdBarrier& b) {
    if (b.t0) {
        if (b.st[3] == 0u) { const unsigned gen = b.st[2]; XB_SPIN(xb_ld(&b.bar[XB_XGEN(b.x)]) == gen, b.bar); __builtin_amdgcn_fence(__ATOMIC_ACQUIRE, "agent"); asm volatile("s_waitcnt vmcnt(0)" ::: "memory"); }
    }
    __syncthreads();
}

struct Args { const void* in[N_PTR]; int ph_lo, ph_hi, li, pad; };

template <int MAP> __device__ __forceinline__ int rowmap(int n, int row_off) {
    if constexpr (MAP == 1) return (n >> 7) * 256 + (n & 127);
    else if constexpr (MAP == 2) return (n >> 7) * 256 + 128 + (n & 127);
    else if constexpr (MAP == 3) return n < 3232 ? n : n + 96;
    else if constexpr (MAP == 4) { const int d = n & 31; return row_off + (n & ~31) + 8 * ((d >> 2) & 3) + 4 * (d >> 4) + (d & 3); }
    else return row_off + n;
}
template <int MAP> __device__ __forceinline__ void transpose_item(const float* W, int K, int N, bf16* WT, int row_off, LAS float* scr, int item, int lane, float wscale = 1.f) {
    const int nblk = N / 32, kb = item / nblk, nb = item % nblk, k0 = 64 * kb, n0 = 32 * nb;
#pragma unroll 8
    for (int i = 0; i < 32; ++i) { const int kk = 2 * i + (lane >> 5); scr[kk * 33 + (lane & 31)] = W[(size_t)(k0 + kk) * N + n0 + (lane & 31)] * wscale; }
    LDS_WAIT(); asm volatile("" ::: "memory");
    const int c = lane & 7;
#pragma unroll
    for (int j = 0; j < 4; ++j) { const int n = (lane >> 3) + 8 * j; const LAS float* s = scr + (8 * c) * 33 + n;
        u32x4 o; o.x = pk2(s[0 * 33], s[1 * 33]); o.y = pk2(s[2 * 33], s[3 * 33]); o.z = pk2(s[4 * 33], s[5 * 33]); o.w = pk2(s[6 * 33], s[7 * 33]);
        *(u32x4*)(WT + (size_t)rowmap<MAP>(n0 + n, row_off) * K + k0 + 8 * c) = o; }
    LDS_WAIT(); asm volatile("" ::: "memory");
}
__device__ __forceinline__ const float* xrow_ptr(const Args& a, int m, int z) {
    if (m < MP) return (const float*)a.in[I_XP + z] + (size_t)m * DM;
    if (m < MP + NS) return (const float*)a.in[I_XS + z] + (size_t)(m - MP) * DM;
    return nullptr;
}
__device__ __forceinline__ void rms_row_to_bf16(const float* xrow, const float* gain, bf16* orow, int lane) {
    f32x4 v[4]; float s = 0.f;
#pragma unroll
    for (int j = 0; j < 4; ++j) { v[j] = xrow ? ((const f32x4*)xrow)[lane + 64 * j] : (f32x4){0.f, 0.f, 0.f, 0.f}; s += (v[j].x * v[j].x + v[j].y * v[j].y) + (v[j].z * v[j].z + v[j].w * v[j].w); }
    const float rstd = 1.f / sqrtf(wave_sum(s) * (1.f / DM) + EPS);
#pragma unroll
    for (int j = 0; j < 4; ++j) { const f32x4 g = ((const f32x4*)gain)[lane + 64 * j];
        u32x2 o; o.x = pk2(v[j].x * rstd * g.x, v[j].y * rstd * g.y); o.y = pk2(v[j].z * rstd * g.z, v[j].w * rstd * g.w);
        ((u32x2*)orow)[lane + 64 * j] = o; }
}
constexpr int CVI_UP = 16 * 88, CVI_DN = 44 * 32, CVI_IN = 16 * 165, CVI_RNN = 20 * 32, CVI_UQ = 6 * 32, CVI_QR = 6 * 16, CVI_UK = 4 * 32, CVI_SQ = 16 * 32, CVI_PPJ = 4 * 32;
constexpr int CV_A = 2 * CVI_UP, CV_B = CV_A + CVI_DN + CVI_IN, CV_N = CV_B + 2 * CVI_UP + CVI_DN + CVI_RNN + CVI_UQ + CVI_QR + 2 * CVI_UK + 3 * CVI_SQ + CVI_PPJ;
__device__ __forceinline__ void convert_item(const Args& a, int z, unsigned char* ws, LAS float* scr, int it, int lane) {
    int r = it;
    if (r < CVI_UP) { transpose_item<1>((const float*)a.in[I_F1G + z], DM, DFF, (bf16*)(ws + WS_BUP1), 0, scr, r, lane); return; } r -= CVI_UP;
    if (r < CVI_UP) { transpose_item<2>((const float*)a.in[I_F1U + z], DM, DFF, (bf16*)(ws + WS_BUP1), 0, scr, r, lane); return; } r -= CVI_UP;
    if (r < CVI_DN) { transpose_item<0>((const float*)a.in[I_F1D + z], DFF, DM, (bf16*)(ws + WS_BDN1), 0, scr, r, lane); return; } r -= CVI_DN;
    if (r < CVI_IN) { transpose_item<3>((const float*)a.in[I_WIN + z], DM, DIN, (bf16*)(ws + WS_BIN), 0, scr, r, lane); return; } r -= CVI_IN;
    if (r < CVI_UP) { transpose_item<1>((const float*)a.in[I_F2G + z], DM, DFF, (bf16*)(ws + WS_BUP2), 0, scr, r, lane); return; } r -= CVI_UP;
    if (r < CVI_UP) { transpose_item<2>((const float*)a.in[I_F2U + z], DM, DFF, (bf16*)(ws + WS_BUP2), 0, scr, r, lane); return; } r -= CVI_UP;
    if (r < CVI_DN) { transpose_item<0>((const float*)a.in[I_F2D + z], DFF, DM, (bf16*)(ws + WS_BDN2), 0, scr, r, lane); return; } r -= CVI_DN;
    if (r < CVI_RNN) { transpose_item<0>((const float*)a.in[I_WRNN + z], DRNN, DM, (bf16*)(ws + WS_BRNN), 0, scr, r, lane); return; } r -= CVI_RNN;
    if (r < CVI_UQ) { transpose_item<0>((const float*)a.in[I_WUQ + z], QL, 1024, (bf16*)(ws + WS_BQ), 0, scr, r, lane, C2); return; } r -= CVI_UQ;
    if (r < CVI_QR) { transpose_item<0>((const float*)a.in[I_WQR + z], QL, 512, (bf16*)(ws + WS_BQ), 1024, scr, r, lane, C2); return; } r -= CVI_QR;
    if (r < CVI_UK) { transpose_item<0>((const float*)a.in[I_WUK + z], KVL, 1024, (bf16*)(ws + WS_BKV), 0, scr, r, lane); return; } r -= CVI_UK;
    if (r < CVI_UK) { transpose_item<0>((const float*)a.in[I_WUV + z], KVL, 1024, (bf16*)(ws + WS_BKV), 1024, scr, r, lane); return; } r -= CVI_UK;
    if (r < CVI_SQ) { transpose_item<0>((const float*)a.in[I_WATT + z], DM, DM, (bf16*)(ws + WS_BATT), 0, scr, r, lane); return; } r -= CVI_SQ;
    if (r < CVI_SQ) { transpose_item<0>((const float*)a.in[I_WOUT + z], DM, DM, (bf16*)(ws + WS_BOUT), 0, scr, r, lane); return; } r -= CVI_SQ;
    if (r < CVI_SQ) { transpose_item<0>((const float*)a.in[I_PG + z], DM, DM, (bf16*)(ws + WS_BPG), 0, scr, r, lane); return; } r -= CVI_SQ;
    transpose_item<0>((const float*)a.in[I_PPJ + z], DPLE, DM, (bf16*)(ws + WS_BPP), 0, scr, r, lane);
}
__device__ __forceinline__ void convert_range(const Args& a, LAS unsigned char* lds, int lo, int hi, int w, int nw, int wv) {
    int z = 0; asm volatile("" : "+s"(z));
    int tid = TIDW(wv); asm volatile("" : "+v"(tid)); const int lane = tid & 63, wave = wv;
    unsigned char* ws = (unsigned char*)a.in[I_WS + z];
    LAS float* scr = (LAS float*)(lds + RING_OFF + wave * 16384);
    for (int it = lo + w; it < hi; it += nw) convert_item(a, z, ws, scr, it, lane);
}
__device__ __forceinline__ void convert_in_tail(const Args& a, LAS unsigned char* lds, int nwg, int G, int c, int lo, int hi, int wv) {
    const int full = (nwg + G - 1) / G, nl = full * G - nwg;
    const int wave = wv;
    if (nl == 0) { convert_range(a, lds, lo, hi, c * NWAVES + wave, G * NWAVES, wv); return; }
    if (c >= G - nl) convert_range(a, lds, lo, hi, (c - (G - nl)) * NWAVES + wave, nl * NWAVES, wv);
}
__device__ __forceinline__ void p0_prologue(const Args& a, LAS unsigned char* lds, int vcu, int G, int tid, int lane, int wave) {
    int z = 0; asm volatile("" : "+s"(z));
    unsigned char* ws = (unsigned char*)a.in[I_WS + z];
    const int gw = vcu * NWAVES + wave, NGW = G * NWAVES;
    convert_range(a, lds, 0, CV_A, gw, NGW, wave);
    const int gt = vcu * 512 + tid, NGT = G * 512;
    for (int i = gt; i < 12288; i += NGT) ((u32x4*)(ws + WS_BIN + (size_t)3232 * DM * 2))[i] = (u32x4){0u, 0u, 0u, 0u};
    for (int i = gt; i < NBLK * 160 * 104; i += NGT) {
        const int n = i / (160 * 104), r = i - n * (160 * 104), j = r / 104, k = r - j * 104;
        float v = 0.f;
        if (k < 80) v = j < 80 ? ((const float*)a.in[I_LWA + z])[(n * 80 + k) * 80 + j] : ((const float*)a.in[I_LWI + z])[(n * 80 + k) * 80 + (j - 80)];
        ((bf16*)(ws + WS_LW))[i] = f2bf(v);
    }
    for (int i = gt; i < ROPE_TAB; i += NGT) {
        const int pos = i >> 4, k = i & 15;
        const double freq = exp2(-(double)k * (13.287712379549449 / 16.0));
        double rev = (double)pos * freq * 0.15915494309189535;
        rev -= floor(rev);
        const float rf = (float)rev;
        ((float*)(ws + WS_ROPE))[i] = __builtin_amdgcn_cosf(rf);
        ((float*)(ws + WS_ROPE))[ROPE_TAB + i] = __builtin_amdgcn_sinf(rf);
    }
    for (int m0 = gw; m0 < MT; m0 += 2 * NGW)
#pragma unroll
    for (int qq = 0; qq < 2; ++qq) { const int m = m0 + qq * NGW; if (m >= MT) break;
        rms_row_to_bf16(xrow_ptr(a, m, z), (const float*)a.in[I_F1PRE + z], (bf16*)(ws + WS_XN) + (size_t)m * DM, lane);
        const float* pr = m < MP ? (const float*)a.in[I_PP + z] + (size_t)m * DPLE : (m < MP + NS ? (const float*)a.in[I_PS + z] + (size_t)(m - MP) * DPLE : nullptr);
        const f32x4 v = pr ? ((const f32x4*)pr)[lane] : (f32x4){0.f, 0.f, 0.f, 0.f};
        u32x2 o; o.x = pk2(v.x, v.y); o.y = pk2(v.z, v.w);
        ((u32x2*)((bf16*)(ws + WS_PB) + (size_t)m * DPLE))[lane] = o;
    }
}

template <int NEXT, int SRC> __device__ __forceinline__ void norm_rows(const Args& a, const bf16* Fin, float coef, int i_post, int i_pre, int first, int NGW, int end, int lane) {
    int z = 0; asm volatile("" : "+s"(z));
    unsigned char* ws = (unsigned char*)a.in[I_WS + z];
    bf16* XR = (bf16*)(ws + WS_XR); bf16* XN = (bf16*)(ws + WS_XN);
    const float* post = (const float*)a.in[i_post + z]; const float* pre = (const float*)a.in[i_pre + z];
    for (int m0 = first; m0 < end; m0 += 2 * NGW) {
        f32x4 f[2][4], x[2][4]; float s[2] = {0.f, 0.f};
#pragma unroll
        for (int q = 0; q < 2; ++q) { const int m = m0 + q * NGW; const bool ok = m < end; const int mm = ok ? m : m0;
            const float* xr = SRC == 0 ? xrow_ptr(a, mm, z) : nullptr;
            const bf16* xb = (SRC == 1 ? XR : XN) + (size_t)mm * DM;
#pragma unroll
            for (int j = 0; j < 4; ++j) {
                const u32x2 w = ((const u32x2*)(Fin + (size_t)mm * DM))[lane + 64 * j];
                f[q][j] = (f32x4){bflo(w.x), bfhi(w.x), bflo(w.y), bfhi(w.y)};
                if constexpr (SRC == 0) x[q][j] = ((const f32x4*)xr)[lane + 64 * j];
                else { const u32x2 xw = ((const u32x2*)xb)[lane + 64 * j]; x[q][j] = (f32x4){bflo(xw.x), bfhi(xw.x), bflo(xw.y), bfhi(xw.y)}; }
                s[q] += (f[q][j].x * f[q][j].x + f[q][j].y * f[q][j].y) + (f[q][j].z * f[q][j].z + f[q][j].w * f[q][j].w);
            } }
#pragma unroll
        for (int q = 0; q < 2; ++q) { const int m = m0 + q * NGW; if (m >= end) break;
            const float rstd = coef / sqrtf(wave_sum(s[q]) * (1.f / DM) + EPS);
            float s2 = 0.f;
#pragma unroll
            for (int j = 0; j < 4; ++j) { const f32x4 g = ((const f32x4*)post)[lane + 64 * j]; x[q][j] = x[q][j] + f[q][j] * g * rstd; s2 += (x[q][j].x * x[q][j].x + x[q][j].y * x[q][j].y) + (x[q][j].z * x[q][j].z + x[q][j].w * x[q][j].w); }
            if constexpr (NEXT == 0) {
#pragma unroll
                for (int j = 0; j < 4; ++j) ((f32x4*)((float*)a.in[I_OUT + z] + O_Y + (size_t)m * DM))[lane + 64 * j] = x[q][j];
            } else {
                if constexpr (NEXT == 1) {
#pragma unroll
                    for (int j = 0; j < 4; ++j) { u32x2 o; o.x = pk2(x[q][j].x, x[q][j].y); o.y = pk2(x[q][j].z, x[q][j].w); ((u32x2*)(XR + (size_t)m * DM))[lane + 64 * j] = o; }
                }
                float r2 = 1.f;
                if constexpr (NEXT == 1) r2 = 1.f / sqrtf(wave_sum(s2) * (1.f / DM) + EPS);
#pragma unroll
                for (int j = 0; j < 4; ++j) {
                    f32x4 g = {1.f, 1.f, 1.f, 1.f};
                    if constexpr (NEXT == 1) g = ((const f32x4*)pre)[lane + 64 * j];
                    u32x2 o; o.x = pk2(x[q][j].x * r2 * g.x, x[q][j].y * r2 * g.y); o.y = pk2(x[q][j].z * r2 * g.z, x[q][j].w * r2 * g.w);
                    ((u32x2*)(XN + (size_t)m * DM))[lane + 64 * j] = o;
                }
            }
        }
    }
}
template <int NEXT, int SRC> __device__ __forceinline__ void sample_norm(const Args& a, unsigned* sig, const bf16* Fin, float coef, int i_post, int i_pre, int G, int vcu, int wv) {
    constexpr int npair = DM >> 5, nitem = 8 * npair;
    const int lane = lane_id();
    for (int item = vcu; item < nitem; item += G) {
        if (item % npair != 0) continue;
        const int tr = item / npair;
        if (wv == 0) { unsigned sp = 0u; while ((unsigned)__builtin_amdgcn_readfirstlane(__hip_atomic_load(sig + 64 * tr, __ATOMIC_RELAXED, __HIP_MEMORY_SCOPE_AGENT)) < (unsigned)npair) { __builtin_amdgcn_s_sleep(1); if (++sp > (1u << 20)) break; }
                       __builtin_amdgcn_fence(__ATOMIC_ACQUIRE, "agent"); asm volatile("s_waitcnt vmcnt(0)" ::: "memory"); }
        __syncthreads();
        norm_rows<NEXT, SRC>(a, Fin, coef, i_post, i_pre, MP + 16 * tr + wv, NWAVES, MP + 16 * tr + 16, lane);
    }
}

__device__ __forceinline__ void mla_prep(const Args& a, int vcu, int G, int lane, int wave) {
    int z = 0; asm volatile("" : "+s"(z));
    unsigned char* ws = (unsigned char*)a.in[I_WS + z];
    const int gw = vcu * NWAVES + wave, NGW = G * NWAVES;
    const bf16* Z = (const bf16*)(ws + WS_Z);
    const float* cosT = (const float*)(ws + WS_ROPE); const float* sinT = cosT + ROPE_TAB;
    const float* qn = (const float*)a.in[I_QNORM + z]; const float* kn = (const float*)a.in[I_KVNORM + z];
    for (int m0 = gw; m0 < MT; m0 += 4 * NGW) {
        unsigned qw[4][3]; u32x2 kw4[4]; float x1[4], x2[4], cs[4], sn4[4];
#pragma unroll
        for (int qq = 0; qq < 4; ++qq) { const int m = m0 + qq * NGW, mm = m < MT ? m : m0; const bf16* zr = Z + (size_t)mm * ZW;
#pragma unroll
            for (int j = 0; j < 3; ++j) qw[qq][j] = ((const unsigned*)(zr + Z_CQ))[lane + 64 * j];
            kw4[qq] = ((const u32x2*)(zr + Z_KV))[lane];
            const int pos = mm < MP ? (mm & (SEQ - 1)) : SEQ, l16 = lane & 15;
            x1[qq] = bf2f(zr[Z_KR + l16]); x2[qq] = bf2f(zr[Z_KR + 16 + l16]); cs[qq] = cosT[pos * 16 + l16]; sn4[qq] = sinT[pos * 16 + l16]; }
#pragma unroll
        for (int qq = 0; qq < 4; ++qq) { const int m = m0 + qq * NGW; if (m >= MT) break;
            float q[6]; float s = 0.f;
#pragma unroll
            for (int j = 0; j < 3; ++j) { const unsigned w = qw[qq][j]; q[2 * j] = bflo(w); q[2 * j + 1] = bfhi(w); s += q[2 * j] * q[2 * j] + q[2 * j + 1] * q[2 * j + 1]; }
            const float rq = __builtin_amdgcn_rsqf(wave_sum(s) * (1.f / QL) + EPS);
#pragma unroll
            for (int j = 0; j < 3; ++j) { const f32x2 g = ((const f32x2*)qn)[lane + 64 * j]; ((unsigned*)((bf16*)(ws + WS_CQ) + (size_t)m * QL))[lane + 64 * j] = pk2(q[2 * j] * rq * g.x, q[2 * j + 1] * rq * g.y); }
            const u32x2 kw = kw4[qq];
            f32x4 kv = {bflo(kw.x), bfhi(kw.x), bflo(kw.y), bfhi(kw.y)};
            const float rk = __builtin_amdgcn_rsqf(wave_sum((kv.x * kv.x + kv.y * kv.y) + (kv.z * kv.z + kv.w * kv.w)) * (1.f / KVL) + EPS);
            kv = kv * rk * ((const f32x4*)kn)[lane];
            { u32x2 o; o.x = pk2(kv.x, kv.y); o.y = pk2(kv.z, kv.w); ((u32x2*)((bf16*)(ws + WS_CKV) + (size_t)m * KVL))[lane] = o; }
            if (m < MP) ((f32x4*)((float*)a.in[I_OUT + z] + O_CKV_P + (size_t)m * KVL))[lane] = kv;
            else if (m < MP + NS) ((f32x4*)((float*)a.in[I_OUT + z] + O_CKV_S + (size_t)(m - MP) * KVL))[lane] = kv;
            if (lane < 16) {
                const float o1 = x1[qq] * cs[qq] - x2[qq] * sn4[qq], o2 = x1[qq] * sn4[qq] + x2[qq] * cs[qq];
                bf16* kr = (bf16*)(ws + WS_KR) + (size_t)m * ROPE;
                kr[lane] = f2bf(o1); kr[16 + lane] = f2bf(o2);
                float* ko = m < MP ? (float*)a.in[I_OUT + z] + O_KR_P + (size_t)m * ROPE : (m < MP + NS ? (float*)a.in[I_OUT + z] + O_KR_S + (size_t)(m - MP) * ROPE : nullptr);
                if (ko) { ko[lane] = o1; ko[16 + lane] = o2; }
            }
        }
    }
    { const float* scv = (const float*)a.in[I_SCONV + z]; float* co = (float*)a.in[I_OUT + z] + O_CONV_S;
      constexpr int NIT = NS * 3 * (DRNN / 64);
      for (int it0 = gw; it0 < NIT; it0 += 4 * NGW) {
          float cv[4];
#pragma unroll
          for (int k = 0; k < 4; ++k) { const int it = it0 + k * NGW, itc = it < NIT ? it : it0; const int sq = itc / 60, r = itc - 60 * sq, j = r / 20, idx = (r - 20 * j) * 64 + lane;
              cv[k] = j < 2 ? scv[(size_t)(sq * 3 + j + 1) * DRNN + idx] : bf2f(Z[(size_t)(MP + sq) * ZW + Z_XR + idx]); }
#pragma unroll
          for (int k = 0; k < 4; ++k) { const int it = it0 + k * NGW; if (it >= NIT) break; const int sq = it / 60, r = it - 60 * sq, j = r / 20, idx = (r - 20 * j) * 64 + lane;
              co[(size_t)(sq * 3 + j) * DRNN + idx] = cv[k]; }
      } }
}


constexpr int L2_LW = 0, L2_CW = 33280, L2_TILE = 35328, L2_TPITCH = 84, L2_TBYTES = 16 * L2_TPITCH * 4, L2_WAVE = 2 * L2_TBYTES;
static_assert(L2_TILE + 8 * L2_WAVE <= RING_BYTES, "RG-LRU LDS map");
__device__ __forceinline__ float one_minus_exp(float x) {
    const float t = x * (1.f + x * (0.5f + x * (0.16666667f + x * 0.041666668f)));
    float e = 1.f - __builtin_amdgcn_exp2f(x * 1.4426950408889634f); asm volatile("" : "+v"(e));
    return x > -0.06f ? -t : e;
}
__device__ __forceinline__ void row4(float v, float (&out)[4]) {
    const unsigned u = __float_as_uint(v);
    const auto h = __builtin_amdgcn_permlane32_swap(u, u, false, false);
    const auto lo = __builtin_amdgcn_permlane16_swap(h[0], h[0], false, false);
    const auto hi = __builtin_amdgcn_permlane16_swap(h[1], h[1], false, false);
    out[0] = __uint_as_float(lo[0]); out[1] = __uint_as_float(lo[1]); out[2] = __uint_as_float(hi[0]); out[3] = __uint_as_float(hi[1]);
}
template <int PASS> __device__ __forceinline__ void lru_load(const bf16* Z, int ch0, int row0, int tib0, int l15, int g4, u32x4 (&zw)[3][5]) {
#pragma unroll
    for (int j = 0; j < 3; ++j) { const int cb = 32 * j + 8 * g4;
#pragma unroll
        for (int t = 0; t < 4; ++t) { u32x4 w = {0u, 0u, 0u, 0u}; if (tib0 + l15 + t - 3 >= 0) w = *(const u32x4*)(Z + (size_t)(row0 + l15 + t - 3) * ZW + Z_XR + ch0 + cb); zw[j][t] = w; }
        if (PASS == 2) { u32x4 w = {0u, 0u, 0u, 0u}; if (cb < 80) w = *(const u32x4*)(Z + (size_t)(row0 + l15) * ZW + Z_YR + ch0 + cb); zw[j][4] = w; }
    }
}
template <int PASS, bool SAMP> __device__ __forceinline__ void lru_tile(const Args& a, int z, unsigned char* ws, LAS unsigned char* lds, int n, int row0, int tib0, int lane, int wave,
                                                                        const float (&gba)[5], const float (&gbi)[5], const float (&gsp)[5], float (&carry)[5], float (&aprod)[5], const u32x4 (&zw)[3][5]) {
    const bf16* Z = (const bf16*)(ws + WS_Z);
    const int l15 = lane & 15, g4 = lane >> 4, ch0 = n * BLK;
    LAS float* xt = (LAS float*)(lds + L2_TILE + wave * L2_WAVE); LAS float* ht = xt + 16 * L2_TPITCH;
    const LAS float* cwl = (const LAS float*)(lds + L2_CW);
    bf16x8 af[3];
#pragma unroll
    for (int j = 0; j < 3; ++j) {
        const int cb = 32 * j + 8 * g4;
        float xc[8];
        { const f32x4 b0 = *(const LAS f32x4*)(cwl + 4 * 96 + cb), b1 = *(const LAS f32x4*)(cwl + 4 * 96 + cb + 4); xc[0] = b0.x; xc[1] = b0.y; xc[2] = b0.z; xc[3] = b0.w; xc[4] = b1.x; xc[5] = b1.y; xc[6] = b1.z; xc[7] = b1.w; }
#pragma unroll
        for (int t = 0; t < 4; ++t) {
            float xv[8];
            if (SAMP && t < 3) {
                const float* sp = (const float*)a.in[I_SCONV + z] + (size_t)((row0 - MP + l15) * 3 + t) * DRNN + ch0 + cb;
                if (cb < 80) { const f32x4 v0 = *(const f32x4*)sp, v1 = *(const f32x4*)(sp + 4); xv[0] = v0.x; xv[1] = v0.y; xv[2] = v0.z; xv[3] = v0.w; xv[4] = v1.x; xv[5] = v1.y; xv[6] = v1.z; xv[7] = v1.w; }
                else { for (int e = 0; e < 8; ++e) xv[e] = 0.f; }
            } else {
                u32x4 w;
                if constexpr (SAMP) w = *(const u32x4*)(Z + (size_t)(row0 + l15) * ZW + Z_XR + ch0 + cb); else w = zw[j][t];
                xv[0] = bflo(w.x); xv[1] = bfhi(w.x); xv[2] = bflo(w.y); xv[3] = bfhi(w.y); xv[4] = bflo(w.z); xv[5] = bfhi(w.z); xv[6] = bflo(w.w); xv[7] = bfhi(w.w);
            }
            const f32x4 w0 = *(const LAS f32x4*)(cwl + t * 96 + cb), w1 = *(const LAS f32x4*)(cwl + t * 96 + cb + 4);
            xc[0] += w0.x * xv[0]; xc[1] += w0.y * xv[1]; xc[2] += w0.z * xv[2]; xc[3] += w0.w * xv[3]; xc[4] += w1.x * xv[4]; xc[5] += w1.y * xv[5]; xc[6] += w1.z * xv[6]; xc[7] += w1.w * xv[7];
        }
        u32x4 pw; pw.x = pk2(xc[0], xc[1]); pw.y = pk2(xc[2], xc[3]); pw.z = pk2(xc[4], xc[5]); pw.w = pk2(xc[6], xc[7]);
        af[j] = __builtin_bit_cast(bf16x8, pw);
        if (cb < 80) { *(LAS f32x4*)(xt + l15 * L2_TPITCH + cb) = (f32x4){xc[0], xc[1], xc[2], xc[3]}; *(LAS f32x4*)(xt + l15 * L2_TPITCH + cb + 4) = (f32x4){xc[4], xc[5], xc[6], xc[7]}; }
    }
    LDS_WAIT();
#pragma unroll
    for (int ct = 0; ct < 5; ++ct) {
        f32x4 ar = {0.f, 0.f, 0.f, 0.f}, ai = {0.f, 0.f, 0.f, 0.f};
#pragma unroll
        for (int j = 0; j < 3; ++j) {
            const bf16x8 br = *(const LAS bf16x8*)(lds + L2_LW + (ct * 16 + l15) * 208 + (32 * j + 8 * g4) * 2);
            const bf16x8 bi = *(const LAS bf16x8*)(lds + L2_LW + (80 + ct * 16 + l15) * 208 + (32 * j + 8 * g4) * 2);
            ar = __builtin_amdgcn_mfma_f32_16x16x32_bf16(af[j], br, ar, 0, 0, 0);
            ai = __builtin_amdgcn_mfma_f32_16x16x32_bf16(af[j], bi, ai, 0, 0, 0);
        }
        const int ch = ct * 16 + l15;
        float av[4], bv[4];
#pragma unroll
        for (int i = 0; i < 4; ++i) {
            const float r = sigmoid_f(ar[i] + gba[ct]), gi = sigmoid_f(ai[i] + gbi[ct]);
            const float la = -8.f * r * gsp[ct];
            av[i] = __builtin_amdgcn_exp2f(la * 1.4426950408889634f);
            bv[i] = __builtin_amdgcn_sqrtf((1.f - av[i]) * (1.f + av[i])) * gi * xt[(4 * g4 + i) * L2_TPITCH + ch];
        }
        float hv[4];
        if constexpr (SAMP) {
            const float* sh = (const float*)a.in[I_SH + z];
#pragma unroll
            for (int i = 0; i < 4; ++i) { const int s = row0 - MP + 4 * g4 + i; hv[i] = av[i] * sh[(size_t)s * DRNN + ch0 + ch] + bv[i]; ((float*)a.in[I_OUT + z])[O_H_S + (size_t)s * DRNN + ch0 + ch] = hv[i]; }
        } else {
            float q[4]; float hl = 0.f, qq = 1.f;
#pragma unroll
            for (int i = 0; i < 4; ++i) { hl = av[i] * hl + bv[i]; qq *= av[i]; hv[i] = hl; q[i] = qq; }
            float cin = carry[ct], call = carry[ct], pall = 1.f;
            float Pq[4], Hq[4];
            row4(qq, Pq); row4(hl, Hq);
#pragma unroll
            for (int gq = 0; gq < 4; ++gq) { const float Pg = Pq[gq], Hg = Hq[gq];
                if (gq < g4) cin = Pg * cin + Hg;
                call = Pg * call + Hg; pall *= Pg; }
#pragma unroll
            for (int i = 0; i < 4; ++i) hv[i] += q[i] * cin;
            carry[ct] = call; aprod[ct] *= pall;
        }
        if constexpr (PASS == 2) {
#pragma unroll
            for (int i = 0; i < 4; ++i) ht[(4 * g4 + i) * L2_TPITCH + ch] = hv[i];
        }
    }
    if constexpr (PASS == 2) {
        LDS_WAIT();
#pragma unroll
        for (int j = 0; j < 3; ++j) { const int cb = 32 * j + 8 * g4;
            if (cb < 80) {
                const f32x4 h0 = *(const LAS f32x4*)(ht + l15 * L2_TPITCH + cb), h1 = *(const LAS f32x4*)(ht + l15 * L2_TPITCH + cb + 4);
                u32x4 y; if constexpr (SAMP) y = *(const u32x4*)(Z + (size_t)(row0 + l15) * ZW + Z_YR + ch0 + cb); else y = zw[j][4];
                u32x4 o; o.x = pk2(h0.x * bflo(y.x), h0.y * bfhi(y.x)); o.y = pk2(h0.z * bflo(y.y), h0.w * bfhi(y.y)); o.z = pk2(h1.x * bflo(y.z), h1.y * bfhi(y.z)); o.w = pk2(h1.z * bflo(y.w), h1.w * bfhi(y.w));
                *(u32x4*)((bf16*)(ws + WS_HG) + (size_t)(row0 + l15) * DRNN + ch0 + cb) = o;
            }
        }
    }
    LDS_WAIT();
}
template <int PASS> __device__ __forceinline__ void lru_cu_unit(const Args& a, LAS unsigned char* lds, int u, int wave) {
    int z = 0; asm volatile("" : "+s"(z));
    int lane_ = lane_id(); asm volatile("" : "+v"(lane_)); const int lane = lane_, l15 = lane & 15;
    unsigned char* ws = (unsigned char*)a.in[I_WS + z];
    const int n = u & 15, ch0 = n * BLK, cidx = 8 * (u >> 4) + wave;
    __syncthreads();
    { const u32x4* src = (const u32x4*)(ws + WS_LW + (size_t)n * 33280); LAS u32x4* dst = (LAS u32x4*)(lds + L2_LW);
      for (int i = TIDW(wave); i < 2080; i += 512) dst[i] = src[i]; }
    { const int tid = TIDW(wave); if (tid < 480) { const int t = tid / 96, c = tid - 96 * t; float v = 0.f;
        if (c < 80) v = t < 4 ? ((const float*)a.in[I_CONVW + z])[t * DRNN + ch0 + c] : ((const float*)a.in[I_CONVB + z])[ch0 + c];
        ((LAS float*)(lds + L2_CW))[tid] = v; } }
    float gba[5], gbi[5], gsp[5], carry[5], aprod[5];
#pragma unroll
    for (int ct = 0; ct < 5; ++ct) { const int cg = ch0 + ct * 16 + l15; gba[ct] = ((const float*)a.in[I_LBA + z])[cg]; gbi[ct] = ((const float*)a.in[I_LBI + z])[cg];
        gsp[ct] = log1pf(expf(-((const float*)a.in[I_LAM + z])[cg])); carry[ct] = 0.f; aprod[ct] = 1.f; }
    const bf16* Zp = (const bf16*)(ws + WS_Z);
    const int row_c = cidx * 128, tib_c = (cidx & 63) * 128, g4 = lane >> 4;
    u32x4 zwA[3][5], zwB[3][5];
    lru_load<PASS>(Zp, ch0, row_c, tib_c, l15, g4, zwA);
    if (PASS == 2) {
        const f32x2* SUM = (const f32x2*)(ws + WS_SUM);
        const int nprev = cidx & 63, base = cidx & ~63, qn = (nprev + 3) >> 2, lo = base + g4 * qn, hi = (lo + qn < base + nprev) ? lo + qn : base + nprev;
        float fa[5], fh[5];
#pragma unroll
        for (int ct = 0; ct < 5; ++ct) { fa[ct] = 1.f; fh[ct] = 0.f; }
        for (int jc = lo; jc < hi; jc += 4) {
            f32x2 sm[4][5];
#pragma unroll
            for (int k = 0; k < 4; ++k)
#pragma unroll
                for (int ct = 0; ct < 5; ++ct) sm[k][ct] = (jc + k < hi) ? SUM[(size_t)(jc + k) * DRNN + ch0 + ct * 16 + l15] : (f32x2){1.f, 0.f};
#pragma unroll
            for (int k = 0; k < 4; ++k)
#pragma unroll
                for (int ct = 0; ct < 5; ++ct) { fh[ct] = sm[k][ct].x * fh[ct] + sm[k][ct].y; fa[ct] = sm[k][ct].x * fa[ct]; }
        }
#pragma unroll
        for (int ct = 0; ct < 5; ++ct) { float c = 0.f;
            float Aq[4], Hq[4]; row4(fa[ct], Aq); row4(fh[ct], Hq);
#pragma unroll
            for (int gq = 0; gq < 4; ++gq) c = Aq[gq] * c + Hq[gq];
            carry[ct] = c; }
    }
    __syncthreads();
#pragma unroll 1
    for (int mt = 0; mt < 8; mt += 2) {
        lru_load<PASS>(Zp, ch0, row_c + 16 * (mt + 1), tib_c + 16 * (mt + 1), l15, g4, zwB);
        lru_tile<PASS, false>(a, z, ws, lds, n, row_c + 16 * mt, tib_c + 16 * mt, lane, wave, gba, gbi, gsp, carry, aprod, zwA);
        if (mt + 2 < 8) lru_load<PASS>(Zp, ch0, row_c + 16 * (mt + 2), tib_c + 16 * (mt + 2), l15, g4, zwA);
        lru_tile<PASS, false>(a, z, ws, lds, n, row_c + 16 * (mt + 1), tib_c + 16 * (mt + 1), lane, wave, gba, gbi, gsp, carry, aprod, zwB);
    }
    if (PASS == 1) { if (lane < 16) { for (int ct = 0; ct < 5; ++ct) ((f32x2*)(ws + WS_SUM))[(size_t)cidx * DRNN + ch0 + ct * 16 + l15] = (f32x2){aprod[ct], carry[ct]}; } }
    else {
        float* out = (float*)a.in[I_OUT + z];
        if ((cidx & 63) == 63) {
            const int bb = cidx >> 6;
            if (lane < 16) { for (int ct = 0; ct < 5; ++ct) out[O_H_P + (size_t)bb * DRNN + ch0 + ct * 16 + l15] = carry[ct]; }
            const bf16* Z = (const bf16*)(ws + WS_Z);
            for (int e = lane; e < 240; e += 64) { const int jj = e / 80, c = e - 80 * jj; out[O_CONV_P + (size_t)(bb * 3 + jj) * DRNN + ch0 + c] = bf2f(Z[(size_t)(bb * SEQ + SEQ - 3 + jj) * ZW + Z_XR + ch0 + c]); }
        }
        if (u < 16) {
            float c2[5], p2[5];
#pragma unroll
            for (int ct = 0; ct < 5; ++ct) { c2[ct] = 0.f; p2[ct] = 1.f; }
            lru_tile<PASS, true>(a, z, ws, lds, n, MP + 16 * wave, 0, lane, wave, gba, gbi, gsp, c2, p2, zwA);
        }
    }
}

constexpr int SA_QIMG = 0, SA_PITCH = 592, SA_KT = 16 * SA_PITCH;
constexpr int SA_SLOT = 66 * 64 * 4, SA_OLAT = 4 * SA_SLOT;
static_assert(SA_OLAT + 16 * 256 * 4 <= RING_BYTES, "decode attention LDS map");
__device__ __forceinline__ void sample_attn_half(const Args& a, LAS unsigned char* lds, int s, int half, int wv) {
    int z = 0; asm volatile("" : "+s"(z));
    int tid = TIDW(wv); asm volatile("" : "+v"(tid)); const int lane = tid & 63, wave = wv;
    unsigned char* ws = (unsigned char*)a.in[I_WS + z];
    const bf16* Qrow = (const bf16*)(ws + WS_Q) + (size_t)(MP + s) * QW;
    const bf16* BKV = (const bf16*)(ws + WS_BKV);
    __syncthreads();
    {
        LAS float* qs = (LAS float*)(lds + SA_KT);
        { const unsigned w = ((const unsigned*)Qrow)[tid]; qs[2 * tid] = bflo(w); qs[2 * tid + 1] = bfhi(w); }
        __syncthreads();
        const int r2 = (tid & 127) * 2, hg = tid >> 7;
#pragma unroll 1
        for (int hh = 0; hh < 4; ++hh) { const int hd = hg * 4 + hh; float a0 = 0.f, a1 = 0.f;
            unsigned wv_[64];
#pragma unroll
            for (int d = 0; d < 64; ++d) wv_[d] = *(const unsigned*)(BKV + (size_t)(hd * 64 + d) * KVL + r2);
#pragma unroll
            for (int d = 0; d < 64; ++d) { const float q = qs[hd * 64 + d]; a0 += q * bflo(wv_[d]); a1 += q * bfhi(wv_[d]); }
            *(LAS unsigned*)(lds + SA_QIMG + hd * SA_PITCH + r2 * 2) = pk2(a0, a1); }
        if ((tid & 31) < 16) { const int hd = tid >> 5, i = tid & 15;
          const float* cosT = (const float*)(ws + WS_ROPE); const float c = cosT[SEQ * 16 + i], sn = cosT[ROPE_TAB + SEQ * 16 + i];
          const float x1 = bf2f(Qrow[1024 + hd * 32 + i]), x2 = bf2f(Qrow[1024 + hd * 32 + 16 + i]);
          *(LAS bf16*)(lds + SA_QIMG + hd * SA_PITCH + (256 + i) * 2) = f2bf(x1 * c - x2 * sn);
          *(LAS bf16*)(lds + SA_QIMG + hd * SA_PITCH + (256 + 16 + i) * 2) = f2bf(x1 * sn + x2 * c); }
    }
    __syncthreads();
    const int g4 = lane >> 4, l15 = lane & 15;
    const LAS unsigned char* qfp = lds + SA_QIMG + l15 * SA_PITCH + 8 * g4 * 2;
    LAS unsigned char* kt = lds + SA_KT + wave * 9472;
    const unsigned ktb = (unsigned)(uintptr_t)kt;
    const int* pt = (const int*)a.in[I_PT + z] + s * NPAGES + half * 32 + wave * 4;
    const float* cckv = (const float*)a.in[I_CCKV + z]; const float* ckr = (const float*)a.in[I_CKR + z];
    float m_run = -1e30f, l_part = 0.f;
    f32x4 oacc[16];
#pragma unroll
    for (int i = 0; i < 16; ++i) oacc[i] = (f32x4){0.f, 0.f, 0.f, 0.f};
    f32x4 stA[18], stB[18];
#define SA_ISSUE(ST, tt) do { const int pid_ = pt[(tt) >> 3]; const float* kb_ = cckv + ((size_t)pid_ * PAGE + ((tt) & 7) * 16) * KVL; const float* rb_ = ckr + ((size_t)pid_ * PAGE + ((tt) & 7) * 16) * ROPE; \
        _Pragma("unroll") for (int i_ = 0; i_ < 16; ++i_) ST[i_] = __builtin_nontemporal_load((const f32x4*)(kb_ + i_ * KVL) + lane); \
        ST[16] = __builtin_nontemporal_load((const f32x4*)rb_ + lane); ST[17] = __builtin_nontemporal_load((const f32x4*)rb_ + 64 + lane); } while (0)
#define SA_TOLDS(ST) do { \
        _Pragma("unroll") for (int i = 0; i < 16; ++i) { u32x2 o; o.x = pk2(ST[i].x, ST[i].y); o.y = pk2(ST[i].z, ST[i].w); *(LAS u32x2*)(kt + i * SA_PITCH + lane * 8) = o; } \
        _Pragma("unroll") for (int k = 0; k < 2; ++k) { u32x2 o; o.x = pk2(ST[16 + k].x, ST[16 + k].y); o.y = pk2(ST[16 + k].z, ST[16 + k].w); *(LAS u32x2*)(kt + (8 * k + (lane >> 3)) * SA_PITCH + (256 + 4 * (lane & 7)) * 2) = o; } } while (0)
#define SA_COMPUTE(SELF) do { \
        LDS_WAIT(); \
        f32x4 sacc = {0.f, 0.f, 0.f, 0.f}; \
        _Pragma("unroll") for (int j = 0; j < 9; ++j) { const bf16x8 kf = *(const LAS bf16x8*)(kt + l15 * SA_PITCH + (32 * j + 8 * g4) * 2); const bf16x8 qfj = *(const LAS bf16x8*)(qfp + 64 * j); sacc = __builtin_amdgcn_mfma_f32_16x16x32_bf16(kf, qfj, sacc, 0, 0, 0); } \
        if (SELF) { _Pragma("unroll") for (int i = 0; i < 4; ++i) if (4 * g4 + i >= 1) sacc[i] = -__builtin_inff(); } \
        float mx = fmaxf(fmaxf(sacc[0], sacc[1]), fmaxf(sacc[2], sacc[3])); \
        mx = fmaxf(mx, __shfl_xor(mx, 16)); mx = fmaxf(mx, __shfl_xor(mx, 32)); \
        const float mn = fmaxf(m_run, mx), alpha = __builtin_amdgcn_exp2f(m_run - mn); \
        m_run = mn; \
        const float p0 = __builtin_amdgcn_exp2f(sacc[0] - mn), p1 = __builtin_amdgcn_exp2f(sacc[1] - mn), p2 = __builtin_amdgcn_exp2f(sacc[2] - mn), p3 = __builtin_amdgcn_exp2f(sacc[3] - mn); \
        l_part = l_part * alpha + ((p0 + p1) + (p2 + p3)); \
        u32x2 pw; pw.x = pk2(p0, p1); pw.y = pk2(p2, p3); \
        const s16x4 pb = __builtin_bit_cast(s16x4, pw); \
        const unsigned vaddr = ktb + (unsigned)((4 * g4 + (l15 >> 2)) * SA_PITCH + (l15 & 3) * 8); \
        _Pragma("unroll") for (int ct = 0; ct < 16; ++ct) { \
            s16x4 vf; \
            asm volatile("ds_read_b64_tr_b16 %0, %1 offset:%2" : "=v"(vf) : "v"(vaddr), "i"(ct * 32) : "memory"); \
            asm volatile("s_waitcnt lgkmcnt(0)" ::: "memory"); \
            oacc[ct] = oacc[ct] * alpha; \
            oacc[ct] = __builtin_amdgcn_mfma_f32_16x16x16bf16_1k(vf, pb, oacc[ct], 0, 0, 0); } } while (0)
    SA_ISSUE(stA, 0); SA_ISSUE(stB, 1);
#pragma unroll 1
    for (int tt = 0; tt < 32; tt += 2) {
        if (tt + 1 < 32) asm volatile("s_waitcnt vmcnt(18)" ::: "memory"); else VM_WAIT();
        asm volatile("" : "+v"(stA[0]), "+v"(stA[1]), "+v"(stA[2]), "+v"(stA[3]), "+v"(stA[4]), "+v"(stA[5]), "+v"(stA[6]), "+v"(stA[7]), "+v"(stA[8]));
        asm volatile("" : "+v"(stA[9]), "+v"(stA[10]), "+v"(stA[11]), "+v"(stA[12]), "+v"(stA[13]), "+v"(stA[14]), "+v"(stA[15]), "+v"(stA[16]), "+v"(stA[17]));
        SA_TOLDS(stA);
        if (tt + 2 < 32) SA_ISSUE(stA, tt + 2);
        SA_COMPUTE(false);
        if (tt + 2 < 32) asm volatile("s_waitcnt vmcnt(18)" ::: "memory"); else VM_WAIT();
        asm volatile("" : "+v"(stB[0]), "+v"(stB[1]), "+v"(stB[2]), "+v"(stB[3]), "+v"(stB[4]), "+v"(stB[5]), "+v"(stB[6]), "+v"(stB[7]), "+v"(stB[8]));
        asm volatile("" : "+v"(stB[9]), "+v"(stB[10]), "+v"(stB[11]), "+v"(stB[12]), "+v"(stB[13]), "+v"(stB[14]), "+v"(stB[15]), "+v"(stB[16]), "+v"(stB[17]));
        SA_TOLDS(stB);
        if (tt + 3 < 32) SA_ISSUE(stB, tt + 3);
        SA_COMPUTE(false);
    }
    if (half == 1 && wave == 7) {
        const bf16* ck = (const bf16*)(ws + WS_CKV) + (size_t)(MP + s) * KVL; const bf16* kr = (const bf16*)(ws + WS_KR) + (size_t)(MP + s) * ROPE;
#pragma unroll
        for (int i = 0; i < 16; ++i) { u32x2 o = {0u, 0u}; if (i == 0) o = ((const u32x2*)ck)[lane]; *(LAS u32x2*)(kt + i * SA_PITCH + lane * 8) = o; }
        if (lane < 32) { *(LAS bf16*)(kt + (256 + lane) * 2) = kr[lane]; }
        else { const int d = lane - 32; for (int i = 1; i < 16; ++i) *(LAS bf16*)(kt + i * SA_PITCH + (256 + d) * 2) = 0; }
        SA_COMPUTE(true);
    }
#undef SA_ISSUE
#undef SA_TOLDS
#undef SA_COMPUTE
    LAS float* slots = (LAS float*)lds;
#pragma unroll 1
    for (int half = 4; half >= 1; half >>= 1) {
        __syncthreads();
        if (wave >= half && wave < 2 * half) { LAS float* sl = slots + (size_t)(wave - half) * (SA_SLOT / 4);
#pragma unroll
            for (int ct = 0; ct < 16; ++ct) { sl[(4 * ct + 0) * 64 + lane] = oacc[ct][0]; sl[(4 * ct + 1) * 64 + lane] = oacc[ct][1]; sl[(4 * ct + 2) * 64 + lane] = oacc[ct][2]; sl[(4 * ct + 3) * 64 + lane] = oacc[ct][3]; }
            sl[64 * 64 + lane] = m_run; sl[65 * 64 + lane] = l_part; }
        __syncthreads();
        if (wave < half) { const LAS float* sl = slots + (size_t)wave * (SA_SLOT / 4);
            const float m2 = sl[64 * 64 + lane], l2 = sl[65 * 64 + lane];
            const float mn = fmaxf(m_run, m2), a1 = __builtin_amdgcn_exp2f(m_run - mn), a2 = __builtin_amdgcn_exp2f(m2 - mn);
            m_run = mn; l_part = a1 * l_part + a2 * l2;
#pragma unroll
            for (int ct = 0; ct < 16; ++ct) { oacc[ct][0] = a1 * oacc[ct][0] + a2 * sl[(4 * ct + 0) * 64 + lane]; oacc[ct][1] = a1 * oacc[ct][1] + a2 * sl[(4 * ct + 1) * 64 + lane];
                                             oacc[ct][2] = a1 * oacc[ct][2] + a2 * sl[(4 * ct + 2) * 64 + lane]; oacc[ct][3] = a1 * oacc[ct][3] + a2 * sl[(4 * ct + 3) * 64 + lane]; } }
    }
    if (wave == 0) {
        float* part = (float*)(ws + WS_PART) + (size_t)(s * 2 + half) * PART_STRIDE;
        float lsum = l_part; lsum += __shfl_xor(lsum, 16); lsum += __shfl_xor(lsum, 32);
#pragma unroll
        for (int ct = 0; ct < 16; ++ct) *(f32x4*)(part + l15 * 256 + ct * 16 + 4 * g4) = oacc[ct];
        if (g4 == 0) { part[4096 + l15] = m_run; part[4096 + 16 + l15] = lsum; }
    }
}
__device__ __forceinline__ void sample_attn_seq(const Args& a, LAS unsigned char* lds, int s, int wv) {
    int z = 0; asm volatile("" : "+s"(z));
    int tid = TIDW(wv); asm volatile("" : "+v"(tid)); const int lane = tid & 63, wave = wv;
    unsigned char* ws = (unsigned char*)a.in[I_WS + z];
    const bf16* Qrow = (const bf16*)(ws + WS_Q) + (size_t)(MP + s) * QW;
    const bf16* BKV = (const bf16*)(ws + WS_BKV);
    __syncthreads();
    {
        LAS float* qs = (LAS float*)(lds + SA_KT);
        { const unsigned w = ((const unsigned*)Qrow)[tid]; qs[2 * tid] = bflo(w); qs[2 * tid + 1] = bfhi(w); }
        __syncthreads();
        const int r2 = (tid & 127) * 2, hg = tid >> 7;
#pragma unroll 1
        for (int hh = 0; hh < 4; ++hh) { const int hd = hg * 4 + hh; float a0 = 0.f, a1 = 0.f;
            unsigned wv_[64];
#pragma unroll
            for (int d = 0; d < 64; ++d) wv_[d] = *(const unsigned*)(BKV + (size_t)(hd * 64 + d) * KVL + r2);
#pragma unroll
            for (int d = 0; d < 64; ++d) { const float q = qs[hd * 64 + d]; a0 += q * bflo(wv_[d]); a1 += q * bfhi(wv_[d]); }
            *(LAS unsigned*)(lds + SA_QIMG + hd * SA_PITCH + r2 * 2) = pk2(a0, a1); }
        if ((tid & 31) < 16) { const int hd = tid >> 5, i = tid & 15;
          const float* cosT = (const float*)(ws + WS_ROPE); const float c = cosT[SEQ * 16 + i], sn = cosT[ROPE_TAB + SEQ * 16 + i];
          const float x1 = bf2f(Qrow[1024 + hd * 32 + i]), x2 = bf2f(Qrow[1024 + hd * 32 + 16 + i]);
          *(LAS bf16*)(lds + SA_QIMG + hd * SA_PITCH + (256 + i) * 2) = f2bf(x1 * c - x2 * sn);
          *(LAS bf16*)(lds + SA_QIMG + hd * SA_PITCH + (256 + 16 + i) * 2) = f2bf(x1 * sn + x2 * c); }
    }
    __syncthreads();
    const int g4 = lane >> 4, l15 = lane & 15;
    const LAS unsigned char* qfp = lds + SA_QIMG + l15 * SA_PITCH + 8 * g4 * 2;
    LAS unsigned char* kt = lds + SA_KT + wave * 9472;
    const unsigned ktb = (unsigned)(uintptr_t)kt;
    const int* pt = (const int*)a.in[I_PT + z] + s * NPAGES + wave * 8;
    const float* cckv = (const float*)a.in[I_CCKV + z]; const float* ckr = (const float*)a.in[I_CKR + z];
    float m_run = -1e30f, l_part = 0.f;
    f32x4 oacc[16];
#pragma unroll
    for (int i = 0; i < 16; ++i) oacc[i] = (f32x4){0.f, 0.f, 0.f, 0.f};
    f32x4 stA[18], stB[18];
#define SA_ISSUE(ST, tt) do { const int pid_ = pt[(tt) >> 3]; const float* kb_ = cckv + ((size_t)pid_ * PAGE + ((tt) & 7) * 16) * KVL; const float* rb_ = ckr + ((size_t)pid_ * PAGE + ((tt) & 7) * 16) * ROPE; \
        _Pragma("unroll") for (int i_ = 0; i_ < 16; ++i_) ST[i_] = __builtin_nontemporal_load((const f32x4*)(kb_ + i_ * KVL) + lane); \
        ST[16] = __builtin_nontemporal_load((const f32x4*)rb_ + lane); ST[17] = __builtin_nontemporal_load((const f32x4*)rb_ + 64 + lane); } while (0)
#define SA_TOLDS(ST) do { \
        _Pragma("unroll") for (int i = 0; i < 16; ++i) { u32x2 o; o.x = pk2(ST[i].x, ST[i].y); o.y = pk2(ST[i].z, ST[i].w); *(LAS u32x2*)(kt + i * SA_PITCH + lane * 8) = o; } \
        _Pragma("unroll") for (int k = 0; k < 2; ++k) { u32x2 o; o.x = pk2(ST[16 + k].x, ST[16 + k].y); o.y = pk2(ST[16 + k].z, ST[16 + k].w); *(LAS u32x2*)(kt + (8 * k + (lane >> 3)) * SA_PITCH + (256 + 4 * (lane & 7)) * 2) = o; } } while (0)
#define SA_TR4(base_) do { \
        asm volatile("ds_read_b64_tr_b16 %0, %4 offset:%5\n\tds_read_b64_tr_b16 %1, %4 offset:%6\n\tds_read_b64_tr_b16 %2, %4 offset:%7\n\tds_read_b64_tr_b16 %3, %4 offset:%8\n\ts_waitcnt lgkmcnt(0)" \
                     : "=&v"(vf[0]), "=&v"(vf[1]), "=&v"(vf[2]), "=&v"(vf[3]) \
                     : "v"(vaddr), "i"(((base_) + 0) * 32), "i"(((base_) + 1) * 32), "i"(((base_) + 2) * 32), "i"(((base_) + 3) * 32) : "memory"); \
        _Pragma("unroll") for (int c_ = 0; c_ < 4; ++c_) oacc[(base_) + c_] = __builtin_amdgcn_mfma_f32_16x16x16bf16_1k(vf[c_], pb, oacc[(base_) + c_], 0, 0, 0); } while (0)
#define SA_COMPUTE(SELF) do { \
        LDS_WAIT(); \
        f32x4 sacc = {0.f, 0.f, 0.f, 0.f}; \
        _Pragma("unroll") for (int j = 0; j < 9; ++j) { const bf16x8 kf = *(const LAS bf16x8*)(kt + l15 * SA_PITCH + (32 * j + 8 * g4) * 2); const bf16x8 qfj = *(const LAS bf16x8*)(qfp + 64 * j); sacc = __builtin_amdgcn_mfma_f32_16x16x32_bf16(kf, qfj, sacc, 0, 0, 0); } \
        if (SELF) { _Pragma("unroll") for (int i = 0; i < 4; ++i) if (4 * g4 + i >= 1) sacc[i] = -__builtin_inff(); } \
        float mx = fmaxf(fmaxf(sacc[0], sacc[1]), fmaxf(sacc[2], sacc[3])); \
        { auto r_ = __builtin_amdgcn_permlane16_swap(__float_as_uint(mx), __float_as_uint(mx), false, false); mx = fmaxf(__uint_as_float(r_[0]), __uint_as_float(r_[1])); } \
        { auto r_ = __builtin_amdgcn_permlane32_swap(__float_as_uint(mx), __float_as_uint(mx), false, false); mx = fmaxf(__uint_as_float(r_[0]), __uint_as_float(r_[1])); } \
        if (__builtin_expect(__any(mx > m_run + 8.f), 0)) { const float mn = fmaxf(m_run, mx), alpha = __builtin_amdgcn_exp2f(m_run - mn); m_run = mn; l_part *= alpha; \
            _Pragma("unroll") for (int ct = 0; ct < 16; ++ct) oacc[ct] = oacc[ct] * alpha; } \
        const float p0 = __builtin_amdgcn_exp2f(sacc[0] - m_run), p1 = __builtin_amdgcn_exp2f(sacc[1] - m_run), p2 = __builtin_amdgcn_exp2f(sacc[2] - m_run), p3 = __builtin_amdgcn_exp2f(sacc[3] - m_run); \
        l_part += (p0 + p1) + (p2 + p3); \
        u32x2 pw; pw.x = pk2(p0, p1); pw.y = pk2(p2, p3); \
        const s16x4 pb = __builtin_bit_cast(s16x4, pw); \
        const unsigned vaddr = ktb + (unsigned)((4 * g4 + (l15 >> 2)) * SA_PITCH + (l15 & 3) * 8); \
        s16x4 vf[4]; SA_TR4(0); SA_TR4(4); SA_TR4(8); SA_TR4(12); } while (0)
    SA_ISSUE(stA, 0); SA_ISSUE(stB, 1);
#pragma unroll 1
    for (int tt = 0; tt < 64; tt += 2) {
        if (tt + 1 < 64) asm volatile("s_waitcnt vmcnt(18)" ::: "memory"); else VM_WAIT();
        asm volatile("" : "+v"(stA[0]), "+v"(stA[1]), "+v"(stA[2]), "+v"(stA[3]), "+v"(stA[4]), "+v"(stA[5]), "+v"(stA[6]), "+v"(stA[7]), "+v"(stA[8]));
        asm volatile("" : "+v"(stA[9]), "+v"(stA[10]), "+v"(stA[11]), "+v"(stA[12]), "+v"(stA[13]), "+v"(stA[14]), "+v"(stA[15]), "+v"(stA[16]), "+v"(stA[17]));
        SA_TOLDS(stA);
        if (tt + 2 < 64) SA_ISSUE(stA, tt + 2);
        SA_COMPUTE(false);
        if (tt + 2 < 64) asm volatile("s_waitcnt vmcnt(18)" ::: "memory"); else VM_WAIT();
        asm volatile("" : "+v"(stB[0]), "+v"(stB[1]), "+v"(stB[2]), "+v"(stB[3]), "+v"(stB[4]), "+v"(stB[5]), "+v"(stB[6]), "+v"(stB[7]), "+v"(stB[8]));
        asm volatile("" : "+v"(stB[9]), "+v"(stB[10]), "+v"(stB[11]), "+v"(stB[12]), "+v"(stB[13]), "+v"(stB[14]), "+v"(stB[15]), "+v"(stB[16]), "+v"(stB[17]));
        SA_TOLDS(stB);
        if (tt + 3 < 64) SA_ISSUE(stB, tt + 3);
        SA_COMPUTE(false);
    }
    if (wave == 7) {
        const bf16* ck = (const bf16*)(ws + WS_CKV) + (size_t)(MP + s) * KVL; const bf16* kr = (const bf16*)(ws + WS_KR) + (size_t)(MP + s) * ROPE;
#pragma unroll
        for (int i = 0; i < 16; ++i) { u32x2 o = {0u, 0u}; if (i == 0) o = ((const u32x2*)ck)[lane]; *(LAS u32x2*)(kt + i * SA_PITCH + lane * 8) = o; }
        if (lane < 32) { *(LAS bf16*)(kt + (256 + lane) * 2) = kr[lane]; }
        else { const int d = lane - 32; for (int i = 1; i < 16; ++i) *(LAS bf16*)(kt + i * SA_PITCH + (256 + d) * 2) = 0; }
        SA_COMPUTE(true);
    }
#undef SA_ISSUE
#undef SA_TOLDS
#undef SA_COMPUTE
#undef SA_TR4
    LAS float* slots = (LAS float*)lds;
#pragma unroll 1
    for (int half = 4; half >= 1; half >>= 1) {
        __syncthreads();
        if (wave >= half && wave < 2 * half) { LAS float* sl = slots + (size_t)(wave - half) * (SA_SLOT / 4);
#pragma unroll
            for (int ct = 0; ct < 16; ++ct) { sl[(4 * ct + 0) * 64 + lane] = oacc[ct][0]; sl[(4 * ct + 1) * 64 + lane] = oacc[ct][1]; sl[(4 * ct + 2) * 64 + lane] = oacc[ct][2]; sl[(4 * ct + 3) * 64 + lane] = oacc[ct][3]; }
            sl[64 * 64 + lane] = m_run; sl[65 * 64 + lane] = l_part; }
        __syncthreads();
        if (wave < half) { const LAS float* sl = slots + (size_t)wave * (SA_SLOT / 4);
            const float m2 = sl[64 * 64 + lane], l2 = sl[65 * 64 + lane];
            const float mn = fmaxf(m_run, m2), a1 = __builtin_amdgcn_exp2f(m_run - mn), a2 = __builtin_amdgcn_exp2f(m2 - mn);
            m_run = mn; l_part = a1 * l_part + a2 * l2;
#pragma unroll
            for (int ct = 0; ct < 16; ++ct) { oacc[ct][0] = a1 * oacc[ct][0] + a2 * sl[(4 * ct + 0) * 64 + lane]; oacc[ct][1] = a1 * oacc[ct][1] + a2 * sl[(4 * ct + 1) * 64 + lane];
                                             oacc[ct][2] = a1 * oacc[ct][2] + a2 * sl[(4 * ct + 2) * 64 + lane]; oacc[ct][3] = a1 * oacc[ct][3] + a2 * sl[(4 * ct + 3) * 64 + lane]; } }
    }
    LAS float* olat = (LAS float*)(lds + SA_OLAT);
    if (wave == 0) {
        float lsum = l_part; lsum += __shfl_xor(lsum, 16); lsum += __shfl_xor(lsum, 32);
        const float il = 1.f / lsum;
#pragma unroll
        for (int ct = 0; ct < 16; ++ct) *(LAS f32x4*)(olat + l15 * 256 + ct * 16 + 4 * g4) = oacc[ct] * il;
    }
    __syncthreads();
    {
        const int hd = tid >> 5, v0 = (tid & 31) * 2;
        const bf16* B = BKV + (size_t)(1024 + hd * 64 + v0) * KVL;
        float a0 = 0.f, a1 = 0.f;
#pragma unroll 8
        for (int r = 0; r < 256; r += 8) { const u32x4 w0 = *(const u32x4*)(B + r), w1 = *(const u32x4*)(B + KVL + r);
            const f32x4 x0 = *(const LAS f32x4*)(olat + hd * 256 + r), x1 = *(const LAS f32x4*)(olat + hd * 256 + r + 4);
            a0 += x0.x * bflo(w0.x) + x0.y * bfhi(w0.x) + x0.z * bflo(w0.y) + x0.w * bfhi(w0.y) + x1.x * bflo(w0.z) + x1.y * bfhi(w0.z) + x1.z * bflo(w0.w) + x1.w * bfhi(w0.w);
            a1 += x0.x * bflo(w1.x) + x0.y * bfhi(w1.x) + x0.z * bflo(w1.y) + x0.w * bfhi(w1.y) + x1.x * bflo(w1.z) + x1.y * bfhi(w1.z) + x1.z * bflo(w1.w) + x1.w * bfhi(w1.w); }
        *(unsigned*)((bf16*)(ws + WS_OB) + (size_t)(MP + s) * DM + hd * 64 + v0) = pk2(a0, a1);
    }
}
__device__ __forceinline__ void sample_combine(const Args& a, LAS unsigned char* lds, int s, int wv) {
    int z = 0; asm volatile("" : "+s"(z));
    int tid = TIDW(wv); asm volatile("" : "+v"(tid));
    unsigned char* ws = (unsigned char*)a.in[I_WS + z];
    const float* part = (const float*)(ws + WS_PART) + (size_t)s * 2 * PART_STRIDE;
    LAS float* olat = (LAS float*)lds;
    __syncthreads();
    {
        const int hd = tid >> 5, cg = (tid & 31) * 8;
        const float m0 = part[4096 + hd], m1 = part[PART_STRIDE + 4096 + hd], mmax = fmaxf(m0, m1);
        const float w0 = __builtin_amdgcn_exp2f(m0 - mmax), w1 = __builtin_amdgcn_exp2f(m1 - mmax);
        const float il = 1.f / (w0 * part[4096 + 16 + hd] + w1 * part[PART_STRIDE + 4096 + 16 + hd]);
        const f32x4 o0 = (*(const f32x4*)(part + hd * 256 + cg) * w0 + *(const f32x4*)(part + PART_STRIDE + hd * 256 + cg) * w1) * il;
        const f32x4 o1 = (*(const f32x4*)(part + hd * 256 + cg + 4) * w0 + *(const f32x4*)(part + PART_STRIDE + hd * 256 + cg + 4) * w1) * il;
        *(LAS f32x4*)(olat + hd * 256 + cg) = o0; *(LAS f32x4*)(olat + hd * 256 + cg + 4) = o1;
    }
    __syncthreads();
    {
        const int hd = tid >> 5, v0 = (tid & 31) * 2;
        const bf16* B = (const bf16*)(ws + WS_BKV) + (size_t)(1024 + hd * 64 + v0) * KVL;
        float a0 = 0.f, a1 = 0.f;
#pragma unroll 8
        for (int r = 0; r < 256; r += 8) { const u32x4 w0 = *(const u32x4*)(B + r), w1 = *(const u32x4*)(B + KVL + r);
            const f32x4 x0 = *(const LAS f32x4*)(olat + hd * 256 + r), x1 = *(const LAS f32x4*)(olat + hd * 256 + r + 4);
            a0 += x0.x * bflo(w0.x) + x0.y * bfhi(w0.x) + x0.z * bflo(w0.y) + x0.w * bfhi(w0.y) + x1.x * bflo(w0.z) + x1.y * bfhi(w0.z) + x1.z * bflo(w0.w) + x1.w * bfhi(w0.w);
            a1 += x0.x * bflo(w1.x) + x0.y * bfhi(w1.x) + x0.z * bflo(w1.y) + x0.w * bfhi(w1.y) + x1.x * bflo(w1.z) + x1.y * bfhi(w1.z) + x1.z * bflo(w1.w) + x1.w * bfhi(w1.w); }
        *(unsigned*)((bf16*)(ws + WS_OB) + (size_t)(MP + s) * DM + hd * 64 + v0) = pk2(a0, a1);
    }
}

namespace pattn4 {
constexpr int NKS = 4, NVS = 4, KSLOT = 12288, VSLOT = 8192;
constexpr int LDS_K = 0, LDS_V = NKS * KSLOT, LDS_WS = LDS_V + NVS * VSLOT, LDS_OST = LDS_WS + 8 * 256, LDS_TOTAL = LDS_OST + 8 * 4096;
static_assert(LDS_TOTAL <= RING_BYTES, "attention LDS map");
constexpr float THR = 8.f;
#define SBAR() __builtin_amdgcn_sched_barrier(0)
#define SGB(mask, n) __builtin_amdgcn_sched_group_barrier(mask, n, 0)
#define WAIT_BAR(N) do { if constexpr (VAR & 4) asm volatile("s_waitcnt vmcnt(" #N ") lgkmcnt(0)" ::: "memory"); else asm volatile("s_waitcnt vmcnt(" #N ") lgkmcnt(0)\n\ts_barrier" ::: "memory"); } while (0)
__device__ __forceinline__ int crow(int r, int hi) { return (r & 3) + 8 * (r >> 2) + 4 * hi; }
__device__ __forceinline__ void mask_tile(f32x16& p0, f32x16& p1, int dq) {
    const float NEG = -__builtin_inff();
#pragma unroll
    for (int r = 0; r < 16; ++r) { const int c = (r & 3) + 8 * (r >> 2); if (dq - c < 0) p0[r] = NEG; if (dq - c - 32 < 0) p1[r] = NEG; }
}
template <int VAR> __device__ __forceinline__ void block(const bf16* Q, const bf16* KVB, const bf16* KR, const float* cosT, bf16* OB, LAS unsigned char* lds, int b, int h, int qb, int t0, int wv,
                                                   bool primed, bool has_next, int nb_, int nh_, int nqb_, bf16x8 (&qr)[6]) {
    int tid = TIDW(wv); asm volatile("" : "+v"(tid));
    const int wid = wv, lane = tid & 63, r32 = lane & 31, hi = lane >> 5;
    const int NT = 4 * (qb + 1);
    const int P0 = qb * 256, qlo = P0 + wid * 32, qm = qlo + r32 - 4 * hi;
    LAS float* wsf = (LAS float*)(lds + LDS_WS) + wid * 64; LAS float* li_l = wsf; LAS float* al_l = wsf + 32;
    const size_t rowbase = (size_t)b * SEQ;
    const bf16* ksrc = KVB + (rowbase + (wid & 3) * 16 + (lane & 15)) * KVW + h * 64 + ((wid >> 2) * 4 + (lane >> 4)) * 8;
    const bf16* rsrc = KR + (rowbase + (wid & 3) * 16 + (lane & 15)) * ROPE + (lane >> 4) * 8;
    const bf16* vsrc = KVB + (rowbase + 16 * (wid & 3) + (lane >> 2)) * KVW + 1024 + h * 64 + (wid >> 2) * 32 + (lane & 3) * 8;
    LAS unsigned char* kdst = lds + LDS_K + (wid & 3) * 3072 + (wid >> 2) * 1024; LAS unsigned char* rdst = lds + LDS_K + (wid & 3) * 3072 + 2048; LAS unsigned char* vdst = lds + LDS_V + wid * 1024;
#define TT(i_) (((i_) + t0 < NT) ? (i_) + t0 : (i_) + t0 - NT)
#define DMA_K(t, slot) do { if constexpr ((VAR & 16) != 0) break; __builtin_amdgcn_global_load_lds((const unsigned*)(ksrc + (size_t)TT(t) * 64 * KVW), (LAS unsigned*)(kdst + (slot) * KSLOT), 16, 0, 0); \
                            __builtin_amdgcn_global_load_lds((const unsigned*)(rsrc + (size_t)TT(t) * 64 * ROPE), (LAS unsigned*)(rdst + (slot) * KSLOT), 16, 0, 0); } while (0)
#define DMA_V(t, slot) do { if constexpr ((VAR & 16) == 0) __builtin_amdgcn_global_load_lds((const unsigned*)(vsrc + (size_t)TT(t) * 64 * KVW), (LAS unsigned*)(vdst + (slot) * VSLOT), 16, 0, 0); } while (0)
    const LAS unsigned char* kb0 = lds + LDS_K + (r32 >> 4) * 3072 + (r32 & 15) * 16 + hi * 256;
    const int vb0 = (int)(uintptr_t)(lds + LDS_V) + ((lane >> 4) & 1) * 32 + (lane & 3) * 8 + (4 * hi + ((lane & 15) >> 2)) * 64;
    float m_reg = 0.f, l_reg = 0.f; f32x16 o[2] = {}; f32x16 negm = f32x16{};
#define PRIME(bb_, hh_, qq_) do { const size_t rb_ = (size_t)(bb_) * SEQ; \
        const bf16* ks_ = KVB + (rb_ + (wid & 3) * 16 + (lane & 15)) * KVW + (hh_) * 64 + ((wid >> 2) * 4 + (lane >> 4)) * 8; \
        const bf16* rs_ = KR + (rb_ + (wid & 3) * 16 + (lane & 15)) * ROPE + (lane >> 4) * 8; \
        const bf16* vs_ = KVB + (rb_ + 16 * (wid & 3) + (lane >> 2)) * KVW + 1024 + (hh_) * 64 + (wid >> 2) * 32 + (lane & 3) * 8; \
        if constexpr ((VAR & 16) == 0) { _Pragma("unroll") for (int t_ = 0; t_ < 3; ++t_) { \
            __builtin_amdgcn_global_load_lds((const unsigned*)(ks_ + (size_t)t_ * 64 * KVW), (LAS unsigned*)(kdst + t_ * KSLOT), 16, 0, 0); \
            __builtin_amdgcn_global_load_lds((const unsigned*)(rs_ + (size_t)t_ * 64 * ROPE), (LAS unsigned*)(rdst + t_ * KSLOT), 16, 0, 0); \
            if (t_ < 2) __builtin_amdgcn_global_load_lds((const unsigned*)(vs_ + (size_t)t_ * 64 * KVW), (LAS unsigned*)(vdst + t_ * VSLOT), 16, 0, 0); } } \
        const bf16* qrow_ = Q + (rb_ + (qq_) * 256 + wid * 32 + r32) * QW; \
        _Pragma("unroll") for (int d0 = 0; d0 < 4; ++d0) qr[d0] = *(const bf16x8*)(qrow_ + (hh_) * 64 + d0 * 16 + hi * 8); \
        _Pragma("unroll") for (int d0 = 4; d0 < 6; ++d0) qr[d0] = *(const bf16x8*)(qrow_ + 1024 + (hh_) * 32 + (d0 - 4) * 16 + hi * 8); } while (0)
    if (!primed) PRIME(b, h, qb);
    bf16x8 kf[12];
#define KLOAD(slot) do { const LAS unsigned char* kb_ = kb0 + (slot) * KSLOT; _Pragma("unroll") for (int d0 = 0; d0 < 6; ++d0) { kf[2 * d0] = *(const LAS bf16x8*)(kb_ + d0 * 512); kf[2 * d0 + 1] = *(const LAS bf16x8*)(kb_ + d0 * 512 + 6144); } } while (0)
#define QK(P0_, P1_) do { if constexpr ((VAR & 32) != 0) { P0_ = negm; P1_ = negm; P0_[0] += __builtin_bit_cast(float, (int)kf[0][0] + (int)kf[11][1]); } else if constexpr ((VAR & 2) != 0) { P0_ = negm; P1_ = negm; _Pragma("unroll") for (int d0 = 0; d0 < 12; ++d0) { P0_[d0] += (float)kf[d0][0]; P1_[d0] += (float)kf[d0][1]; } } else { P0_ = __builtin_amdgcn_mfma_f32_32x32x16_bf16(kf[0], qr[0], negm, 0, 0, 0); P1_ = __builtin_amdgcn_mfma_f32_32x32x16_bf16(kf[1], qr[0], negm, 0, 0, 0); \
        _Pragma("unroll") for (int d0 = 1; d0 < 6; ++d0) { P0_ = __builtin_amdgcn_mfma_f32_32x32x16_bf16(kf[2 * d0], qr[d0], P0_, 0, 0, 0); P1_ = __builtin_amdgcn_mfma_f32_32x32x16_bf16(kf[2 * d0 + 1], qr[d0], P1_, 0, 0, 0); } } } while (0)
#define RESC(al) do { if (__any((al) < 1.f)) { if (hi == 0) al_l[r32] = (al); asm volatile("s_waitcnt lgkmcnt(0)" ::: "memory"); \
        _Pragma("unroll") for (int d_ = 0; d_ < 2; ++d_) _Pragma("unroll") for (int r = 0; r < 16; ++r) o[d_][r] *= al_l[crow(r, hi)]; } } while (0)
#define MASKT(P0_, P1_, t) do { const int kbm_ = TT(t) * 64; if (kbm_ + 63 > qlo) mask_tile(P0_, P1_, qm - kbm_); } while (0)
#define ROWMAX(P0_, P1_, pm_) do { float m0_ = fmaxf(P0_[0], P1_[0]), m1_ = fmaxf(P0_[1], P1_[1]), m2_ = fmaxf(P0_[2], P1_[2]), m3_ = fmaxf(P0_[3], P1_[3]); \
        _Pragma("unroll") for (int r = 4; r < 16; r += 4) { m0_ = fmaxf(fmaxf(m0_, P0_[r]), P1_[r]); m1_ = fmaxf(fmaxf(m1_, P0_[r + 1]), P1_[r + 1]); m2_ = fmaxf(fmaxf(m2_, P0_[r + 2]), P1_[r + 2]); m3_ = fmaxf(fmaxf(m3_, P0_[r + 3]), P1_[r + 3]); } \
        pm_ = fmaxf(fmaxf(m0_, m1_), fmaxf(m2_, m3_)); \
        auto rr_ = __builtin_amdgcn_permlane32_swap(__float_as_uint(pm_), __float_as_uint(pm_), false, false); pm_ = fmaxf(__uint_as_float(rr_[0]), __uint_as_float(rr_[1])); } while (0)
#define SHIFT(P0_, P1_, dl_) do { m_reg += (dl_); _Pragma("unroll") for (int r = 0; r < 16; ++r) { P0_[r] -= (dl_); P1_[r] -= (dl_); } _Pragma("unroll") for (int r = 0; r < 16; ++r) negm[r] = -m_reg; } while (0)
#define EXP16(P_) do { if constexpr ((VAR & 1) == 0) { _Pragma("unroll") for (int r = 0; r < 16; ++r) P_[r] = __builtin_amdgcn_exp2f(P_[r]); } } while (0)
#define PACKP(P0_, P1_) do { \
        { u32x4 w_ = {pk2(P0_[0], P0_[1]), pk2(P0_[2], P0_[3]), pk2(P0_[4], P0_[5]), pk2(P0_[6], P0_[7])}; pa0 = __builtin_bit_cast(bf16x8, w_); } \
        { u32x4 w_ = {pk2(P0_[8], P0_[9]), pk2(P0_[10], P0_[11]), pk2(P0_[12], P0_[13]), pk2(P0_[14], P0_[15])}; pa1 = __builtin_bit_cast(bf16x8, w_); } \
        { u32x4 w_ = {pk2(P1_[0], P1_[1]), pk2(P1_[2], P1_[3]), pk2(P1_[4], P1_[5]), pk2(P1_[6], P1_[7])}; pa2 = __builtin_bit_cast(bf16x8, w_); } \
        { u32x4 w_ = {pk2(P1_[8], P1_[9]), pk2(P1_[10], P1_[11]), pk2(P1_[12], P1_[13]), pk2(P1_[14], P1_[15])}; pa3 = __builtin_bit_cast(bf16x8, w_); } } while (0)
#define SOFTMAX2(P0_, P1_, al_) do { EXP16(P1_); float ps_ = 0.f; _Pragma("unroll") for (int r = 0; r < 16; ++r) ps_ += P0_[r] + P1_[r]; \
        auto rr_ = __builtin_amdgcn_permlane32_swap(__float_as_uint(ps_), __float_as_uint(ps_), false, false); ps_ = __uint_as_float(rr_[0]) + __uint_as_float(rr_[1]); \
        l_reg = l_reg * (al_) + ps_; PACKP(P0_, P1_); } while (0)
    s16x4 vl[8], vh[8];
#define TRRD(dst, off) asm volatile("ds_read_b64_tr_b16 %0, %1 offset:%2" : "=&v"(dst) : "v"(vb_), "i"(off) : "memory")
#define VREAD(slot) do { const int vb_ = vb0 + (slot) * VSLOT; \
        TRRD(vl[0], 0); TRRD(vh[0], 512); TRRD(vl[1], 1024); TRRD(vh[1], 1536); TRRD(vl[2], 2048); TRRD(vh[2], 2560); TRRD(vl[3], 3072); TRRD(vh[3], 3584); \
        TRRD(vl[4], 4096); TRRD(vh[4], 4608); TRRD(vl[5], 5120); TRRD(vh[5], 5632); TRRD(vl[6], 6144); TRRD(vh[6], 6656); TRRD(vl[7], 7168); TRRD(vh[7], 7680); } while (0)
#define VF(i) (bf16x8){vl[i][0], vl[i][1], vl[i][2], vl[i][3], vh[i][0], vh[i][1], vh[i][2], vh[i][3]}
#define PVALL() do { if constexpr ((VAR & 32) != 0) { o[0][0] += (float)vl[0][0] + (float)vh[7][1] + (float)pa0[0] + (float)pa3[1]; } else if constexpr ((VAR & 8) != 0) { PVH(0); PVH(1); } else { \
        o[0] = __builtin_amdgcn_mfma_f32_32x32x16_bf16(pa0, VF(0), o[0], 0, 0, 0); o[1] = __builtin_amdgcn_mfma_f32_32x32x16_bf16(pa0, VF(4), o[1], 0, 0, 0); \
        o[0] = __builtin_amdgcn_mfma_f32_32x32x16_bf16(pa1, VF(1), o[0], 0, 0, 0); o[1] = __builtin_amdgcn_mfma_f32_32x32x16_bf16(pa1, VF(5), o[1], 0, 0, 0); \
        o[0] = __builtin_amdgcn_mfma_f32_32x32x16_bf16(pa2, VF(2), o[0], 0, 0, 0); o[1] = __builtin_amdgcn_mfma_f32_32x32x16_bf16(pa2, VF(6), o[1], 0, 0, 0); \
        o[0] = __builtin_amdgcn_mfma_f32_32x32x16_bf16(pa3, VF(3), o[0], 0, 0, 0); o[1] = __builtin_amdgcn_mfma_f32_32x32x16_bf16(pa3, VF(7), o[1], 0, 0, 0); } } while (0)
#define PVH(d0) do { if constexpr ((VAR & 8) != 0) { _Pragma("unroll") for (int e_ = 0; e_ < 4; ++e_) { o[d0][e_] += (float)vl[4 * (d0) + e_][0] + (float)vh[4 * (d0) + e_][1] + (float)pa0[e_] + (float)pa1[e_] + (float)pa2[e_] + (float)pa3[e_]; } } else { o[d0] = __builtin_amdgcn_mfma_f32_32x32x16_bf16(pa0, VF(4 * (d0) + 0), o[d0], 0, 0, 0); o[d0] = __builtin_amdgcn_mfma_f32_32x32x16_bf16(pa1, VF(4 * (d0) + 1), o[d0], 0, 0, 0); \
        o[d0] = __builtin_amdgcn_mfma_f32_32x32x16_bf16(pa2, VF(4 * (d0) + 2), o[d0], 0, 0, 0); o[d0] = __builtin_amdgcn_mfma_f32_32x32x16_bf16(pa3, VF(4 * (d0) + 3), o[d0], 0, 0, 0); } } while (0)
    f32x16 px0, px1; bf16x8 pa0, pa1, pa2, pa3;
#define TILE_VALU(al_) bf16x8 pn0, pn1, pn2, pn3; do { EXP16(px0); EXP16(px1); float s0_ = px0[0] + px1[0], s1_ = px0[1] + px1[1], s2_ = px0[2] + px1[2], s3_ = px0[3] + px1[3]; \
        _Pragma("unroll") for (int r = 4; r < 16; r += 4) { s0_ += px0[r] + px1[r]; s1_ += px0[r + 1] + px1[r + 1]; s2_ += px0[r + 2] + px1[r + 2]; s3_ += px0[r + 3] + px1[r + 3]; } \
        float ps_ = (s0_ + s1_) + (s2_ + s3_); \
        auto rr_ = __builtin_amdgcn_permlane32_swap(__float_as_uint(ps_), __float_as_uint(ps_), false, false); ps_ = __uint_as_float(rr_[0]) + __uint_as_float(rr_[1]); \
        l_reg = l_reg * (al_) + ps_; \
        { u32x4 w_ = {pk2(px0[0], px0[1]), pk2(px0[2], px0[3]), pk2(px0[4], px0[5]), pk2(px0[6], px0[7])}; pn0 = __builtin_bit_cast(bf16x8, w_); } \
        { u32x4 w_ = {pk2(px0[8], px0[9]), pk2(px0[10], px0[11]), pk2(px0[12], px0[13]), pk2(px0[14], px0[15])}; pn1 = __builtin_bit_cast(bf16x8, w_); } \
        { u32x4 w_ = {pk2(px1[0], px1[1]), pk2(px1[2], px1[3]), pk2(px1[4], px1[5]), pk2(px1[6], px1[7])}; pn2 = __builtin_bit_cast(bf16x8, w_); } \
        { u32x4 w_ = {pk2(px1[8], px1[9]), pk2(px1[10], px1[11]), pk2(px1[12], px1[13]), pk2(px1[14], px1[15])}; pn3 = __builtin_bit_cast(bf16x8, w_); } } while (0)
    if (primed) { WAIT_BAR(4); } else { WAIT_BAR(0); }
    asm volatile("" : "+v"(qr[0]), "+v"(qr[1]), "+v"(qr[2]), "+v"(qr[3]), "+v"(qr[4]), "+v"(qr[5]));
    {
        const float* ct_ = cosT + (size_t)(P0 + wid * 32 + r32) * 16 + 8 * hi; const float* st_ = ct_ + ROPE_TAB;
        const f32x4 c0 = *(const f32x4*)ct_, c1 = *(const f32x4*)(ct_ + 4), s0 = *(const f32x4*)st_, s1 = *(const f32x4*)(st_ + 4);
        const u32x4 w1 = __builtin_bit_cast(u32x4, qr[4]), w2 = __builtin_bit_cast(u32x4, qr[5]);
        const f32x4 x1a = {bflo(w1.x), bfhi(w1.x), bflo(w1.y), bfhi(w1.y)}, x1b = {bflo(w1.z), bfhi(w1.z), bflo(w1.w), bfhi(w1.w)};
        const f32x4 x2a = {bflo(w2.x), bfhi(w2.x), bflo(w2.y), bfhi(w2.y)}, x2b = {bflo(w2.z), bfhi(w2.z), bflo(w2.w), bfhi(w2.w)};
        const f32x4 o1a = x1a * c0 - x2a * s0, o1b = x1b * c1 - x2b * s1, o2a = x1a * s0 + x2a * c0, o2b = x1b * s1 + x2b * c1;
        u32x4 r1 = {pk2(o1a.x, o1a.y), pk2(o1a.z, o1a.w), pk2(o1b.x, o1b.y), pk2(o1b.z, o1b.w)}, r2 = {pk2(o2a.x, o2a.y), pk2(o2a.z, o2a.w), pk2(o2b.x, o2b.y), pk2(o2b.z, o2b.w)};
        qr[4] = __builtin_bit_cast(bf16x8, r1); qr[5] = __builtin_bit_cast(bf16x8, r2); }
    const bool trail = wid >= 4;
#define PBAR_M(t) do { if ((t) + 3 < NT) { WAIT_BAR(6); } else { WAIT_BAR(0); } } while (0)
#define PBAR_V(t) do { if ((t) + 3 < NT) { WAIT_BAR(6); } else { WAIT_BAR(0); } } while (0)
    if (trail) WAIT_BAR(0);
    DMA_K(3, 3); DMA_V(2, 2);
    KLOAD(0); QK(px0, px1);
    PBAR_V(0);
    MASKT(px0, px1, 0);
    { float pm; ROWMAX(px0, px1, pm); SHIFT(px0, px1, pm); TILE_VALU(1.f); pa0 = pn0; pa1 = pn1; pa2 = pn2; pa3 = pn3; }
    int sk = 1, sv = 0;
#pragma unroll 1
    for (int t = 1; t < NT; ++t) {
        PBAR_M(t);
        { if (t + 3 < NT) DMA_K(t + 3, (sk + 3) & 3); if (t + 2 < NT) DMA_V(t + 2, (sk + 2) & 3); }
        SBAR();
        KLOAD(sk); VREAD(sv);
        SBAR();
        QK(px0, px1);
        SBAR(); asm volatile("s_waitcnt lgkmcnt(0)" ::: "memory"); SBAR();
        PVALL();
        PBAR_V(t);
        MASKT(px0, px1, t);
        float pm_, alX = 1.f; ROWMAX(px0, px1, pm_);
        if (__builtin_expect(__any(pm_ > THR), 0)) { const float dl_ = fmaxf(pm_, 0.f); SHIFT(px0, px1, dl_); alX = __builtin_amdgcn_exp2f(-dl_); }
        TILE_VALU(alX);
        pa0 = pn0; pa1 = pn1; pa2 = pn2; pa3 = pn3;
        RESC(alX);
        sk = (sk + 1) & 3; sv = (sv + 1) & 3;
    }
    WAIT_BAR(0);
    VREAD(sv); asm volatile("s_waitcnt lgkmcnt(0)" ::: "memory"); SBAR(); PVALL();
    if (!trail) WAIT_BAR(0);
    if (has_next) PRIME(nb_, nh_, nqb_);
#undef PBAR_M
#undef PBAR_V
    if (hi == 0) li_l[r32] = l_reg; asm volatile("s_waitcnt lgkmcnt(0)" ::: "memory");
    bf16* Ow = OB + (rowbase + P0 + wid * 32) * DM + h * 64;
    {
        LAS bf16* stg = (LAS bf16*)(lds + LDS_OST) + wid * 2048;
#pragma unroll
        for (int r = 0; r < 16; ++r) { const int orow = crow(r, hi); const float rl = __builtin_amdgcn_rcpf(li_l[orow]);
#pragma unroll
            for (int d0 = 0; d0 < 2; ++d0) stg[orow * 64 + d0 * 32 + r32] = f2bf(o[d0][r] * rl); }
        asm volatile("s_waitcnt lgkmcnt(0)" ::: "memory");
#pragma unroll
        for (int i4 = 0; i4 < 4; ++i4) { const int row = i4 * 8 + (lane >> 3), ch = lane & 7; const u32x4 v = *(const LAS u32x4*)(stg + row * 64 + ch * 8); *(u32x4*)(Ow + (size_t)row * DM + ch * 8) = v; }
    }
    if (!has_next) WAIT_BAR(0);
#undef PRIME
#undef TT
#undef DMA_K
#undef DMA_V
#undef KLOAD
#undef QK
#undef RESC
#undef MASKT
#undef ROWMAX
#undef SHIFT
#undef EXP16
#undef PACKP
#undef SOFTMAX2
#undef TILE_VALU
#undef TRRD
#undef VREAD
#undef VF
#undef PVH
#undef PVALL
#undef STEP
}
#undef SBAR
#undef SGB
#undef WAIT_BAR
}

#ifndef MK_PER_PHASE
#define MK_PER_PHASE 0
#endif
#ifndef REPEAT_MASK
#define REPEAT_MASK 0
#endif
#ifndef ATT_SHADOW
#define ATT_SHADOW -1
#endif
#ifndef P7_ONLY
#define P7_ONLY 0
#endif
__device__ __forceinline__ int q_grab(unsigned* que, LAS int* slot, int wv) {
    if (wv == 0) { if (lane_id() == 0) *slot = (int)__hip_atomic_fetch_add(que, 1u, __ATOMIC_RELAXED, __HIP_MEMORY_SCOPE_AGENT); }
    __syncthreads();
    const int r = __builtin_amdgcn_readfirstlane(*slot);
    __syncthreads();
    return r;
}
constexpr int N_PHASES = 17;
__global__ void __launch_bounds__(NWAVES * 64, 2) hybrid_fwd(Args args) {
    extern __shared__ __attribute__((aligned(16))) unsigned char lds_raw[];
    LAS unsigned char* lds = (LAS unsigned char*)lds_raw;
    const int wv0 = __builtin_amdgcn_readfirstlane(threadIdx.x >> 6);
    for (int u = threadIdx.x; u < (LDS_BYTES - LDSCTL_OFF) / 4; u += NWAVES * 64) ((LAS unsigned*)(lds + LDSCTL_OFF))[u] = 0u;
    __syncthreads();
    if (!MK_PER_PHASE) (void)xcd_barrier_post((unsigned*)((unsigned char*)args.in[I_WS] + WS_CTL) + CW_BAR, (volatile LAS unsigned*)(lds + MISC_OFF) + 8);
    const int lo = args.ph_lo, hi = args.ph_hi;
#define IN(k) (lo <= (k) && (k) < hi)
#define PH_BEGIN int z = 0; asm volatile("" : "+s"(z)); int tid = TIDW(wv0); asm volatile("" : "+v"(tid)); const int lane = tid & 63, wave = wv0; \
    const int G = gridDim.x; const int bx = blockIdx.x; const int vcu = (G % 8 == 0) ? (bx % 8) * (G / 8) + bx / 8 : bx; unsigned char* ws = (unsigned char*)args.in[I_WS + z]; \
    LAS unsigned char* ring = lds + RING_OFF; (void)lane; (void)wave; (void)vcu; (void)ws; (void)ring; (void)tid;
#define SEAM(k) do { if (IN(k) && IN((k) + 1)) { int zb = 0; asm volatile("" : "+s"(zb)); XcdBarrier bar; bar.bar = (unsigned*)((unsigned char*)args.in[I_WS + zb] + WS_CTL) + CW_BAR; bar.x = xb_xcc_id(); \
        bar.st = (volatile LAS unsigned*)(lds + MISC_OFF) + 8; bar.t0 = (TIDW(wv0) == 0); xcd_barrier(bar); } } while (0)
    typedef pg8::StaticOrder SO;
#define GBAR() do { int zb = 0; asm volatile("" : "+s"(zb)); XcdBarrier bar; bar.bar = (unsigned*)((unsigned char*)args.in[I_WS + zb] + WS_CTL) + CW_BAR; bar.x = xb_xcc_id(); \
        bar.st = (volatile LAS unsigned*)(lds + MISC_OFF) + 8; bar.t0 = (TIDW(wv0) == 0); xcd_barrier(bar); } while (0)
#define BAR_ARRIVE() do { int zb = 0; asm volatile("" : "+s"(zb)); XcdBarrier bar; bar.bar = (unsigned*)((unsigned char*)args.in[I_WS + zb] + WS_CTL) + CW_BAR; bar.x = xb_xcc_id(); \
        bar.st = (volatile LAS unsigned*)(lds + MISC_OFF) + 8; bar.t0 = (TIDW(wv0) == 0); xcd_barrier_arrive(bar); } while (0)
#define BAR_FINISH() do { int zb = 0; asm volatile("" : "+s"(zb)); XcdBarrier bar; bar.bar = (unsigned*)((unsigned char*)args.in[I_WS + zb] + WS_CTL) + CW_BAR; bar.x = xb_xcc_id(); \
        bar.st = (volatile LAS unsigned*)(lds + MISC_OFF) + 8; bar.t0 = (TIDW(wv0) == 0); xcd_barrier_finish(bar); } while (0)
#define PHASE(k, ...) if (IN(k)) { { constexpr int rep = 0; (void)rep; __VA_ARGS__ } if constexpr (((REPEAT_MASK) >> (k)) & 1) { GBAR(); { constexpr int rep = 1; (void)rep; __VA_ARGS__ } } }

    PHASE(0, { PH_BEGIN p0_prologue(args, lds, vcu, G, tid, lane, wave); })
    SEAM(0);
    PHASE(1, { PH_BEGIN pg8::Gemm g{(const bf16*)(ws + WS_XN), (const bf16*)(ws + WS_BUP1), MT, 2 * DFF, DM}; SO S; S.init(MT, 2 * DFF, G, bx);
        pg8::Epi<pg8::EM_SWIGLU> E{(bf16*)(ws + WS_H), DFF, nullptr, 0, nullptr, 0, 1.f};
        pg8::gemm_phase<pg8::Epi<pg8::EM_SWIGLU>, SO, true, true>(ring, g, S, E, wv0);
        if (rep == 0) convert_in_tail(args, lds, S.nwg, G, bx, CV_A, CV_B, wv0); })
    SEAM(1);
    PHASE(2, { PH_BEGIN sgemm_sample<pg8::EM_PLAIN, DFF>(lds, (const bf16*)(ws + WS_H), (const bf16*)(ws + WS_BDN1), DM, (bf16*)(ws + WS_F), DM, nullptr, 0, nullptr, 0, vcu, G, wv0, (unsigned*)(ws + WS_CTL) + CW_SN + 0 * 8 * 64);
        pg8::Gemm g{(const bf16*)(ws + WS_H), (const bf16*)(ws + WS_BDN1), MP, DM, DFF}; SO S; S.init(MP, DM, G, bx);
        pg8::EpiNorm<1, 0> E{(const float*)args.in[I_XP + z], (bf16*)(ws + WS_XR), (bf16*)(ws + WS_XN), nullptr, (const float*)args.in[I_F1POST + z], (const float*)args.in[I_MIXPRE + z], 0.5f, (float*)(ws + WS_NSLOT) + (size_t)0 * 2 * 64 * 256 * 4, (unsigned*)(ws + WS_CTL) + CW_PN + 0 * 2 * 64 * 64, nullptr};
        pg8::gemm_phase<pg8::EpiNorm<1, 0>, SO, true, true>(ring, g, S, E, wv0);
        sample_norm<1, 0>(args, (unsigned*)(ws + WS_CTL) + CW_SN + 0 * 8 * 64, (const bf16*)(ws + WS_F), 0.5f, I_F1POST, I_MIXPRE, G, vcu, wv0); })
    SEAM(3);
    PHASE(4, { PH_BEGIN pg8::Gemm g{(const bf16*)(ws + WS_XN), (const bf16*)(ws + WS_BIN), MT, ZW, DM}; SO S; S.init(MT, ZW, G, bx);
        pg8::Epi<pg8::EM_WIN> E{(bf16*)(ws + WS_Z), ZW, nullptr, 0, nullptr, 0, 1.f};
        pg8::gemm_phase<pg8::Epi<pg8::EM_WIN>, SO, true, true>(ring, g, S, E, wv0);
        if (rep == 0) convert_in_tail(args, lds, S.nwg, G, bx, CV_B, CV_N, wv0); })
    SEAM(4);
    PHASE(5, { PH_BEGIN
        for (int u = vcu; u < 256; u += G) lru_cu_unit<1>(args, lds, u, wv0);
        mla_prep(args, vcu, G, lane, wave);
    })
    SEAM(5);
    PHASE(6, {
        { PH_BEGIN for (int u = vcu; u < 256; u += G) lru_cu_unit<2>(args, lds, u, wv0); }
        __syncthreads();
        { PH_BEGIN sgemm_sample<pg8::EM_PLAIN, QL>(lds, (const bf16*)(ws + WS_CQ), (const bf16*)(ws + WS_BQ), QW, (bf16*)(ws + WS_Q), QW, nullptr, 0, nullptr, 0, vcu, G, wv0);
          sgemm_sample<pg8::EM_PLAIN, DPLE>(lds, (const bf16*)(ws + WS_PB), (const bf16*)(ws + WS_BPP), DM, (bf16*)(ws + WS_PPB), DM, nullptr, 0, nullptr, 0, vcu, G, wv0); }
    })
    SEAM(6);
    PHASE(7, {
        bool dec7;
        { PH_BEGIN const int nq = (G % 8 == 0) ? 8 : 1, q = (nq == 8) ? (bx & 7) : 0, ci = (nq == 8) ? (bx >> 3) : bx, cpq = G / nq, ndq = (NDEC / nq < cpq) ? NDEC / nq : cpq;
          const bool early = EARLY_DEC && (G == 256); dec7 = early && ci < ndq;
          if (!dec7) {
            const int Gp = early ? G - ndq * nq : G, cp = early ? (ci - ndq) * 8 + q : bx, vcup = early ? q * (cpq - ndq) + (ci - ndq) : vcu;
            sgemm_sample<pg8::EM_MULZ, DRNN>(lds, (const bf16*)(ws + WS_HG), (const bf16*)(ws + WS_BRNN), DM, (bf16*)(ws + WS_YAG), DM, (const bf16*)(ws + WS_Z) + Z_GA, ZW, nullptr, 0, vcup, Gp, wv0);
            { pg8::Gemm g{(const bf16*)(ws + WS_CQ), (const bf16*)(ws + WS_BQ), MP, QW, QL}; SO S; S.init(MP, QW, Gp, cp);
              pg8::Epi<pg8::EM_PLAIN> E{(bf16*)(ws + WS_Q), QW, nullptr, 0, nullptr, 0, 1.f};
              pg8::gemm_phase<pg8::Epi<pg8::EM_PLAIN>, SO, true, true>(ring, g, S, E, wv0); } } }
        if (!dec7) { PH_BEGIN const int nq = (G % 8 == 0) ? 8 : 1, q = (nq == 8) ? (bx & 7) : 0, ci = (nq == 8) ? (bx >> 3) : bx, cpq = G / nq, ndq = (NDEC / nq < cpq) ? NDEC / nq : cpq;
          const bool early = EARLY_DEC && (G == 256); const int Gp = early ? G - ndq * nq : G, cp = early ? (ci - ndq) * 8 + q : bx;
          pg8::Gemm g{(const bf16*)(ws + WS_CKV), (const bf16*)(ws + WS_BKV), MP, KVW, KVL}; SO S; S.init(MP, KVW, Gp, cp);
          pg8::Epi<pg8::EM_PLAIN> E{(bf16*)(ws + WS_KVB), KVW, nullptr, 0, nullptr, 0, 1.f};
          pg8::gemm_phase<pg8::Epi<pg8::EM_PLAIN>, SO, true, true>(ring, g, S, E, wv0); }
        BAR_ARRIVE();
        if (!dec7) BAR_FINISH();
    })
    PHASE(8, { PH_BEGIN
        const int nq = (G % 8 == 0) ? 8 : 1, q = (nq == 8) ? (bx & 7) : 0, ci = (nq == 8) ? (bx >> 3) : bx, cpq = G / nq;
        {
            const int ndq = (NDEC / nq < cpq) ? NDEC / nq : cpq, nd = ndq * nq;
            if (ci < ndq) {
                _Pragma("unroll 1") for (int sq = q * ndq + ci; sq < NS; sq += nd) {
                    sample_attn_seq(args, lds, sq, wv0);
                }
                __syncthreads();
                if (EARLY_DEC && G == 256) BAR_FINISH();
            }
        }
        {
            unsigned* que = (unsigned*)(ws + WS_CTL) + CW_QUE + 64 * q;
            LAS int* slot = (LAS int*)(lds + MISC_OFF) + 64;
            const int hq = 32 / nq, nblk = 32 * hq, npq = 64 / nq, ny = 4 * npq, ya0 = nblk - 10, nitem = nblk + ny;
            int cur = q_grab(que, slot, wv0), nxt = nitem; if (cur < nitem) nxt = q_grab(que, slot, wv0);
            _Pragma("unroll 1") while (cur < nitem) {
                if (cur >= ya0 && cur < ya0 + ny) {
                    const int t = cur - ya0;
                    pg8::Gemm g{(const bf16*)(ws + WS_HG), (const bf16*)(ws + WS_BRNN), MP, DM, DRNN}; pg8::OneUnit T; T.u.pm = q * npq + (t % npq); T.u.pn = t / npq;
                    pg8::Epi<pg8::EM_MULZ> E{(bf16*)(ws + WS_YAG), DM, (const bf16*)(ws + WS_Z) + Z_GA, ZW, nullptr, 0, 1.f};
                    pg8::gemm_phase<pg8::Epi<pg8::EM_MULZ>, pg8::OneUnit, true, true>(ring, g, T, E, wv0);
                    cur = nxt; if (cur < nitem) nxt = q_grab(que, slot, wv0);
                    continue;
                }
                bf16x8 qr[6]; bool primed = false, more;
                do {
                    const int kc = cur < ya0 ? cur : cur - ny, bh = hq * q + 2 * (kc >> 6) + (kc & 1), qb = 31 - ((kc & 63) >> 1);
                    more = nxt < nitem && !(nxt >= ya0 && nxt < ya0 + ny);
                    const int kn = more ? (nxt < ya0 ? nxt : nxt - ny) : 0, bhn = hq * q + 2 * (kn >> 6) + (kn & 1), qbn = 31 - ((kn & 63) >> 1);
                    pattn4::block<0>((const bf16*)(ws + WS_Q), (const bf16*)(ws + WS_KVB), (const bf16*)(ws + WS_KR), (const float*)(ws + WS_ROPE), (bf16*)(ws + WS_OB), lds, bh >> 4, bh & 15, qb, 0, wv0,
                                     primed, more, bhn >> 4, bhn & 15, qbn, qr);
                    primed = true; cur = nxt; if (cur < nitem) nxt = q_grab(que, slot, wv0);
                } while (more);
            }
        }
        __syncthreads();
#if ATT_SHADOW >= 0
        GBAR();
        { int z2 = 0; asm volatile("" : "+s"(z2)); unsigned char* ws2 = (unsigned char*)args.in[I_WS + z2];
          const int G2 = gridDim.x, bx2 = blockIdx.x, vcu2 = (G2 % 8 == 0) ? (bx2 % 8) * (G2 / 8) + bx2 / 8 : bx2;
          bf16x8 qrs[6];
          for (int L = vcu2; L < 512; L += G2) { const int bh = L >> 4, x = L & 15;
            pattn4::block<ATT_SHADOW>((const bf16*)(ws2 + WS_Q), (const bf16*)(ws2 + WS_KVB), (const bf16*)(ws2 + WS_KR), (const float*)(ws2 + WS_ROPE), (bf16*)(ws2 + WS_END), lds, bh >> 4, bh & 15, x, 0, wv0, false, false, 0, 0, 0, qrs);
            pattn4::block<ATT_SHADOW>((const bf16*)(ws2 + WS_Q), (const bf16*)(ws2 + WS_KVB), (const bf16*)(ws2 + WS_KR), (const float*)(ws2 + WS_ROPE), (bf16*)(ws2 + WS_END), lds, bh >> 4, bh & 15, 31 - x, 0, wv0, false, false, 0, 0, 0, qrs); } }
        __syncthreads();
#endif
    })
    SEAM(8);
    PHASE(9, { PH_BEGIN sgemm_sample<pg8::EM_FMAZ, DM>(lds, (const bf16*)(ws + WS_OB), (const bf16*)(ws + WS_BATT), DM, (bf16*)(ws + WS_MX), DM, (const bf16*)(ws + WS_Z) + Z_GB, ZW, (const bf16*)(ws + WS_YAG), DM, vcu, G, wv0);
        pg8::Gemm g{(const bf16*)(ws + WS_OB), (const bf16*)(ws + WS_BATT), MP, DM, DM}; SO S; S.init(MP, DM, G, bx);
        pg8::Epi<pg8::EM_FMAZ> E{(bf16*)(ws + WS_MX), DM, (const bf16*)(ws + WS_Z) + Z_GB, ZW, (const bf16*)(ws + WS_YAG), DM, 1.f};
        pg8::gemm_phase<pg8::Epi<pg8::EM_FMAZ>, SO, true, true>(ring, g, S, E, wv0); })
    SEAM(9);
    PHASE(10, { PH_BEGIN sgemm_sample<pg8::EM_PLAIN, DM>(lds, (const bf16*)(ws + WS_MX), (const bf16*)(ws + WS_BOUT), DM, (bf16*)(ws + WS_F), DM, nullptr, 0, nullptr, 0, vcu, G, wv0, (unsigned*)(ws + WS_CTL) + CW_SN + 1 * 8 * 64);
        pg8::Gemm g{(const bf16*)(ws + WS_MX), (const bf16*)(ws + WS_BOUT), MP, DM, DM}; SO S; S.init(MP, DM, G, bx);
        pg8::EpiNorm<1, 1> E{nullptr, (bf16*)(ws + WS_XR), (bf16*)(ws + WS_XN), nullptr, (const float*)args.in[I_MIXPOST + z], (const float*)args.in[I_F2PRE + z], 1.0f, (float*)(ws + WS_NSLOT) + (size_t)1 * 2 * 64 * 256 * 4, (unsigned*)(ws + WS_CTL) + CW_PN + 1 * 2 * 64 * 64, nullptr};
        pg8::gemm_phase<pg8::EpiNorm<1, 1>, SO, true, true>(ring, g, S, E, wv0);
        sample_norm<1, 1>(args, (unsigned*)(ws + WS_CTL) + CW_SN + 1 * 8 * 64, (const bf16*)(ws + WS_F), 1.0f, I_MIXPOST, I_F2PRE, G, vcu, wv0); })
    SEAM(11);
    PHASE(12, { PH_BEGIN pg8::Gemm g{(const bf16*)(ws + WS_XN), (const bf16*)(ws + WS_BUP2), MT, 2 * DFF, DM}; SO S; S.init(MT, 2 * DFF, G, bx);
        pg8::Epi<pg8::EM_SWIGLU> E{(bf16*)(ws + WS_H), DFF, nullptr, 0, nullptr, 0, 1.f};
        pg8::gemm_phase<pg8::Epi<pg8::EM_SWIGLU>, SO, true, true>(ring, g, S, E, wv0); }
        { PH_BEGIN const int nwg0 = (MT / 256) * (2 * DFF / 256), full = (nwg0 + G - 1) / G, nl = full * G - nwg0;
          if (nl == 0 || bx >= G - nl) { pg8::Gemm g2{(const bf16*)(ws + WS_PB), (const bf16*)(ws + WS_BPP), MP, DM, DPLE}; SO T; T.init(MP, DM, nl == 0 ? G : nl, nl == 0 ? bx : bx - (G - nl));
            pg8::Epi<pg8::EM_PLAIN> E2{(bf16*)(ws + WS_PPB), DM, nullptr, 0, nullptr, 0, 1.f};
            pg8::gemm_phase<pg8::Epi<pg8::EM_PLAIN>, SO, true, true>(ring, g2, T, E2, wv0); } } )
    SEAM(12);
    PHASE(13, { PH_BEGIN sgemm_sample<pg8::EM_PLAIN, DFF>(lds, (const bf16*)(ws + WS_H), (const bf16*)(ws + WS_BDN2), DM, (bf16*)(ws + WS_F), DM, nullptr, 0, nullptr, 0, vcu, G, wv0, (unsigned*)(ws + WS_CTL) + CW_SN + 2 * 8 * 64);
        pg8::Gemm g{(const bf16*)(ws + WS_H), (const bf16*)(ws + WS_BDN2), MP, DM, DFF}; SO S; S.init(MP, DM, G, bx);
        pg8::EpiNorm<2, 1> E{nullptr, (bf16*)(ws + WS_XR), (bf16*)(ws + WS_XN), nullptr, (const float*)args.in[I_F2POST + z], nullptr, 0.5f, (float*)(ws + WS_NSLOT) + (size_t)2 * 2 * 64 * 256 * 4, (unsigned*)(ws + WS_CTL) + CW_PN + 2 * 2 * 64 * 64, nullptr};
        pg8::gemm_phase<pg8::EpiNorm<2, 1>, SO, true, true>(ring, g, S, E, wv0);
        sample_norm<2, 1>(args, (unsigned*)(ws + WS_CTL) + CW_SN + 2 * 8 * 64, (const bf16*)(ws + WS_F), 0.5f, I_F2POST, I_F2POST, G, vcu, wv0); })
    SEAM(14);
    PHASE(15, { PH_BEGIN sgemm_sample<pg8::EM_SIGMUL, DM>(lds, (const bf16*)(ws + WS_XN), (const bf16*)(ws + WS_BPG), DM, (bf16*)(ws + WS_F), DM, (const bf16*)(ws + WS_PPB), DM, nullptr, 0, vcu, G, wv0, (unsigned*)(ws + WS_CTL) + CW_SN + 3 * 8 * 64);
        pg8::Gemm g{(const bf16*)(ws + WS_XN), (const bf16*)(ws + WS_BPG), MP, DM, DM}; SO S; S.init(MP, DM, G, bx);
        pg8::EpiNorm<0, 2, 1> E{nullptr, nullptr, (bf16*)(ws + WS_XN), (float*)args.in[I_OUT + z] + O_Y, (const float*)args.in[I_PPOST + z], nullptr, 1.0f, (float*)(ws + WS_NSLOT) + (size_t)3 * 2 * 64 * 256 * 4, (unsigned*)(ws + WS_CTL) + CW_PN + 3 * 2 * 64 * 64, (const bf16*)(ws + WS_PPB)};
        pg8::gemm_phase<pg8::EpiNorm<0, 2, 1>, SO, true, true>(ring, g, S, E, wv0);
        sample_norm<0, 2>(args, (unsigned*)(ws + WS_CTL) + CW_SN + 3 * 8 * 64, (const bf16*)(ws + WS_F), 1.0f, I_PPOST, I_PPOST, G, vcu, wv0); })
#undef IN
#undef SEAM
#undef PHASE
#undef GBAR
#undef PH_BEGIN
}

extern "C" void kernel_launch(void* const* d_in, const int* in_sizes, int n_in, void* d_out, int out_size, void* d_ws, size_t ws_size, hipStream_t stream) {
    static int grid = 0;
    if (grid == 0) {
        if (n_in != N_IN || (size_t)out_size != O_END || ws_size < WS_END) { fprintf(stderr, "kernel_launch: unexpected shapes (n_in %d, out %d, ws %zu)\n", n_in, out_size, ws_size); grid = -1; return; }
        int dev = 0, cus = 0, per_cu = 0;
        if (hipGetDevice(&dev) != hipSuccess || hipDeviceGetAttribute(&cus, hipDeviceAttributeMultiprocessorCount, dev) != hipSuccess) { grid = -1; return; }
        if (hipFuncSetAttribute((const void*)hybrid_fwd, hipFuncAttributeMaxDynamicSharedMemorySize, LDS_BYTES) != hipSuccess) { fprintf(stderr, "kernel_launch: hipFuncSetAttribute failed\n"); grid = -1; return; }
        if (hipOccupancyMaxActiveBlocksPerMultiprocessor(&per_cu, (const void*)hybrid_fwd, NWAVES * 64, LDS_BYTES) != hipSuccess || per_cu < 1) { fprintf(stderr, "kernel_launch: occupancy query says %d\n", per_cu); }
        (void)hipGetLastError();
        grid = cus;
    }
    if (grid < 0) return;
    (void)hipMemsetAsync((char*)d_ws + WS_CTL, 0, CTL_ZERO_BYTES, stream);
    Args a{};
    for (int i = 0; i < N_IN; ++i) a.in[i] = d_in[i];
    a.in[I_OUT] = d_out; a.in[I_WS] = d_ws; a.pad = 0;
#if MK_PER_PHASE
    for (int p = 0; p < N_PHASES; ++p) { a.ph_lo = p; a.ph_hi = p + 1; a.li = p; hipLaunchKernelGGL(hybrid_fwd, dim3(grid), dim3(NWAVES * 64), LDS_BYTES, stream, a); }
#else
    a.ph_lo = 0; a.ph_hi = N_PHASES; a.li = 0;
    hipLaunchKernelGGL(hybrid_fwd, dim3(grid), dim3(NWAVES * 64), LDS_BYTES, stream, a);
#endif
    const hipError_t le = hipPeekAtLastError();
    if (le != hipSuccess) fprintf(stderr, "kernel_launch: launch failed: %s\n", hipGetErrorName(le));
}
```

```cpp
#include <hip/hip_runtime.h>
#include <cstdio>
#include <cstdint>

#define GAS __attribute__((address_space(1)))
#define LAS __attribute__((address_space(3)))
typedef unsigned short bf16;
typedef short bf16x8 __attribute__((ext_vector_type(8)));
typedef short s16x4 __attribute__((ext_vector_type(4)));
typedef float f32x2 __attribute__((ext_vector_type(2)));
typedef float f32x4 __attribute__((ext_vector_type(4)));
typedef float f32x16 __attribute__((ext_vector_type(16)));
typedef unsigned u32x2 __attribute__((ext_vector_type(2)));
typedef unsigned u32x4 __attribute__((ext_vector_type(4)));
typedef __bf16 bf16x2_t __attribute__((ext_vector_type(2)));

constexpr int DM = 1024, SEQ = 8192, NBATCH = 2, MP = NBATCH * SEQ, NS = 128, MT = 16640, NMT = MT / 256;
constexpr int DFF = 2816, DRNN = 1280, NBLK = 16, BLK = 80, QL = 384, KVL = 256, ROPE = 32, NH = 16;
constexpr int DPLE = 256, DIN = 5280, ZW = 5376;
constexpr int Z_XR = 0, Z_YR = 1280, Z_CQ = 2560, Z_KV = 2944, Z_KR = 3200, Z_GA = 3328, Z_GB = 4352;
constexpr int QW = 1536, KVW = 2048;
constexpr int PAGE = 128, NPAGES = 64;
constexpr float EPS = 1e-6f;
constexpr float C2 = 0.10206207261596577f * 1.4426950408889634f;
constexpr size_t O_Y = 0, O_CKV_P = 16908288, O_KR_P = 21102592, O_H_P = 21626880, O_CONV_P = 21629440, O_CKV_S = 21637120, O_KR_S = 21669888, O_H_S = 21673984, O_CONV_S = 21837824, O_END = 22329344;
enum { I_XP = 0, I_XS, I_PP, I_PS, I_CCKV, I_CKR, I_SH, I_SCONV, I_PT, I_F1PRE, I_F1G, I_F1U, I_F1D, I_F1POST, I_MIXPRE, I_WIN, I_CONVW, I_CONVB, I_LWA, I_LBA, I_LWI, I_LBI, I_LAM,
       I_WRNN, I_QNORM, I_WUQ, I_WQR, I_KVNORM, I_WUK, I_WUV, I_WATT, I_WOUT, I_MIXPOST, I_F2PRE, I_F2G, I_F2U, I_F2D, I_F2POST, I_PG, I_PPJ, I_PPOST, N_IN, I_OUT = N_IN, I_WS, N_PTR };

constexpr size_t MiB = 1u << 20;
constexpr size_t WS_CTL = 0, CTL_ZERO_BYTES = 256 * 1024;
constexpr size_t WS_BUP1 = 2 * MiB, WS_BDN1 = 13 * MiB, WS_BIN = 19 * MiB, WS_BRNN = 30 * MiB, WS_BQ = 33 * MiB, WS_BKV = 35 * MiB, WS_BATT = 36 * MiB, WS_BOUT = 38 * MiB,
                 WS_BUP2 = 40 * MiB, WS_BDN2 = 51 * MiB, WS_BPG = 57 * MiB, WS_BPP = 59 * MiB, WS_LW = 60 * MiB, WS_ROPE = 61 * MiB, WS_SUM = 63 * MiB;
constexpr size_t WS_XN = 64 * MiB, WS_F = 97 * MiB, WS_H = 130 * MiB, WS_XR = 220 * MiB, WS_Z = 285 * MiB, WS_CQ = 456 * MiB, WS_CKV = 469 * MiB, WS_KR = 478 * MiB, WS_Q = 480 * MiB,
                 WS_KVB = 529 * MiB, WS_PB = 593 * MiB, WS_PPB = 602 * MiB, WS_HG = 635 * MiB, WS_YAG = 676 * MiB, WS_OB = 709 * MiB, WS_MX = 742 * MiB, WS_PART = 775 * MiB, WS_NSLOT = 808 * MiB, WS_END = 810 * MiB;
constexpr int ROPE_TAB = 8193 * 16;
constexpr int PART_STRIDE = 16 * 256 + 32;
constexpr int CW_BAR = 4096;
constexpr int CW_PN = 8192;
constexpr int CW_SN = 49152;
constexpr int CW_QUE = 2048;
#ifndef EARLY_DEC
#define EARLY_DEC 0
#endif
#ifndef NDEC
#define NDEC 64
#endif

__device__ __forceinline__ float bflo(unsigned w) { return __uint_as_float(w << 16); }
__device__ __forceinline__ float bfhi(unsigned w) { return __uint_as_float(w & 0xffff0000u); }
__device__ __forceinline__ float bf2f(bf16 v) { return __uint_as_float((unsigned)v << 16); }
__device__ __forceinline__ unsigned pk2(float lo, float hi) { f32x2 v = {lo, hi}; bf16x2_t b = __builtin_convertvector(v, bf16x2_t); return __builtin_bit_cast(unsigned, b); }
__device__ __forceinline__ bf16 f2bf(float f) { return (bf16)(pk2(f, 0.f) & 0xffffu); }
__device__ __forceinline__ float sigmoid_f(float x) { return __builtin_amdgcn_rcpf(1.f + __builtin_amdgcn_exp2f(-1.4426950408889634f * x)); }
__device__ __forceinline__ float silu_f(float x) { return x * sigmoid_f(x); }
__device__ __forceinline__ float gelu_tanh_f(float x) { const float u = 0.7978845608028654f * (x + 0.044715f * x * x * x); return x * sigmoid_f(2.f * u); }
__device__ __forceinline__ float wave_sum(float v) {
#define WS_DPP(ctrl) v += __uint_as_float((unsigned)__builtin_amdgcn_update_dpp(0, (int)__float_as_uint(v), ctrl, 0xf, 0xf, false))
    WS_DPP(0xB1); WS_DPP(0x4E); WS_DPP(0x141); WS_DPP(0x140);
#undef WS_DPP
    { const unsigned u = __float_as_uint(v); const auto r = __builtin_amdgcn_permlane16_swap(u, u, false, false); v = __uint_as_float(r[0]) + __uint_as_float(r[1]); }
    { const unsigned u = __float_as_uint(v); const auto r = __builtin_amdgcn_permlane32_swap(u, u, false, false); v = __uint_as_float(r[0]) + __uint_as_float(r[1]); }
    return v;
}
__device__ __forceinline__ int lane_id() { return (int)__builtin_amdgcn_mbcnt_hi(~0u, __builtin_amdgcn_mbcnt_lo(~0u, 0u)); }
#define TIDW(wv) ((wv) * 64 + lane_id())
#define LDS_WAIT() asm volatile("s_waitcnt lgkmcnt(0)" ::: "memory")
#define VM_WAIT() asm volatile("s_waitcnt vmcnt(0)" ::: "memory")

namespace pg8 {
typedef unsigned short bf16_t;
constexpr int BM = 256, BK = 64, HALF = 128, HTB = HALF * BK * 2, STAGE_BYTES = 8 * HTB, NXCD = 8, WGM = 8;
__host__ __device__ __forceinline__ int lds_byte(int r, int c) { const int st = (r >> 4) * 2 + (c >> 5), rr = r & 15, cc = c & 31, ob = rr * 64 + cc * 2; return st * 1024 + (ob ^ (((ob >> 9) & 1) << 5)); }
__host__ __device__ __forceinline__ void stage_rc(int b, int& R, int& C) { const int st = b / 1024, sb = b % 1024, swz = sb ^ (((sb >> 9) & 1) << 5); R = (st >> 1) * 16 + swz / 64; C = (st & 1) * 32 + (swz % 64) / 2; }
__host__ __device__ __forceinline__ int perm32(int rho) { const int n = rho >> 4, i = rho & 15; return 8 * (i >> 2) + 4 * n + (i & 3); }
struct Unit { int pm, pn; };
struct Gemm { const bf16_t* A; const bf16_t* Bt; int M, N, K; };
struct StaticOrder {
    int nM, nN, nwg, G, c;
    __host__ __device__ void init(int M, int N, int G_, int c_) { nM = M / BM; nN = N / BM; nwg = nM * nN; G = G_; c = c_; }
    __host__ __device__ bool next(int i, Unit& u) const {
        const long L = (long)i * G + c; if (L >= nwg) return false;
        int wgid = (int)L; { const int q = nwg / NXCD, r = nwg % NXCD, xcd = wgid % NXCD, off = wgid / NXCD; wgid = (xcd < r ? xcd * (q + 1) : r * (q + 1) + (xcd - r) * q) + off; }
        const int nig = WGM * nN, gid = wgid / nig, fm = gid * WGM, gsz = (nM - fm) < WGM ? (nM - fm) : WGM;
        u.pm = fm + ((wgid % nig) % gsz); u.pn = (wgid % nig) / gsz; return true;
    }
    __device__ __forceinline__ void a_ready(const Unit&) const {}
    __device__ __forceinline__ void done(const Unit&) const {}
};
enum { EM_PLAIN = 0, EM_SWIGLU, EM_WIN, EM_SCALE, EM_MULZ, EM_FMAZ, EM_SIGMUL };
template <int MODE> struct Epi {
    static constexpr bool PERM = true, AFTER_DRAIN = false;
    bf16_t* O; int ldc;
    const bf16_t* aux; int ldaux;
    const bf16_t* add; int ldadd;
    float scale;
    __device__ __forceinline__ void operator()(const f32x4 (&acc)[2][2][4][2], const Unit& u, int wr, int wc, int fr, int fq) const {
        const int row0 = u.pm * BM + wr * 64 + fr;
        if constexpr (MODE == EM_SWIGLU) {
            const int col = u.pn * HALF + wc * 32 + 8 * fq;
#pragma unroll
            for (int ai = 0; ai < 2; ++ai)
#pragma unroll
                for (int m = 0; m < 4; ++m) {
                    const f32x4 g0 = acc[ai][0][m][0], g1 = acc[ai][0][m][1], u0 = acc[ai][1][m][0], u1 = acc[ai][1][m][1];
                    u32x4 w; w.x = pk2(silu_f(g0[0]) * u0[0], silu_f(g0[1]) * u0[1]); w.y = pk2(silu_f(g0[2]) * u0[2], silu_f(g0[3]) * u0[3]);
                    w.z = pk2(silu_f(g1[0]) * u1[0], silu_f(g1[1]) * u1[1]); w.w = pk2(silu_f(g1[2]) * u1[2], silu_f(g1[3]) * u1[3]);
                    *(u32x4*)(O + (size_t)(row0 + ai * HALF + m * 16) * ldc + col) = w;
                }
        } else {
            int act = 0;
            if constexpr (MODE == EM_WIN) act = (u.pn >= 5 && u.pn < 10) ? 1 : (u.pn >= 13 ? 2 : 0);
#pragma unroll
            for (int ai = 0; ai < 2; ++ai)
#pragma unroll
                for (int m = 0; m < 4; ++m) {
                    const int row = row0 + ai * HALF + m * 16;
#pragma unroll
                    for (int bj = 0; bj < 2; ++bj) {
                        const int col = u.pn * BM + bj * HALF + wc * 32 + 8 * fq;
                        f32x4 v0 = acc[ai][bj][m][0], v1 = acc[ai][bj][m][1];
                        if constexpr (MODE == EM_WIN) {
                            if (act == 1) { for (int j = 0; j < 4; ++j) { v0[j] = gelu_tanh_f(v0[j]); v1[j] = gelu_tanh_f(v1[j]); } }
                            else if (act == 2) { for (int j = 0; j < 4; ++j) { v0[j] = sigmoid_f(v0[j]); v1[j] = sigmoid_f(v1[j]); } }
                        }
                        if constexpr (MODE == EM_SCALE) { v0 = v0 * scale; v1 = v1 * scale; }
                        if constexpr (MODE == EM_MULZ || MODE == EM_FMAZ || MODE == EM_SIGMUL) {
                            const u32x4 z = *(const u32x4*)(aux + (size_t)row * ldaux + col);
                            f32x4 z0 = {bflo(z.x), bfhi(z.x), bflo(z.y), bfhi(z.y)}, z1 = {bflo(z.z), bfhi(z.z), bflo(z.w), bfhi(z.w)};
                            if constexpr (MODE == EM_SIGMUL) { for (int j = 0; j < 4; ++j) { v0[j] = sigmoid_f(v0[j]); v1[j] = sigmoid_f(v1[j]); } }
                            v0 = v0 * z0; v1 = v1 * z1;
                            if constexpr (MODE == EM_FMAZ) {
                                const u32x4 y = *(const u32x4*)(add + (size_t)row * ldadd + col);
                                v0 += (f32x4){bflo(y.x), bfhi(y.x), bflo(y.y), bfhi(y.y)}; v1 += (f32x4){bflo(y.z), bfhi(y.z), bflo(y.w), bfhi(y.w)};
                            }
                        }
                        u32x4 w; w.x = pk2(v0[0], v0[1]); w.y = pk2(v0[2], v0[3]); w.z = pk2(v1[0], v1[1]); w.w = pk2(v1[2], v1[3]);
                        *(u32x4*)(O + (size_t)row * ldc + col) = w;
                    }
                }
        }
    }
};

struct OneUnit { Unit u; __device__ __forceinline__ bool next(int i, Unit& o) const { if (i != 0) return false; o = u; return true; }
    __device__ __forceinline__ void a_ready(const Unit&) const {} __device__ __forceinline__ void done(const Unit&) const {} };
template <int NEXT, int SRC, int PRE = 0> struct EpiNorm {
    static constexpr bool PERM = true, AFTER_DRAIN = true;
    const float* xin; bf16_t* XR; bf16_t* XN; float* Y; const float* gpost; const float* gpre; float coef; float* slots; unsigned* cnt; const bf16_t* aux;
    __device__ __forceinline__ void operator()(const f32x4 (&)[2][2][4][2], const Unit&, int, int, int, int) const {}
    __device__ __forceinline__ void stats(const f32x4 (&v)[2][2][4][2], const Unit& u, int wr, int wc, int fr, int fq, LAS unsigned char* lds, int wid, int lane, int which, float c) const {
        LAS float* P = (LAS float*)lds; LAS float* S = (LAS float*)(lds + 4096);
#pragma unroll
        for (int ai = 0; ai < 2; ++ai)
#pragma unroll
            for (int m = 0; m < 4; ++m) { float q = 0.f;
#pragma unroll
                for (int bj = 0; bj < 2; ++bj)
#pragma unroll
                    for (int n = 0; n < 2; ++n) { const f32x4 x = v[ai][bj][m][n]; q += (x[0] * x[0] + x[1] * x[1]) + (x[2] * x[2] + x[3] * x[3]); }
                { const unsigned uq = __float_as_uint(q); const auto r_ = __builtin_amdgcn_permlane16_swap(uq, uq, false, false); q = __uint_as_float(r_[0]) + __uint_as_float(r_[1]); }
                { const unsigned uq = __float_as_uint(q); const auto r_ = __builtin_amdgcn_permlane32_swap(uq, uq, false, false); q = __uint_as_float(r_[0]) + __uint_as_float(r_[1]); }
                if (fq == 0) P[(ai * HALF + wr * 64 + m * 16 + fr) * 4 + wc] = q; }
        asm volatile("s_waitcnt lgkmcnt(0)" ::: "memory"); __builtin_amdgcn_s_barrier(); asm volatile("" ::: "memory");
        const int row = wid * 32 + (lane & 31);
        float* slot = slots + ((size_t)(which * 64 + u.pm) * BM + row) * 4;
        unsigned* c0 = cnt + (size_t)(which * 64 + u.pm) * 64;
        if (lane < 32) { const f32x4 p4 = *(const LAS f32x4*)(P + row * 4); __hip_atomic_store(slot + u.pn, (p4[0] + p4[1]) + (p4[2] + p4[3]), __ATOMIC_RELAXED, __HIP_MEMORY_SCOPE_AGENT); }
        asm volatile("s_waitcnt vmcnt(0)" ::: "memory");
        if (lane == 0) (void)__hip_atomic_fetch_add(c0, 1u, __ATOMIC_RELAXED, __HIP_MEMORY_SCOPE_AGENT);
        if (wid == 0) { unsigned sp = 0u;
            while ((unsigned)__builtin_amdgcn_readfirstlane(__hip_atomic_load(c0, __ATOMIC_RELAXED, __HIP_MEMORY_SCOPE_AGENT)) < 32u) { __builtin_amdgcn_s_sleep(1); if (++sp > (1u << 20)) break; }
            __builtin_amdgcn_fence(__ATOMIC_ACQUIRE, "agent"); }
        asm volatile("s_waitcnt vmcnt(0) lgkmcnt(0)" ::: "memory"); __builtin_amdgcn_s_barrier(); asm volatile("" ::: "memory");
        if (lane < 32) { float t = 0.f;
#pragma unroll
            for (int k = 0; k < 4; ++k) t += __hip_atomic_load(slot + k, __ATOMIC_RELAXED, __HIP_MEMORY_SCOPE_AGENT);
            S[row] = c / sqrtf(t * (1.f / 1024.f) + 1e-6f); }
        asm volatile("s_waitcnt vmcnt(0) lgkmcnt(0)" ::: "memory"); __builtin_amdgcn_s_barrier(); asm volatile("" ::: "memory");
    }
    __device__ __forceinline__ void fused(f32x4 (&acc)[2][2][4][2], const Unit& u, int wr, int wc, int fr, int fq, LAS unsigned char* lds, int wid, int lane) const {
        const LAS float* S = (const LAS float*)(lds + 4096);
        if constexpr (PRE == 1) {
#pragma unroll
            for (int bj = 0; bj < 2; ++bj)
#pragma unroll
                for (int ai = 0; ai < 2; ++ai)
#pragma unroll
                    for (int m = 0; m < 4; ++m) { const size_t off = (size_t)(u.pm * BM + ai * HALF + wr * 64 + m * 16 + fr) * 1024 + u.pn * BM + bj * HALF + wc * 32 + 8 * fq;
                        const u32x4 zq = *(const u32x4*)(aux + off); f32x4 v0 = acc[ai][bj][m][0], v1 = acc[ai][bj][m][1];
#pragma unroll
                        for (int j = 0; j < 4; ++j) { v0[j] = sigmoid_f(v0[j]); v1[j] = sigmoid_f(v1[j]); }
                        acc[ai][bj][m][0] = v0 * (f32x4){bflo(zq.x), bfhi(zq.x), bflo(zq.y), bfhi(zq.y)}; acc[ai][bj][m][1] = v1 * (f32x4){bflo(zq.z), bfhi(zq.z), bflo(zq.w), bfhi(zq.w)}; }
        }
        stats(acc, u, wr, wc, fr, fq, lds, wid, lane, 0, coef);
#pragma unroll
        for (int bj = 0; bj < 2; ++bj) {
            const int col = u.pn * BM + bj * HALF + wc * 32 + 8 * fq;
            const f32x4 g0 = *(const f32x4*)(gpost + col), g1 = *(const f32x4*)(gpost + col + 4);
#pragma unroll
            for (int ai = 0; ai < 2; ++ai)
#pragma unroll
                for (int m = 0; m < 4; ++m) {
                    const int rl = ai * HALF + wr * 64 + m * 16 + fr; const size_t off = (size_t)(u.pm * BM + rl) * 1024 + col; const float r = S[rl];
                    f32x4 x0, x1;
                    if constexpr (SRC == 0) { x0 = *(const f32x4*)(xin + off); x1 = *(const f32x4*)(xin + off + 4); }
                    else { const u32x4 w = *(const u32x4*)((SRC == 1 ? XR : XN) + off); x0 = (f32x4){bflo(w.x), bfhi(w.x), bflo(w.y), bfhi(w.y)}; x1 = (f32x4){bflo(w.z), bfhi(w.z), bflo(w.w), bfhi(w.w)}; }
                    x0 = x0 + acc[ai][bj][m][0] * g0 * r; x1 = x1 + acc[ai][bj][m][1] * g1 * r;
                    acc[ai][bj][m][0] = x0; acc[ai][bj][m][1] = x1;
                    if constexpr (NEXT == 0) { *(f32x4*)(Y + off) = x0; *(f32x4*)(Y + off + 4) = x1; }
                    else { u32x4 w; w.x = pk2(x0[0], x0[1]); w.y = pk2(x0[2], x0[3]); w.z = pk2(x1[0], x1[1]); w.w = pk2(x1[2], x1[3]); *(u32x4*)((NEXT == 1 ? XR : XN) + off) = w; }
                }
        }
        if constexpr (NEXT == 1) {
            stats(acc, u, wr, wc, fr, fq, lds, wid, lane, 1, 1.f);
#pragma unroll
            for (int bj = 0; bj < 2; ++bj) {
                const int col = u.pn * BM + bj * HALF + wc * 32 + 8 * fq;
                const f32x4 g0 = *(const f32x4*)(gpre + col), g1 = *(const f32x4*)(gpre + col + 4);
#pragma unroll
                for (int ai = 0; ai < 2; ++ai)
#pragma unroll
                    for (int m = 0; m < 4; ++m) {
                        const int rl = ai * HALF + wr * 64 + m * 16 + fr; const size_t off = (size_t)(u.pm * BM + rl) * 1024 + col; const float r = S[rl];
                        const f32x4 x0 = acc[ai][bj][m][0] * g0 * r, x1 = acc[ai][bj][m][1] * g1 * r;
                        u32x4 w; w.x = pk2(x0[0], x0[1]); w.y = pk2(x0[2], x0[3]); w.z = pk2(x1[0], x1[1]); w.w = pk2(x1[2], x1[3]); *(u32x4*)(XN + off) = w;
                    }
            }
        }
    }
};
template <class EpiT, class Sched, bool ALIGN_EPI = false, bool SP2 = false>
__device__ __forceinline__ void gemm_phase(LAS unsigned char* lds, const Gemm g, const Sched& S, const EpiT& E, int wv) {
    int tid_ = TIDW(wv); asm volatile("" : "+v"(tid_));
    const int tid = tid_, wid = __builtin_amdgcn_readfirstlane(tid >> 6), lane = tid & 63, wr = wid >> 2, wc = wid & 3, fr = lane & 15, fq = lane >> 4;
    const int K = g.K, nt = K / BK;
    unsigned voffA[2], voffB[2];
#pragma unroll
    for (int i = 0; i < 2; ++i) { int R, C; stage_rc(tid * 16 + i * 8192, R, C); const int Rb = EpiT::PERM ? ((R & ~31) + perm32(R & 31)) : R;
        voffA[i] = (unsigned)(R * K + C) * 2u; voffB[i] = (unsigned)(Rb * K + C) * 2u; }
    const size_t kstep = (size_t)(BK * 2);
    const size_t hstep = (size_t)HALF * K * 2;
    const size_t tstep = 2 * hstep;
    const unsigned ldsw = (unsigned)wid * 1024u;
    const int aoff = lds_byte(wr * 64 + fr, fq * 8), boff = lds_byte(wc * 32 + fr, fq * 8);
#define PG8_SA(b, h) (((b) * 2 + (h)) * HTB)
#define PG8_SB(b, h) ((4 + (b) * 2 + (h)) * HTB)
#define PG8_STAGE(bufoff, gbase, voff) do { _Pragma("unroll") for (int _i = 0; _i < 2; ++_i) \
        __builtin_amdgcn_global_load_lds((const unsigned*)((const char*)(gbase) + (voff)[_i]), (LAS unsigned*)(lds + (bufoff) + ldsw + _i * 8192), 16, 0, 0); } while (0)
#define PG8_LDA(dst, b, h) do { _Pragma("unroll") for (int m = 0; m < 4; ++m) _Pragma("unroll") for (int k = 0; k < 2; ++k) dst[m][k] = *(const LAS bf16x8*)(lds + PG8_SA(b, h) + aoff + m * 2048 + k * 1024); } while (0)
#define PG8_LDB(dst, b, h) do { _Pragma("unroll") for (int n = 0; n < 2; ++n) _Pragma("unroll") for (int k = 0; k < 2; ++k) dst[n][k] = *(const LAS bf16x8*)(lds + PG8_SB(b, h) + boff + n * 2048 + k * 1024); } while (0)
#define PG8_MMA(ai, bj, At, Bt) do { __builtin_amdgcn_s_setprio(1); _Pragma("unroll") for (int m = 0; m < 4; ++m) _Pragma("unroll") for (int n = 0; n < 2; ++n) _Pragma("unroll") for (int k = 0; k < 2; ++k) \
        acc[ai][bj][m][n] = __builtin_amdgcn_mfma_f32_16x16x32_bf16(Bt[n][k], At[m][k], acc[ai][bj][m][n], 0, 0, 0); __builtin_amdgcn_s_setprio(0); } while (0)
#define PG8_WAIT_V(n) asm volatile("s_waitcnt vmcnt(" #n ")" ::: "memory")
#define PG8_WAIT_L(n) asm volatile("s_waitcnt lgkmcnt(" #n ")" ::: "memory")
#define PG8_BAR __builtin_amdgcn_s_barrier()
#define PG8_SCHED __builtin_amdgcn_sched_barrier(0)
    Unit cur, nxt; int ui = 0;
    if (!S.next(0, cur)) return;
    f32x4 acc[2][2][4][2];
#pragma unroll
    for (int a = 0; a < 2; ++a)
#pragma unroll
        for (int b = 0; b < 2; ++b)
#pragma unroll
            for (int m = 0; m < 4; ++m)
#pragma unroll
                for (int n = 0; n < 2; ++n) acc[a][b][m][n] = (f32x4){0.f, 0.f, 0.f, 0.f};
    bf16x8 At[4][2], B0[2][2], B1[2][2];
    const char* cA = (const char*)g.A + (size_t)cur.pm * tstep; const char* cB = (const char*)g.Bt + (size_t)cur.pn * tstep;
    S.a_ready(cur);
    if constexpr (SP2) {
        PG8_STAGE(PG8_SB(0, 0), cB, voffB); PG8_STAGE(PG8_SB(0, 1), cB + hstep, voffB); PG8_STAGE(PG8_SA(0, 0), cA, voffA); PG8_STAGE(PG8_SA(0, 1), cA + hstep, voffA);
        if (wr == 1) PG8_BAR;
        PG8_WAIT_V(2); PG8_BAR;
        PG8_STAGE(PG8_SB(1, 0), cB + kstep, voffB); PG8_STAGE(PG8_SA(1, 0), cA + kstep, voffA); PG8_STAGE(PG8_SB(1, 1), cB + hstep + kstep, voffB);
        PG8_WAIT_V(6); PG8_BAR;
    } else {
        PG8_STAGE(PG8_SB(0, 0), cB, voffB); PG8_STAGE(PG8_SA(0, 0), cA, voffA); PG8_STAGE(PG8_SB(0, 1), cB + hstep, voffB); PG8_STAGE(PG8_SA(0, 1), cA + hstep, voffA);
        if (wr == 1) PG8_BAR;
        PG8_WAIT_V(4); PG8_BAR;
        PG8_STAGE(PG8_SB(1, 0), cB + kstep, voffB); PG8_STAGE(PG8_SA(1, 0), cA + kstep, voffA); PG8_STAGE(PG8_SB(1, 1), cB + hstep + kstep, voffB);
        PG8_WAIT_V(6); PG8_BAR;
    }
    for (;;) {
        const bool has_next = S.next(ui + 1, nxt);
        const char* nA = has_next ? (const char*)g.A + (size_t)nxt.pm * tstep : cA; const char* nB = has_next ? (const char*)g.Bt + (size_t)nxt.pn * tstep : cB;
        for (int t = 0; t < nt; t += 2) {
            const bool last = (t == nt - 2);
            const char* a1 = cA + (size_t)(t + 1) * kstep;
            const char* a2 = last ? nA : cA + (size_t)(t + 2) * kstep; const char* b2 = last ? nB : cB + (size_t)(t + 2) * kstep;
            const char* a3 = a2 + kstep; const char* b3 = b2 + kstep;
            if (last && has_next) S.a_ready(nxt);
            if constexpr (SP2) {
            PG8_LDB(B0, 0, 0); PG8_LDB(B1, 0, 1); PG8_SCHED; PG8_LDA(At, 0, 0); PG8_STAGE(PG8_SA(1, 1), a1 + hstep, voffA);
            PG8_WAIT_V(8); PG8_WAIT_L(0); PG8_BAR; PG8_MMA(0, 0, At, B0); PG8_MMA(0, 1, At, B1); PG8_BAR; PG8_SCHED;
            PG8_LDA(At, 0, 1); PG8_STAGE(PG8_SB(0, 0), b2, voffB); PG8_STAGE(PG8_SB(0, 1), b2 + hstep, voffB); PG8_STAGE(PG8_SA(0, 0), a2, voffA);
            PG8_WAIT_V(8); PG8_WAIT_L(0); PG8_BAR; PG8_MMA(1, 0, At, B0); PG8_MMA(1, 1, At, B1); PG8_BAR; PG8_SCHED;
            PG8_LDB(B0, 1, 0); PG8_LDB(B1, 1, 1); PG8_SCHED; PG8_LDA(At, 1, 0); PG8_STAGE(PG8_SA(0, 1), a2 + hstep, voffA);
            PG8_WAIT_V(8); PG8_WAIT_L(0); PG8_BAR; PG8_MMA(0, 0, At, B0); PG8_MMA(0, 1, At, B1); PG8_BAR; PG8_SCHED;
            PG8_LDA(At, 1, 1); PG8_STAGE(PG8_SB(1, 0), b3, voffB); PG8_STAGE(PG8_SB(1, 1), b3 + hstep, voffB); PG8_STAGE(PG8_SA(1, 0), a3, voffA);
            PG8_WAIT_V(8); PG8_WAIT_L(0); PG8_BAR; PG8_MMA(1, 0, At, B0); PG8_MMA(1, 1, At, B1); PG8_BAR; PG8_SCHED;
            } else {
            PG8_LDB(B0, 0, 0); PG8_SCHED; PG8_LDA(At, 0, 0); PG8_STAGE(PG8_SA(1, 1), a1 + hstep, voffA);
            PG8_WAIT_L(8); PG8_BAR; PG8_WAIT_L(0); PG8_MMA(0, 0, At, B0); PG8_BAR; PG8_SCHED;
            PG8_LDB(B1, 0, 1); PG8_STAGE(PG8_SB(0, 0), b2, voffB);
            PG8_BAR; PG8_WAIT_L(0); PG8_MMA(0, 1, At, B1); PG8_BAR;
            PG8_LDA(At, 0, 1); PG8_STAGE(PG8_SA(0, 0), a2, voffA);
            PG8_BAR; PG8_WAIT_L(0); PG8_MMA(1, 0, At, B0); PG8_BAR; PG8_SCHED;
            PG8_STAGE(PG8_SB(0, 1), b2 + hstep, voffB);
            PG8_WAIT_V(6); PG8_BAR; PG8_MMA(1, 1, At, B1); PG8_BAR;
            PG8_LDB(B0, 1, 0); PG8_SCHED; PG8_LDA(At, 1, 0); PG8_STAGE(PG8_SA(0, 1), a2 + hstep, voffA);
            PG8_WAIT_L(8); PG8_BAR; PG8_WAIT_L(0); PG8_MMA(0, 0, At, B0); PG8_BAR; PG8_SCHED;
            PG8_LDB(B1, 1, 1); PG8_STAGE(PG8_SB(1, 0), b3, voffB);
            PG8_BAR; PG8_WAIT_L(0); PG8_MMA(0, 1, At, B1); PG8_BAR;
            PG8_LDA(At, 1, 1); PG8_STAGE(PG8_SA(1, 0), a3, voffA);
            PG8_BAR; PG8_WAIT_L(0); PG8_MMA(1, 0, At, B0); PG8_BAR; PG8_SCHED;
            PG8_STAGE(PG8_SB(1, 1), b3 + hstep, voffB);
            PG8_WAIT_V(6); PG8_BAR; PG8_MMA(1, 1, At, B1); PG8_BAR;
            }
        }
        if constexpr (ALIGN_EPI) { if (wr == 0) PG8_BAR; }
        if constexpr (!EpiT::AFTER_DRAIN) { E(acc, cur, wr, wc, fr, fq); S.done(cur); }
        if (!has_next) break;
#pragma unroll
        for (int a = 0; a < 2; ++a)
#pragma unroll
            for (int b = 0; b < 2; ++b)
#pragma unroll
                for (int m = 0; m < 4; ++m)
#pragma unroll
                    for (int n = 0; n < 2; ++n) acc[a][b][m][n] = (f32x4){0.f, 0.f, 0.f, 0.f};
        cur = nxt; cA = nA; cB = nB; ++ui;
        if constexpr (ALIGN_EPI) { if (wr == 1) PG8_BAR; }
    }
    PG8_WAIT_V(0);
    if constexpr (!ALIGN_EPI) { if (wr == 0) PG8_BAR; }
    PG8_BAR;
    if constexpr (EpiT::AFTER_DRAIN) E.fused(acc, cur, wr, wc, fr, fq, lds, wid, lane);
#undef PG8_SA
#undef PG8_SB
#undef PG8_STAGE
#undef PG8_LDA
#undef PG8_LDB
#undef PG8_MMA
#undef PG8_WAIT_V
#undef PG8_WAIT_L
#undef PG8_BAR
#undef PG8_SCHED
}
}

template <int MODE, int K> __device__ __forceinline__ void sgemm_sample(LAS unsigned char* lds, const bf16* A, const bf16* Bt, int N, bf16* O, int ldc, const bf16* aux, int ldaux, const bf16* add, int ldadd, int vcu, int G, int wv,
                                                                 unsigned* sig = nullptr) {
    int tid = TIDW(wv); asm volatile("" : "+v"(tid));
    const int lane = tid & 63, wave = __builtin_amdgcn_readfirstlane(tid >> 6), l15 = lane & 15, g4 = lane >> 4, tsel = wave & 1, kq = wave >> 1;
    constexpr int kn = K >> 2, KQ = kn / 32;
    const int npair = N >> 5, nitem = 8 * npair;
    LAS f32x4* red = (LAS f32x4*)lds;
    for (int item = vcu; item < nitem; item += G) {
        const int tr = item / npair, ct = 2 * (item - tr * npair) + tsel;
        const int row = MP + tr * 16 + l15;
        const bf16* ap = A + (size_t)row * K + kq * kn + 8 * g4;
        const bf16* bp = Bt + (size_t)(ct * 16 + l15) * K + kq * kn + 8 * g4;
        f32x4 acc = {0.f, 0.f, 0.f, 0.f};
        bf16x8 av[KQ], bv[KQ];
#pragma unroll
        for (int k = 0; k < KQ; ++k) { av[k] = *(const bf16x8*)(ap + 32 * k); bv[k] = *(const bf16x8*)(bp + 32 * k); }
        u32x2 zz = {0u, 0u}, yy = {0u, 0u};
        if constexpr (MODE == pg8::EM_MULZ || MODE == pg8::EM_FMAZ || MODE == pg8::EM_SIGMUL) { if (kq == 0) zz = *(const u32x2*)(aux + (size_t)row * ldaux + ct * 16 + 4 * g4); }
        if constexpr (MODE == pg8::EM_FMAZ) { if (kq == 0) yy = *(const u32x2*)(add + (size_t)row * ldadd + ct * 16 + 4 * g4); }
#pragma unroll
        for (int k = 0; k < KQ; ++k) acc = __builtin_amdgcn_mfma_f32_16x16x32_bf16(bv[k], av[k], acc, 0, 0, 0);
        __syncthreads();
        if (kq > 0) red[(tsel * 3 + (kq - 1)) * 64 + lane] = acc;
        __syncthreads();
        if (kq == 0) {
            acc = acc + red[(tsel * 3 + 0) * 64 + lane] + red[(tsel * 3 + 1) * 64 + lane] + red[(tsel * 3 + 2) * 64 + lane];
            const int col = ct * 16 + 4 * g4;
            f32x4 v = acc;
            if constexpr (MODE == pg8::EM_MULZ || MODE == pg8::EM_FMAZ || MODE == pg8::EM_SIGMUL) {
                const f32x4 zf = {bflo(zz.x), bfhi(zz.x), bflo(zz.y), bfhi(zz.y)};
                if constexpr (MODE == pg8::EM_SIGMUL) { for (int j = 0; j < 4; ++j) v[j] = sigmoid_f(v[j]); }
                v = v * zf;
                if constexpr (MODE == pg8::EM_FMAZ) { v += (f32x4){bflo(yy.x), bfhi(yy.x), bflo(yy.y), bfhi(yy.y)}; }
            }
            u32x2 w; w.x = pk2(v[0], v[1]); w.y = pk2(v[2], v[3]);
            if (sig) __hip_atomic_store((unsigned long long*)(O + (size_t)row * ldc + col), ((unsigned long long)w.y << 32) | w.x, __ATOMIC_RELAXED, __HIP_MEMORY_SCOPE_AGENT);
            else *(u32x2*)(O + (size_t)row * ldc + col) = w;
        }
    }
    if (sig) asm volatile("s_waitcnt vmcnt(0)" ::: "memory");
    __syncthreads();
    if (sig && wv == 0 && lane == 0) { for (int item = vcu; item < nitem; item += G) (void)__hip_atomic_fetch_add(sig + 64 * (item / npair), 1u, __ATOMIC_RELAXED, __HIP_MEMORY_SCOPE_AGENT); }
}

constexpr int RING_OFF = 0, RING_BYTES = 131072;
constexpr int LDSCTL_OFF = RING_BYTES, MISC_OFF = LDSCTL_OFF + 320;
constexpr int LDS_BYTES = 147456;
constexpr int NWAVES = 8;

#define XB_TMO      128
#define XB_XCNT(j)  (256  + 64 * (j))
#define XB_XSUB(j)  (1280 + 64 * (j))
#define XB_XGEN(j)  (2304 + 64 * (j))
#define XB_TOP      3328
#define XB_TOPGEN   3392
#define XCD_BAR_WORDS 3456
#define XB_SPIN_CAP (1u << 18)
__device__ __forceinline__ unsigned xb_ld(unsigned* p)              { return __hip_atomic_load(p, __ATOMIC_RELAXED, __HIP_MEMORY_SCOPE_AGENT); }
__device__ __forceinline__ unsigned xb_add(unsigned* p, unsigned v) { return __hip_atomic_fetch_add(p, v, __ATOMIC_RELAXED, __HIP_MEMORY_SCOPE_AGENT); }
__device__ __forceinline__ unsigned xb_xcc_id() { return (unsigned)__builtin_amdgcn_s_getreg((3 << 11) | 20) & 0xFu; }
#define XB_SPIN(cond, bar) do { unsigned _sp = 0; while (cond) { __builtin_amdgcn_s_sleep(1); \
    if ((++_sp & 255u) == 0u) { if (xb_ld(&(bar)[XB_TMO])) break; if (_sp > XB_SPIN_CAP) { atomicAdd(&(bar)[XB_TMO], 1u); break; } } } } while (0)
struct XcdBarrier { unsigned* bar; unsigned x; volatile LAS unsigned* st; bool t0; };
__device__ __forceinline__ XcdBarrier xcd_barrier_post(unsigned* bar, volatile LAS unsigned* st) {
    XcdBarrier b; b.bar = bar; b.x = xb_xcc_id(); b.st = st;
    if (threadIdx.x == 0) (void)xb_add(&bar[XB_XCNT(b.x)], 1u);
    return b;
}
__device__ __forceinline__ void xcd_barrier_complete(unsigned* bar, unsigned x, unsigned& nloc, unsigned& nx) {
    const unsigned G = gridDim.x * gridDim.y * gridDim.z;
    unsigned sum, cnt, mine, sp = 0u;
    for (;;) {
        sum = 0u; cnt = 0u; mine = 0u;
#pragma unroll
        for (unsigned j = 0; j < 16; ++j) { const unsigned c = xb_ld(&bar[XB_XCNT(j)]); sum += c; cnt += (c > 0u) ? 1u : 0u; mine = (j == x) ? c : mine; }
        if (sum == G) break;
        __builtin_amdgcn_s_sleep(1);
        if ((++sp & 255u) == 0u) { if (xb_ld(&bar[XB_TMO])) break; if (sp > XB_SPIN_CAP) { atomicAdd(&bar[XB_TMO], 1u); break; } }
    }
    nloc = mine > 0u ? mine : 1u; nx = cnt > 0u ? cnt : 1u;
}
__device__ __forceinline__ void xcd_barrier(const XcdBarrier& b) {
    asm volatile("s_waitcnt vmcnt(0)" ::: "memory");
    __syncthreads();
    if (b.t0) {
        unsigned* bar = b.bar;
        __builtin_amdgcn_s_waitcnt(0);
        unsigned nloc = b.st[0], nx = b.st[1];
        if (nloc == 0u) { xcd_barrier_complete(bar, b.x, nloc, nx); b.st[0] = nloc; b.st[1] = nx; }
        const unsigned old = xb_add(&bar[XB_XSUB(b.x)], 1u);
        const unsigned gen = old / nloc;
        if (old + 1u == (gen + 1u) * nloc) {
            __builtin_amdgcn_fence(__ATOMIC_RELEASE, "agent");
            asm volatile("s_waitcnt vmcnt(0)" ::: "memory");
            const unsigned og = xb_add(&bar[XB_TOP], 1u);
            const unsigned tg = og / nx;
            if (og + 1u == (tg + 1u) * nx) xb_add(&bar[XB_TOPGEN], 1u);
            else XB_SPIN(xb_ld(&bar[XB_TOPGEN]) == tg, bar);
            __builtin_amdgcn_fence(__ATOMIC_ACQUIRE, "agent");
            xb_add(&bar[XB_XGEN(b.x)], 1u);
            asm volatile("s_waitcnt vmcnt(0)" ::: "memory");
        } else {
            XB_SPIN(xb_ld(&bar[XB_XGEN(b.x)]) == gen, bar);
            __builtin_amdgcn_fence(__ATOMIC_ACQUIRE, "agent");
            asm volatile("s_waitcnt vmcnt(0)" ::: "memory");
        }
    }
    __syncthreads();
}
__device__ __forceinline__ void xcd_barrier_arrive(const XcdBarrier& b) {
    asm volatile("s_waitcnt vmcnt(0)" ::: "memory");
    __syncthreads();
    if (b.t0) {
        unsigned* bar = b.bar;
        __builtin_amdgcn_s_waitcnt(0);
        unsigned nloc = b.st[0], nx = b.st[1];
        if (nloc == 0u) { xcd_barrier_complete(bar, b.x, nloc, nx); b.st[0] = nloc; b.st[1] = nx; }
        const unsigned old = xb_add(&bar[XB_XSUB(b.x)], 1u);
        const unsigned gen = old / nloc;
        if (old + 1u == (gen + 1u) * nloc) {
            __builtin_amdgcn_fence(__ATOMIC_RELEASE, "agent");
            asm volatile("s_waitcnt vmcnt(0)" ::: "memory");
            const unsigned og = xb_add(&bar[XB_TOP], 1u);
            const unsigned tg = og / nx;
            if (og + 1u == (tg + 1u) * nx) xb_add(&bar[XB_TOPGEN], 1u);
            else XB_SPIN(xb_ld(&bar[XB_TOPGEN]) == tg, bar);
            __builtin_amdgcn_fence(__ATOMIC_ACQUIRE, "agent");
            xb_add(&bar[XB_XGEN(b.x)], 1u);
            asm volatile("s_waitcnt vmcnt(0)" ::: "memory");
            b.st[3] = 1u;
        } else { b.st[2] = gen; b.st[3] = 0u; }
    }
    __syncthreads();
}
__device__ __forceinline__ void xcd_barrier_finish(const XcdBarrier& b) {
    if (b.t0) {
        if (b.st[3] == 0u) { const unsigned gen = b.st[2]; XB_SPIN(xb_ld(&b.bar[XB_XGEN(b.x)]) == gen, b.bar); __builtin_amdgcn_fence(__ATOMIC_ACQUIRE, "agent"); asm volatile("s_waitcnt vmcnt(0)" ::: "memory"); }
    }
    __syncthreads();
}

struct Args { const void* in[N_PTR]; int ph_lo, ph_hi, li, pad; };

template <int MAP> __device__ __forceinline__ int rowmap(int n, int row_off) {
    if constexpr (MAP == 1) return (n >> 7) * 256 + (n & 127);
    else if constexpr (MAP == 2) return (n >> 7) * 256 + 128 + (n & 127);
    else if constexpr (MAP == 3) return n < 3232 ? n : n + 96;
    else if constexpr (MAP == 4) { const int d = n & 31; return row_off + (n & ~31) + 8 * ((d >> 2) & 3) + 4 * (d >> 4) + (d & 3); }
    else return row_off + n;
}
template <int MAP> __device__ __forceinline__ void transpose_item(const float* W, int K, int N, bf16* WT, int row_off, LAS float* scr, int item, int lane, float wscale = 1.f) {
    const int nblk = N / 32, kb = item / nblk, nb = item % nblk, k0 = 64 * kb, n0 = 32 * nb;
#pragma unroll 8
    for (int i = 0; i < 32; ++i) { const int kk = 2 * i + (lane >> 5); scr[kk * 33 + (lane & 31)] = W[(size_t)(k0 + kk) * N + n0 + (lane & 31)] * wscale; }
    LDS_WAIT(); asm volatile("" ::: "memory");
    const int c = lane & 7;
#pragma unroll
    for (int j = 0; j < 4; ++j) { const int n = (lane >> 3) + 8 * j; const LAS float* s = scr + (8 * c) * 33 + n;
        u32x4 o; o.x = pk2(s[0 * 33], s[1 * 33]); o.y = pk2(s[2 * 33], s[3 * 33]); o.z = pk2(s[4 * 33], s[5 * 33]); o.w = pk2(s[6 * 33], s[7 * 33]);
        *(u32x4*)(WT + (size_t)rowmap<MAP>(n0 + n, row_off) * K + k0 + 8 * c) = o; }
    LDS_WAIT(); asm volatile("" ::: "memory");
}
__device__ __forceinline__ const float* xrow_ptr(const Args& a, int m, int z) {
    if (m < MP) return (const float*)a.in[I_XP + z] + (size_t)m * DM;
    if (m < MP + NS) return (const float*)a.in[I_XS + z] + (size_t)(m - MP) * DM;
    return nullptr;
}
__device__ __forceinline__ void rms_row_to_bf16(const float* xrow, const float* gain, bf16* orow, int lane) {
    f32x4 v[4]; float s = 0.f;
#pragma unroll
    for (int j = 0; j < 4; ++j) { v[j] = xrow ? ((const f32x4*)xrow)[lane + 64 * j] : (f32x4){0.f, 0.f, 0.f, 0.f}; s += (v[j].x * v[j].x + v[j].y * v[j].y) + (v[j].z * v[j].z + v[j].w * v[j].w); }
    const float rstd = 1.f / sqrtf(wave_sum(s) * (1.f / DM) + EPS);
#pragma unroll
    for (int j = 0; j < 4; ++j) { const f32x4 g = ((const f32x4*)gain)[lane + 64 * j];
        u32x2 o; o.x = pk2(v[j].x * rstd * g.x, v[j].y * rstd * g.y); o.y = pk2(v[j].z * rstd * g.z, v[j].w * rstd * g.w);
        ((u32x2*)orow)[lane + 64 * j] = o; }
}
constexpr int CVI_UP = 16 * 88, CVI_DN = 44 * 32, CVI_IN = 16 * 165, CVI_RNN = 20 * 32, CVI_UQ = 6 * 32, CVI_QR = 6 * 16, CVI_UK = 4 * 32, CVI_SQ = 16 * 32, CVI_PPJ = 4 * 32;
constexpr int CV_A = 2 * CVI_UP, CV_B = CV_A + CVI_DN + CVI_IN, CV_N = CV_B + 2 * CVI_UP + CVI_DN + CVI_RNN + CVI_UQ + CVI_QR + 2 * CVI_UK + 3 * CVI_SQ + CVI_PPJ;
__device__ __forceinline__ void convert_item(const Args& a, int z, unsigned char* ws, LAS float* scr, int it, int lane) {
    int r = it;
    if (r < CVI_UP) { transpose_item<1>((const float*)a.in[I_F1G + z], DM, DFF, (bf16*)(ws + WS_BUP1), 0, scr, r, lane); return; } r -= CVI_UP;
    if (r < CVI_UP) { transpose_item<2>((const float*)a.in[I_F1U + z], DM, DFF, (bf16*)(ws + WS_BUP1), 0, scr, r, lane); return; } r -= CVI_UP;
    if (r < CVI_DN) { transpose_item<0>((const float*)a.in[I_F1D + z], DFF, DM, (bf16*)(ws + WS_BDN1), 0, scr, r, lane); return; } r -= CVI_DN;
    if (r < CVI_IN) { transpose_item<3>((const float*)a.in[I_WIN + z], DM, DIN, (bf16*)(ws + WS_BIN), 0, scr, r, lane); return; } r -= CVI_IN;
    if (r < CVI_UP) { transpose_item<1>((const float*)a.in[I_F2G + z], DM, DFF, (bf16*)(ws + WS_BUP2), 0, scr, r, lane); return; } r -= CVI_UP;
    if (r < CVI_UP) { transpose_item<2>((const float*)a.in[I_F2U + z], DM, DFF, (bf16*)(ws + WS_BUP2), 0, scr, r, lane); return; } r -= CVI_UP;
    if (r < CVI_DN) { transpose_item<0>((const float*)a.in[I_F2D + z], DFF, DM, (bf16*)(ws + WS_BDN2), 0, scr, r, lane); return; } r -= CVI_DN;
    if (r < CVI_RNN) { transpose_item<0>((const float*)a.in[I_WRNN + z], DRNN, DM, (bf16*)(ws + WS_BRNN), 0, scr, r, lane); return; } r -= CVI_RNN;
    if (r < CVI_UQ) { transpose_item<0>((const float*)a.in[I_WUQ + z], QL, 1024, (bf16*)(ws + WS_BQ), 0, scr, r, lane, C2); return; } r -= CVI_UQ;
    if (r < CVI_QR) { transpose_item<0>((const float*)a.in[I_WQR + z], QL, 512, (bf16*)(ws + WS_BQ), 1024, scr, r, lane, C2); return; } r -= CVI_QR;
    if (r < CVI_UK) { transpose_item<0>((const float*)a.in[I_WUK + z], KVL, 1024, (bf16*)(ws + WS_BKV), 0, scr, r, lane); return; } r -= CVI_UK;
    if (r < CVI_UK) { transpose_item<0>((const float*)a.in[I_WUV + z], KVL, 1024, (bf16*)(ws + WS_BKV), 1024, scr, r, lane); return; } r -= CVI_UK;
    if (r < CVI_SQ) { transpose_item<0>((const float*)a.in[I_WATT + z], DM, DM, (bf16*)(ws + WS_BATT), 0, scr, r, lane); return; } r -= CVI_SQ;
    if (r < CVI_SQ) { transpose_item<0>((const float*)a.in[I_WOUT + z], DM, DM, (bf16*)(ws + WS_BOUT), 0, scr, r, lane); return; } r -= CVI_SQ;
    if (r < CVI_SQ) { transpose_item<0>((const float*)a.in[I_PG + z], DM, DM, (bf16*)(ws + WS_BPG), 0, scr, r, lane); return; } r -= CVI_SQ;
    transpose_item<0>((const float*)a.in[I_PPJ + z], DPLE, DM, (bf16*)(ws + WS_BPP), 0, scr, r, lane);
}
__device__ __forceinline__ void convert_range(const Args& a, LAS unsigned char* lds, int lo, int hi, int w, int nw, int wv) {
    int z = 0; asm volatile("" : "+s"(z));
    int tid = TIDW(wv); asm volatile("" : "+v"(tid)); const int lane = tid & 63, wave = wv;
    unsigned char* ws = (unsigned char*)a.in[I_WS + z];
    LAS float* scr = (LAS float*)(lds + RING_OFF + wave * 16384);
    for (int it = lo + w; it < hi; it += nw) convert_item(a, z, ws, scr, it, lane);
}
__device__ __forceinline__ void convert_in_tail(const Args& a, LAS unsigned char* lds, int nwg, int G, int c, int lo, int hi, int wv) {
    const int full = (nwg + G - 1) / G, nl = full * G - nwg;
    const int wave = wv;
    if (nl == 0) { convert_range(a, lds, lo, hi, c * NWAVES + wave, G * NWAVES, wv); return; }
    if (c >= G - nl) convert_range(a, lds, lo, hi, (c - (G - nl)) * NWAVES + wave, nl * NWAVES, wv);
}
__device__ __forceinline__ void p0_prologue(const Args& a, LAS unsigned char* lds, int vcu, int G, int tid, int lane, int wave) {
    int z = 0; asm volatile("" : "+s"(z));
    unsigned char* ws = (unsigned char*)a.in[I_WS + z];
    const int gw = vcu * NWAVES + wave, NGW = G * NWAVES;
    convert_range(a, lds, 0, CV_A, gw, NGW, wave);
    const int gt = vcu * 512 + tid, NGT = G * 512;
    for (int i = gt; i < 12288; i += NGT) ((u32x4*)(ws + WS_BIN + (size_t)3232 * DM * 2))[i] = (u32x4){0u, 0u, 0u, 0u};
    for (int i = gt; i < NBLK * 160 * 104; i += NGT) {
        const int n = i / (160 * 104), r = i - n * (160 * 104), j = r / 104, k = r - j * 104;
        float v = 0.f;
        if (k < 80) v = j < 80 ? ((const float*)a.in[I_LWA + z])[(n * 80 + k) * 80 + j] : ((const float*)a.in[I_LWI + z])[(n * 80 + k) * 80 + (j - 80)];
        ((bf16*)(ws + WS_LW))[i] = f2bf(v);
    }
    for (int i = gt; i < ROPE_TAB; i += NGT) {
        const int pos = i >> 4, k = i & 15;
        const double freq = exp2(-(double)k * (13.287712379549449 / 16.0));
        double rev = (double)pos * freq * 0.15915494309189535;
        rev -= floor(rev);
        const float rf = (float)rev;
        ((float*)(ws + WS_ROPE))[i] = __builtin_amdgcn_cosf(rf);
        ((float*)(ws + WS_ROPE))[ROPE_TAB + i] = __builtin_amdgcn_sinf(rf);
    }
    for (int m0 = gw; m0 < MT; m0 += 2 * NGW)
#pragma unroll
    for (int qq = 0; qq < 2; ++qq) { const int m = m0 + qq * NGW; if (m >= MT) break;
        rms_row_to_bf16(xrow_ptr(a, m, z), (const float*)a.in[I_F1PRE + z], (bf16*)(ws + WS_XN) + (size_t)m * DM, lane);
        const float* pr = m < MP ? (const float*)a.in[I_PP + z] + (size_t)m * DPLE : (m < MP + NS ? (const float*)a.in[I_PS + z] + (size_t)(m - MP) * DPLE : nullptr);
        const f32x4 v = pr ? ((const f32x4*)pr)[lane] : (f32x4){0.f, 0.f, 0.f, 0.f};
        u32x2 o; o.x = pk2(v.x, v.y); o.y = pk2(v.z, v.w);
        ((u32x2*)((bf16*)(ws + WS_PB) + (size_t)m * DPLE))[lane] = o;
    }
}

template <int NEXT, int SRC> __device__ __forceinline__ void norm_rows(const Args& a, const bf16* Fin, float coef, int i_post, int i_pre, int first, int NGW, int end, int lane) {
    int z = 0; asm volatile("" : "+s"(z));
    unsigned char* ws = (unsigned char*)a.in[I_WS + z];
    bf16* XR = (bf16*)(ws + WS_XR); bf16* XN = (bf16*)(ws + WS_XN);
    const float* post = (const float*)a.in[i_post + z]; const float* pre = (const float*)a.in[i_pre + z];
    for (int m0 = first; m0 < end; m0 += 2 * NGW) {
        f32x4 f[2][4], x[2][4]; float s[2] = {0.f, 0.f};
#pragma unroll
        for (int q = 0; q < 2; ++q) { const int m = m0 + q * NGW; const bool ok = m < end; const int mm = ok ? m : m0;
            const float* xr = SRC == 0 ? xrow_ptr(a, mm, z) : nullptr;
            const bf16* xb = (SRC == 1 ? XR : XN) + (size_t)mm * DM;
#pragma unroll
            for (int j = 0; j < 4; ++j) {
                const u32x2 w = ((const u32x2*)(Fin + (size_t)mm * DM))[lane + 64 * j];
                f[q][j] = (f32x4){bflo(w.x), bfhi(w.x), bflo(w.y), bfhi(w.y)};
                if constexpr (SRC == 0) x[q][j] = ((const f32x4*)xr)[lane + 64 * j];
                else { const u32x2 xw = ((const u32x2*)xb)[lane + 64 * j]; x[q][j] = (f32x4){bflo(xw.x), bfhi(xw.x), bflo(xw.y), bfhi(xw.y)}; }
                s[q] += (f[q][j].x * f[q][j].x + f[q][j].y * f[q][j].y) + (f[q][j].z * f[q][j].z + f[q][j].w * f[q][j].w);
            } }
#pragma unroll
        for (int q = 0; q < 2; ++q) { const int m = m0 + q * NGW; if (m >= end) break;
            const float rstd = coef / sqrtf(wave_sum(s[q]) * (1.f / DM) + EPS);
            float s2 = 0.f;
#pragma unroll
            for (int j = 0; j < 4; ++j) { const f32x4 g = ((const f32x4*)post)[lane + 64 * j]; x[q][j] = x[q][j] + f[q][j] * g * rstd; s2 += (x[q][j].x * x[q][j].x + x[q][j].y * x[q][j].y) + (x[q][j].z * x[q][j].z + x[q][j].w * x[q][j].w); }
            if constexpr (NEXT == 0) {
#pragma unroll
                for (int j = 0; j < 4; ++j) ((f32x4*)((float*)a.in[I_OUT + z] + O_Y + (size_t)m * DM))[lane + 64 * j] = x[q][j];
            } else {
                if constexpr (NEXT == 1) {
#pragma unroll
                    for (int j = 0; j < 4; ++j) { u32x2 o; o.x = pk2(x[q][j].x, x[q][j].y); o.y = pk2(x[q][j].z, x[q][j].w); ((u32x2*)(XR + (size_t)m * DM))[lane + 64 * j] = o; }
                }
                float r2 = 1.f;
                if constexpr (NEXT == 1) r2 = 1.f / sqrtf(wave_sum(s2) * (1.f / DM) + EPS);
#pragma unroll
                for (int j = 0; j < 4; ++j) {
                    f32x4 g = {1.f, 1.f, 1.f, 1.f};
                    if constexpr (NEXT == 1) g = ((const f32x4*)pre)[lane + 64 * j];
                    u32x2 o; o.x = pk2(x[q][j].x * r2 * g.x, x[q][j].y * r2 * g.y); o.y = pk2(x[q][j].z * r2 * g.z, x[q][j].w * r2 * g.w);
                    ((u32x2*)(XN + (size_t)m * DM))[lane + 64 * j] = o;
                }
            }
        }
    }
}
template <int NEXT, int SRC> __device__ __forceinline__ void sample_norm(const Args& a, unsigned* sig, const bf16* Fin, float coef, int i_post, int i_pre, int G, int vcu, int wv) {
    constexpr int npair = DM >> 5, nitem = 8 * npair;
    const int lane = lane_id();
    for (int item = vcu; item < nitem; item += G) {
        if (item % npair != 0) continue;
        const int tr = item / npair;
        if (wv == 0) { unsigned sp = 0u; while ((unsigned)__builtin_amdgcn_readfirstlane(__hip_atomic_load(sig + 64 * tr, __ATOMIC_RELAXED, __HIP_MEMORY_SCOPE_AGENT)) < (unsigned)npair) { __builtin_amdgcn_s_sleep(1); if (++sp > (1u << 20)) break; }
                       __builtin_amdgcn_fence(__ATOMIC_ACQUIRE, "agent"); asm volatile("s_waitcnt vmcnt(0)" ::: "memory"); }
        __syncthreads();
        norm_rows<NEXT, SRC>(a, Fin, coef, i_post, i_pre, MP + 16 * tr + wv, NWAVES, MP + 16 * tr + 16, lane);
    }
}

__device__ __forceinline__ void mla_prep(const Args& a, int vcu, int G, int lane, int wave) {
    int z = 0; asm volatile("" : "+s"(z));
    unsigned char* ws = (unsigned char*)a.in[I_WS + z];
    const int gw = vcu * NWAVES + wave, NGW = G * NWAVES;
    const bf16* Z = (const bf16*)(ws + WS_Z);
    const float* cosT = (const float*)(ws + WS_ROPE); const float* sinT = cosT + ROPE_TAB;
    const float* qn = (const float*)a.in[I_QNORM + z]; const float* kn = (const float*)a.in[I_KVNORM + z];
    for (int m0 = gw; m0 < MT; m0 += 4 * NGW) {
        unsigned qw[4][3]; u32x2 kw4[4]; float x1[4], x2[4], cs[4], sn4[4];
#pragma unroll
        for (int qq = 0; qq < 4; ++qq) { const int m = m0 + qq * NGW, mm = m < MT ? m : m0; const bf16* zr = Z + (size_t)mm * ZW;
#pragma unroll
            for (int j = 0; j < 3; ++j) qw[qq][j] = ((const unsigned*)(zr + Z_CQ))[lane + 64 * j];
            kw4[qq] = ((const u32x2*)(zr + Z_KV))[lane];
            const int pos = mm < MP ? (mm & (SEQ - 1)) : SEQ, l16 = lane & 15;
            x1[qq] = bf2f(zr[Z_KR + l16]); x2[qq] = bf2f(zr[Z_KR + 16 + l16]); cs[qq] = cosT[pos * 16 + l16]; sn4[qq] = sinT[pos * 16 + l16]; }
#pragma unroll
        for (int qq = 0; qq < 4; ++qq) { const int m = m0 + qq * NGW; if (m >= MT) break;
            float q[6]; float s = 0.f;
#pragma unroll
            for (int j = 0; j < 3; ++j) { const unsigned w = qw[qq][j]; q[2 * j] = bflo(w); q[2 * j + 1] = bfhi(w); s += q[2 * j] * q[2 * j] + q[2 * j + 1] * q[2 * j + 1]; }
            const float rq = __builtin_amdgcn_rsqf(wave_sum(s) * (1.f / QL) + EPS);
#pragma unroll
            for (int j = 0; j < 3; ++j) { const f32x2 g = ((const f32x2*)qn)[lane + 64 * j]; ((unsigned*)((bf16*)(ws + WS_CQ) + (size_t)m * QL))[lane + 64 * j] = pk2(q[2 * j] * rq * g.x, q[2 * j + 1] * rq * g.y); }
            const u32x2 kw = kw4[qq];
            f32x4 kv = {bflo(kw.x), bfhi(kw.x), bflo(kw.y), bfhi(kw.y)};
            const float rk = __builtin_amdgcn_rsqf(wave_sum((kv.x * kv.x + kv.y * kv.y) + (kv.z * kv.z + kv.w * kv.w)) * (1.f / KVL) + EPS);
            kv = kv * rk * ((const f32x4*)kn)[lane];
            { u32x2 o; o.x = pk2(kv.x, kv.y); o.y = pk2(kv.z, kv.w); ((u32x2*)((bf16*)(ws + WS_CKV) + (size_t)m * KVL))[lane] = o; }
            if (m < MP) ((f32x4*)((float*)a.in[I_OUT + z] + O_CKV_P + (size_t)m * KVL))[lane] = kv;
            else if (m < MP + NS) ((f32x4*)((float*)a.in[I_OUT + z] + O_CKV_S + (size_t)(m - MP) * KVL))[lane] = kv;
            if (lane < 16) {
                const float o1 = x1[qq] * cs[qq] - x2[qq] * sn4[qq], o2 = x1[qq] * sn4[qq] + x2[qq] * cs[qq];
                bf16* kr = (bf16*)(ws + WS_KR) + (size_t)m * ROPE;
                kr[lane] = f2bf(o1); kr[16 + lane] = f2bf(o2);
                float* ko = m < MP ? (float*)a.in[I_OUT + z] + O_KR_P + (size_t)m * ROPE : (m < MP + NS ? (float*)a.in[I_OUT + z] + O_KR_S + (size_t)(m - MP) * ROPE : nullptr);
                if (ko) { ko[lane] = o1; ko[16 + lane] = o2; }
            }
        }
    }
    { const float* scv = (const float*)a.in[I_SCONV + z]; float* co = (float*)a.in[I_OUT + z] + O_CONV_S;
      for (int it = gw; it < NS * 3 * (DRNN / 64); it += NGW) { const int sq = it / 60, r = it - 60 * sq, j = r / 20, idx = (r - 20 * j) * 64 + lane;
          co[(size_t)(sq * 3 + j) * DRNN + idx] = j < 2 ? scv[(size_t)(sq * 3 + j + 1) * DRNN + idx] : bf2f(Z[(size_t)(MP + sq) * ZW + Z_XR + idx]); } }
}


constexpr int L2_LW = 0, L2_CW = 33280, L2_TILE = 35328, L2_TPITCH = 84, L2_TBYTES = 16 * L2_TPITCH * 4, L2_WAVE = 2 * L2_TBYTES;
static_assert(L2_TILE + 8 * L2_WAVE <= RING_BYTES, "RG-LRU LDS map");
__device__ __forceinline__ float one_minus_exp(float x) {
    const float t = x * (1.f + x * (0.5f + x * (0.16666667f + x * 0.041666668f)));
    float e = 1.f - __builtin_amdgcn_exp2f(x * 1.4426950408889634f); asm volatile("" : "+v"(e));
    return x > -0.06f ? -t : e;
}
__device__ __forceinline__ void row4(float v, float (&out)[4]) {
    const unsigned u = __float_as_uint(v);
    const auto h = __builtin_amdgcn_permlane32_swap(u, u, false, false);
    const auto lo = __builtin_amdgcn_permlane16_swap(h[0], h[0], false, false);
    const auto hi = __builtin_amdgcn_permlane16_swap(h[1], h[1], false, false);
    out[0] = __uint_as_float(lo[0]); out[1] = __uint_as_float(lo[1]); out[2] = __uint_as_float(hi[0]); out[3] = __uint_as_float(hi[1]);
}
template <int PASS> __device__ __forceinline__ void lru_load(const bf16* Z, int ch0, int row0, int tib0, int l15, int g4, u32x4 (&zw)[3][5]) {
#pragma unroll
    for (int j = 0; j < 3; ++j) { const int cb = 32 * j + 8 * g4;
#pragma unroll
        for (int t = 0; t < 4; ++t) { u32x4 w = {0u, 0u, 0u, 0u}; if (tib0 + l15 + t - 3 >= 0) w = *(const u32x4*)(Z + (size_t)(row0 + l15 + t - 3) * ZW + Z_XR + ch0 + cb); zw[j][t] = w; }
        if (PASS == 2) { u32x4 w = {0u, 0u, 0u, 0u}; if (cb < 80) w = *(const u32x4*)(Z + (size_t)(row0 + l15) * ZW + Z_YR + ch0 + cb); zw[j][4] = w; }
    }
}
template <int PASS, bool SAMP> __device__ __forceinline__ void lru_tile(const Args& a, int z, unsigned char* ws, LAS unsigned char* lds, int n, int row0, int tib0, int lane, int wave,
                                                                        const float (&gba)[5], const float (&gbi)[5], const float (&gsp)[5], float (&carry)[5], float (&aprod)[5], const u32x4 (&zw)[3][5]) {
    const bf16* Z = (const bf16*)(ws + WS_Z);
    const int l15 = lane & 15, g4 = lane >> 4, ch0 = n * BLK;
    LAS float* xt = (LAS float*)(lds + L2_TILE + wave * L2_WAVE); LAS float* ht = xt + 16 * L2_TPITCH;
    const LAS float* cwl = (const LAS float*)(lds + L2_CW);
    bf16x8 af[3];
#pragma unroll
    for (int j = 0; j < 3; ++j) {
        const int cb = 32 * j + 8 * g4;
        float xc[8];
        { const f32x4 b0 = *(const LAS f32x4*)(cwl + 4 * 96 + cb), b1 = *(const LAS f32x4*)(cwl + 4 * 96 + cb + 4); xc[0] = b0.x; xc[1] = b0.y; xc[2] = b0.z; xc[3] = b0.w; xc[4] = b1.x; xc[5] = b1.y; xc[6] = b1.z; xc[7] = b1.w; }
#pragma unroll
        for (int t = 0; t < 4; ++t) {
            float xv[8];
            if (SAMP && t < 3) {
                const float* sp = (const float*)a.in[I_SCONV + z] + (size_t)((row0 - MP + l15) * 3 + t) * DRNN + ch0 + cb;
                if (cb < 80) { const f32x4 v0 = *(const f32x4*)sp, v1 = *(const f32x4*)(sp + 4); xv[0] = v0.x; xv[1] = v0.y; xv[2] = v0.z; xv[3] = v0.w; xv[4] = v1.x; xv[5] = v1.y; xv[6] = v1.z; xv[7] = v1.w; }
                else { for (int e = 0; e < 8; ++e) xv[e] = 0.f; }
            } else {
                u32x4 w;
                if constexpr (SAMP) w = *(const u32x4*)(Z + (size_t)(row0 + l15) * ZW + Z_XR + ch0 + cb); else w = zw[j][t];
                xv[0] = bflo(w.x); xv[1] = bfhi(w.x); xv[2] = bflo(w.y); xv[3] = bfhi(w.y); xv[4] = bflo(w.z); xv[5] = bfhi(w.z); xv[6] = bflo(w.w); xv[7] = bfhi(w.w);
            }
            const f32x4 w0 = *(const LAS f32x4*)(cwl + t * 96 + cb), w1 = *(const LAS f32x4*)(cwl + t * 96 + cb + 4);
            xc[0] += w0.x * xv[0]; xc[1] += w0.y * xv[1]; xc[2] += w0.z * xv[2]; xc[3] += w0.w * xv[3]; xc[4] += w1.x * xv[4]; xc[5] += w1.y * xv[5]; xc[6] += w1.z * xv[6]; xc[7] += w1.w * xv[7];
        }
        u32x4 pw; pw.x = pk2(xc[0], xc[1]); pw.y = pk2(xc[2], xc[3]); pw.z = pk2(xc[4], xc[5]); pw.w = pk2(xc[6], xc[7]);
        af[j] = __builtin_bit_cast(bf16x8, pw);
        if (cb < 80) { *(LAS f32x4*)(xt + l15 * L2_TPITCH + cb) = (f32x4){xc[0], xc[1], xc[2], xc[3]}; *(LAS f32x4*)(xt + l15 * L2_TPITCH + cb + 4) = (f32x4){xc[4], xc[5], xc[6], xc[7]}; }
    }
    LDS_WAIT();
#pragma unroll
    for (int ct = 0; ct < 5; ++ct) {
        f32x4 ar = {0.f, 0.f, 0.f, 0.f}, ai = {0.f, 0.f, 0.f, 0.f};
#pragma unroll
        for (int j = 0; j < 3; ++j) {
            const bf16x8 br = *(const LAS bf16x8*)(lds + L2_LW + (ct * 16 + l15) * 208 + (32 * j + 8 * g4) * 2);
            const bf16x8 bi = *(const LAS bf16x8*)(lds + L2_LW + (80 + ct * 16 + l15) * 208 + (32 * j + 8 * g4) * 2);
            ar = __builtin_amdgcn_mfma_f32_16x16x32_bf16(af[j], br, ar, 0, 0, 0);
            ai = __builtin_amdgcn_mfma_f32_16x16x32_bf16(af[j], bi, ai, 0, 0, 0);
        }
        const int ch = ct * 16 + l15;
        float av[4], bv[4];
#pragma unroll
        for (int i = 0; i < 4; ++i) {
            const float r = sigmoid_f(ar[i] + gba[ct]), gi = sigmoid_f(ai[i] + gbi[ct]);
            const float la = -8.f * r * gsp[ct];
            av[i] = __builtin_amdgcn_exp2f(la * 1.4426950408889634f);
            bv[i] = __builtin_amdgcn_sqrtf((1.f - av[i]) * (1.f + av[i])) * gi * xt[(4 * g4 + i) * L2_TPITCH + ch];
        }
        float hv[4];
        if constexpr (SAMP) {
            const float* sh = (const float*)a.in[I_SH + z];
#pragma unroll
            for (int i = 0; i < 4; ++i) { const int s = row0 - MP + 4 * g4 + i; hv[i] = av[i] * sh[(size_t)s * DRNN + ch0 + ch] + bv[i]; ((float*)a.in[I_OUT + z])[O_H_S + (size_t)s * DRNN + ch0 + ch] = hv[i]; }
        } else {
            float q[4]; float hl = 0.f, qq = 1.f;
#pragma unroll
            for (int i = 0; i < 4; ++i) { hl = av[i] * hl + bv[i]; qq *= av[i]; hv[i] = hl; q[i] = qq; }
            float cin = carry[ct], call = carry[ct], pall = 1.f;
            float Pq[4], Hq[4];
            row4(qq, Pq); row4(hl, Hq);
#pragma unroll
            for (int gq = 0; gq < 4; ++gq) { const float Pg = Pq[gq], Hg = Hq[gq];
                if (gq < g4) cin = Pg * cin + Hg;
                call = Pg * call + Hg; pall *= Pg; }
#pragma unroll
            for (int i = 0; i < 4; ++i) hv[i] += q[i] * cin;
            carry[ct] = call; aprod[ct] *= pall;
        }
        if constexpr (PASS == 2) {
#pragma unroll
            for (int i = 0; i < 4; ++i) ht[(4 * g4 + i) * L2_TPITCH + ch] = hv[i];
        }
    }
    if constexpr (PASS == 2) {
        LDS_WAIT();
#pragma unroll
        for (int j = 0; j < 3; ++j) { const int cb = 32 * j + 8 * g4;
            if (cb < 80) {
                const f32x4 h0 = *(const LAS f32x4*)(ht + l15 * L2_TPITCH + cb), h1 = *(const LAS f32x4*)(ht + l15 * L2_TPITCH + cb + 4);
                u32x4 y; if constexpr (SAMP) y = *(const u32x4*)(Z + (size_t)(row0 + l15) * ZW + Z_YR + ch0 + cb); else y = zw[j][4];
                u32x4 o; o.x = pk2(h0.x * bflo(y.x), h0.y * bfhi(y.x)); o.y = pk2(h0.z * bflo(y.y), h0.w * bfhi(y.y)); o.z = pk2(h1.x * bflo(y.z), h1.y * bfhi(y.z)); o.w = pk2(h1.z * bflo(y.w), h1.w * bfhi(y.w));
                *(u32x4*)((bf16*)(ws + WS_HG) + (size_t)(row0 + l15) * DRNN + ch0 + cb) = o;
            }
        }
    }
    LDS_WAIT();
}
template <int PASS> __device__ __forceinline__ void lru_cu_unit(const Args& a, LAS unsigned char* lds, int u, int wave) {
    int z = 0; asm volatile("" : "+s"(z));
    int lane_ = lane_id(); asm volatile("" : "+v"(lane_)); const int lane = lane_, l15 = lane & 15;
    unsigned char* ws = (unsigned char*)a.in[I_WS + z];
    const int n = u & 15, ch0 = n * BLK, cidx = 8 * (u >> 4) + wave;
    __syncthreads();
    { const u32x4* src = (const u32x4*)(ws + WS_LW + (size_t)n * 33280); LAS u32x4* dst = (LAS u32x4*)(lds + L2_LW);
      for (int i = TIDW(wave); i < 2080; i += 512) dst[i] = src[i]; }
    { const int tid = TIDW(wave); if (tid < 480) { const int t = tid / 96, c = tid - 96 * t; float v = 0.f;
        if (c < 80) v = t < 4 ? ((const float*)a.in[I_CONVW + z])[t * DRNN + ch0 + c] : ((const float*)a.in[I_CONVB + z])[ch0 + c];
        ((LAS float*)(lds + L2_CW))[tid] = v; } }
    float gba[5], gbi[5], gsp[5], carry[5], aprod[5];
#pragma unroll
    for (int ct = 0; ct < 5; ++ct) { const int cg = ch0 + ct * 16 + l15; gba[ct] = ((const float*)a.in[I_LBA + z])[cg]; gbi[ct] = ((const float*)a.in[I_LBI + z])[cg];
        gsp[ct] = log1pf(expf(-((const float*)a.in[I_LAM + z])[cg])); carry[ct] = 0.f; aprod[ct] = 1.f; }
    const bf16* Zp = (const bf16*)(ws + WS_Z);
    const int row_c = cidx * 128, tib_c = (cidx & 63) * 128, g4 = lane >> 4;
    u32x4 zwA[3][5], zwB[3][5];
    lru_load<PASS>(Zp, ch0, row_c, tib_c, l15, g4, zwA);
    if (PASS == 2) {
        const f32x2* SUM = (const f32x2*)(ws + WS_SUM);
        const int nprev = cidx & 63, base = cidx & ~63, qn = (nprev + 3) >> 2, lo = base + g4 * qn, hi = (lo + qn < base + nprev) ? lo + qn : base + nprev;
        float fa[5], fh[5];
#pragma unroll
        for (int ct = 0; ct < 5; ++ct) { fa[ct] = 1.f; fh[ct] = 0.f; }
        for (int jc = lo; jc < hi; jc += 4) {
            f32x2 sm[4][5];
#pragma unroll
            for (int k = 0; k < 4; ++k)
#pragma unroll
                for (int ct = 0; ct < 5; ++ct) sm[k][ct] = (jc + k < hi) ? SUM[(size_t)(jc + k) * DRNN + ch0 + ct * 16 + l15] : (f32x2){1.f, 0.f};
#pragma unroll
            for (int k = 0; k < 4; ++k)
#pragma unroll
                for (int ct = 0; ct < 5; ++ct) { fh[ct] = sm[k][ct].x * fh[ct] + sm[k][ct].y; fa[ct] = sm[k][ct].x * fa[ct]; }
        }
#pragma unroll
        for (int ct = 0; ct < 5; ++ct) { float c = 0.f;
            float Aq[4], Hq[4]; row4(fa[ct], Aq); row4(fh[ct], Hq);
#pragma unroll
            for (int gq = 0; gq < 4; ++gq) c = Aq[gq] * c + Hq[gq];
            carry[ct] = c; }
    }
    __syncthreads();
#pragma unroll 1
    for (int mt = 0; mt < 8; mt += 2) {
        lru_load<PASS>(Zp, ch0, row_c + 16 * (mt + 1), tib_c + 16 * (mt + 1), l15, g4, zwB);
        lru_tile<PASS, false>(a, z, ws, lds, n, row_c + 16 * mt, tib_c + 16 * mt, lane, wave, gba, gbi, gsp, carry, aprod, zwA);
        if (mt + 2 < 8) lru_load<PASS>(Zp, ch0, row_c + 16 * (mt + 2), tib_c + 16 * (mt + 2), l15, g4, zwA);
        lru_tile<PASS, false>(a, z, ws, lds, n, row_c + 16 * (mt + 1), tib_c + 16 * (mt + 1), lane, wave, gba, gbi, gsp, carry, aprod, zwB);
    }
    if (PASS == 1) { if (lane < 16) { for (int ct = 0; ct < 5; ++ct) ((f32x2*)(ws + WS_SUM))[(size_t)cidx * DRNN + ch0 + ct * 16 + l15] = (f32x2){aprod[ct], carry[ct]}; } }
    else {
        float* out = (float*)a.in[I_OUT + z];
        if ((cidx & 63) == 63) {
            const int bb = cidx >> 6;
            if (lane < 16) { for (int ct = 0; ct < 5; ++ct) out[O_H_P + (size_t)bb * DRNN + ch0 + ct * 16 + l15] = carry[ct]; }
            const bf16* Z = (const bf16*)(ws + WS_Z);
            for (int e = lane; e < 240; e += 64) { const int jj = e / 80, c = e - 80 * jj; out[O_CONV_P + (size_t)(bb * 3 + jj) * DRNN + ch0 + c] = bf2f(Z[(size_t)(bb * SEQ + SEQ - 3 + jj) * ZW + Z_XR + ch0 + c]); }
        }
        if (u < 16) {
            float c2[5], p2[5];
#pragma unroll
            for (int ct = 0; ct < 5; ++ct) { c2[ct] = 0.f; p2[ct] = 1.f; }
            lru_tile<PASS, true>(a, z, ws, lds, n, MP + 16 * wave, 0, lane, wave, gba, gbi, gsp, c2, p2, zwA);
        }
    }
}

constexpr int SA_QIMG = 0, SA_PITCH = 592, SA_KT = 16 * SA_PITCH;
constexpr int SA_SLOT = 66 * 64 * 4, SA_OLAT = 4 * SA_SLOT;
static_assert(SA_OLAT + 16 * 256 * 4 <= RING_BYTES, "decode attention LDS map");
__device__ __forceinline__ void sample_attn_half(const Args& a, LAS unsigned char* lds, int s, int half, int wv) {
    int z = 0; asm volatile("" : "+s"(z));
    int tid = TIDW(wv); asm volatile("" : "+v"(tid)); const int lane = tid & 63, wave = wv;
    unsigned char* ws = (unsigned char*)a.in[I_WS + z];
    const bf16* Qrow = (const bf16*)(ws + WS_Q) + (size_t)(MP + s) * QW;
    const bf16* BKV = (const bf16*)(ws + WS_BKV);
    __syncthreads();
    {
        LAS float* qs = (LAS float*)(lds + SA_KT);
        { const unsigned w = ((const unsigned*)Qrow)[tid]; qs[2 * tid] = bflo(w); qs[2 * tid + 1] = bfhi(w); }
        __syncthreads();
        const int r2 = (tid & 127) * 2, hg = tid >> 7;
#pragma unroll 1
        for (int hh = 0; hh < 4; ++hh) { const int hd = hg * 4 + hh; float a0 = 0.f, a1 = 0.f;
            unsigned wv_[64];
#pragma unroll
            for (int d = 0; d < 64; ++d) wv_[d] = *(const unsigned*)(BKV + (size_t)(hd * 64 + d) * KVL + r2);
#pragma unroll
            for (int d = 0; d < 64; ++d) { const float q = qs[hd * 64 + d]; a0 += q * bflo(wv_[d]); a1 += q * bfhi(wv_[d]); }
            *(LAS unsigned*)(lds + SA_QIMG + hd * SA_PITCH + r2 * 2) = pk2(a0, a1); }
        if ((tid & 31) < 16) { const int hd = tid >> 5, i = tid & 15;
          const float* cosT = (const float*)(ws + WS_ROPE); const float c = cosT[SEQ * 16 + i], sn = cosT[ROPE_TAB + SEQ * 16 + i];
          const float x1 = bf2f(Qrow[1024 + hd * 32 + i]), x2 = bf2f(Qrow[1024 + hd * 32 + 16 + i]);
          *(LAS bf16*)(lds + SA_QIMG + hd * SA_PITCH + (256 + i) * 2) = f2bf(x1 * c - x2 * sn);
          *(LAS bf16*)(lds + SA_QIMG + hd * SA_PITCH + (256 + 16 + i) * 2) = f2bf(x1 * sn + x2 * c); }
    }
    __syncthreads();
    const int g4 = lane >> 4, l15 = lane & 15;
    const LAS unsigned char* qfp = lds + SA_QIMG + l15 * SA_PITCH + 8 * g4 * 2;
    LAS unsigned char* kt = lds + SA_KT + wave * 9472;
    const unsigned ktb = (unsigned)(uintptr_t)kt;
    const int* pt = (const int*)a.in[I_PT + z] + s * NPAGES + half * 32 + wave * 4;
    const float* cckv = (const float*)a.in[I_CCKV + z]; const float* ckr = (const float*)a.in[I_CKR + z];
    float m_run = -1e30f, l_part = 0.f;
    f32x4 oacc[16];
#pragma unroll
    for (int i = 0; i < 16; ++i) oacc[i] = (f32x4){0.f, 0.f, 0.f, 0.f};
    f32x4 stA[18], stB[18];
#define SA_ISSUE(ST, tt) do { const int pid_ = pt[(tt) >> 3]; const float* kb_ = cckv + ((size_t)pid_ * PAGE + ((tt) & 7) * 16) * KVL; const float* rb_ = ckr + ((size_t)pid_ * PAGE + ((tt) & 7) * 16) * ROPE; \
        _Pragma("unroll") for (int i_ = 0; i_ < 16; ++i_) ST[i_] = __builtin_nontemporal_load((const f32x4*)(kb_ + i_ * KVL) + lane); \
        ST[16] = __builtin_nontemporal_load((const f32x4*)rb_ + lane); ST[17] = __builtin_nontemporal_load((const f32x4*)rb_ + 64 + lane); } while (0)
#define SA_TOLDS(ST) do { \
        _Pragma("unroll") for (int i = 0; i < 16; ++i) { u32x2 o; o.x = pk2(ST[i].x, ST[i].y); o.y = pk2(ST[i].z, ST[i].w); *(LAS u32x2*)(kt + i * SA_PITCH + lane * 8) = o; } \
        _Pragma("unroll") for (int k = 0; k < 2; ++k) { u32x2 o; o.x = pk2(ST[16 + k].x, ST[16 + k].y); o.y = pk2(ST[16 + k].z, ST[16 + k].w); *(LAS u32x2*)(kt + (8 * k + (lane >> 3)) * SA_PITCH + (256 + 4 * (lane & 7)) * 2) = o; } } while (0)
#define SA_COMPUTE(SELF) do { \
        LDS_WAIT(); \
        f32x4 sacc = {0.f, 0.f, 0.f, 0.f}; \
        _Pragma("unroll") for (int j = 0; j < 9; ++j) { const bf16x8 kf = *(const LAS bf16x8*)(kt + l15 * SA_PITCH + (32 * j + 8 * g4) * 2); const bf16x8 qfj = *(const LAS bf16x8*)(qfp + 64 * j); sacc = __builtin_amdgcn_mfma_f32_16x16x32_bf16(kf, qfj, sacc, 0, 0, 0); } \
        if (SELF) { _Pragma("unroll") for (int i = 0; i < 4; ++i) if (4 * g4 + i >= 1) sacc[i] = -__builtin_inff(); } \
        float mx = fmaxf(fmaxf(sacc[0], sacc[1]), fmaxf(sacc[2], sacc[3])); \
        mx = fmaxf(mx, __shfl_xor(mx, 16)); mx = fmaxf(mx, __shfl_xor(mx, 32)); \
        const float mn = fmaxf(m_run, mx), alpha = __builtin_amdgcn_exp2f(m_run - mn); \
        m_run = mn; \
        const float p0 = __builtin_amdgcn_exp2f(sacc[0] - mn), p1 = __builtin_amdgcn_exp2f(sacc[1] - mn), p2 = __builtin_amdgcn_exp2f(sacc[2] - mn), p3 = __builtin_amdgcn_exp2f(sacc[3] - mn); \
        l_part = l_part * alpha + ((p0 + p1) + (p2 + p3)); \
        u32x2 pw; pw.x = pk2(p0, p1); pw.y = pk2(p2, p3); \
        const s16x4 pb = __builtin_bit_cast(s16x4, pw); \
        const unsigned vaddr = ktb + (unsigned)((4 * g4 + (l15 >> 2)) * SA_PITCH + (l15 & 3) * 8); \
        _Pragma("unroll") for (int ct = 0; ct < 16; ++ct) { \
            s16x4 vf; \
            asm volatile("ds_read_b64_tr_b16 %0, %1 offset:%2" : "=v"(vf) : "v"(vaddr), "i"(ct * 32) : "memory"); \
            asm volatile("s_waitcnt lgkmcnt(0)" ::: "memory"); \
            oacc[ct] = oacc[ct] * alpha; \
            oacc[ct] = __builtin_amdgcn_mfma_f32_16x16x16bf16_1k(vf, pb, oacc[ct], 0, 0, 0); } } while (0)
    SA_ISSUE(stA, 0); SA_ISSUE(stB, 1);
#pragma unroll 1
    for (int tt = 0; tt < 32; tt += 2) {
        if (tt + 1 < 32) asm volatile("s_waitcnt vmcnt(18)" ::: "memory"); else VM_WAIT();
        asm volatile("" : "+v"(stA[0]), "+v"(stA[1]), "+v"(stA[2]), "+v"(stA[3]), "+v"(stA[4]), "+v"(stA[5]), "+v"(stA[6]), "+v"(stA[7]), "+v"(stA[8]));
        asm volatile("" : "+v"(stA[9]), "+v"(stA[10]), "+v"(stA[11]), "+v"(stA[12]), "+v"(stA[13]), "+v"(stA[14]), "+v"(stA[15]), "+v"(stA[16]), "+v"(stA[17]));
        SA_TOLDS(stA);
        if (tt + 2 < 32) SA_ISSUE(stA, tt + 2);
        SA_COMPUTE(false);
        if (tt + 2 < 32) asm volatile("s_waitcnt vmcnt(18)" ::: "memory"); else VM_WAIT();
        asm volatile("" : "+v"(stB[0]), "+v"(stB[1]), "+v"(stB[2]), "+v"(stB[3]), "+v"(stB[4]), "+v"(stB[5]), "+v"(stB[6]), "+v"(stB[7]), "+v"(stB[8]));
        asm volatile("" : "+v"(stB[9]), "+v"(stB[10]), "+v"(stB[11]), "+v"(stB[12]), "+v"(stB[13]), "+v"(stB[14]), "+v"(stB[15]), "+v"(stB[16]), "+v"(stB[17]));
        SA_TOLDS(stB);
        if (tt + 3 < 32) SA_ISSUE(stB, tt + 3);
        SA_COMPUTE(false);
    }
    if (half == 1 && wave == 7) {
        const bf16* ck = (const bf16*)(ws + WS_CKV) + (size_t)(MP + s) * KVL; const bf16* kr = (const bf16*)(ws + WS_KR) + (size_t)(MP + s) * ROPE;
#pragma unroll
        for (int i = 0; i < 16; ++i) { u32x2 o = {0u, 0u}; if (i == 0) o = ((const u32x2*)ck)[lane]; *(LAS u32x2*)(kt + i * SA_PITCH + lane * 8) = o; }
        if (lane < 32) { *(LAS bf16*)(kt + (256 + lane) * 2) = kr[lane]; }
        else { const int d = lane - 32; for (int i = 1; i < 16; ++i) *(LAS bf16*)(kt + i * SA_PITCH + (256 + d) * 2) = 0; }
        SA_COMPUTE(true);
    }
#undef SA_ISSUE
#undef SA_TOLDS
#undef SA_COMPUTE
    LAS float* slots = (LAS float*)lds;
#pragma unroll 1
    for (int half = 4; half >= 1; half >>= 1) {
        __syncthreads();
        if (wave >= half && wave < 2 * half) { LAS float* sl = slots + (size_t)(wave - half) * (SA_SLOT / 4);
#pragma unroll
            for (int ct = 0; ct < 16; ++ct) { sl[(4 * ct + 0) * 64 + lane] = oacc[ct][0]; sl[(4 * ct + 1) * 64 + lane] = oacc[ct][1]; sl[(4 * ct + 2) * 64 + lane] = oacc[ct][2]; sl[(4 * ct + 3) * 64 + lane] = oacc[ct][3]; }
            sl[64 * 64 + lane] = m_run; sl[65 * 64 + lane] = l_part; }
        __syncthreads();
        if (wave < half) { const LAS float* sl = slots + (size_t)wave * (SA_SLOT / 4);
            const float m2 = sl[64 * 64 + lane], l2 = sl[65 * 64 + lane];
            const float mn = fmaxf(m_run, m2), a1 = __builtin_amdgcn_exp2f(m_run - mn), a2 = __builtin_amdgcn_exp2f(m2 - mn);
            m_run = mn; l_part = a1 * l_part + a2 * l2;
#pragma unroll
            for (int ct = 0; ct < 16; ++ct) { oacc[ct][0] = a1 * oacc[ct][0] + a2 * sl[(4 * ct + 0) * 64 + lane]; oacc[ct][1] = a1 * oacc[ct][1] + a2 * sl[(4 * ct + 1) * 64 + lane];
                                             oacc[ct][2] = a1 * oacc[ct][2] + a2 * sl[(4 * ct + 2) * 64 + lane]; oacc[ct][3] = a1 * oacc[ct][3] + a2 * sl[(4 * ct + 3) * 64 + lane]; } }
    }
    if (wave == 0) {
        float* part = (float*)(ws + WS_PART) + (size_t)(s * 2 + half) * PART_STRIDE;
        float lsum = l_part; lsum += __shfl_xor(lsum, 16); lsum += __shfl_xor(lsum, 32);
#pragma unroll
        for (int ct = 0; ct < 16; ++ct) *(f32x4*)(part + l15 * 256 + ct * 16 + 4 * g4) = oacc[ct];
        if (g4 == 0) { part[4096 + l15] = m_run; part[4096 + 16 + l15] = lsum; }
    }
}
__device__ __forceinline__ void sample_attn_seq(const Args& a, LAS unsigned char* lds, int s, int wv) {
    int z = 0; asm volatile("" : "+s"(z));
    int tid = TIDW(wv); asm volatile("" : "+v"(tid)); const int lane = tid & 63, wave = wv;
    unsigned char* ws = (unsigned char*)a.in[I_WS + z];
    const bf16* Qrow = (const bf16*)(ws + WS_Q) + (size_t)(MP + s) * QW;
    const bf16* BKV = (const bf16*)(ws + WS_BKV);
    __syncthreads();
    {
        LAS float* qs = (LAS float*)(lds + SA_KT);
        { const unsigned w = ((const unsigned*)Qrow)[tid]; qs[2 * tid] = bflo(w); qs[2 * tid + 1] = bfhi(w); }
        __syncthreads();
        const int r2 = (tid & 127) * 2, hg = tid >> 7;
#pragma unroll 1
        for (int hh = 0; hh < 4; ++hh) { const int hd = hg * 4 + hh; float a0 = 0.f, a1 = 0.f;
            unsigned wv_[64];
#pragma unroll
            for (int d = 0; d < 64; ++d) wv_[d] = *(const unsigned*)(BKV + (size_t)(hd * 64 + d) * KVL + r2);
#pragma unroll
            for (int d = 0; d < 64; ++d) { const float q = qs[hd * 64 + d]; a0 += q * bflo(wv_[d]); a1 += q * bfhi(wv_[d]); }
            *(LAS unsigned*)(lds + SA_QIMG + hd * SA_PITCH + r2 * 2) = pk2(a0, a1); }
        if ((tid & 31) < 16) { const int hd = tid >> 5, i = tid & 15;
          const float* cosT = (const float*)(ws + WS_ROPE); const float c = cosT[SEQ * 16 + i], sn = cosT[ROPE_TAB + SEQ * 16 + i];
          const float x1 = bf2f(Qrow[1024 + hd * 32 + i]), x2 = bf2f(Qrow[1024 + hd * 32 + 16 + i]);
          *(LAS bf16*)(lds + SA_QIMG + hd * SA_PITCH + (256 + i) * 2) = f2bf(x1 * c - x2 * sn);
          *(LAS bf16*)(lds + SA_QIMG + hd * SA_PITCH + (256 + 16 + i) * 2) = f2bf(x1 * sn + x2 * c); }
    }
    __syncthreads();
    const int g4 = lane >> 4, l15 = lane & 15;
    const LAS unsigned char* qfp = lds + SA_QIMG + l15 * SA_PITCH + 8 * g4 * 2;
    LAS unsigned char* kt = lds + SA_KT + wave * 9472;
    const unsigned ktb = (unsigned)(uintptr_t)kt;
    const int* pt = (const int*)a.in[I_PT + z] + s * NPAGES + wave * 8;
    const float* cckv = (const float*)a.in[I_CCKV + z]; const float* ckr = (const float*)a.in[I_CKR + z];
    float m_run = -1e30f, l_part = 0.f;
    f32x4 oacc[16];
#pragma unroll
    for (int i = 0; i < 16; ++i) oacc[i] = (f32x4){0.f, 0.f, 0.f, 0.f};
    f32x4 stA[18], stB[18];
#define SA_ISSUE(ST, tt) do { const int pid_ = pt[(tt) >> 3]; const float* kb_ = cckv + ((size_t)pid_ * PAGE + ((tt) & 7) * 16) * KVL; const float* rb_ = ckr + ((size_t)pid_ * PAGE + ((tt) & 7) * 16) * ROPE; \
        _Pragma("unroll") for (int i_ = 0; i_ < 16; ++i_) ST[i_] = __builtin_nontemporal_load((const f32x4*)(kb_ + i_ * KVL) + lane); \
        ST[16] = __builtin_nontemporal_load((const f32x4*)rb_ + lane); ST[17] = __builtin_nontemporal_load((const f32x4*)rb_ + 64 + lane); } while (0)
#define SA_TOLDS(ST) do { \
        _Pragma("unroll") for (int i = 0; i < 16; ++i) { u32x2 o; o.x = pk2(ST[i].x, ST[i].y); o.y = pk2(ST[i].z, ST[i].w); *(LAS u32x2*)(kt + i * SA_PITCH + lane * 8) = o; } \
        _Pragma("unroll") for (int k = 0; k < 2; ++k) { u32x2 o; o.x = pk2(ST[16 + k].x, ST[16 + k].y); o.y = pk2(ST[16 + k].z, ST[16 + k].w); *(LAS u32x2*)(kt + (8 * k + (lane >> 3)) * SA_PITCH + (256 + 4 * (lane & 7)) * 2) = o; } } while (0)
#define SA_TR4(base_) do { \
        asm volatile("ds_read_b64_tr_b16 %0, %4 offset:%5\n\tds_read_b64_tr_b16 %1, %4 offset:%6\n\tds_read_b64_tr_b16 %2, %4 offset:%7\n\tds_read_b64_tr_b16 %3, %4 offset:%8\n\ts_waitcnt lgkmcnt(0)" \
                     : "=&v"(vf[0]), "=&v"(vf[1]), "=&v"(vf[2]), "=&v"(vf[3]) \
                     : "v"(vaddr), "i"(((base_) + 0) * 32), "i"(((base_) + 1) * 32), "i"(((base_) + 2) * 32), "i"(((base_) + 3) * 32) : "memory"); \
        _Pragma("unroll") for (int c_ = 0; c_ < 4; ++c_) oacc[(base_) + c_] = __builtin_amdgcn_mfma_f32_16x16x16bf16_1k(vf[c_], pb, oacc[(base_) + c_], 0, 0, 0); } while (0)
#define SA_COMPUTE(SELF) do { \
        LDS_WAIT(); \
        f32x4 sacc = {0.f, 0.f, 0.f, 0.f}; \
        _Pragma("unroll") for (int j = 0; j < 9; ++j) { const bf16x8 kf = *(const LAS bf16x8*)(kt + l15 * SA_PITCH + (32 * j + 8 * g4) * 2); const bf16x8 qfj = *(const LAS bf16x8*)(qfp + 64 * j); sacc = __builtin_amdgcn_mfma_f32_16x16x32_bf16(kf, qfj, sacc, 0, 0, 0); } \
        if (SELF) { _Pragma("unroll") for (int i = 0; i < 4; ++i) if (4 * g4 + i >= 1) sacc[i] = -__builtin_inff(); } \
        float mx = fmaxf(fmaxf(sacc[0], sacc[1]), fmaxf(sacc[2], sacc[3])); \
        { auto r_ = __builtin_amdgcn_permlane16_swap(__float_as_uint(mx), __float_as_uint(mx), false, false); mx = fmaxf(__uint_as_float(r_[0]), __uint_as_float(r_[1])); } \
        { auto r_ = __builtin_amdgcn_permlane32_swap(__float_as_uint(mx), __float_as_uint(mx), false, false); mx = fmaxf(__uint_as_float(r_[0]), __uint_as_float(r_[1])); } \
        if (__builtin_expect(__any(mx > m_run + 8.f), 0)) { const float mn = fmaxf(m_run, mx), alpha = __builtin_amdgcn_exp2f(m_run - mn); m_run = mn; l_part *= alpha; \
            _Pragma("unroll") for (int ct = 0; ct < 16; ++ct) oacc[ct] = oacc[ct] * alpha; } \
        const float p0 = __builtin_amdgcn_exp2f(sacc[0] - m_run), p1 = __builtin_amdgcn_exp2f(sacc[1] - m_run), p2 = __builtin_amdgcn_exp2f(sacc[2] - m_run), p3 = __builtin_amdgcn_exp2f(sacc[3] - m_run); \
        l_part += (p0 + p1) + (p2 + p3); \
        u32x2 pw; pw.x = pk2(p0, p1); pw.y = pk2(p2, p3); \
        const s16x4 pb = __builtin_bit_cast(s16x4, pw); \
        const unsigned vaddr = ktb + (unsigned)((4 * g4 + (l15 >> 2)) * SA_PITCH + (l15 & 3) * 8); \
        s16x4 vf[4]; SA_TR4(0); SA_TR4(4); SA_TR4(8); SA_TR4(12); } while (0)
    SA_ISSUE(stA, 0); SA_ISSUE(stB, 1);
#pragma unroll 1
    for (int tt = 0; tt < 64; tt += 2) {
        if (tt + 1 < 64) asm volatile("s_waitcnt vmcnt(18)" ::: "memory"); else VM_WAIT();
        asm volatile("" : "+v"(stA[0]), "+v"(stA[1]), "+v"(stA[2]), "+v"(stA[3]), "+v"(stA[4]), "+v"(stA[5]), "+v"(stA[6]), "+v"(stA[7]), "+v"(stA[8]));
        asm volatile("" : "+v"(stA[9]), "+v"(stA[10]), "+v"(stA[11]), "+v"(stA[12]), "+v"(stA[13]), "+v"(stA[14]), "+v"(stA[15]), "+v"(stA[16]), "+v"(stA[17]));
        SA_TOLDS(stA);
        if (tt + 2 < 64) SA_ISSUE(stA, tt + 2);
        SA_COMPUTE(false);
        if (tt + 2 < 64) asm volatile("s_waitcnt vmcnt(18)" ::: "memory"); else VM_WAIT();
        asm volatile("" : "+v"(stB[0]), "+v"(stB[1]), "+v"(stB[2]), "+v"(stB[3]), "+v"(stB[4]), "+v"(stB[5]), "+v"(stB[6]), "+v"(stB[7]), "+v"(stB[8]));
        asm volatile("" : "+v"(stB[9]), "+v"(stB[10]), "+v"(stB[11]), "+v"(stB[12]), "+v"(stB[13]), "+v"(stB[14]), "+v"(stB[15]), "+v"(stB[16]), "+v"(stB[17]));
        SA_TOLDS(stB);
        if (tt + 3 < 64) SA_ISSUE(stB, tt + 3);
        SA_COMPUTE(false);
    }
    if (wave == 7) {
        const bf16* ck = (const bf16*)(ws + WS_CKV) + (size_t)(MP + s) * KVL; const bf16* kr = (const bf16*)(ws + WS_KR) + (size_t)(MP + s) * ROPE;
#pragma unroll
        for (int i = 0; i < 16; ++i) { u32x2 o = {0u, 0u}; if (i == 0) o = ((const u32x2*)ck)[lane]; *(LAS u32x2*)(kt + i * SA_PITCH + lane * 8) = o; }
        if (lane < 32) { *(LAS bf16*)(kt + (256 + lane) * 2) = kr[lane]; }
        else { const int d = lane - 32; for (int i = 1; i < 16; ++i) *(LAS bf16*)(kt + i * SA_PITCH + (256 + d) * 2) = 0; }
        SA_COMPUTE(true);
    }
#undef SA_ISSUE
#undef SA_TOLDS
#undef SA_COMPUTE
#undef SA_TR4
    LAS float* slots = (LAS float*)lds;
#pragma unroll 1
    for (int half = 4; half >= 1; half >>= 1) {
        __syncthreads();
        if (wave >= half && wave < 2 * half) { LAS float* sl = slots + (size_t)(wave - half) * (SA_SLOT / 4);
#pragma unroll
            for (int ct = 0; ct < 16; ++ct) { sl[(4 * ct + 0) * 64 + lane] = oacc[ct][0]; sl[(4 * ct + 1) * 64 + lane] = oacc[ct][1]; sl[(4 * ct + 2) * 64 + lane] = oacc[ct][2]; sl[(4 * ct + 3) * 64 + lane] = oacc[ct][3]; }
            sl[64 * 64 + lane] = m_run; sl[65 * 64 + lane] = l_part; }
        __syncthreads();
        if (wave < half) { const LAS float* sl = slots + (size_t)wave * (SA_SLOT / 4);
            const float m2 = sl[64 * 64 + lane], l2 = sl[65 * 64 + lane];
            const float mn = fmaxf(m_run, m2), a1 = __builtin_amdgcn_exp2f(m_run - mn), a2 = __builtin_amdgcn_exp2f(m2 - mn);
            m_run = mn; l_part = a1 * l_part + a2 * l2;
#pragma unroll
            for (int ct = 0; ct < 16; ++ct) { oacc[ct][0] = a1 * oacc[ct][0] + a2 * sl[(4 * ct + 0) * 64 + lane]; oacc[ct][1] = a1 * oacc[ct][1] + a2 * sl[(4 * ct + 1) * 64 + lane];
                                             oacc[ct][2] = a1 * oacc[ct][2] + a2 * sl[(4 * ct + 2) * 64 + lane]; oacc[ct][3] = a1 * oacc[ct][3] + a2 * sl[(4 * ct + 3) * 64 + lane]; } }
    }
    LAS float* olat = (LAS float*)(lds + SA_OLAT);
    if (wave == 0) {
        float lsum = l_part; lsum += __shfl_xor(lsum, 16); lsum += __shfl_xor(lsum, 32);
        const float il = 1.f / lsum;
#pragma unroll
        for (int ct = 0; ct < 16; ++ct) *(LAS f32x4*)(olat + l15 * 256 + ct * 16 + 4 * g4) = oacc[ct] * il;
    }
    __syncthreads();
    {
        const int hd = tid >> 5, v0 = (tid & 31) * 2;
        const bf16* B = BKV + (size_t)(1024 + hd * 64 + v0) * KVL;
        float a0 = 0.f, a1 = 0.f;
#pragma unroll 8
        for (int r = 0; r < 256; r += 8) { const u32x4 w0 = *(const u32x4*)(B + r), w1 = *(const u32x4*)(B + KVL + r);
            const f32x4 x0 = *(const LAS f32x4*)(olat + hd * 256 + r), x1 = *(const LAS f32x4*)(olat + hd * 256 + r + 4);
            a0 += x0.x * bflo(w0.x) + x0.y * bfhi(w0.x) + x0.z * bflo(w0.y) + x0.w * bfhi(w0.y) + x1.x * bflo(w0.z) + x1.y * bfhi(w0.z) + x1.z * bflo(w0.w) + x1.w * bfhi(w0.w);
            a1 += x0.x * bflo(w1.x) + x0.y * bfhi(w1.x) + x0.z * bflo(w1.y) + x0.w * bfhi(w1.y) + x1.x * bflo(w1.z) + x1.y * bfhi(w1.z) + x1.z * bflo(w1.w) + x1.w * bfhi(w1.w); }
        *(unsigned*)((bf16*)(ws + WS_OB) + (size_t)(MP + s) * DM + hd * 64 + v0) = pk2(a0, a1);
    }
}
__device__ __forceinline__ void sample_combine(const Args& a, LAS unsigned char* lds, int s, int wv) {
    int z = 0; asm volatile("" : "+s"(z));
    int tid = TIDW(wv); asm volatile("" : "+v"(tid));
    unsigned char* ws = (unsigned char*)a.in[I_WS + z];
    const float* part = (const float*)(ws + WS_PART) + (size_t)s * 2 * PART_STRIDE;
    LAS float* olat = (LAS float*)lds;
    __syncthreads();
    {
        const int hd = tid >> 5, cg = (tid & 31) * 8;
        const float m0 = part[4096 + hd], m1 = part[PART_STRIDE + 4096 + hd], mmax = fmaxf(m0, m1);
        const float w0 = __builtin_amdgcn_exp2f(m0 - mmax), w1 = __builtin_amdgcn_exp2f(m1 - mmax);
        const float il = 1.f / (w0 * part[4096 + 16 + hd] + w1 * part[PART_STRIDE + 4096 + 16 + hd]);
        const f32x4 o0 = (*(const f32x4*)(part + hd * 256 + cg) * w0 + *(const f32x4*)(part + PART_STRIDE + hd * 256 + cg) * w1) * il;
        const f32x4 o1 = (*(const f32x4*)(part + hd * 256 + cg + 4) * w0 + *(const f32x4*)(part + PART_STRIDE + hd * 256 + cg + 4) * w1) * il;
        *(LAS f32x4*)(olat + hd * 256 + cg) = o0; *(LAS f32x4*)(olat + hd * 256 + cg + 4) = o1;
    }
    __syncthreads();
    {
        const int hd = tid >> 5, v0 = (tid & 31) * 2;
        const bf16* B = (const bf16*)(ws + WS_BKV) + (size_t)(1024 + hd * 64 + v0) * KVL;
        float a0 = 0.f, a1 = 0.f;
#pragma unroll 8
        for (int r = 0; r < 256; r += 8) { const u32x4 w0 = *(const u32x4*)(B + r), w1 = *(const u32x4*)(B + KVL + r);
            const f32x4 x0 = *(const LAS f32x4*)(olat + hd * 256 + r), x1 = *(const LAS f32x4*)(olat + hd * 256 + r + 4);
            a0 += x0.x * bflo(w0.x) + x0.y * bfhi(w0.x) + x0.z * bflo(w0.y) + x0.w * bfhi(w0.y) + x1.x * bflo(w0.z) + x1.y * bfhi(w0.z) + x1.z * bflo(w0.w) + x1.w * bfhi(w0.w);
            a1 += x0.x * bflo(w1.x) + x0.y * bfhi(w1.x) + x0.z * bflo(w1.y) + x0.w * bfhi(w1.y) + x1.x * bflo(w1.z) + x1.y * bfhi(w1.z) + x1.z * bflo(w1.w) + x1.w * bfhi(w1.w); }
        *(unsigned*)((bf16*)(ws + WS_OB) + (size_t)(MP + s) * DM + hd * 64 + v0) = pk2(a0, a1);
    }
}

namespace pattn4 {
constexpr int NKS = 4, NVS = 4, KSLOT = 12288, VSLOT = 8192;
constexpr int LDS_K = 0, LDS_V = NKS * KSLOT, LDS_WS = LDS_V + NVS * VSLOT, LDS_OST = LDS_WS + 8 * 256, LDS_TOTAL = LDS_OST + 8 * 4096;
static_assert(LDS_TOTAL <= RING_BYTES, "attention LDS map");
constexpr float THR = 8.f;
#define SBAR() __builtin_amdgcn_sched_barrier(0)
#define SGB(mask, n) __builtin_amdgcn_sched_group_barrier(mask, n, 0)
#define WAIT_BAR(N) do { if constexpr (VAR & 4) asm volatile("s_waitcnt vmcnt(" #N ") lgkmcnt(0)" ::: "memory"); else asm volatile("s_waitcnt vmcnt(" #N ") lgkmcnt(0)\n\ts_barrier" ::: "memory"); } while (0)
__device__ __forceinline__ int crow(int r, int hi) { return (r & 3) + 8 * (r >> 2) + 4 * hi; }
__device__ __forceinline__ void mask_tile(f32x16& p0, f32x16& p1, int dq) {
    const float NEG = -__builtin_inff();
#pragma unroll
    for (int r = 0; r < 16; ++r) { const int c = (r & 3) + 8 * (r >> 2); if (dq - c < 0) p0[r] = NEG; if (dq - c - 32 < 0) p1[r] = NEG; }
}
template <int VAR> __device__ __forceinline__ void block(const bf16* Q, const bf16* KVB, const bf16* KR, const float* cosT, bf16* OB, LAS unsigned char* lds, int b, int h, int qb, int t0, int wv,
                                                   bool primed, bool has_next, int nb_, int nh_, int nqb_, bf16x8 (&qr)[6], unsigned* qnext = nullptr, int* pend = nullptr) {
    int tid = TIDW(wv); asm volatile("" : "+v"(tid));
    const int wid = wv, lane = tid & 63, r32 = lane & 31, hi = lane >> 5;
    const int NT = 4 * (qb + 1);
    const int P0 = qb * 256, qlo = P0 + wid * 32, qm = qlo + r32 - 4 * hi;
    LAS float* wsf = (LAS float*)(lds + LDS_WS) + wid * 64; LAS float* li_l = wsf; LAS float* al_l = wsf + 32;
    const size_t rowbase = (size_t)b * SEQ;
    const bf16* ksrc = KVB + (rowbase + (wid & 3) * 16 + (lane & 15)) * KVW + h * 64 + ((wid >> 2) * 4 + (lane >> 4)) * 8;
    const bf16* rsrc = KR + (rowbase + (wid & 3) * 16 + (lane & 15)) * ROPE + (lane >> 4) * 8;
    const bf16* vsrc = KVB + (rowbase + 16 * (wid & 3) + (lane >> 2)) * KVW + 1024 + h * 64 + (wid >> 2) * 32 + (lane & 3) * 8;
    LAS unsigned char* kdst = lds + LDS_K + (wid & 3) * 3072 + (wid >> 2) * 1024; LAS unsigned char* rdst = lds + LDS_K + (wid & 3) * 3072 + 2048; LAS unsigned char* vdst = lds + LDS_V + wid * 1024;
#define TT(i_) (((i_) + t0 < NT) ? (i_) + t0 : (i_) + t0 - NT)
#define DMA_K(t, slot) do { if constexpr ((VAR & 16) != 0) break; __builtin_amdgcn_global_load_lds((const unsigned*)(ksrc + (size_t)TT(t) * 64 * KVW), (LAS unsigned*)(kdst + (slot) * KSLOT), 16, 0, 0); \
                            __builtin_amdgcn_global_load_lds((const unsigned*)(rsrc + (size_t)TT(t) * 64 * ROPE), (LAS unsigned*)(rdst + (slot) * KSLOT), 16, 0, 0); } while (0)
#define DMA_V(t, slot) do { if constexpr ((VAR & 16) == 0) __builtin_amdgcn_global_load_lds((const unsigned*)(vsrc + (size_t)TT(t) * 64 * KVW), (LAS unsigned*)(vdst + (slot) * VSLOT), 16, 0, 0); } while (0)
    const LAS unsigned char* kb0 = lds + LDS_K + (r32 >> 4) * 3072 + (r32 & 15) * 16 + hi * 256;
    const int vb0 = (int)(uintptr_t)(lds + LDS_V) + ((lane >> 4) & 1) * 32 + (lane & 3) * 8 + (4 * hi + ((lane & 15) >> 2)) * 64;
    float m_reg = 0.f, l_reg = 0.f; f32x16 o[2] = {}; f32x16 negm = f32x16{};
#define PRIME(bb_, hh_, qq_) do { const size_t rb_ = (size_t)(bb_) * SEQ; \
        const bf16* ks_ = KVB + (rb_ + (wid & 3) * 16 + (lane & 15)) * KVW + (hh_) * 64 + ((wid >> 2) * 4 + (lane >> 4)) * 8; \
        const bf16* rs_ = KR + (rb_ + (wid & 3) * 16 + (lane & 15)) * ROPE + (lane >> 4) * 8; \
        const bf16* vs_ = KVB + (rb_ + 16 * (wid & 3) + (lane >> 2)) * KVW + 1024 + (hh_) * 64 + (wid >> 2) * 32 + (lane & 3) * 8; \
        if constexpr ((VAR & 16) == 0) { _Pragma("unroll") for (int t_ = 0; t_ < 3; ++t_) { \
            __builtin_amdgcn_global_load_lds((const unsigned*)(ks_ + (size_t)t_ * 64 * KVW), (LAS unsigned*)(kdst + t_ * KSLOT), 16, 0, 0); \
            __builtin_amdgcn_global_load_lds((const unsigned*)(rs_ + (size_t)t_ * 64 * ROPE), (LAS unsigned*)(rdst + t_ * KSLOT), 16, 0, 0); \
            if (t_ < 2) __builtin_amdgcn_global_load_lds((const unsigned*)(vs_ + (size_t)t_ * 64 * KVW), (LAS unsigned*)(vdst + t_ * VSLOT), 16, 0, 0); } } \
        const bf16* qrow_ = Q + (rb_ + (qq_) * 256 + wid * 32 + r32) * QW; \
        _Pragma("unroll") for (int d0 = 0; d0 < 4; ++d0) qr[d0] = *(const bf16x8*)(qrow_ + (hh_) * 64 + d0 * 16 + hi * 8); \
        _Pragma("unroll") for (int d0 = 4; d0 < 6; ++d0) qr[d0] = *(const bf16x8*)(qrow_ + 1024 + (hh_) * 32 + (d0 - 4) * 16 + hi * 8); } while (0)
    if (!primed) PRIME(b, h, qb);
    bf16x8 kf[12];
#define KLOAD(slot) do { const LAS unsigned char* kb_ = kb0 + (slot) * KSLOT; _Pragma("unroll") for (int d0 = 0; d0 < 6; ++d0) { kf[2 * d0] = *(const LAS bf16x8*)(kb_ + d0 * 512); kf[2 * d0 + 1] = *(const LAS bf16x8*)(kb_ + d0 * 512 + 6144); } } while (0)
#define QK(P0_, P1_) do { if constexpr ((VAR & 32) != 0) { P0_ = negm; P1_ = negm; P0_[0] += __builtin_bit_cast(float, (int)kf[0][0] + (int)kf[11][1]); } else if constexpr ((VAR & 2) != 0) { P0_ = negm; P1_ = negm; _Pragma("unroll") for (int d0 = 0; d0 < 12; ++d0) { P0_[d0] += (float)kf[d0][0]; P1_[d0] += (float)kf[d0][1]; } } else { P0_ = __builtin_amdgcn_mfma_f32_32x32x16_bf16(kf[0], qr[0], negm, 0, 0, 0); P1_ = __builtin_amdgcn_mfma_f32_32x32x16_bf16(kf[1], qr[0], negm, 0, 0, 0); \
        _Pragma("unroll") for (int d0 = 1; d0 < 6; ++d0) { P0_ = __builtin_amdgcn_mfma_f32_32x32x16_bf16(kf[2 * d0], qr[d0], P0_, 0, 0, 0); P1_ = __builtin_amdgcn_mfma_f32_32x32x16_bf16(kf[2 * d0 + 1], qr[d0], P1_, 0, 0, 0); } } } while (0)
#define RESC(al) do { if (__any((al) < 1.f)) { if (hi == 0) al_l[r32] = (al); asm volatile("s_waitcnt lgkmcnt(0)" ::: "memory"); \
        _Pragma("unroll") for (int d_ = 0; d_ < 2; ++d_) _Pragma("unroll") for (int r = 0; r < 16; ++r) o[d_][r] *= al_l[crow(r, hi)]; } } while (0)
#define MASKT(P0_, P1_, t) do { const int kbm_ = TT(t) * 64; if (kbm_ + 63 > qlo) mask_tile(P0_, P1_, qm - kbm_); } while (0)
#define ROWMAX(P0_, P1_, pm_) do { float m0_ = fmaxf(P0_[0], P1_[0]), m1_ = fmaxf(P0_[1], P1_[1]), m2_ = fmaxf(P0_[2], P1_[2]), m3_ = fmaxf(P0_[3], P1_[3]); \
        _Pragma("unroll") for (int r = 4; r < 16; r += 4) { m0_ = fmaxf(fmaxf(m0_, P0_[r]), P1_[r]); m1_ = fmaxf(fmaxf(m1_, P0_[r + 1]), P1_[r + 1]); m2_ = fmaxf(fmaxf(m2_, P0_[r + 2]), P1_[r + 2]); m3_ = fmaxf(fmaxf(m3_, P0_[r + 3]), P1_[r + 3]); } \
        pm_ = fmaxf(fmaxf(m0_, m1_), fmaxf(m2_, m3_)); \
        auto rr_ = __builtin_amdgcn_permlane32_swap(__float_as_uint(pm_), __float_as_uint(pm_), false, false); pm_ = fmaxf(__uint_as_float(rr_[0]), __uint_as_float(rr_[1])); } while (0)
#define SHIFT(P0_, P1_, dl_) do { m_reg += (dl_); _Pragma("unroll") for (int r = 0; r < 16; ++r) { P0_[r] -= (dl_); P1_[r] -= (dl_); } _Pragma("unroll") for (int r = 0; r < 16; ++r) negm[r] = -m_reg; } while (0)
#define EXP16(P_) do { if constexpr ((VAR & 1) == 0) { _Pragma("unroll") for (int r = 0; r < 16; ++r) P_[r] = __builtin_amdgcn_exp2f(P_[r]); } } while (0)
#define PACKP(P0_, P1_) do { \
        { u32x4 w_ = {pk2(P0_[0], P0_[1]), pk2(P0_[2], P0_[3]), pk2(P0_[4], P0_[5]), pk2(P0_[6], P0_[7])}; pa0 = __builtin_bit_cast(bf16x8, w_); } \
        { u32x4 w_ = {pk2(P0_[8], P0_[9]), pk2(P0_[10], P0_[11]), pk2(P0_[12], P0_[13]), pk2(P0_[14], P0_[15])}; pa1 = __builtin_bit_cast(bf16x8, w_); } \
        { u32x4 w_ = {pk2(P1_[0], P1_[1]), pk2(P1_[2], P1_[3]), pk2(P1_[4], P1_[5]), pk2(P1_[6], P1_[7])}; pa2 = __builtin_bit_cast(bf16x8, w_); } \
        { u32x4 w_ = {pk2(P1_[8], P1_[9]), pk2(P1_[10], P1_[11]), pk2(P1_[12], P1_[13]), pk2(P1_[14], P1_[15])}; pa3 = __builtin_bit_cast(bf16x8, w_); } } while (0)
#define SOFTMAX2(P0_, P1_, al_) do { EXP16(P1_); float ps_ = 0.f; _Pragma("unroll") for (int r = 0; r < 16; ++r) ps_ += P0_[r] + P1_[r]; \
        auto rr_ = __builtin_amdgcn_permlane32_swap(__float_as_uint(ps_), __float_as_uint(ps_), false, false); ps_ = __uint_as_float(rr_[0]) + __uint_as_float(rr_[1]); \
        l_reg = l_reg * (al_) + ps_; PACKP(P0_, P1_); } while (0)
    s16x4 vl[8], vh[8];
#define TRRD(dst, off) asm volatile("ds_read_b64_tr_b16 %0, %1 offset:%2" : "=&v"(dst) : "v"(vb_), "i"(off) : "memory")
#define VREAD(slot) do { const int vb_ = vb0 + (slot) * VSLOT; \
        TRRD(vl[0], 0); TRRD(vh[0], 512); TRRD(vl[1], 1024); TRRD(vh[1], 1536); TRRD(vl[2], 2048); TRRD(vh[2], 2560); TRRD(vl[3], 3072); TRRD(vh[3], 3584); \
        TRRD(vl[4], 4096); TRRD(vh[4], 4608); TRRD(vl[5], 5120); TRRD(vh[5], 5632); TRRD(vl[6], 6144); TRRD(vh[6], 6656); TRRD(vl[7], 7168); TRRD(vh[7], 7680); } while (0)
#define VF(i) (bf16x8){vl[i][0], vl[i][1], vl[i][2], vl[i][3], vh[i][0], vh[i][1], vh[i][2], vh[i][3]}
#define PVALL() do { if constexpr ((VAR & 32) != 0) { o[0][0] += (float)vl[0][0] + (float)vh[7][1] + (float)pa0[0] + (float)pa3[1]; } else if constexpr ((VAR & 8) != 0) { PVH(0); PVH(1); } else { \
        o[0] = __builtin_amdgcn_mfma_f32_32x32x16_bf16(pa0, VF(0), o[0], 0, 0, 0); o[1] = __builtin_amdgcn_mfma_f32_32x32x16_bf16(pa0, VF(4), o[1], 0, 0, 0); \
        o[0] = __builtin_amdgcn_mfma_f32_32x32x16_bf16(pa1, VF(1), o[0], 0, 0, 0); o[1] = __builtin_amdgcn_mfma_f32_32x32x16_bf16(pa1, VF(5), o[1], 0, 0, 0); \
        o[0] = __builtin_amdgcn_mfma_f32_32x32x16_bf16(pa2, VF(2), o[0], 0, 0, 0); o[1] = __builtin_amdgcn_mfma_f32_32x32x16_bf16(pa2, VF(6), o[1], 0, 0, 0); \
        o[0] = __builtin_amdgcn_mfma_f32_32x32x16_bf16(pa3, VF(3), o[0], 0, 0, 0); o[1] = __builtin_amdgcn_mfma_f32_32x32x16_bf16(pa3, VF(7), o[1], 0, 0, 0); } } while (0)
#define PVH(d0) do { if constexpr ((VAR & 8) != 0) { _Pragma("unroll") for (int e_ = 0; e_ < 4; ++e_) { o[d0][e_] += (float)vl[4 * (d0) + e_][0] + (float)vh[4 * (d0) + e_][1] + (float)pa0[e_] + (float)pa1[e_] + (float)pa2[e_] + (float)pa3[e_]; } } else { o[d0] = __builtin_amdgcn_mfma_f32_32x32x16_bf16(pa0, VF(4 * (d0) + 0), o[d0], 0, 0, 0); o[d0] = __builtin_amdgcn_mfma_f32_32x32x16_bf16(pa1, VF(4 * (d0) + 1), o[d0], 0, 0, 0); \
        o[d0] = __builtin_amdgcn_mfma_f32_32x32x16_bf16(pa2, VF(4 * (d0) + 2), o[d0], 0, 0, 0); o[d0] = __builtin_amdgcn_mfma_f32_32x32x16_bf16(pa3, VF(4 * (d0) + 3), o[d0], 0, 0, 0); } } while (0)
    f32x16 px0, px1; bf16x8 pa0, pa1, pa2, pa3;
#define TILE_VALU(al_) bf16x8 pn0, pn1, pn2, pn3; do { EXP16(px0); EXP16(px1); float s0_ = px0[0] + px1[0], s1_ = px0[1] + px1[1], s2_ = px0[2] + px1[2], s3_ = px0[3] + px1[3]; \
        _Pragma("unroll") for (int r = 4; r < 16; r += 4) { s0_ += px0[r] + px1[r]; s1_ += px0[r + 1] + px1[r + 1]; s2_ += px0[r + 2] + px1[r + 2]; s3_ += px0[r + 3] + px1[r + 3]; } \
        float ps_ = (s0_ + s1_) + (s2_ + s3_); \
        auto rr_ = __builtin_amdgcn_permlane32_swap(__float_as_uint(ps_), __float_as_uint(ps_), false, false); ps_ = __uint_as_float(rr_[0]) + __uint_as_float(rr_[1]); \
        l_reg = l_reg * (al_) + ps_; \
        { u32x4 w_ = {pk2(px0[0], px0[1]), pk2(px0[2], px0[3]), pk2(px0[4], px0[5]), pk2(px0[6], px0[7])}; pn0 = __builtin_bit_cast(bf16x8, w_); } \
        { u32x4 w_ = {pk2(px0[8], px0[9]), pk2(px0[10], px0[11]), pk2(px0[12], px0[13]), pk2(px0[14], px0[15])}; pn1 = __builtin_bit_cast(bf16x8, w_); } \
        { u32x4 w_ = {pk2(px1[0], px1[1]), pk2(px1[2], px1[3]), pk2(px1[4], px1[5]), pk2(px1[6], px1[7])}; pn2 = __builtin_bit_cast(bf16x8, w_); } \
        { u32x4 w_ = {pk2(px1[8], px1[9]), pk2(px1[10], px1[11]), pk2(px1[12], px1[13]), pk2(px1[14], px1[15])}; pn3 = __builtin_bit_cast(bf16x8, w_); } } while (0)
    if (primed) { WAIT_BAR(4); } else { WAIT_BAR(0); }
    asm volatile("" : "+v"(qr[0]), "+v"(qr[1]), "+v"(qr[2]), "+v"(qr[3]), "+v"(qr[4]), "+v"(qr[5]));
    {
        const float* ct_ = cosT + (size_t)(P0 + wid * 32 + r32) * 16 + 8 * hi; const float* st_ = ct_ + ROPE_TAB;
        const f32x4 c0 = *(const f32x4*)ct_, c1 = *(const f32x4*)(ct_ + 4), s0 = *(const f32x4*)st_, s1 = *(const f32x4*)(st_ + 4);
        const u32x4 w1 = __builtin_bit_cast(u32x4, qr[4]), w2 = __builtin_bit_cast(u32x4, qr[5]);
        const f32x4 x1a = {bflo(w1.x), bfhi(w1.x), bflo(w1.y), bfhi(w1.y)}, x1b = {bflo(w1.z), bfhi(w1.z), bflo(w1.w), bfhi(w1.w)};
        const f32x4 x2a = {bflo(w2.x), bfhi(w2.x), bflo(w2.y), bfhi(w2.y)}, x2b = {bflo(w2.z), bfhi(w2.z), bflo(w2.w), bfhi(w2.w)};
        const f32x4 o1a = x1a * c0 - x2a * s0, o1b = x1b * c1 - x2b * s1, o2a = x1a * s0 + x2a * c0, o2b = x1b * s1 + x2b * c1;
        u32x4 r1 = {pk2(o1a.x, o1a.y), pk2(o1a.z, o1a.w), pk2(o1b.x, o1b.y), pk2(o1b.z, o1b.w)}, r2 = {pk2(o2a.x, o2a.y), pk2(o2a.z, o2a.w), pk2(o2b.x, o2b.y), pk2(o2b.z, o2b.w)};
        qr[4] = __builtin_bit_cast(bf16x8, r1); qr[5] = __builtin_bit_cast(bf16x8, r2); }
    const bool trail = wid >= 4;
#define PBAR_M(t) do { if ((t) + 3 < NT) { WAIT_BAR(6); } else { WAIT_BAR(0); } } while (0)
#define PBAR_V(t) do { if ((t) + 3 < NT) { WAIT_BAR(6); } else { WAIT_BAR(0); } } while (0)
    if (trail) WAIT_BAR(0);
    DMA_K(3, 3); DMA_V(2, 2);
    KLOAD(0); QK(px0, px1);
    PBAR_V(0);
    MASKT(px0, px1, 0);
    { float pm; ROWMAX(px0, px1, pm); SHIFT(px0, px1, pm); TILE_VALU(1.f); pa0 = pn0; pa1 = pn1; pa2 = pn2; pa3 = pn3; }
    int sk = 1, sv = 0;
#pragma unroll 1
    for (int t = 1; t < NT; ++t) {
        PBAR_M(t);
        { if (t + 3 < NT) DMA_K(t + 3, (sk + 3) & 3); if (t + 2 < NT) DMA_V(t + 2, (sk + 2) & 3); }
        SBAR();
        KLOAD(sk); VREAD(sv);
        SBAR();
        QK(px0, px1);
        SBAR(); asm volatile("s_waitcnt lgkmcnt(0)" ::: "memory"); SBAR();
        PVALL();
        PBAR_V(t);
        MASKT(px0, px1, t);
        float pm_, alX = 1.f; ROWMAX(px0, px1, pm_);
        if (__builtin_expect(__any(pm_ > THR), 0)) { const float dl_ = fmaxf(pm_, 0.f); SHIFT(px0, px1, dl_); alX = __builtin_amdgcn_exp2f(-dl_); }
        TILE_VALU(alX);
        pa0 = pn0; pa1 = pn1; pa2 = pn2; pa3 = pn3;
        RESC(alX);
        sk = (sk + 1) & 3; sv = (sv + 1) & 3;
    }
    WAIT_BAR(0);
    VREAD(sv); asm volatile("s_waitcnt lgkmcnt(0)" ::: "memory"); SBAR(); PVALL();
    if (!trail) WAIT_BAR(0);
    if (has_next) PRIME(nb_, nh_, nqb_);
    if (qnext != nullptr && wid == 0 && lane == 0) *pend = (int)__hip_atomic_fetch_add(qnext, 1u, __ATOMIC_RELAXED, __HIP_MEMORY_SCOPE_AGENT);
#undef PBAR_M
#undef PBAR_V
    if (hi == 0) li_l[r32] = l_reg; asm volatile("s_waitcnt lgkmcnt(0)" ::: "memory");
    bf16* Ow = OB + (rowbase + P0 + wid * 32) * DM + h * 64;
    {
        LAS bf16* stg = (LAS bf16*)(lds + LDS_OST) + wid * 2048;
#pragma unroll
        for (int r = 0; r < 16; ++r) { const int orow = crow(r, hi); const float rl = __builtin_amdgcn_rcpf(li_l[orow]);
#pragma unroll
            for (int d0 = 0; d0 < 2; ++d0) stg[orow * 64 + d0 * 32 + r32] = f2bf(o[d0][r] * rl); }
        asm volatile("s_waitcnt lgkmcnt(0)" ::: "memory");
#pragma unroll
        for (int i4 = 0; i4 < 4; ++i4) { const int row = i4 * 8 + (lane >> 3), ch = lane & 7; const u32x4 v = *(const LAS u32x4*)(stg + row * 64 + ch * 8); *(u32x4*)(Ow + (size_t)row * DM + ch * 8) = v; }
    }
    if (!has_next) WAIT_BAR(0);
#undef PRIME
#undef TT
#undef DMA_K
#undef DMA_V
#undef KLOAD
#undef QK
#undef RESC
#undef MASKT
#undef ROWMAX
#undef SHIFT
#undef EXP16
#undef PACKP
#undef SOFTMAX2
#undef TILE_VALU
#undef TRRD
#undef VREAD
#undef VF
#undef PVH
#undef PVALL
#undef STEP
}
#undef SBAR
#undef SGB
#undef WAIT_BAR
}

#ifndef MK_PER_PHASE
#define MK_PER_PHASE 0
#endif
#ifndef REPEAT_MASK
#define REPEAT_MASK 0
#endif
#ifndef ATT_SHADOW
#define ATT_SHADOW -1
#endif
#ifndef P7_ONLY
#define P7_ONLY 0
#endif
__device__ __forceinline__ int q_grab(unsigned* que, LAS int* slot, int wv) {
    if (wv == 0) { if (lane_id() == 0) *slot = (int)__hip_atomic_fetch_add(que, 1u, __ATOMIC_RELAXED, __HIP_MEMORY_SCOPE_AGENT); }
    __syncthreads();
    const int r = __builtin_amdgcn_readfirstlane(*slot);
    __syncthreads();
    return r;
}
__device__ __forceinline__ int q_finish(int pend, LAS int* slot, int wv) {
    if (wv == 0) { if (lane_id() == 0) *slot = pend; }
    __syncthreads();
    const int r = __builtin_amdgcn_readfirstlane(*slot);
    __syncthreads();
    return r;
}
constexpr int N_PHASES = 17;
__global__ void __launch_bounds__(NWAVES * 64, 2) hybrid_fwd(Args args) {
    extern __shared__ __attribute__((aligned(16))) unsigned char lds_raw[];
    LAS unsigned char* lds = (LAS unsigned char*)lds_raw;
    const int wv0 = __builtin_amdgcn_readfirstlane(threadIdx.x >> 6);
    for (int u = threadIdx.x; u < (LDS_BYTES - LDSCTL_OFF) / 4; u += NWAVES * 64) ((LAS unsigned*)(lds + LDSCTL_OFF))[u] = 0u;
    __syncthreads();
    if (!MK_PER_PHASE) (void)xcd_barrier_post((unsigned*)((unsigned char*)args.in[I_WS] + WS_CTL) + CW_BAR, (volatile LAS unsigned*)(lds + MISC_OFF) + 8);
    const int lo = args.ph_lo, hi = args.ph_hi;
#define IN(k) (lo <= (k) && (k) < hi)
#define PH_BEGIN int z = 0; asm volatile("" : "+s"(z)); int tid = TIDW(wv0); asm volatile("" : "+v"(tid)); const int lane = tid & 63, wave = wv0; \
    const int G = gridDim.x; const int bx = blockIdx.x; const int vcu = (G % 8 == 0) ? (bx % 8) * (G / 8) + bx / 8 : bx; unsigned char* ws = (unsigned char*)args.in[I_WS + z]; \
    LAS unsigned char* ring = lds + RING_OFF; (void)lane; (void)wave; (void)vcu; (void)ws; (void)ring; (void)tid;
#define SEAM(k) do { if (IN(k) && IN((k) + 1)) { int zb = 0; asm volatile("" : "+s"(zb)); XcdBarrier bar; bar.bar = (unsigned*)((unsigned char*)args.in[I_WS + zb] + WS_CTL) + CW_BAR; bar.x = xb_xcc_id(); \
        bar.st = (volatile LAS unsigned*)(lds + MISC_OFF) + 8; bar.t0 = (TIDW(wv0) == 0); xcd_barrier(bar); } } while (0)
    typedef pg8::StaticOrder SO;
#define GBAR() do { int zb = 0; asm volatile("" : "+s"(zb)); XcdBarrier bar; bar.bar = (unsigned*)((unsigned char*)args.in[I_WS + zb] + WS_CTL) + CW_BAR; bar.x = xb_xcc_id(); \
        bar.st = (volatile LAS unsigned*)(lds + MISC_OFF) + 8; bar.t0 = (TIDW(wv0) == 0); xcd_barrier(bar); } while (0)
#define BAR_ARRIVE() do { int zb = 0; asm volatile("" : "+s"(zb)); XcdBarrier bar; bar.bar = (unsigned*)((unsigned char*)args.in[I_WS + zb] + WS_CTL) + CW_BAR; bar.x = xb_xcc_id(); \
        bar.st = (volatile LAS unsigned*)(lds + MISC_OFF) + 8; bar.t0 = (TIDW(wv0) == 0); xcd_barrier_arrive(bar); } while (0)
#define BAR_FINISH() do { int zb = 0; asm volatile("" : "+s"(zb)); XcdBarrier bar; bar.bar = (unsigned*)((unsigned char*)args.in[I_WS + zb] + WS_CTL) + CW_BAR; bar.x = xb_xcc_id(); \
        bar.st = (volatile LAS unsigned*)(lds + MISC_OFF) + 8; bar.t0 = (TIDW(wv0) == 0); xcd_barrier_finish(bar); } while (0)
#define PHASE(k, ...) if (IN(k)) { { constexpr int rep = 0; (void)rep; __VA_ARGS__ } if constexpr (((REPEAT_MASK) >> (k)) & 1) { GBAR(); { constexpr int rep = 1; (void)rep; __VA_ARGS__ } } }

    PHASE(0, { PH_BEGIN p0_prologue(args, lds, vcu, G, tid, lane, wave); })
    SEAM(0);
    PHASE(1, { PH_BEGIN pg8::Gemm g{(const bf16*)(ws + WS_XN), (const bf16*)(ws + WS_BUP1), MT, 2 * DFF, DM}; SO S; S.init(MT, 2 * DFF, G, bx);
        pg8::Epi<pg8::EM_SWIGLU> E{(bf16*)(ws + WS_H), DFF, nullptr, 0, nullptr, 0, 1.f};
        pg8::gemm_phase<pg8::Epi<pg8::EM_SWIGLU>, SO, true, true>(ring, g, S, E, wv0);
        if (rep == 0) convert_in_tail(args, lds, S.nwg, G, bx, CV_A, CV_B, wv0); })
    SEAM(1);
    PHASE(2, { PH_BEGIN sgemm_sample<pg8::EM_PLAIN, DFF>(lds, (const bf16*)(ws + WS_H), (const bf16*)(ws + WS_BDN1), DM, (bf16*)(ws + WS_F), DM, nullptr, 0, nullptr, 0, vcu, G, wv0, (unsigned*)(ws + WS_CTL) + CW_SN + 0 * 8 * 64);
        pg8::Gemm g{(const bf16*)(ws + WS_H), (const bf16*)(ws + WS_BDN1), MP, DM, DFF}; SO S; S.init(MP, DM, G, bx);
        pg8::EpiNorm<1, 0> E{(const float*)args.in[I_XP + z], (bf16*)(ws + WS_XR), (bf16*)(ws + WS_XN), nullptr, (const float*)args.in[I_F1POST + z], (const float*)args.in[I_MIXPRE + z], 0.5f, (float*)(ws + WS_NSLOT) + (size_t)0 * 2 * 64 * 256 * 4, (unsigned*)(ws + WS_CTL) + CW_PN + 0 * 2 * 64 * 64, nullptr};
        pg8::gemm_phase<pg8::EpiNorm<1, 0>, SO, true, true>(ring, g, S, E, wv0);
        sample_norm<1, 0>(args, (unsigned*)(ws + WS_CTL) + CW_SN + 0 * 8 * 64, (const bf16*)(ws + WS_F), 0.5f, I_F1POST, I_MIXPRE, G, vcu, wv0); })
    SEAM(3);
    PHASE(4, { PH_BEGIN pg8::Gemm g{(const bf16*)(ws + WS_XN), (const bf16*)(ws + WS_BIN), MT, ZW, DM}; SO S; S.init(MT, ZW, G, bx);
        pg8::Epi<pg8::EM_WIN> E{(bf16*)(ws + WS_Z), ZW, nullptr, 0, nullptr, 0, 1.f};
        pg8::gemm_phase<pg8::Epi<pg8::EM_WIN>, SO, true, true>(ring, g, S, E, wv0);
        if (rep == 0) convert_in_tail(args, lds, S.nwg, G, bx, CV_B, CV_N, wv0); })
    SEAM(4);
    PHASE(5, { PH_BEGIN
        for (int u = vcu; u < 256; u += G) lru_cu_unit<1>(args, lds, u, wv0);
        mla_prep(args, vcu, G, lane, wave);
    })
    SEAM(5);
    PHASE(6, {
        { PH_BEGIN for (int u = vcu; u < 256; u += G) lru_cu_unit<2>(args, lds, u, wv0); }
        __syncthreads();
        { PH_BEGIN sgemm_sample<pg8::EM_PLAIN, QL>(lds, (const bf16*)(ws + WS_CQ), (const bf16*)(ws + WS_BQ), QW, (bf16*)(ws + WS_Q), QW, nullptr, 0, nullptr, 0, vcu, G, wv0);
          sgemm_sample<pg8::EM_PLAIN, DPLE>(lds, (const bf16*)(ws + WS_PB), (const bf16*)(ws + WS_BPP), DM, (bf16*)(ws + WS_PPB), DM, nullptr, 0, nullptr, 0, vcu, G, wv0); }
    })
    SEAM(6);
    PHASE(7, {
        bool dec7;
        { PH_BEGIN const int nq = (G % 8 == 0) ? 8 : 1, q = (nq == 8) ? (bx & 7) : 0, ci = (nq == 8) ? (bx >> 3) : bx, cpq = G / nq, ndq = (NDEC / nq < cpq) ? NDEC / nq : cpq;
          const bool early = EARLY_DEC && (G == 256); dec7 = early && ci < ndq;
          if (!dec7) {
            const int Gp = early ? G - ndq * nq : G, cp = early ? (ci - ndq) * 8 + q : bx, vcup = early ? q * (cpq - ndq) + (ci - ndq) : vcu;
            sgemm_sample<pg8::EM_MULZ, DRNN>(lds, (const bf16*)(ws + WS_HG), (const bf16*)(ws + WS_BRNN), DM, (bf16*)(ws + WS_YAG), DM, (const bf16*)(ws + WS_Z) + Z_GA, ZW, nullptr, 0, vcup, Gp, wv0);
            { pg8::Gemm g{(const bf16*)(ws + WS_CQ), (const bf16*)(ws + WS_BQ), MP, QW, QL}; SO S; S.init(MP, QW, Gp, cp);
              pg8::Epi<pg8::EM_PLAIN> E{(bf16*)(ws + WS_Q), QW, nullptr, 0, nullptr, 0, 1.f};
              pg8::gemm_phase<pg8::Epi<pg8::EM_PLAIN>, SO, true, true>(ring, g, S, E, wv0); } } }
        if (!dec7) { PH_BEGIN const int nq = (G % 8 == 0) ? 8 : 1, q = (nq == 8) ? (bx & 7) : 0, ci = (nq == 8) ? (bx >> 3) : bx, cpq = G / nq, ndq = (NDEC / nq < cpq) ? NDEC / nq : cpq;
          const bool early = EARLY_DEC && (G == 256); const int Gp = early ? G - ndq * nq : G, cp = early ? (ci - ndq) * 8 + q : bx;
          pg8::Gemm g{(const bf16*)(ws + WS_CKV), (const bf16*)(ws + WS_BKV), MP, KVW, KVL}; SO S; S.init(MP, KVW, Gp, cp);
          pg8::Epi<pg8::EM_PLAIN> E{(bf16*)(ws + WS_KVB), KVW, nullptr, 0, nullptr, 0, 1.f};
          pg8::gemm_phase<pg8::Epi<pg8::EM_PLAIN>, SO, true, true>(ring, g, S, E, wv0); }
        BAR_ARRIVE();
        if (!dec7) BAR_FINISH();
    })
    PHASE(8, { PH_BEGIN
        const int nq = (G % 8 == 0) ? 8 : 1, q = (nq == 8) ? (bx & 7) : 0, ci = (nq == 8) ? (bx >> 3) : bx, cpq = G / nq;
        {
            const int ndq = (NDEC / nq < cpq) ? NDEC / nq : cpq, nd = ndq * nq;
            if (ci < ndq) {
                _Pragma("unroll 1") for (int sq = q * ndq + ci; sq < NS; sq += nd) {
                    sample_attn_seq(args, lds, sq, wv0);
                }
                __syncthreads();
                if (EARLY_DEC && G == 256) BAR_FINISH();
            }
        }
        {
            unsigned* que = (unsigned*)(ws + WS_CTL) + CW_QUE + 64 * q;
            LAS int* slot = (LAS int*)(lds + MISC_OFF) + 64;
            const int hq = 32 / nq, nblk = 32 * hq, npq = 64 / nq, ny = 4 * npq, ya0 = nblk - 10, nitem = nblk + ny;
            int cur = q_grab(que, slot, wv0), nxt = nitem; if (cur < nitem) nxt = q_grab(que, slot, wv0);
            _Pragma("unroll 1") while (cur < nitem) {
                if (cur >= ya0 && cur < ya0 + ny) {
                    const int t = cur - ya0;
                    pg8::Gemm g{(const bf16*)(ws + WS_HG), (const bf16*)(ws + WS_BRNN), MP, DM, DRNN}; pg8::OneUnit T; T.u.pm = q * npq + (t % npq); T.u.pn = t / npq;
                    pg8::Epi<pg8::EM_MULZ> E{(bf16*)(ws + WS_YAG), DM, (const bf16*)(ws + WS_Z) + Z_GA, ZW, nullptr, 0, 1.f};
                    pg8::gemm_phase<pg8::Epi<pg8::EM_MULZ>, pg8::OneUnit, true, true>(ring, g, T, E, wv0);
                    cur = nxt; if (cur < nitem) nxt = q_grab(que, slot, wv0);
                    continue;
                }
                bf16x8 qr[6]; bool primed = false, more;
                do {
                    const int kc = cur < ya0 ? cur : cur - ny, bh = hq * q + 2 * (kc >> 6) + (kc & 1), qb = 31 - ((kc & 63) >> 1);
                    more = nxt < nitem && !(nxt >= ya0 && nxt < ya0 + ny);
                    const int kn = more ? (nxt < ya0 ? nxt : nxt - ny) : 0, bhn = hq * q + 2 * (kn >> 6) + (kn & 1), qbn = 31 - ((kn & 63) >> 1);
                    const bool early = nxt < nitem; int pend = 0;
                    pattn4::block<0>((const bf16*)(ws + WS_Q), (const bf16*)(ws + WS_KVB), (const bf16*)(ws + WS_KR), (const float*)(ws + WS_ROPE), (bf16*)(ws + WS_OB), lds, bh >> 4, bh & 15, qb, 0, wv0,
                                     primed, more, bhn >> 4, bhn & 15, qbn, qr, early ? que : nullptr, &pend);
                    primed = true; cur = nxt; if (early) nxt = q_finish(pend, slot, wv0);
                } while (more);
            }
        }
        __syncthreads();
#if ATT_SHADOW >= 0
        GBAR();
        { int z2 = 0; asm volatile("" : "+s"(z2)); unsigned char* ws2 = (unsigned char*)args.in[I_WS + z2];
          const int G2 = gridDim.x, bx2 = blockIdx.x, vcu2 = (G2 % 8 == 0) ? (bx2 % 8) * (G2 / 8) + bx2 / 8 : bx2;
          bf16x8 qrs[6];
          for (int L = vcu2; L < 512; L += G2) { const int bh = L >> 4, x = L & 15;
            pattn4::block<ATT_SHADOW>((const bf16*)(ws2 + WS_Q), (const bf16*)(ws2 + WS_KVB), (const bf16*)(ws2 + WS_KR), (const float*)(ws2 + WS_ROPE), (bf16*)(ws2 + WS_END), lds, bh >> 4, bh & 15, x, 0, wv0, false, false, 0, 0, 0, qrs);
            pattn4::block<ATT_SHADOW>((const bf16*)(ws2 + WS_Q), (const bf16*)(ws2 + WS_KVB), (const bf16*)(ws2 + WS_KR), (const float*)(ws2 + WS_ROPE), (bf16*)(ws2 + WS_END), lds, bh >> 4, bh & 15, 31 - x, 0, wv0, false, false, 0, 0, 0, qrs); } }
        __syncthreads();
#endif
    })
    SEAM(8);
    PHASE(9, { PH_BEGIN sgemm_sample<pg8::EM_FMAZ, DM>(lds, (const bf16*)(ws + WS_OB), (const bf16*)(ws + WS_BATT), DM, (bf16*)(ws + WS_MX), DM, (const bf16*)(ws + WS_Z) + Z_GB, ZW, (const bf16*)(ws + WS_YAG), DM, vcu, G, wv0);
        pg8::Gemm g{(const bf16*)(ws + WS_OB), (const bf16*)(ws + WS_BATT), MP, DM, DM}; SO S; S.init(MP, DM, G, bx);
        pg8::Epi<pg8::EM_FMAZ> E{(bf16*)(ws + WS_MX), DM, (const bf16*)(ws + WS_Z) + Z_GB, ZW, (const bf16*)(ws + WS_YAG), DM, 1.f};
        pg8::gemm_phase<pg8::Epi<pg8::EM_FMAZ>, SO, true, true>(ring, g, S, E, wv0); })
    SEAM(9);
    PHASE(10, { PH_BEGIN sgemm_sample<pg8::EM_PLAIN, DM>(lds, (const bf16*)(ws + WS_MX), (const bf16*)(ws + WS_BOUT), DM, (bf16*)(ws + WS_F), DM, nullptr, 0, nullptr, 0, vcu, G, wv0, (unsigned*)(ws + WS_CTL) + CW_SN + 1 * 8 * 64);
        pg8::Gemm g{(const bf16*)(ws + WS_MX), (const bf16*)(ws + WS_BOUT), MP, DM, DM}; SO S; S.init(MP, DM, G, bx);
        pg8::EpiNorm<1, 1> E{nullptr, (bf16*)(ws + WS_XR), (bf16*)(ws + WS_XN), nullptr, (const float*)args.in[I_MIXPOST + z], (const float*)args.in[I_F2PRE + z], 1.0f, (float*)(ws + WS_NSLOT) + (size_t)1 * 2 * 64 * 256 * 4, (unsigned*)(ws + WS_CTL) + CW_PN + 1 * 2 * 64 * 64, nullptr};
        pg8::gemm_phase<pg8::EpiNorm<1, 1>, SO, true, true>(ring, g, S, E, wv0);
        sample_norm<1, 1>(args, (unsigned*)(ws + WS_CTL) + CW_SN + 1 * 8 * 64, (const bf16*)(ws + WS_F), 1.0f, I_MIXPOST, I_F2PRE, G, vcu, wv0); })
    SEAM(11);
    PHASE(12, { PH_BEGIN pg8::Gemm g{(const bf16*)(ws + WS_XN), (const bf16*)(ws + WS_BUP2), MT, 2 * DFF, DM}; SO S; S.init(MT, 2 * DFF, G, bx);
        pg8::Epi<pg8::EM_SWIGLU> E{(bf16*)(ws + WS_H), DFF, nullptr, 0, nullptr, 0, 1.f};
        pg8::gemm_phase<pg8::Epi<pg8::EM_SWIGLU>, SO, true, true>(ring, g, S, E, wv0); }
        { PH_BEGIN const int nwg0 = (MT / 256) * (2 * DFF / 256), full = (nwg0 + G - 1) / G, nl = full * G - nwg0;
          if (nl == 0 || bx >= G - nl) { pg8::Gemm g2{(const bf16*)(ws + WS_PB), (const bf16*)(ws + WS_BPP), MP, DM, DPLE}; SO T; T.init(MP, DM, nl == 0 ? G : nl, nl == 0 ? bx : bx - (G - nl));
            pg8::Epi<pg8::EM_PLAIN> E2{(bf16*)(ws + WS_PPB), DM, nullptr, 0, nullptr, 0, 1.f};
            pg8::gemm_phase<pg8::Epi<pg8::EM_PLAIN>, SO, true, true>(ring, g2, T, E2, wv0); } } )
    SEAM(12);
    PHASE(13, { PH_BEGIN sgemm_sample<pg8::EM_PLAIN, DFF>(lds, (const bf16*)(ws + WS_H), (const bf16*)(ws + WS_BDN2), DM, (bf16*)(ws + WS_F), DM, nullptr, 0, nullptr, 0, vcu, G, wv0, (unsigned*)(ws + WS_CTL) + CW_SN + 2 * 8 * 64);
        pg8::Gemm g{(const bf16*)(ws + WS_H), (const bf16*)(ws + WS_BDN2), MP, DM, DFF}; SO S; S.init(MP, DM, G, bx);
        pg8::EpiNorm<2, 1> E{nullptr, (bf16*)(ws + WS_XR), (bf16*)(ws + WS_XN), nullptr, (const float*)args.in[I_F2POST + z], nullptr, 0.5f, (float*)(ws + WS_NSLOT) + (size_t)2 * 2 * 64 * 256 * 4, (unsigned*)(ws + WS_CTL) + CW_PN + 2 * 2 * 64 * 64, nullptr};
        pg8::gemm_phase<pg8::EpiNorm<2, 1>, SO, true, true>(ring, g, S, E, wv0);
        sample_norm<2, 1>(args, (unsigned*)(ws + WS_CTL) + CW_SN + 2 * 8 * 64, (const bf16*)(ws + WS_F), 0.5f, I_F2POST, I_F2POST, G, vcu, wv0); })
    SEAM(14);
    PHASE(15, { PH_BEGIN sgemm_sample<pg8::EM_SIGMUL, DM>(lds, (const bf16*)(ws + WS_XN), (const bf16*)(ws + WS_BPG), DM, (bf16*)(ws + WS_F), DM, (const bf16*)(ws + WS_PPB), DM, nullptr, 0, vcu, G, wv0, (unsigned*)(ws + WS_CTL) + CW_SN + 3 * 8 * 64);
        pg8::Gemm g{(const bf16*)(ws + WS_XN), (const bf16*)(ws + WS_BPG), MP, DM, DM}; SO S; S.init(MP, DM, G, bx);
        pg8::EpiNorm<0, 2, 1> E{nullptr, nullptr, (bf16*)(ws + WS_XN), (float*)args.in[I_OUT + z] + O_Y, (const float*)args.in[I_PPOST + z], nullptr, 1.0f, (float*)(ws + WS_NSLOT) + (size_t)3 * 2 * 64 * 256 * 4, (unsigned*)(ws + WS_CTL) + CW_PN + 3 * 2 * 64 * 64, (const bf16*)(ws + WS_PPB)};
        pg8::gemm_phase<pg8::EpiNorm<0, 2, 1>, SO, true, true>(ring, g, S, E, wv0);
        sample_norm<0, 2>(args, (unsigned*)(ws + WS_CTL) + CW_SN + 3 * 8 * 64, (const bf16*)(ws + WS_F), 1.0f, I_PPOST, I_PPOST, G, vcu, wv0); })
#undef IN
#undef SEAM
#undef PHASE
#undef GBAR
#undef PH_BEGIN
}

extern "C" void kernel_launch(void* const* d_in, const int* in_sizes, int n_in, void* d_out, int out_size, void* d_ws, size_t ws_size, hipStream_t stream) {
    static int grid = 0;
    if (grid == 0) {
        if (n_in != N_IN || (size_t)out_size != O_END || ws_size < WS_END) { fprintf(stderr, "kernel_launch: unexpected shapes (n_in %d, out %d, ws %zu)\n", n_in, out_size, ws_size); grid = -1; return; }
        int dev = 0, cus = 0, per_cu = 0;
        if (hipGetDevice(&dev) != hipSuccess || hipDeviceGetAttribute(&cus, hipDeviceAttributeMultiprocessorCount, dev) != hipSuccess) { grid = -1; return; }
        if (hipFuncSetAttribute((const void*)hybrid_fwd, hipFuncAttributeMaxDynamicSharedMemorySize, LDS_BYTES) != hipSuccess) { fprintf(stderr, "kernel_launch: hipFuncSetAttribute failed\n"); grid = -1; return; }
        if (hipOccupancyMaxActiveBlocksPerMultiprocessor(&per_cu, (const void*)hybrid_fwd, NWAVES * 64, LDS_BYTES) != hipSuccess || per_cu < 1) { fprintf(stderr, "kernel_launch: occupancy query says %d\n", per_cu); }
        (void)hipGetLastError();
        grid = cus;
    }
    if (grid < 0) return;
    (void)hipMemsetAsync((char*)d_ws + WS_CTL, 0, CTL_ZERO_BYTES, stream);
    Args a{};
    for (int i = 0; i < N_IN; ++i) a.in[i] = d_in[i];
    a.in[I_OUT] = d_out; a.in[I_WS] = d_ws; a.pad = 0;
#if MK_PER_PHASE
    for (int p = 0; p < N_PHASES; ++p) { a.ph_lo = p; a.ph_hi = p + 1; a.li = p; hipLaunchKernelGGL(hybrid_fwd, dim3(grid), dim3(NWAVES * 64), LDS_BYTES, stream, a); }
#else
    a.ph_lo = 0; a.ph_hi = N_PHASES; a.li = 0;
    hipLaunchKernelGGL(hybrid_fwd, dim3(grid), dim3(NWAVES * 64), LDS_BYTES, stream, a);
#endif
    const hipError_t le = hipPeekAtLastError();
    if (le != hipSuccess) fprintf(stderr, "kernel_launch: launch failed: %s\n", hipGetErrorName(le));
}
```

```cpp
#include <hip/hip_runtime.h>
#include <cstdio>
#include <cstdint>

#define GAS __attribute__((address_space(1)))
#define LAS __attribute__((address_space(3)))
typedef unsigned short bf16;
typedef short bf16x8 __attribute__((ext_vector_type(8)));
typedef short s16x4 __attribute__((ext_vector_type(4)));
typedef float f32x2 __attribute__((ext_vector_type(2)));
typedef float f32x4 __attribute__((ext_vector_type(4)));
typedef float f32x16 __attribute__((ext_vector_type(16)));
typedef unsigned u32x2 __attribute__((ext_vector_type(2)));
typedef unsigned u32x4 __attribute__((ext_vector_type(4)));
typedef __bf16 bf16x2_t __attribute__((ext_vector_type(2)));

constexpr int DM = 1024, SEQ = 8192, NBATCH = 2, MP = NBATCH * SEQ, NS = 128, MT = 16640, NMT = MT / 256;
constexpr int DFF = 2816, DRNN = 1280, NBLK = 16, BLK = 80, QL = 384, KVL = 256, ROPE = 32, NH = 16;
constexpr int DPLE = 256, DIN = 5280, ZW = 5376;
constexpr int Z_XR = 0, Z_YR = 1280, Z_CQ = 2560, Z_KV = 2944, Z_KR = 3200, Z_GA = 3328, Z_GB = 4352;
constexpr int QW = 1536, KVW = 2048;
constexpr int PAGE = 128, NPAGES = 64;
constexpr float EPS = 1e-6f;
constexpr float C2 = 0.10206207261596577f * 1.4426950408889634f;
constexpr size_t O_Y = 0, O_CKV_P = 16908288, O_KR_P = 21102592, O_H_P = 21626880, O_CONV_P = 21629440, O_CKV_S = 21637120, O_KR_S = 21669888, O_H_S = 21673984, O_CONV_S = 21837824, O_END = 22329344;
enum { I_XP = 0, I_XS, I_PP, I_PS, I_CCKV, I_CKR, I_SH, I_SCONV, I_PT, I_F1PRE, I_F1G, I_F1U, I_F1D, I_F1POST, I_MIXPRE, I_WIN, I_CONVW, I_CONVB, I_LWA, I_LBA, I_LWI, I_LBI, I_LAM,
       I_WRNN, I_QNORM, I_WUQ, I_WQR, I_KVNORM, I_WUK, I_WUV, I_WATT, I_WOUT, I_MIXPOST, I_F2PRE, I_F2G, I_F2U, I_F2D, I_F2POST, I_PG, I_PPJ, I_PPOST, N_IN, I_OUT = N_IN, I_WS, N_PTR };

constexpr size_t MiB = 1u << 20;
constexpr size_t WS_CTL = 0, CTL_ZERO_BYTES = 256 * 1024;
constexpr size_t WS_BUP1 = 2 * MiB, WS_BDN1 = 13 * MiB, WS_BIN = 19 * MiB, WS_BRNN = 30 * MiB, WS_BQ = 33 * MiB, WS_BKV = 35 * MiB, WS_BATT = 36 * MiB, WS_BOUT = 38 * MiB,
                 WS_BUP2 = 40 * MiB, WS_BDN2 = 51 * MiB, WS_BPG = 57 * MiB, WS_BPP = 59 * MiB, WS_LW = 60 * MiB, WS_ROPE = 61 * MiB, WS_SUM = 63 * MiB;
constexpr size_t WS_XN = 64 * MiB, WS_F = 97 * MiB, WS_H = 130 * MiB, WS_XR = 220 * MiB, WS_Z = 285 * MiB, WS_CQ = 456 * MiB, WS_CKV = 469 * MiB, WS_KR = 478 * MiB, WS_Q = 480 * MiB,
                 WS_KVB = 529 * MiB, WS_PB = 593 * MiB, WS_PPB = 602 * MiB, WS_HG = 635 * MiB, WS_YAG = 676 * MiB, WS_OB = 709 * MiB, WS_MX = 742 * MiB, WS_PART = 775 * MiB, WS_NSLOT = 808 * MiB, WS_END = 810 * MiB;
constexpr int ROPE_TAB = 8193 * 16;
constexpr int PART_STRIDE = 16 * 256 + 32;
constexpr int CW_BAR = 4096;
constexpr int CW_PN = 8192;
constexpr int CW_SN = 49152;
constexpr int CW_QUE = 2048;
#ifndef EARLY_DEC
#define EARLY_DEC 0
#endif
#ifndef NDEC
#define NDEC 64
#endif

__device__ __forceinline__ float bflo(unsigned w) { return __uint_as_float(w << 16); }
__device__ __forceinline__ float bfhi(unsigned w) { return __uint_as_float(w & 0xffff0000u); }
__device__ __forceinline__ float bf2f(bf16 v) { return __uint_as_float((unsigned)v << 16); }
__device__ __forceinline__ unsigned pk2(float lo, float hi) { f32x2 v = {lo, hi}; bf16x2_t b = __builtin_convertvector(v, bf16x2_t); return __builtin_bit_cast(unsigned, b); }
__device__ __forceinline__ bf16 f2bf(float f) { return (bf16)(pk2(f, 0.f) & 0xffffu); }
__device__ __forceinline__ float sigmoid_f(float x) { return __builtin_amdgcn_rcpf(1.f + __builtin_amdgcn_exp2f(-1.4426950408889634f * x)); }
__device__ __forceinline__ float silu_f(float x) { return x * sigmoid_f(x); }
__device__ __forceinline__ float gelu_tanh_f(float x) { const float u = 0.7978845608028654f * (x + 0.044715f * x * x * x); return x * sigmoid_f(2.f * u); }
__device__ __forceinline__ float wave_sum(float v) {
#define WS_DPP(ctrl) v += __uint_as_float((unsigned)__builtin_amdgcn_update_dpp(0, (int)__float_as_uint(v), ctrl, 0xf, 0xf, false))
    WS_DPP(0xB1); WS_DPP(0x4E); WS_DPP(0x141); WS_DPP(0x140);
#undef WS_DPP
    { const unsigned u = __float_as_uint(v); const auto r = __builtin_amdgcn_permlane16_swap(u, u, false, false); v = __uint_as_float(r[0]) + __uint_as_float(r[1]); }
    { const unsigned u = __float_as_uint(v); const auto r = __builtin_amdgcn_permlane32_swap(u, u, false, false); v = __uint_as_float(r[0]) + __uint_as_float(r[1]); }
    return v;
}
__device__ __forceinline__ int lane_id() { return (int)__builtin_amdgcn_mbcnt_hi(~0u, __builtin_amdgcn_mbcnt_lo(~0u, 0u)); }
#define TIDW(wv) ((wv) * 64 + lane_id())
#define LDS_WAIT() asm volatile("s_waitcnt lgkmcnt(0)" ::: "memory")
#define VM_WAIT() asm volatile("s_waitcnt vmcnt(0)" ::: "memory")

namespace pg8 {
typedef unsigned short bf16_t;
constexpr int BM = 256, BK = 64, HALF = 128, HTB = HALF * BK * 2, STAGE_BYTES = 8 * HTB, NXCD = 8, WGM = 8;
__host__ __device__ __forceinline__ int lds_byte(int r, int c) { const int st = (r >> 4) * 2 + (c >> 5), rr = r & 15, cc = c & 31, ob = rr * 64 + cc * 2; return st * 1024 + (ob ^ (((ob >> 9) & 1) << 5)); }
__host__ __device__ __forceinline__ void stage_rc(int b, int& R, int& C) { const int st = b / 1024, sb = b % 1024, swz = sb ^ (((sb >> 9) & 1) << 5); R = (st >> 1) * 16 + swz / 64; C = (st & 1) * 32 + (swz % 64) / 2; }
__host__ __device__ __forceinline__ int perm32(int rho) { const int n = rho >> 4, i = rho & 15; return 8 * (i >> 2) + 4 * n + (i & 3); }
struct Unit { int pm, pn; };
struct Gemm { const bf16_t* A; const bf16_t* Bt; int M, N, K; };
struct StaticOrder {
    int nM, nN, nwg, G, c;
    __host__ __device__ void init(int M, int N, int G_, int c_) { nM = M / BM; nN = N / BM; nwg = nM * nN; G = G_; c = c_; }
    __host__ __device__ bool next(int i, Unit& u) const {
        const long L = (long)i * G + c; if (L >= nwg) return false;
        int wgid = (int)L; { const int q = nwg / NXCD, r = nwg % NXCD, xcd = wgid % NXCD, off = wgid / NXCD; wgid = (xcd < r ? xcd * (q + 1) : r * (q + 1) + (xcd - r) * q) + off; }
        const int nig = WGM * nN, gid = wgid / nig, fm = gid * WGM, gsz = (nM - fm) < WGM ? (nM - fm) : WGM;
        u.pm = fm + ((wgid % nig) % gsz); u.pn = (wgid % nig) / gsz; return true;
    }
    __device__ __forceinline__ void a_ready(const Unit&) const {}
    __device__ __forceinline__ void done(const Unit&) const {}
};
enum { EM_PLAIN = 0, EM_SWIGLU, EM_WIN, EM_SCALE, EM_MULZ, EM_FMAZ, EM_SIGMUL };
template <int MODE> struct Epi {
    static constexpr bool PERM = true, AFTER_DRAIN = false;
    bf16_t* O; int ldc;
    const bf16_t* aux; int ldaux;
    const bf16_t* add; int ldadd;
    float scale;
    __device__ __forceinline__ void operator()(const f32x4 (&acc)[2][2][4][2], const Unit& u, int wr, int wc, int fr, int fq) const {
        const int row0 = u.pm * BM + wr * 64 + fr;
        if constexpr (MODE == EM_SWIGLU) {
            const int col = u.pn * HALF + wc * 32 + 8 * fq;
#pragma unroll
            for (int ai = 0; ai < 2; ++ai)
#pragma unroll
                for (int m = 0; m < 4; ++m) {
                    const f32x4 g0 = acc[ai][0][m][0], g1 = acc[ai][0][m][1], u0 = acc[ai][1][m][0], u1 = acc[ai][1][m][1];
                    u32x4 w; w.x = pk2(silu_f(g0[0]) * u0[0], silu_f(g0[1]) * u0[1]); w.y = pk2(silu_f(g0[2]) * u0[2], silu_f(g0[3]) * u0[3]);
                    w.z = pk2(silu_f(g1[0]) * u1[0], silu_f(g1[1]) * u1[1]); w.w = pk2(silu_f(g1[2]) * u1[2], silu_f(g1[3]) * u1[3]);
                    *(u32x4*)(O + (size_t)(row0 + ai * HALF + m * 16) * ldc + col) = w;
                }
        } else {
            int act = 0;
            if constexpr (MODE == EM_WIN) act = (u.pn >= 5 && u.pn < 10) ? 1 : (u.pn >= 13 ? 2 : 0);
#pragma unroll
            for (int ai = 0; ai < 2; ++ai)
#pragma unroll
                for (int m = 0; m < 4; ++m) {
                    const int row = row0 + ai * HALF + m * 16;
#pragma unroll
                    for (int bj = 0; bj < 2; ++bj) {
                        const int col = u.pn * BM + bj * HALF + wc * 32 + 8 * fq;
                        f32x4 v0 = acc[ai][bj][m][0], v1 = acc[ai][bj][m][1];
                        if constexpr (MODE == EM_WIN) {
                            if (act == 1) { for (int j = 0; j < 4; ++j) { v0[j] = gelu_tanh_f(v0[j]); v1[j] = gelu_tanh_f(v1[j]); } }
                            else if (act == 2) { for (int j = 0; j < 4; ++j) { v0[j] = sigmoid_f(v0[j]); v1[j] = sigmoid_f(v1[j]); } }
                        }
                        if constexpr (MODE == EM_SCALE) { v0 = v0 * scale; v1 = v1 * scale; }
                        if constexpr (MODE == EM_MULZ || MODE == EM_FMAZ || MODE == EM_SIGMUL) {
                            const u32x4 z = *(const u32x4*)(aux + (size_t)row * ldaux + col);
                            f32x4 z0 = {bflo(z.x), bfhi(z.x), bflo(z.y), bfhi(z.y)}, z1 = {bflo(z.z), bfhi(z.z), bflo(z.w), bfhi(z.w)};
                            if constexpr (MODE == EM_SIGMUL) { for (int j = 0; j < 4; ++j) { v0[j] = sigmoid_f(v0[j]); v1[j] = sigmoid_f(v1[j]); } }
                            v0 = v0 * z0; v1 = v1 * z1;
                            if constexpr (MODE == EM_FMAZ) {
                                const u32x4 y = *(const u32x4*)(add + (size_t)row * ldadd + col);
                                v0 += (f32x4){bflo(y.x), bfhi(y.x), bflo(y.y), bfhi(y.y)}; v1 += (f32x4){bflo(y.z), bfhi(y.z), bflo(y.w), bfhi(y.w)};
                            }
                        }
                        u32x4 w; w.x = pk2(v0[0], v0[1]); w.y = pk2(v0[2], v0[3]); w.z = pk2(v1[0], v1[1]); w.w = pk2(v1[2], v1[3]);
                        *(u32x4*)(O + (size_t)row * ldc + col) = w;
                    }
                }
        }
    }
};

struct OneUnit { Unit u; __device__ __forceinline__ bool next(int i, Unit& o) const { if (i != 0) return false; o = u; return true; }
    __device__ __forceinline__ void a_ready(const Unit&) const {} __device__ __forceinline__ void done(const Unit&) const {} };
template <int NEXT, int SRC, int PRE = 0> struct EpiNorm {
    static constexpr bool PERM = true, AFTER_DRAIN = true;
    const float* xin; bf16_t* XR; bf16_t* XN; float* Y; const float* gpost; const float* gpre; float coef; float* slots; unsigned* cnt; const bf16_t* aux;
    __device__ __forceinline__ void operator()(const f32x4 (&)[2][2][4][2], const Unit&, int, int, int, int) const {}
    __device__ __forceinline__ void stats(const f32x4 (&v)[2][2][4][2], const Unit& u, int wr, int wc, int fr, int fq, LAS unsigned char* lds, int wid, int lane, int which, float c) const {
        LAS float* P = (LAS float*)lds; LAS float* S = (LAS float*)(lds + 4096);
#pragma unroll
        for (int ai = 0; ai < 2; ++ai)
#pragma unroll
            for (int m = 0; m < 4; ++m) { float q = 0.f;
#pragma unroll
                for (int bj = 0; bj < 2; ++bj)
#pragma unroll
                    for (int n = 0; n < 2; ++n) { const f32x4 x = v[ai][bj][m][n]; q += (x[0] * x[0] + x[1] * x[1]) + (x[2] * x[2] + x[3] * x[3]); }
                { const unsigned uq = __float_as_uint(q); const auto r_ = __builtin_amdgcn_permlane16_swap(uq, uq, false, false); q = __uint_as_float(r_[0]) + __uint_as_float(r_[1]); }
                { const unsigned uq = __float_as_uint(q); const auto r_ = __builtin_amdgcn_permlane32_swap(uq, uq, false, false); q = __uint_as_float(r_[0]) + __uint_as_float(r_[1]); }
                if (fq == 0) P[(ai * HALF + wr * 64 + m * 16 + fr) * 4 + wc] = q; }
        asm volatile("s_waitcnt lgkmcnt(0)" ::: "memory"); __builtin_amdgcn_s_barrier(); asm volatile("" ::: "memory");
        const int row = wid * 32 + (lane & 31);
        float* slot = slots + ((size_t)(which * 64 + u.pm) * BM + row) * 4;
        unsigned* c0 = cnt + (size_t)(which * 64 + u.pm) * 64;
        if (lane < 32) { const f32x4 p4 = *(const LAS f32x4*)(P + row * 4); __hip_atomic_store(slot + u.pn, (p4[0] + p4[1]) + (p4[2] + p4[3]), __ATOMIC_RELAXED, __HIP_MEMORY_SCOPE_AGENT); }
        asm volatile("s_waitcnt vmcnt(0)" ::: "memory");
        if (lane == 0) (void)__hip_atomic_fetch_add(c0, 1u, __ATOMIC_RELAXED, __HIP_MEMORY_SCOPE_AGENT);
        if (wid == 0) { unsigned sp = 0u;
            while ((unsigned)__builtin_amdgcn_readfirstlane(__hip_atomic_load(c0, __ATOMIC_RELAXED, __HIP_MEMORY_SCOPE_AGENT)) < 32u) { __builtin_amdgcn_s_sleep(1); if (++sp > (1u << 20)) break; }
            __builtin_amdgcn_fence(__ATOMIC_ACQUIRE, "agent"); }
        asm volatile("s_waitcnt vmcnt(0) lgkmcnt(0)" ::: "memory"); __builtin_amdgcn_s_barrier(); asm volatile("" ::: "memory");
        if (lane < 32) { float t = 0.f;
#pragma unroll
            for (int k = 0; k < 4; ++k) t += __hip_atomic_load(slot + k, __ATOMIC_RELAXED, __HIP_MEMORY_SCOPE_AGENT);
            S[row] = c / sqrtf(t * (1.f / 1024.f) + 1e-6f); }
        asm volatile("s_waitcnt vmcnt(0) lgkmcnt(0)" ::: "memory"); __builtin_amdgcn_s_barrier(); asm volatile("" ::: "memory");
    }
    __device__ __forceinline__ void fused(f32x4 (&acc)[2][2][4][2], const Unit& u, int wr, int wc, int fr, int fq, LAS unsigned char* lds, int wid, int lane) const {
        const LAS float* S = (const LAS float*)(lds + 4096);
        if constexpr (PRE == 1) {
#pragma unroll
            for (int bj = 0; bj < 2; ++bj)
#pragma unroll
                for (int ai = 0; ai < 2; ++ai)
#pragma unroll
                    for (int m = 0; m < 4; ++m) { const size_t off = (size_t)(u.pm * BM + ai * HALF + wr * 64 + m * 16 + fr) * 1024 + u.pn * BM + bj * HALF + wc * 32 + 8 * fq;
                        const u32x4 zq = *(const u32x4*)(aux + off); f32x4 v0 = acc[ai][bj][m][0], v1 = acc[ai][bj][m][1];
#pragma unroll
                        for (int j = 0; j < 4; ++j) { v0[j] = sigmoid_f(v0[j]); v1[j] = sigmoid_f(v1[j]); }
                        acc[ai][bj][m][0] = v0 * (f32x4){bflo(zq.x), bfhi(zq.x), bflo(zq.y), bfhi(zq.y)}; acc[ai][bj][m][1] = v1 * (f32x4){bflo(zq.z), bfhi(zq.z), bflo(zq.w), bfhi(zq.w)}; }
        }
        stats(acc, u, wr, wc, fr, fq, lds, wid, lane, 0, coef);
#pragma unroll
        for (int bj = 0; bj < 2; ++bj) {
            const int col = u.pn * BM + bj * HALF + wc * 32 + 8 * fq;
            const f32x4 g0 = *(const f32x4*)(gpost + col), g1 = *(const f32x4*)(gpost + col + 4);
#pragma unroll
            for (int ai = 0; ai < 2; ++ai)
#pragma unroll
                for (int m = 0; m < 4; ++m) {
                    const int rl = ai * HALF + wr * 64 + m * 16 + fr; const size_t off = (size_t)(u.pm * BM + rl) * 1024 + col; const float r = S[rl];
                    f32x4 x0, x1;
                    if constexpr (SRC == 0) { x0 = *(const f32x4*)(xin + off); x1 = *(const f32x4*)(xin + off + 4); }
                    else { const u32x4 w = *(const u32x4*)((SRC == 1 ? XR : XN) + off); x0 = (f32x4){bflo(w.x), bfhi(w.x), bflo(w.y), bfhi(w.y)}; x1 = (f32x4){bflo(w.z), bfhi(w.z), bflo(w.w), bfhi(w.w)}; }
                    x0 = x0 + acc[ai][bj][m][0] * g0 * r; x1 = x1 + acc[ai][bj][m][1] * g1 * r;
                    acc[ai][bj][m][0] = x0; acc[ai][bj][m][1] = x1;
                    if constexpr (NEXT == 0) { *(f32x4*)(Y + off) = x0; *(f32x4*)(Y + off + 4) = x1; }
                    else { u32x4 w; w.x = pk2(x0[0], x0[1]); w.y = pk2(x0[2], x0[3]); w.z = pk2(x1[0], x1[1]); w.w = pk2(x1[2], x1[3]); *(u32x4*)((NEXT == 1 ? XR : XN) + off) = w; }
                }
        }
        if constexpr (NEXT == 1) {
            stats(acc, u, wr, wc, fr, fq, lds, wid, lane, 1, 1.f);
#pragma unroll
            for (int bj = 0; bj < 2; ++bj) {
                const int col = u.pn * BM + bj * HALF + wc * 32 + 8 * fq;
                const f32x4 g0 = *(const f32x4*)(gpre + col), g1 = *(const f32x4*)(gpre + col + 4);
#pragma unroll
                for (int ai = 0; ai < 2; ++ai)
#pragma unroll
                    for (int m = 0; m < 4; ++m) {
                        const int rl = ai * HALF + wr * 64 + m * 16 + fr; const size_t off = (size_t)(u.pm * BM + rl) * 1024 + col; const float r = S[rl];
                        const f32x4 x0 = acc[ai][bj][m][0] * g0 * r, x1 = acc[ai][bj][m][1] * g1 * r;
                        u32x4 w; w.x = pk2(x0[0], x0[1]); w.y = pk2(x0[2], x0[3]); w.z = pk2(x1[0], x1[1]); w.w = pk2(x1[2], x1[3]); *(u32x4*)(XN + off) = w;
                    }
            }
        }
    }
};
struct NoPre { __device__ __forceinline__ void operator()() const {} };
template <class EpiT, class Sched, bool ALIGN_EPI = false, bool SP2 = false, class Pre = NoPre>
__device__ __forceinline__ void gemm_phase(LAS unsigned char* lds, const Gemm g, const Sched& S, const EpiT& E, int wv, const Pre& pre = Pre()) {
    int tid_ = TIDW(wv); asm volatile("" : "+v"(tid_));
    const int tid = tid_, wid = __builtin_amdgcn_readfirstlane(tid >> 6), lane = tid & 63, wr = wid >> 2, wc = wid & 3, fr = lane & 15, fq = lane >> 4;
    const int K = g.K, nt = K / BK;
    unsigned voffA[2], voffB[2];
#pragma unroll
    for (int i = 0; i < 2; ++i) { int R, C; stage_rc(tid * 16 + i * 8192, R, C); const int Rb = EpiT::PERM ? ((R & ~31) + perm32(R & 31)) : R;
        voffA[i] = (unsigned)(R * K + C) * 2u; voffB[i] = (unsigned)(Rb * K + C) * 2u; }
    const size_t kstep = (size_t)(BK * 2);
    const size_t hstep = (size_t)HALF * K * 2;
    const size_t tstep = 2 * hstep;
    const unsigned ldsw = (unsigned)wid * 1024u;
    const int aoff = lds_byte(wr * 64 + fr, fq * 8), boff = lds_byte(wc * 32 + fr, fq * 8);
#define PG8_SA(b, h) (((b) * 2 + (h)) * HTB)
#define PG8_SB(b, h) ((4 + (b) * 2 + (h)) * HTB)
#define PG8_STAGE(bufoff, gbase, voff) do { _Pragma("unroll") for (int _i = 0; _i < 2; ++_i) \
        __builtin_amdgcn_global_load_lds((const unsigned*)((const char*)(gbase) + (voff)[_i]), (LAS unsigned*)(lds + (bufoff) + ldsw + _i * 8192), 16, 0, 0); } while (0)
#define PG8_LDA(dst, b, h) do { _Pragma("unroll") for (int m = 0; m < 4; ++m) _Pragma("unroll") for (int k = 0; k < 2; ++k) dst[m][k] = *(const LAS bf16x8*)(lds + PG8_SA(b, h) + aoff + m * 2048 + k * 1024); } while (0)
#define PG8_LDB(dst, b, h) do { _Pragma("unroll") for (int n = 0; n < 2; ++n) _Pragma("unroll") for (int k = 0; k < 2; ++k) dst[n][k] = *(const LAS bf16x8*)(lds + PG8_SB(b, h) + boff + n * 2048 + k * 1024); } while (0)
#define PG8_MMA(ai, bj, At, Bt) do { __builtin_amdgcn_s_setprio(1); _Pragma("unroll") for (int m = 0; m < 4; ++m) _Pragma("unroll") for (int n = 0; n < 2; ++n) _Pragma("unroll") for (int k = 0; k < 2; ++k) \
        acc[ai][bj][m][n] = __builtin_amdgcn_mfma_f32_16x16x32_bf16(Bt[n][k], At[m][k], acc[ai][bj][m][n], 0, 0, 0); __builtin_amdgcn_s_setprio(0); } while (0)
#define PG8_WAIT_V(n) asm volatile("s_waitcnt vmcnt(" #n ")" ::: "memory")
#define PG8_WAIT_L(n) asm volatile("s_waitcnt lgkmcnt(" #n ")" ::: "memory")
#define PG8_BAR __builtin_amdgcn_s_barrier()
#define PG8_SCHED __builtin_amdgcn_sched_barrier(0)
    Unit cur, nxt; int ui = 0;
    if (!S.next(0, cur)) return;
    f32x4 acc[2][2][4][2];
#pragma unroll
    for (int a = 0; a < 2; ++a)
#pragma unroll
        for (int b = 0; b < 2; ++b)
#pragma unroll
            for (int m = 0; m < 4; ++m)
#pragma unroll
                for (int n = 0; n < 2; ++n) acc[a][b][m][n] = (f32x4){0.f, 0.f, 0.f, 0.f};
    bf16x8 At[4][2], B0[2][2], B1[2][2];
    const char* cA = (const char*)g.A + (size_t)cur.pm * tstep; const char* cB = (const char*)g.Bt + (size_t)cur.pn * tstep;
    S.a_ready(cur);
    if constexpr (SP2) {
        PG8_STAGE(PG8_SB(0, 0), cB, voffB); PG8_STAGE(PG8_SB(0, 1), cB + hstep, voffB); PG8_STAGE(PG8_SA(0, 0), cA, voffA); PG8_STAGE(PG8_SA(0, 1), cA + hstep, voffA);
        pre();
        if (wr == 1) PG8_BAR;
        PG8_WAIT_V(2); PG8_BAR;
        PG8_STAGE(PG8_SB(1, 0), cB + kstep, voffB); PG8_STAGE(PG8_SA(1, 0), cA + kstep, voffA); PG8_STAGE(PG8_SB(1, 1), cB + hstep + kstep, voffB);
        PG8_WAIT_V(6); PG8_BAR;
    } else {
        PG8_STAGE(PG8_SB(0, 0), cB, voffB); PG8_STAGE(PG8_SA(0, 0), cA, voffA); PG8_STAGE(PG8_SB(0, 1), cB + hstep, voffB); PG8_STAGE(PG8_SA(0, 1), cA + hstep, voffA);
        if (wr == 1) PG8_BAR;
        PG8_WAIT_V(4); PG8_BAR;
        PG8_STAGE(PG8_SB(1, 0), cB + kstep, voffB); PG8_STAGE(PG8_SA(1, 0), cA + kstep, voffA); PG8_STAGE(PG8_SB(1, 1), cB + hstep + kstep, voffB);
        PG8_WAIT_V(6); PG8_BAR;
    }
    for (;;) {
        const bool has_next = S.next(ui + 1, nxt);
        const char* nA = has_next ? (const char*)g.A + (size_t)nxt.pm * tstep : cA; const char* nB = has_next ? (const char*)g.Bt + (size_t)nxt.pn * tstep : cB;
        for (int t = 0; t < nt; t += 2) {
            const bool last = (t == nt - 2);
            const char* a1 = cA + (size_t)(t + 1) * kstep;
            const char* a2 = last ? nA : cA + (size_t)(t + 2) * kstep; const char* b2 = last ? nB : cB + (size_t)(t + 2) * kstep;
            const char* a3 = a2 + kstep; const char* b3 = b2 + kstep;
            if (last && has_next) S.a_ready(nxt);
            if constexpr (SP2) {
            PG8_LDB(B0, 0, 0); PG8_LDB(B1, 0, 1); PG8_SCHED; PG8_LDA(At, 0, 0); PG8_STAGE(PG8_SA(1, 1), a1 + hstep, voffA);
            PG8_WAIT_V(8); PG8_WAIT_L(0); PG8_BAR; PG8_MMA(0, 0, At, B0); PG8_MMA(0, 1, At, B1); PG8_BAR; PG8_SCHED;
            PG8_LDA(At, 0, 1); PG8_STAGE(PG8_SB(0, 0), b2, voffB); PG8_STAGE(PG8_SB(0, 1), b2 + hstep, voffB); PG8_STAGE(PG8_SA(0, 0), a2, voffA);
            PG8_WAIT_V(8); PG8_WAIT_L(0); PG8_BAR; PG8_MMA(1, 0, At, B0); PG8_MMA(1, 1, At, B1); PG8_BAR; PG8_SCHED;
            PG8_LDB(B0, 1, 0); PG8_LDB(B1, 1, 1); PG8_SCHED; PG8_LDA(At, 1, 0); PG8_STAGE(PG8_SA(0, 1), a2 + hstep, voffA);
            PG8_WAIT_V(8); PG8_WAIT_L(0); PG8_BAR; PG8_MMA(0, 0, At, B0); PG8_MMA(0, 1, At, B1); PG8_BAR; PG8_SCHED;
            PG8_LDA(At, 1, 1); PG8_STAGE(PG8_SB(1, 0), b3, voffB); PG8_STAGE(PG8_SB(1, 1), b3 + hstep, voffB); PG8_STAGE(PG8_SA(1, 0), a3, voffA);
            PG8_WAIT_V(8); PG8_WAIT_L(0); PG8_BAR; PG8_MMA(1, 0, At, B0); PG8_MMA(1, 1, At, B1); PG8_BAR; PG8_SCHED;
            } else {
            PG8_LDB(B0, 0, 0); PG8_SCHED; PG8_LDA(At, 0, 0); PG8_STAGE(PG8_SA(1, 1), a1 + hstep, voffA);
            PG8_WAIT_L(8); PG8_BAR; PG8_WAIT_L(0); PG8_MMA(0, 0, At, B0); PG8_BAR; PG8_SCHED;
            PG8_LDB(B1, 0, 1); PG8_STAGE(PG8_SB(0, 0), b2, voffB);
            PG8_BAR; PG8_WAIT_L(0); PG8_MMA(0, 1, At, B1); PG8_BAR;
            PG8_LDA(At, 0, 1); PG8_STAGE(PG8_SA(0, 0), a2, voffA);
            PG8_BAR; PG8_WAIT_L(0); PG8_MMA(1, 0, At, B0); PG8_BAR; PG8_SCHED;
            PG8_STAGE(PG8_SB(0, 1), b2 + hstep, voffB);
            PG8_WAIT_V(6); PG8_BAR; PG8_MMA(1, 1, At, B1); PG8_BAR;
            PG8_LDB(B0, 1, 0); PG8_SCHED; PG8_LDA(At, 1, 0); PG8_STAGE(PG8_SA(0, 1), a2 + hstep, voffA);
            PG8_WAIT_L(8); PG8_BAR; PG8_WAIT_L(0); PG8_MMA(0, 0, At, B0); PG8_BAR; PG8_SCHED;
            PG8_LDB(B1, 1, 1); PG8_STAGE(PG8_SB(1, 0), b3, voffB);
            PG8_BAR; PG8_WAIT_L(0); PG8_MMA(0, 1, At, B1); PG8_BAR;
            PG8_LDA(At, 1, 1); PG8_STAGE(PG8_SA(1, 0), a3, voffA);
            PG8_BAR; PG8_WAIT_L(0); PG8_MMA(1, 0, At, B0); PG8_BAR; PG8_SCHED;
            PG8_STAGE(PG8_SB(1, 1), b3 + hstep, voffB);
            PG8_WAIT_V(6); PG8_BAR; PG8_MMA(1, 1, At, B1); PG8_BAR;
            }
        }
        if constexpr (ALIGN_EPI) { if (wr == 0) PG8_BAR; }
        if constexpr (!EpiT::AFTER_DRAIN) { E(acc, cur, wr, wc, fr, fq); S.done(cur); }
        if (!has_next) break;
#pragma unroll
        for (int a = 0; a < 2; ++a)
#pragma unroll
            for (int b = 0; b < 2; ++b)
#pragma unroll
                for (int m = 0; m < 4; ++m)
#pragma unroll
                    for (int n = 0; n < 2; ++n) acc[a][b][m][n] = (f32x4){0.f, 0.f, 0.f, 0.f};
        cur = nxt; cA = nA; cB = nB; ++ui;
        if constexpr (ALIGN_EPI) { if (wr == 1) PG8_BAR; }
    }
    PG8_WAIT_V(0);
    if constexpr (!ALIGN_EPI) { if (wr == 0) PG8_BAR; }
    PG8_BAR;
    if constexpr (EpiT::AFTER_DRAIN) E.fused(acc, cur, wr, wc, fr, fq, lds, wid, lane);
#undef PG8_SA
#undef PG8_SB
#undef PG8_STAGE
#undef PG8_LDA
#undef PG8_LDB
#undef PG8_MMA
#undef PG8_WAIT_V
#undef PG8_WAIT_L
#undef PG8_BAR
#undef PG8_SCHED
}
}

template <int MODE, int K> __device__ __forceinline__ void sgemm_sample(LAS unsigned char* lds, const bf16* A, const bf16* Bt, int N, bf16* O, int ldc, const bf16* aux, int ldaux, const bf16* add, int ldadd, int vcu, int G, int wv,
                                                                 unsigned* sig = nullptr) {
    int tid = TIDW(wv); asm volatile("" : "+v"(tid));
    const int lane = tid & 63, wave = __builtin_amdgcn_readfirstlane(tid >> 6), l15 = lane & 15, g4 = lane >> 4, tsel = wave & 1, kq = wave >> 1;
    constexpr int kn = K >> 2, KQ = kn / 32;
    const int npair = N >> 5, nitem = 8 * npair;
    LAS f32x4* red = (LAS f32x4*)lds;
    for (int item = vcu; item < nitem; item += G) {
        const int tr = item / npair, ct = 2 * (item - tr * npair) + tsel;
        const int row = MP + tr * 16 + l15;
        const bf16* ap = A + (size_t)row * K + kq * kn + 8 * g4;
        const bf16* bp = Bt + (size_t)(ct * 16 + l15) * K + kq * kn + 8 * g4;
        f32x4 acc = {0.f, 0.f, 0.f, 0.f};
        bf16x8 av[KQ], bv[KQ];
#pragma unroll
        for (int k = 0; k < KQ; ++k) { av[k] = *(const bf16x8*)(ap + 32 * k); bv[k] = *(const bf16x8*)(bp + 32 * k); }
        u32x2 zz = {0u, 0u}, yy = {0u, 0u};
        if constexpr (MODE == pg8::EM_MULZ || MODE == pg8::EM_FMAZ || MODE == pg8::EM_SIGMUL) { if (kq == 0) zz = *(const u32x2*)(aux + (size_t)row * ldaux + ct * 16 + 4 * g4); }
        if constexpr (MODE == pg8::EM_FMAZ) { if (kq == 0) yy = *(const u32x2*)(add + (size_t)row * ldadd + ct * 16 + 4 * g4); }
#pragma unroll
        for (int k = 0; k < KQ; ++k) acc = __builtin_amdgcn_mfma_f32_16x16x32_bf16(bv[k], av[k], acc, 0, 0, 0);
        __syncthreads();
        if (kq > 0) red[(tsel * 3 + (kq - 1)) * 64 + lane] = acc;
        __syncthreads();
        if (kq == 0) {
            acc = acc + red[(tsel * 3 + 0) * 64 + lane] + red[(tsel * 3 + 1) * 64 + lane] + red[(tsel * 3 + 2) * 64 + lane];
            const int col = ct * 16 + 4 * g4;
            f32x4 v = acc;
            if constexpr (MODE == pg8::EM_MULZ || MODE == pg8::EM_FMAZ || MODE == pg8::EM_SIGMUL) {
                const f32x4 zf = {bflo(zz.x), bfhi(zz.x), bflo(zz.y), bfhi(zz.y)};
                if constexpr (MODE == pg8::EM_SIGMUL) { for (int j = 0; j < 4; ++j) v[j] = sigmoid_f(v[j]); }
                v = v * zf;
                if constexpr (MODE == pg8::EM_FMAZ) { v += (f32x4){bflo(yy.x), bfhi(yy.x), bflo(yy.y), bfhi(yy.y)}; }
            }
            u32x2 w; w.x = pk2(v[0], v[1]); w.y = pk2(v[2], v[3]);
            if (sig) __hip_atomic_store((unsigned long long*)(O + (size_t)row * ldc + col), ((unsigned long long)w.y << 32) | w.x, __ATOMIC_RELAXED, __HIP_MEMORY_SCOPE_AGENT);
            else *(u32x2*)(O + (size_t)row * ldc + col) = w;
        }
    }
    if (sig) asm volatile("s_waitcnt vmcnt(0)" ::: "memory");
    __syncthreads();
    if (sig && wv == 0 && lane == 0) { for (int item = vcu; item < nitem; item += G) (void)__hip_atomic_fetch_add(sig + 64 * (item / npair), 1u, __ATOMIC_RELAXED, __HIP_MEMORY_SCOPE_AGENT); }
}

constexpr int RING_OFF = 0, RING_BYTES = 131072;
constexpr int LDSCTL_OFF = RING_BYTES, MISC_OFF = LDSCTL_OFF + 320;
constexpr int LDS_BYTES = 147456;
constexpr int NWAVES = 8;

#define XB_TMO      128
#define XB_XCNT(j)  (256  + 64 * (j))
#define XB_XSUB(j)  (1280 + 64 * (j))
#define XB_XGEN(j)  (2304 + 64 * (j))
#define XB_TOP      3328
#define XB_TOPGEN   3392
#define XCD_BAR_WORDS 3456
#define XB_SPIN_CAP (1u << 18)
__device__ __forceinline__ unsigned xb_ld(unsigned* p)              { return __hip_atomic_load(p, __ATOMIC_RELAXED, __HIP_MEMORY_SCOPE_AGENT); }
__device__ __forceinline__ unsigned xb_add(unsigned* p, unsigned v) { return __hip_atomic_fetch_add(p, v, __ATOMIC_RELAXED, __HIP_MEMORY_SCOPE_AGENT); }
__device__ __forceinline__ unsigned xb_xcc_id() { return (unsigned)__builtin_amdgcn_s_getreg((3 << 11) | 20) & 0xFu; }
#define XB_SPIN(cond, bar) do { unsigned _sp = 0; while (cond) { __builtin_amdgcn_s_sleep(1); \
    if ((++_sp & 255u) == 0u) { if (xb_ld(&(bar)[XB_TMO])) break; if (_sp > XB_SPIN_CAP) { atomicAdd(&(bar)[XB_TMO], 1u); break; } } } } while (0)
struct XcdBarrier { unsigned* bar; unsigned x; volatile LAS unsigned* st; bool t0; };
__device__ __forceinline__ XcdBarrier xcd_barrier_post(unsigned* bar, volatile LAS unsigned* st) {
    XcdBarrier b; b.bar = bar; b.x = xb_xcc_id(); b.st = st;
    if (threadIdx.x == 0) (void)xb_add(&bar[XB_XCNT(b.x)], 1u);
    return b;
}
__device__ __forceinline__ void xcd_barrier_complete(unsigned* bar, unsigned x, unsigned& nloc, unsigned& nx) {
    const unsigned G = gridDim.x * gridDim.y * gridDim.z;
    unsigned sum, cnt, mine, sp = 0u;
    for (;;) {
        sum = 0u; cnt = 0u; mine = 0u;
#pragma unroll
        for (unsigned j = 0; j < 16; ++j) { const unsigned c = xb_ld(&bar[XB_XCNT(j)]); sum += c; cnt += (c > 0u) ? 1u : 0u; mine = (j == x) ? c : mine; }
        if (sum == G) break;
        __builtin_amdgcn_s_sleep(1);
        if ((++sp & 255u) == 0u) { if (xb_ld(&bar[XB_TMO])) break; if (sp > XB_SPIN_CAP) { atomicAdd(&bar[XB_TMO], 1u); break; } }
    }
    nloc = mine > 0u ? mine : 1u; nx = cnt > 0u ? cnt : 1u;
}
__device__ __forceinline__ void xcd_barrier(const XcdBarrier& b) {
    asm volatile("s_waitcnt vmcnt(0)" ::: "memory");
    __syncthreads();
    if (b.t0) {
        unsigned* bar = b.bar;
        __builtin_amdgcn_s_waitcnt(0);
        unsigned nloc = b.st[0], nx = b.st[1];
        if (nloc == 0u) { xcd_barrier_complete(bar, b.x, nloc, nx); b.st[0] = nloc; b.st[1] = nx; }
        const unsigned old = xb_add(&bar[XB_XSUB(b.x)], 1u);
        const unsigned gen = old / nloc;
        if (old + 1u == (gen + 1u) * nloc) {
            __builtin_amdgcn_fence(__ATOMIC_RELEASE, "agent");
            asm volatile("s_waitcnt vmcnt(0)" ::: "memory");
            const unsigned og = xb_add(&bar[XB_TOP], 1u);
            const unsigned tg = og / nx;
            if (og + 1u == (tg + 1u) * nx) xb_add(&bar[XB_TOPGEN], 1u);
            else XB_SPIN(xb_ld(&bar[XB_TOPGEN]) == tg, bar);
            __builtin_amdgcn_fence(__ATOMIC_ACQUIRE, "agent");
            xb_add(&bar[XB_XGEN(b.x)], 1u);
            asm volatile("s_waitcnt vmcnt(0)" ::: "memory");
        } else {
            XB_SPIN(xb_ld(&bar[XB_XGEN(b.x)]) == gen, bar);
            __builtin_amdgcn_fence(__ATOMIC_ACQUIRE, "agent");
            asm volatile("s_waitcnt vmcnt(0)" ::: "memory");
        }
    }
    __syncthreads();
}
__device__ __forceinline__ void xcd_barrier_arrive(const XcdBarrier& b) {
    asm volatile("s_waitcnt vmcnt(0)" ::: "memory");
    __syncthreads();
    if (b.t0) {
        unsigned* bar = b.bar;
        __builtin_amdgcn_s_waitcnt(0);
        unsigned nloc = b.st[0], nx = b.st[1];
        if (nloc == 0u) { xcd_barrier_complete(bar, b.x, nloc, nx); b.st[0] = nloc; b.st[1] = nx; }
        const unsigned old = xb_add(&bar[XB_XSUB(b.x)], 1u);
        const unsigned gen = old / nloc;
        if (old + 1u == (gen + 1u) * nloc) {
            __builtin_amdgcn_fence(__ATOMIC_RELEASE, "agent");
            asm volatile("s_waitcnt vmcnt(0)" ::: "memory");
            const unsigned og = xb_add(&bar[XB_TOP], 1u);
            const unsigned tg = og / nx;
            if (og + 1u == (tg + 1u) * nx) xb_add(&bar[XB_TOPGEN], 1u);
            else XB_SPIN(xb_ld(&bar[XB_TOPGEN]) == tg, bar);
            __builtin_amdgcn_fence(__ATOMIC_ACQUIRE, "agent");
            xb_add(&bar[XB_XGEN(b.x)], 1u);
            asm volatile("s_waitcnt vmcnt(0)" ::: "memory");
            b.st[3] = 1u;
        } else { b.st[2] = gen; b.st[3] = 0u; }
    }
    __syncthreads();
}
__device__ __forceinline__ void xcd_barrier_finish(const XcdBarrier& b) {
    if (b.t0) {
        if (b.st[3] == 0u) { const unsigned gen = b.st[2]; XB_SPIN(xb_ld(&b.bar[XB_XGEN(b.x)]) == gen, b.bar); __builtin_amdgcn_fence(__ATOMIC_ACQUIRE, "agent"); asm volatile("s_waitcnt vmcnt(0)" ::: "memory"); }
    }
    __syncthreads();
}

struct Args { const void* in[N_PTR]; int ph_lo, ph_hi, li, pad; };

template <int MAP> __device__ __forceinline__ int rowmap(int n, int row_off) {
    if constexpr (MAP == 1) return (n >> 7) * 256 + (n & 127);
    else if constexpr (MAP == 2) return (n >> 7) * 256 + 128 + (n & 127);
    else if constexpr (MAP == 3) return n < 3232 ? n : n + 96;
    else if constexpr (MAP == 4) { const int d = n & 31; return row_off + (n & ~31) + 8 * ((d >> 2) & 3) + 4 * (d >> 4) + (d & 3); }
    else return row_off + n;
}
template <int MAP> __device__ __forceinline__ void transpose_item(const float* W, int K, int N, bf16* WT, int row_off, LAS float* scr, int item, int lane, float wscale = 1.f) {
    const int nblk = N / 32, kb = item / nblk, nb = item % nblk, k0 = 64 * kb, n0 = 32 * nb;
#pragma unroll 8
    for (int i = 0; i < 32; ++i) { const int kk = 2 * i + (lane >> 5); scr[kk * 33 + (lane & 31)] = W[(size_t)(k0 + kk) * N + n0 + (lane & 31)] * wscale; }
    LDS_WAIT(); asm volatile("" ::: "memory");
    const int c = lane & 7;
#pragma unroll
    for (int j = 0; j < 4; ++j) { const int n = (lane >> 3) + 8 * j; const LAS float* s = scr + (8 * c) * 33 + n;
        u32x4 o; o.x = pk2(s[0 * 33], s[1 * 33]); o.y = pk2(s[2 * 33], s[3 * 33]); o.z = pk2(s[4 * 33], s[5 * 33]); o.w = pk2(s[6 * 33], s[7 * 33]);
        *(u32x4*)(WT + (size_t)rowmap<MAP>(n0 + n, row_off) * K + k0 + 8 * c) = o; }
    LDS_WAIT(); asm volatile("" ::: "memory");
}
__device__ __forceinline__ const float* xrow_ptr(const Args& a, int m, int z) {
    if (m < MP) return (const float*)a.in[I_XP + z] + (size_t)m * DM;
    if (m < MP + NS) return (const float*)a.in[I_XS + z] + (size_t)(m - MP) * DM;
    return nullptr;
}
__device__ __forceinline__ void rms_row_to_bf16(const float* xrow, const float* gain, bf16* orow, int lane) {
    f32x4 v[4]; float s = 0.f;
#pragma unroll
    for (int j = 0; j < 4; ++j) { v[j] = xrow ? ((const f32x4*)xrow)[lane + 64 * j] : (f32x4){0.f, 0.f, 0.f, 0.f}; s += (v[j].x * v[j].x + v[j].y * v[j].y) + (v[j].z * v[j].z + v[j].w * v[j].w); }
    const float rstd = 1.f / sqrtf(wave_sum(s) * (1.f / DM) + EPS);
#pragma unroll
    for (int j = 0; j < 4; ++j) { const f32x4 g = ((const f32x4*)gain)[lane + 64 * j];
        u32x2 o; o.x = pk2(v[j].x * rstd * g.x, v[j].y * rstd * g.y); o.y = pk2(v[j].z * rstd * g.z, v[j].w * rstd * g.w);
        ((u32x2*)orow)[lane + 64 * j] = o; }
}
constexpr int CVI_UP = 16 * 88, CVI_DN = 44 * 32, CVI_IN = 16 * 165, CVI_RNN = 20 * 32, CVI_UQ = 6 * 32, CVI_QR = 6 * 16, CVI_UK = 4 * 32, CVI_SQ = 16 * 32, CVI_PPJ = 4 * 32;
constexpr int CV_A = 2 * CVI_UP, CV_B = CV_A + CVI_DN + CVI_IN, CV_N = CV_B + 2 * CVI_UP + CVI_DN + CVI_RNN + CVI_UQ + CVI_QR + 2 * CVI_UK + 3 * CVI_SQ + CVI_PPJ;
__device__ __forceinline__ void convert_item(const Args& a, int z, unsigned char* ws, LAS float* scr, int it, int lane) {
    int r = it;
    if (r < CVI_UP) { transpose_item<1>((const float*)a.in[I_F1G + z], DM, DFF, (bf16*)(ws + WS_BUP1), 0, scr, r, lane); return; } r -= CVI_UP;
    if (r < CVI_UP) { transpose_item<2>((const float*)a.in[I_F1U + z], DM, DFF, (bf16*)(ws + WS_BUP1), 0, scr, r, lane); return; } r -= CVI_UP;
    if (r < CVI_DN) { transpose_item<0>((const float*)a.in[I_F1D + z], DFF, DM, (bf16*)(ws + WS_BDN1), 0, scr, r, lane); return; } r -= CVI_DN;
    if (r < CVI_IN) { transpose_item<3>((const float*)a.in[I_WIN + z], DM, DIN, (bf16*)(ws + WS_BIN), 0, scr, r, lane); return; } r -= CVI_IN;
    if (r < CVI_UP) { transpose_item<1>((const float*)a.in[I_F2G + z], DM, DFF, (bf16*)(ws + WS_BUP2), 0, scr, r, lane); return; } r -= CVI_UP;
    if (r < CVI_UP) { transpose_item<2>((const float*)a.in[I_F2U + z], DM, DFF, (bf16*)(ws + WS_BUP2), 0, scr, r, lane); return; } r -= CVI_UP;
    if (r < CVI_DN) { transpose_item<0>((const float*)a.in[I_F2D + z], DFF, DM, (bf16*)(ws + WS_BDN2), 0, scr, r, lane); return; } r -= CVI_DN;
    if (r < CVI_RNN) { transpose_item<0>((const float*)a.in[I_WRNN + z], DRNN, DM, (bf16*)(ws + WS_BRNN), 0, scr, r, lane); return; } r -= CVI_RNN;
    if (r < CVI_UQ) { transpose_item<0>((const float*)a.in[I_WUQ + z], QL, 1024, (bf16*)(ws + WS_BQ), 0, scr, r, lane, C2); return; } r -= CVI_UQ;
    if (r < CVI_QR) { transpose_item<0>((const float*)a.in[I_WQR + z], QL, 512, (bf16*)(ws + WS_BQ), 1024, scr, r, lane, C2); return; } r -= CVI_QR;
    if (r < CVI_UK) { transpose_item<0>((const float*)a.in[I_WUK + z], KVL, 1024, (bf16*)(ws + WS_BKV), 0, scr, r, lane); return; } r -= CVI_UK;
    if (r < CVI_UK) { transpose_item<0>((const float*)a.in[I_WUV + z], KVL, 1024, (bf16*)(ws + WS_BKV), 1024, scr, r, lane); return; } r -= CVI_UK;
    if (r < CVI_SQ) { transpose_item<0>((const float*)a.in[I_WATT + z], DM, DM, (bf16*)(ws + WS_BATT), 0, scr, r, lane); return; } r -= CVI_SQ;
    if (r < CVI_SQ) { transpose_item<0>((const float*)a.in[I_WOUT + z], DM, DM, (bf16*)(ws + WS_BOUT), 0, scr, r, lane); return; } r -= CVI_SQ;
    if (r < CVI_SQ) { transpose_item<0>((const float*)a.in[I_PG + z], DM, DM, (bf16*)(ws + WS_BPG), 0, scr, r, lane); return; } r -= CVI_SQ;
    transpose_item<0>((const float*)a.in[I_PPJ + z], DPLE, DM, (bf16*)(ws + WS_BPP), 0, scr, r, lane);
}
__device__ __forceinline__ void convert_range(const Args& a, LAS unsigned char* lds, int lo, int hi, int w, int nw, int wv) {
    int z = 0; asm volatile("" : "+s"(z));
    int tid = TIDW(wv); asm volatile("" : "+v"(tid)); const int lane = tid & 63, wave = wv;
    unsigned char* ws = (unsigned char*)a.in[I_WS + z];
    LAS float* scr = (LAS float*)(lds + RING_OFF + wave * 16384);
    for (int it = lo + w; it < hi; it += nw) convert_item(a, z, ws, scr, it, lane);
}
__device__ __forceinline__ void convert_in_tail(const Args& a, LAS unsigned char* lds, int nwg, int G, int c, int lo, int hi, int wv) {
    const int full = (nwg + G - 1) / G, nl = full * G - nwg;
    const int wave = wv;
    if (nl == 0) { convert_range(a, lds, lo, hi, c * NWAVES + wave, G * NWAVES, wv); return; }
    if (c >= G - nl) convert_range(a, lds, lo, hi, (c - (G - nl)) * NWAVES + wave, nl * NWAVES, wv);
}
__device__ __forceinline__ void p0_prologue(const Args& a, LAS unsigned char* lds, int vcu, int G, int tid, int lane, int wave) {
    int z = 0; asm volatile("" : "+s"(z));
    unsigned char* ws = (unsigned char*)a.in[I_WS + z];
    const int gw = vcu * NWAVES + wave, NGW = G * NWAVES;
    convert_range(a, lds, 0, CV_A, gw, NGW, wave);
    const int gt = vcu * 512 + tid, NGT = G * 512;
    for (int i = gt; i < 12288; i += NGT) ((u32x4*)(ws + WS_BIN + (size_t)3232 * DM * 2))[i] = (u32x4){0u, 0u, 0u, 0u};
    for (int i = gt; i < NBLK * 160 * 104; i += NGT) {
        const int n = i / (160 * 104), r = i - n * (160 * 104), j = r / 104, k = r - j * 104;
        float v = 0.f;
        if (k < 80) v = j < 80 ? ((const float*)a.in[I_LWA + z])[(n * 80 + k) * 80 + j] : ((const float*)a.in[I_LWI + z])[(n * 80 + k) * 80 + (j - 80)];
        ((bf16*)(ws + WS_LW))[i] = f2bf(v);
    }
    for (int i = gt; i < ROPE_TAB; i += NGT) {
        const int pos = i >> 4, k = i & 15;
        const double freq = exp2(-(double)k * (13.287712379549449 / 16.0));
        double rev = (double)pos * freq * 0.15915494309189535;
        rev -= floor(rev);
        const float rf = (float)rev;
        ((float*)(ws + WS_ROPE))[i] = __builtin_amdgcn_cosf(rf);
        ((float*)(ws + WS_ROPE))[ROPE_TAB + i] = __builtin_amdgcn_sinf(rf);
    }
    for (int m0 = gw; m0 < MT; m0 += 2 * NGW)
#pragma unroll
    for (int qq = 0; qq < 2; ++qq) { const int m = m0 + qq * NGW; if (m >= MT) break;
        rms_row_to_bf16(xrow_ptr(a, m, z), (const float*)a.in[I_F1PRE + z], (bf16*)(ws + WS_XN) + (size_t)m * DM, lane);
        const float* pr = m < MP ? (const float*)a.in[I_PP + z] + (size_t)m * DPLE : (m < MP + NS ? (const float*)a.in[I_PS + z] + (size_t)(m - MP) * DPLE : nullptr);
        const f32x4 v = pr ? ((const f32x4*)pr)[lane] : (f32x4){0.f, 0.f, 0.f, 0.f};
        u32x2 o; o.x = pk2(v.x, v.y); o.y = pk2(v.z, v.w);
        ((u32x2*)((bf16*)(ws + WS_PB) + (size_t)m * DPLE))[lane] = o;
    }
}

template <int NEXT, int SRC> __device__ __forceinline__ void norm_rows(const Args& a, const bf16* Fin, float coef, int i_post, int i_pre, int first, int NGW, int end, int lane) {
    int z = 0; asm volatile("" : "+s"(z));
    unsigned char* ws = (unsigned char*)a.in[I_WS + z];
    bf16* XR = (bf16*)(ws + WS_XR); bf16* XN = (bf16*)(ws + WS_XN);
    const float* post = (const float*)a.in[i_post + z]; const float* pre = (const float*)a.in[i_pre + z];
    for (int m0 = first; m0 < end; m0 += 2 * NGW) {
        f32x4 f[2][4], x[2][4]; float s[2] = {0.f, 0.f};
#pragma unroll
        for (int q = 0; q < 2; ++q) { const int m = m0 + q * NGW; const bool ok = m < end; const int mm = ok ? m : m0;
            const float* xr = SRC == 0 ? xrow_ptr(a, mm, z) : nullptr;
            const bf16* xb = (SRC == 1 ? XR : XN) + (size_t)mm * DM;
#pragma unroll
            for (int j = 0; j < 4; ++j) {
                const u32x2 w = ((const u32x2*)(Fin + (size_t)mm * DM))[lane + 64 * j];
                f[q][j] = (f32x4){bflo(w.x), bfhi(w.x), bflo(w.y), bfhi(w.y)};
                if constexpr (SRC == 0) x[q][j] = ((const f32x4*)xr)[lane + 64 * j];
                else { const u32x2 xw = ((const u32x2*)xb)[lane + 64 * j]; x[q][j] = (f32x4){bflo(xw.x), bfhi(xw.x), bflo(xw.y), bfhi(xw.y)}; }
                s[q] += (f[q][j].x * f[q][j].x + f[q][j].y * f[q][j].y) + (f[q][j].z * f[q][j].z + f[q][j].w * f[q][j].w);
            } }
#pragma unroll
        for (int q = 0; q < 2; ++q) { const int m = m0 + q * NGW; if (m >= end) break;
            const float rstd = coef / sqrtf(wave_sum(s[q]) * (1.f / DM) + EPS);
            float s2 = 0.f;
#pragma unroll
            for (int j = 0; j < 4; ++j) { const f32x4 g = ((const f32x4*)post)[lane + 64 * j]; x[q][j] = x[q][j] + f[q][j] * g * rstd; s2 += (x[q][j].x * x[q][j].x + x[q][j].y * x[q][j].y) + (x[q][j].z * x[q][j].z + x[q][j].w * x[q][j].w); }
            if constexpr (NEXT == 0) {
#pragma unroll
                for (int j = 0; j < 4; ++j) ((f32x4*)((float*)a.in[I_OUT + z] + O_Y + (size_t)m * DM))[lane + 64 * j] = x[q][j];
            } else {
                if constexpr (NEXT == 1) {
#pragma unroll
                    for (int j = 0; j < 4; ++j) { u32x2 o; o.x = pk2(x[q][j].x, x[q][j].y); o.y = pk2(x[q][j].z, x[q][j].w); ((u32x2*)(XR + (size_t)m * DM))[lane + 64 * j] = o; }
                }
                float r2 = 1.f;
                if constexpr (NEXT == 1) r2 = 1.f / sqrtf(wave_sum(s2) * (1.f / DM) + EPS);
#pragma unroll
                for (int j = 0; j < 4; ++j) {
                    f32x4 g = {1.f, 1.f, 1.f, 1.f};
                    if constexpr (NEXT == 1) g = ((const f32x4*)pre)[lane + 64 * j];
                    u32x2 o; o.x = pk2(x[q][j].x * r2 * g.x, x[q][j].y * r2 * g.y); o.y = pk2(x[q][j].z * r2 * g.z, x[q][j].w * r2 * g.w);
                    ((u32x2*)(XN + (size_t)m * DM))[lane + 64 * j] = o;
                }
            }
        }
    }
}
template <int NEXT, int SRC> __device__ __forceinline__ void sample_norm(const Args& a, unsigned* sig, const bf16* Fin, float coef, int i_post, int i_pre, int G, int vcu, int wv) {
    constexpr int npair = DM >> 5, nitem = 8 * npair;
    const int lane = lane_id();
    for (int item = vcu; item < nitem; item += G) {
        if (item % npair != 0) continue;
        const int tr = item / npair;
        if (wv == 0) { unsigned sp = 0u; while ((unsigned)__builtin_amdgcn_readfirstlane(__hip_atomic_load(sig + 64 * tr, __ATOMIC_RELAXED, __HIP_MEMORY_SCOPE_AGENT)) < (unsigned)npair) { __builtin_amdgcn_s_sleep(1); if (++sp > (1u << 20)) break; }
                       __builtin_amdgcn_fence(__ATOMIC_ACQUIRE, "agent"); asm volatile("s_waitcnt vmcnt(0)" ::: "memory"); }
        __syncthreads();
        norm_rows<NEXT, SRC>(a, Fin, coef, i_post, i_pre, MP + 16 * tr + wv, NWAVES, MP + 16 * tr + 16, lane);
    }
}

__device__ __forceinline__ void mla_prep(const Args& a, int vcu, int G, int lane, int wave) {
    int z = 0; asm volatile("" : "+s"(z));
    unsigned char* ws = (unsigned char*)a.in[I_WS + z];
    const int gw = vcu * NWAVES + wave, NGW = G * NWAVES;
    const bf16* Z = (const bf16*)(ws + WS_Z);
    const float* cosT = (const float*)(ws + WS_ROPE); const float* sinT = cosT + ROPE_TAB;
    const float* qn = (const float*)a.in[I_QNORM + z]; const float* kn = (const float*)a.in[I_KVNORM + z];
    for (int m0 = gw; m0 < MT; m0 += 4 * NGW) {
        unsigned qw[4][3]; u32x2 kw4[4]; float x1[4], x2[4], cs[4], sn4[4];
#pragma unroll
        for (int qq = 0; qq < 4; ++qq) { const int m = m0 + qq * NGW, mm = m < MT ? m : m0; const bf16* zr = Z + (size_t)mm * ZW;
#pragma unroll
            for (int j = 0; j < 3; ++j) qw[qq][j] = ((const unsigned*)(zr + Z_CQ))[lane + 64 * j];
            kw4[qq] = ((const u32x2*)(zr + Z_KV))[lane];
            const int pos = mm < MP ? (mm & (SEQ - 1)) : SEQ, l16 = lane & 15;
            x1[qq] = bf2f(zr[Z_KR + l16]); x2[qq] = bf2f(zr[Z_KR + 16 + l16]); cs[qq] = cosT[pos * 16 + l16]; sn4[qq] = sinT[pos * 16 + l16]; }
#pragma unroll
        for (int qq = 0; qq < 4; ++qq) { const int m = m0 + qq * NGW; if (m >= MT) break;
            float q[6]; float s = 0.f;
#pragma unroll
            for (int j = 0; j < 3; ++j) { const unsigned w = qw[qq][j]; q[2 * j] = bflo(w); q[2 * j + 1] = bfhi(w); s += q[2 * j] * q[2 * j] + q[2 * j + 1] * q[2 * j + 1]; }
            const float rq = __builtin_amdgcn_rsqf(wave_sum(s) * (1.f / QL) + EPS);
#pragma unroll
            for (int j = 0; j < 3; ++j) { const f32x2 g = ((const f32x2*)qn)[lane + 64 * j]; ((unsigned*)((bf16*)(ws + WS_CQ) + (size_t)m * QL))[lane + 64 * j] = pk2(q[2 * j] * rq * g.x, q[2 * j + 1] * rq * g.y); }
            const u32x2 kw = kw4[qq];
            f32x4 kv = {bflo(kw.x), bfhi(kw.x), bflo(kw.y), bfhi(kw.y)};
            const float rk = __builtin_amdgcn_rsqf(wave_sum((kv.x * kv.x + kv.y * kv.y) + (kv.z * kv.z + kv.w * kv.w)) * (1.f / KVL) + EPS);
            kv = kv * rk * ((const f32x4*)kn)[lane];
            { u32x2 o; o.x = pk2(kv.x, kv.y); o.y = pk2(kv.z, kv.w); ((u32x2*)((bf16*)(ws + WS_CKV) + (size_t)m * KVL))[lane] = o; }
            if (m < MP) ((f32x4*)((float*)a.in[I_OUT + z] + O_CKV_P + (size_t)m * KVL))[lane] = kv;
            else if (m < MP + NS) ((f32x4*)((float*)a.in[I_OUT + z] + O_CKV_S + (size_t)(m - MP) * KVL))[lane] = kv;
            if (lane < 16) {
                const float o1 = x1[qq] * cs[qq] - x2[qq] * sn4[qq], o2 = x1[qq] * sn4[qq] + x2[qq] * cs[qq];
                bf16* kr = (bf16*)(ws + WS_KR) + (size_t)m * ROPE;
                kr[lane] = f2bf(o1); kr[16 + lane] = f2bf(o2);
                float* ko = m < MP ? (float*)a.in[I_OUT + z] + O_KR_P + (size_t)m * ROPE : (m < MP + NS ? (float*)a.in[I_OUT + z] + O_KR_S + (size_t)(m - MP) * ROPE : nullptr);
                if (ko) { ko[lane] = o1; ko[16 + lane] = o2; }
            }
        }
    }
    { const float* scv = (const float*)a.in[I_SCONV + z]; float* co = (float*)a.in[I_OUT + z] + O_CONV_S;
      for (int it = gw; it < NS * 3 * (DRNN / 64); it += NGW) { const int sq = it / 60, r = it - 60 * sq, j = r / 20, idx = (r - 20 * j) * 64 + lane;
          co[(size_t)(sq * 3 + j) * DRNN + idx] = j < 2 ? scv[(size_t)(sq * 3 + j + 1) * DRNN + idx] : bf2f(Z[(size_t)(MP + sq) * ZW + Z_XR + idx]); } }
}


constexpr int L2_LW = 0, L2_CW = 33280, L2_TILE = 35328, L2_TPITCH = 84, L2_TBYTES = 16 * L2_TPITCH * 4, L2_WAVE = 2 * L2_TBYTES;
static_assert(L2_TILE + 8 * L2_WAVE <= RING_BYTES, "RG-LRU LDS map");
__device__ __forceinline__ float one_minus_exp(float x) {
    const float t = x * (1.f + x * (0.5f + x * (0.16666667f + x * 0.041666668f)));
    float e = 1.f - __builtin_amdgcn_exp2f(x * 1.4426950408889634f); asm volatile("" : "+v"(e));
    return x > -0.06f ? -t : e;
}
__device__ __forceinline__ void row4(float v, float (&out)[4]) {
    const unsigned u = __float_as_uint(v);
    const auto h = __builtin_amdgcn_permlane32_swap(u, u, false, false);
    const auto lo = __builtin_amdgcn_permlane16_swap(h[0], h[0], false, false);
    const auto hi = __builtin_amdgcn_permlane16_swap(h[1], h[1], false, false);
    out[0] = __uint_as_float(lo[0]); out[1] = __uint_as_float(lo[1]); out[2] = __uint_as_float(hi[0]); out[3] = __uint_as_float(hi[1]);
}
template <int PASS> __device__ __forceinline__ void lru_load(const bf16* Z, int ch0, int row0, int tib0, int l15, int g4, u32x4 (&zw)[3][5]) {
#pragma unroll
    for (int j = 0; j < 3; ++j) { const int cb = 32 * j + 8 * g4;
#pragma unroll
        for (int t = 0; t < 4; ++t) { u32x4 w = {0u, 0u, 0u, 0u}; if (tib0 + l15 + t - 3 >= 0) w = *(const u32x4*)(Z + (size_t)(row0 + l15 + t - 3) * ZW + Z_XR + ch0 + cb); zw[j][t] = w; }
        if (PASS == 2) { u32x4 w = {0u, 0u, 0u, 0u}; if (cb < 80) w = *(const u32x4*)(Z + (size_t)(row0 + l15) * ZW + Z_YR + ch0 + cb); zw[j][4] = w; }
    }
}
template <int PASS, bool SAMP> __device__ __forceinline__ void lru_tile(const Args& a, int z, unsigned char* ws, LAS unsigned char* lds, int n, int row0, int tib0, int lane, int wave,
                                                                        const float (&gba)[5], const float (&gbi)[5], const float (&gsp)[5], float (&carry)[5], float (&aprod)[5], const u32x4 (&zw)[3][5]) {
    const bf16* Z = (const bf16*)(ws + WS_Z);
    const int l15 = lane & 15, g4 = lane >> 4, ch0 = n * BLK;
    LAS float* xt = (LAS float*)(lds + L2_TILE + wave * L2_WAVE); LAS float* ht = xt + 16 * L2_TPITCH;
    const LAS float* cwl = (const LAS float*)(lds + L2_CW);
    bf16x8 af[3];
#pragma unroll
    for (int j = 0; j < 3; ++j) {
        const int cb = 32 * j + 8 * g4;
        float xc[8];
        { const f32x4 b0 = *(const LAS f32x4*)(cwl + 4 * 96 + cb), b1 = *(const LAS f32x4*)(cwl + 4 * 96 + cb + 4); xc[0] = b0.x; xc[1] = b0.y; xc[2] = b0.z; xc[3] = b0.w; xc[4] = b1.x; xc[5] = b1.y; xc[6] = b1.z; xc[7] = b1.w; }
#pragma unroll
        for (int t = 0; t < 4; ++t) {
            float xv[8];
            if (SAMP && t < 3) {
                const float* sp = (const float*)a.in[I_SCONV + z] + (size_t)((row0 - MP + l15) * 3 + t) * DRNN + ch0 + cb;
                if (cb < 80) { const f32x4 v0 = *(const f32x4*)sp, v1 = *(const f32x4*)(sp + 4); xv[0] = v0.x; xv[1] = v0.y; xv[2] = v0.z; xv[3] = v0.w; xv[4] = v1.x; xv[5] = v1.y; xv[6] = v1.z; xv[7] = v1.w; }
                else { for (int e = 0; e < 8; ++e) xv[e] = 0.f; }
            } else {
                u32x4 w;
                if constexpr (SAMP) w = *(const u32x4*)(Z + (size_t)(row0 + l15) * ZW + Z_XR + ch0 + cb); else w = zw[j][t];
                xv[0] = bflo(w.x); xv[1] = bfhi(w.x); xv[2] = bflo(w.y); xv[3] = bfhi(w.y); xv[4] = bflo(w.z); xv[5] = bfhi(w.z); xv[6] = bflo(w.w); xv[7] = bfhi(w.w);
            }
            const f32x4 w0 = *(const LAS f32x4*)(cwl + t * 96 + cb), w1 = *(const LAS f32x4*)(cwl + t * 96 + cb + 4);
            xc[0] += w0.x * xv[0]; xc[1] += w0.y * xv[1]; xc[2] += w0.z * xv[2]; xc[3] += w0.w * xv[3]; xc[4] += w1.x * xv[4]; xc[5] += w1.y * xv[5]; xc[6] += w1.z * xv[6]; xc[7] += w1.w * xv[7];
        }
        u32x4 pw; pw.x = pk2(xc[0], xc[1]); pw.y = pk2(xc[2], xc[3]); pw.z = pk2(xc[4], xc[5]); pw.w = pk2(xc[6], xc[7]);
        af[j] = __builtin_bit_cast(bf16x8, pw);
        if (cb < 80) { *(LAS f32x4*)(xt + l15 * L2_TPITCH + cb) = (f32x4){xc[0], xc[1], xc[2], xc[3]}; *(LAS f32x4*)(xt + l15 * L2_TPITCH + cb + 4) = (f32x4){xc[4], xc[5], xc[6], xc[7]}; }
    }
    LDS_WAIT();
#pragma unroll
    for (int ct = 0; ct < 5; ++ct) {
        f32x4 ar = {0.f, 0.f, 0.f, 0.f}, ai = {0.f, 0.f, 0.f, 0.f};
#pragma unroll
        for (int j = 0; j < 3; ++j) {
            const bf16x8 br = *(const LAS bf16x8*)(lds + L2_LW + (ct * 16 + l15) * 208 + (32 * j + 8 * g4) * 2);
            const bf16x8 bi = *(const LAS bf16x8*)(lds + L2_LW + (80 + ct * 16 + l15) * 208 + (32 * j + 8 * g4) * 2);
            ar = __builtin_amdgcn_mfma_f32_16x16x32_bf16(af[j], br, ar, 0, 0, 0);
            ai = __builtin_amdgcn_mfma_f32_16x16x32_bf16(af[j], bi, ai, 0, 0, 0);
        }
        const int ch = ct * 16 + l15;
        float av[4], bv[4];
#pragma unroll
        for (int i = 0; i < 4; ++i) {
            const float r = sigmoid_f(ar[i] + gba[ct]), gi = sigmoid_f(ai[i] + gbi[ct]);
            const float la = -8.f * r * gsp[ct];
            av[i] = __builtin_amdgcn_exp2f(la * 1.4426950408889634f);
            bv[i] = __builtin_amdgcn_sqrtf((1.f - av[i]) * (1.f + av[i])) * gi * xt[(4 * g4 + i) * L2_TPITCH + ch];
        }
        float hv[4];
        if constexpr (SAMP) {
            const float* sh = (const float*)a.in[I_SH + z];
#pragma unroll
            for (int i = 0; i < 4; ++i) { const int s = row0 - MP + 4 * g4 + i; hv[i] = av[i] * sh[(size_t)s * DRNN + ch0 + ch] + bv[i]; ((float*)a.in[I_OUT + z])[O_H_S + (size_t)s * DRNN + ch0 + ch] = hv[i]; }
        } else {
            float q[4]; float hl = 0.f, qq = 1.f;
#pragma unroll
            for (int i = 0; i < 4; ++i) { hl = av[i] * hl + bv[i]; qq *= av[i]; hv[i] = hl; q[i] = qq; }
            float cin = carry[ct], call = carry[ct], pall = 1.f;
            float Pq[4], Hq[4];
            row4(qq, Pq); row4(hl, Hq);
#pragma unroll
            for (int gq = 0; gq < 4; ++gq) { const float Pg = Pq[gq], Hg = Hq[gq];
                if (gq < g4) cin = Pg * cin + Hg;
                call = Pg * call + Hg; pall *= Pg; }
#pragma unroll
            for (int i = 0; i < 4; ++i) hv[i] += q[i] * cin;
            carry[ct] = call; aprod[ct] *= pall;
        }
        if constexpr (PASS == 2) {
#pragma unroll
            for (int i = 0; i < 4; ++i) ht[(4 * g4 + i) * L2_TPITCH + ch] = hv[i];
        }
    }
    if constexpr (PASS == 2) {
        LDS_WAIT();
#pragma unroll
        for (int j = 0; j < 3; ++j) { const int cb = 32 * j + 8 * g4;
            if (cb < 80) {
                const f32x4 h0 = *(const LAS f32x4*)(ht + l15 * L2_TPITCH + cb), h1 = *(const LAS f32x4*)(ht + l15 * L2_TPITCH + cb + 4);
                u32x4 y; if constexpr (SAMP) y = *(const u32x4*)(Z + (size_t)(row0 + l15) * ZW + Z_YR + ch0 + cb); else y = zw[j][4];
                u32x4 o; o.x = pk2(h0.x * bflo(y.x), h0.y * bfhi(y.x)); o.y = pk2(h0.z * bflo(y.y), h0.w * bfhi(y.y)); o.z = pk2(h1.x * bflo(y.z), h1.y * bfhi(y.z)); o.w = pk2(h1.z * bflo(y.w), h1.w * bfhi(y.w));
                *(u32x4*)((bf16*)(ws + WS_HG) + (size_t)(row0 + l15) * DRNN + ch0 + cb) = o;
            }
        }
    }
    LDS_WAIT();
}
template <int PASS> __device__ __forceinline__ void lru_cu_unit(const Args& a, LAS unsigned char* lds, int u, int wave) {
    int z = 0; asm volatile("" : "+s"(z));
    int lane_ = lane_id(); asm volatile("" : "+v"(lane_)); const int lane = lane_, l15 = lane & 15;
    unsigned char* ws = (unsigned char*)a.in[I_WS + z];
    const int n = u & 15, ch0 = n * BLK, cidx = 8 * (u >> 4) + wave;
    __syncthreads();
    { const u32x4* src = (const u32x4*)(ws + WS_LW + (size_t)n * 33280); LAS u32x4* dst = (LAS u32x4*)(lds + L2_LW);
      for (int i = TIDW(wave); i < 2080; i += 512) dst[i] = src[i]; }
    { const int tid = TIDW(wave); if (tid < 480) { const int t = tid / 96, c = tid - 96 * t; float v = 0.f;
        if (c < 80) v = t < 4 ? ((const float*)a.in[I_CONVW + z])[t * DRNN + ch0 + c] : ((const float*)a.in[I_CONVB + z])[ch0 + c];
        ((LAS float*)(lds + L2_CW))[tid] = v; } }
    float gba[5], gbi[5], gsp[5], carry[5], aprod[5];
#pragma unroll
    for (int ct = 0; ct < 5; ++ct) { const int cg = ch0 + ct * 16 + l15; gba[ct] = ((const float*)a.in[I_LBA + z])[cg]; gbi[ct] = ((const float*)a.in[I_LBI + z])[cg];
        gsp[ct] = log1pf(expf(-((const float*)a.in[I_LAM + z])[cg])); carry[ct] = 0.f; aprod[ct] = 1.f; }
    const bf16* Zp = (const bf16*)(ws + WS_Z);
    const int row_c = cidx * 128, tib_c = (cidx & 63) * 128, g4 = lane >> 4;
    u32x4 zwA[3][5], zwB[3][5];
    lru_load<PASS>(Zp, ch0, row_c, tib_c, l15, g4, zwA);
    if (PASS == 2) {
        const f32x2* SUM = (const f32x2*)(ws + WS_SUM);
        const int nprev = cidx & 63, base = cidx & ~63, qn = (nprev + 3) >> 2, lo = base + g4 * qn, hi = (lo + qn < base + nprev) ? lo + qn : base + nprev;
        float fa[5], fh[5];
#pragma unroll
        for (int ct = 0; ct < 5; ++ct) { fa[ct] = 1.f; fh[ct] = 0.f; }
        for (int jc = lo; jc < hi; jc += 4) {
            f32x2 sm[4][5];
#pragma unroll
            for (int k = 0; k < 4; ++k)
#pragma unroll
                for (int ct = 0; ct < 5; ++ct) sm[k][ct] = (jc + k < hi) ? SUM[(size_t)(jc + k) * DRNN + ch0 + ct * 16 + l15] : (f32x2){1.f, 0.f};
#pragma unroll
            for (int k = 0; k < 4; ++k)
#pragma unroll
                for (int ct = 0; ct < 5; ++ct) { fh[ct] = sm[k][ct].x * fh[ct] + sm[k][ct].y; fa[ct] = sm[k][ct].x * fa[ct]; }
        }
#pragma unroll
        for (int ct = 0; ct < 5; ++ct) { float c = 0.f;
            float Aq[4], Hq[4]; row4(fa[ct], Aq); row4(fh[ct], Hq);
#pragma unroll
            for (int gq = 0; gq < 4; ++gq) c = Aq[gq] * c + Hq[gq];
            carry[ct] = c; }
    }
    __syncthreads();
#pragma unroll 1
    for (int mt = 0; mt < 8; mt += 2) {
        lru_load<PASS>(Zp, ch0, row_c + 16 * (mt + 1), tib_c + 16 * (mt + 1), l15, g4, zwB);
        lru_tile<PASS, false>(a, z, ws, lds, n, row_c + 16 * mt, tib_c + 16 * mt, lane, wave, gba, gbi, gsp, carry, aprod, zwA);
        if (mt + 2 < 8) lru_load<PASS>(Zp, ch0, row_c + 16 * (mt + 2), tib_c + 16 * (mt + 2), l15, g4, zwA);
        lru_tile<PASS, false>(a, z, ws, lds, n, row_c + 16 * (mt + 1), tib_c + 16 * (mt + 1), lane, wave, gba, gbi, gsp, carry, aprod, zwB);
    }
    if (PASS == 1) { if (lane < 16) { for (int ct = 0; ct < 5; ++ct) ((f32x2*)(ws + WS_SUM))[(size_t)cidx * DRNN + ch0 + ct * 16 + l15] = (f32x2){aprod[ct], carry[ct]}; } }
    else {
        float* out = (float*)a.in[I_OUT + z];
        if ((cidx & 63) == 63) {
            const int bb = cidx >> 6;
            if (lane < 16) { for (int ct = 0; ct < 5; ++ct) out[O_H_P + (size_t)bb * DRNN + ch0 + ct * 16 + l15] = carry[ct]; }
            const bf16* Z = (const bf16*)(ws + WS_Z);
            for (int e = lane; e < 240; e += 64) { const int jj = e / 80, c = e - 80 * jj; out[O_CONV_P + (size_t)(bb * 3 + jj) * DRNN + ch0 + c] = bf2f(Z[(size_t)(bb * SEQ + SEQ - 3 + jj) * ZW + Z_XR + ch0 + c]); }
        }
        if (u < 16) {
            float c2[5], p2[5];
#pragma unroll
            for (int ct = 0; ct < 5; ++ct) { c2[ct] = 0.f; p2[ct] = 1.f; }
            lru_tile<PASS, true>(a, z, ws, lds, n, MP + 16 * wave, 0, lane, wave, gba, gbi, gsp, c2, p2, zwA);
        }
    }
}

constexpr int SA_QIMG = 0, SA_PITCH = 592, SA_KT = 16 * SA_PITCH;
constexpr int SA_SLOT = 66 * 64 * 4, SA_OLAT = 4 * SA_SLOT;
static_assert(SA_OLAT + 16 * 256 * 4 <= RING_BYTES, "decode attention LDS map");
__device__ __forceinline__ void sample_attn_half(const Args& a, LAS unsigned char* lds, int s, int half, int wv) {
    int z = 0; asm volatile("" : "+s"(z));
    int tid = TIDW(wv); asm volatile("" : "+v"(tid)); const int lane = tid & 63, wave = wv;
    unsigned char* ws = (unsigned char*)a.in[I_WS + z];
    const bf16* Qrow = (const bf16*)(ws + WS_Q) + (size_t)(MP + s) * QW;
    const bf16* BKV = (const bf16*)(ws + WS_BKV);
    __syncthreads();
    {
        LAS float* qs = (LAS float*)(lds + SA_KT);
        { const unsigned w = ((const unsigned*)Qrow)[tid]; qs[2 * tid] = bflo(w); qs[2 * tid + 1] = bfhi(w); }
        __syncthreads();
        const int r2 = (tid & 127) * 2, hg = tid >> 7;
#pragma unroll 1
        for (int hh = 0; hh < 4; ++hh) { const int hd = hg * 4 + hh; float a0 = 0.f, a1 = 0.f;
            unsigned wv_[64];
#pragma unroll
            for (int d = 0; d < 64; ++d) wv_[d] = *(const unsigned*)(BKV + (size_t)(hd * 64 + d) * KVL + r2);
#pragma unroll
            for (int d = 0; d < 64; ++d) { const float q = qs[hd * 64 + d]; a0 += q * bflo(wv_[d]); a1 += q * bfhi(wv_[d]); }
            *(LAS unsigned*)(lds + SA_QIMG + hd * SA_PITCH + r2 * 2) = pk2(a0, a1); }
        if ((tid & 31) < 16) { const int hd = tid >> 5, i = tid & 15;
          const float* cosT = (const float*)(ws + WS_ROPE); const float c = cosT[SEQ * 16 + i], sn = cosT[ROPE_TAB + SEQ * 16 + i];
          const float x1 = bf2f(Qrow[1024 + hd * 32 + i]), x2 = bf2f(Qrow[1024 + hd * 32 + 16 + i]);
          *(LAS bf16*)(lds + SA_QIMG + hd * SA_PITCH + (256 + i) * 2) = f2bf(x1 * c - x2 * sn);
          *(LAS bf16*)(lds + SA_QIMG + hd * SA_PITCH + (256 + 16 + i) * 2) = f2bf(x1 * sn + x2 * c); }
    }
    __syncthreads();
    const int g4 = lane >> 4, l15 = lane & 15;
    const LAS unsigned char* qfp = lds + SA_QIMG + l15 * SA_PITCH + 8 * g4 * 2;
    LAS unsigned char* kt = lds + SA_KT + wave * 9472;
    const unsigned ktb = (unsigned)(uintptr_t)kt;
    const int* pt = (const int*)a.in[I_PT + z] + s * NPAGES + half * 32 + wave * 4;
    const float* cckv = (const float*)a.in[I_CCKV + z]; const float* ckr = (const float*)a.in[I_CKR + z];
    float m_run = -1e30f, l_part = 0.f;
    f32x4 oacc[16];
#pragma unroll
    for (int i = 0; i < 16; ++i) oacc[i] = (f32x4){0.f, 0.f, 0.f, 0.f};
    f32x4 stA[18], stB[18];
#define SA_ISSUE(ST, tt) do { const int pid_ = pt[(tt) >> 3]; const float* kb_ = cckv + ((size_t)pid_ * PAGE + ((tt) & 7) * 16) * KVL; const float* rb_ = ckr + ((size_t)pid_ * PAGE + ((tt) & 7) * 16) * ROPE; \
        _Pragma("unroll") for (int i_ = 0; i_ < 16; ++i_) ST[i_] = __builtin_nontemporal_load((const f32x4*)(kb_ + i_ * KVL) + lane); \
        ST[16] = __builtin_nontemporal_load((const f32x4*)rb_ + lane); ST[17] = __builtin_nontemporal_load((const f32x4*)rb_ + 64 + lane); } while (0)
#define SA_TOLDS(ST) do { \
        _Pragma("unroll") for (int i = 0; i < 16; ++i) { u32x2 o; o.x = pk2(ST[i].x, ST[i].y); o.y = pk2(ST[i].z, ST[i].w); *(LAS u32x2*)(kt + i * SA_PITCH + lane * 8) = o; } \
        _Pragma("unroll") for (int k = 0; k < 2; ++k) { u32x2 o; o.x = pk2(ST[16 + k].x, ST[16 + k].y); o.y = pk2(ST[16 + k].z, ST[16 + k].w); *(LAS u32x2*)(kt + (8 * k + (lane >> 3)) * SA_PITCH + (256 + 4 * (lane & 7)) * 2) = o; } } while (0)
#define SA_COMPUTE(SELF) do { \
        LDS_WAIT(); \
        f32x4 sacc = {0.f, 0.f, 0.f, 0.f}; \
        _Pragma("unroll") for (int j = 0; j < 9; ++j) { const bf16x8 kf = *(const LAS bf16x8*)(kt + l15 * SA_PITCH + (32 * j + 8 * g4) * 2); const bf16x8 qfj = *(const LAS bf16x8*)(qfp + 64 * j); sacc = __builtin_amdgcn_mfma_f32_16x16x32_bf16(kf, qfj, sacc, 0, 0, 0); } \
        if (SELF) { _Pragma("unroll") for (int i = 0; i < 4; ++i) if (4 * g4 + i >= 1) sacc[i] = -__builtin_inff(); } \
        float mx = fmaxf(fmaxf(sacc[0], sacc[1]), fmaxf(sacc[2], sacc[3])); \
        mx = fmaxf(mx, __shfl_xor(mx, 16)); mx = fmaxf(mx, __shfl_xor(mx, 32)); \
        const float mn = fmaxf(m_run, mx), alpha = __builtin_amdgcn_exp2f(m_run - mn); \
        m_run = mn; \
        const float p0 = __builtin_amdgcn_exp2f(sacc[0] - mn), p1 = __builtin_amdgcn_exp2f(sacc[1] - mn), p2 = __builtin_amdgcn_exp2f(sacc[2] - mn), p3 = __builtin_amdgcn_exp2f(sacc[3] - mn); \
        l_part = l_part * alpha + ((p0 + p1) + (p2 + p3)); \
        u32x2 pw; pw.x = pk2(p0, p1); pw.y = pk2(p2, p3); \
        const s16x4 pb = __builtin_bit_cast(s16x4, pw); \
        const unsigned vaddr = ktb + (unsigned)((4 * g4 + (l15 >> 2)) * SA_PITCH + (l15 & 3) * 8); \
        _Pragma("unroll") for (int ct = 0; ct < 16; ++ct) { \
            s16x4 vf; \
            asm volatile("ds_read_b64_tr_b16 %0, %1 offset:%2" : "=v"(vf) : "v"(vaddr), "i"(ct * 32) : "memory"); \
            asm volatile("s_waitcnt lgkmcnt(0)" ::: "memory"); \
            oacc[ct] = oacc[ct] * alpha; \
            oacc[ct] = __builtin_amdgcn_mfma_f32_16x16x16bf16_1k(vf, pb, oacc[ct], 0, 0, 0); } } while (0)
    SA_ISSUE(stA, 0); SA_ISSUE(stB, 1);
#pragma unroll 1
    for (int tt = 0; tt < 32; tt += 2) {
        if (tt + 1 < 32) asm volatile("s_waitcnt vmcnt(18)" ::: "memory"); else VM_WAIT();
        asm volatile("" : "+v"(stA[0]), "+v"(stA[1]), "+v"(stA[2]), "+v"(stA[3]), "+v"(stA[4]), "+v"(stA[5]), "+v"(stA[6]), "+v"(stA[7]), "+v"(stA[8]));
        asm volatile("" : "+v"(stA[9]), "+v"(stA[10]), "+v"(stA[11]), "+v"(stA[12]), "+v"(stA[13]), "+v"(stA[14]), "+v"(stA[15]), "+v"(stA[16]), "+v"(stA[17]));
        SA_TOLDS(stA);
        if (tt + 2 < 32) SA_ISSUE(stA, tt + 2);
        SA_COMPUTE(false);
        if (tt + 2 < 32) asm volatile("s_waitcnt vmcnt(18)" ::: "memory"); else VM_WAIT();
        asm volatile("" : "+v"(stB[0]), "+v"(stB[1]), "+v"(stB[2]), "+v"(stB[3]), "+v"(stB[4]), "+v"(stB[5]), "+v"(stB[6]), "+v"(stB[7]), "+v"(stB[8]));
        asm volatile("" : "+v"(stB[9]), "+v"(stB[10]), "+v"(stB[11]), "+v"(stB[12]), "+v"(stB[13]), "+v"(stB[14]), "+v"(stB[15]), "+v"(stB[16]), "+v"(stB[17]));
        SA_TOLDS(stB);
        if (tt + 3 < 32) SA_ISSUE(stB, tt + 3);
        SA_COMPUTE(false);
    }
    if (half == 1 && wave == 7) {
        const bf16* ck = (const bf16*)(ws + WS_CKV) + (size_t)(MP + s) * KVL; const bf16* kr = (const bf16*)(ws + WS_KR) + (size_t)(MP + s) * ROPE;
#pragma unroll
        for (int i = 0; i < 16; ++i) { u32x2 o = {0u, 0u}; if (i == 0) o = ((const u32x2*)ck)[lane]; *(LAS u32x2*)(kt + i * SA_PITCH + lane * 8) = o; }
        if (lane < 32) { *(LAS bf16*)(kt + (256 + lane) * 2) = kr[lane]; }
        else { const int d = lane - 32; for (int i = 1; i < 16; ++i) *(LAS bf16*)(kt + i * SA_PITCH + (256 + d) * 2) = 0; }
        SA_COMPUTE(true);
    }
#undef SA_ISSUE
#undef SA_TOLDS
#undef SA_COMPUTE
    LAS float* slots = (LAS float*)lds;
#pragma unroll 1
    for (int half = 4; half >= 1; half >>= 1) {
        __syncthreads();
        if (wave >= half && wave < 2 * half) { LAS float* sl = slots + (size_t)(wave - half) * (SA_SLOT / 4);
#pragma unroll
            for (int ct = 0; ct < 16; ++ct) { sl[(4 * ct + 0) * 64 + lane] = oacc[ct][0]; sl[(4 * ct + 1) * 64 + lane] = oacc[ct][1]; sl[(4 * ct + 2) * 64 + lane] = oacc[ct][2]; sl[(4 * ct + 3) * 64 + lane] = oacc[ct][3]; }
            sl[64 * 64 + lane] = m_run; sl[65 * 64 + lane] = l_part; }
        __syncthreads();
        if (wave < half) { const LAS float* sl = slots + (size_t)wave * (SA_SLOT / 4);
            const float m2 = sl[64 * 64 + lane], l2 = sl[65 * 64 + lane];
            const float mn = fmaxf(m_run, m2), a1 = __builtin_amdgcn_exp2f(m_run - mn), a2 = __builtin_amdgcn_exp2f(m2 - mn);
            m_run = mn; l_part = a1 * l_part + a2 * l2;
#pragma unroll
            for (int ct = 0; ct < 16; ++ct) { oacc[ct][0] = a1 * oacc[ct][0] + a2 * sl[(4 * ct + 0) * 64 + lane]; oacc[ct][1] = a1 * oacc[ct][1] + a2 * sl[(4 * ct + 1) * 64 + lane];
                                             oacc[ct][2] = a1 * oacc[ct][2] + a2 * sl[(4 * ct + 2) * 64 + lane]; oacc[ct][3] = a1 * oacc[ct][3] + a2 * sl[(4 * ct + 3) * 64 + lane]; } }
    }
    if (wave == 0) {
        float* part = (float*)(ws + WS_PART) + (size_t)(s * 2 + half) * PART_STRIDE;
        float lsum = l_part; lsum += __shfl_xor(lsum, 16); lsum += __shfl_xor(lsum, 32);
#pragma unroll
        for (int ct = 0; ct < 16; ++ct) *(f32x4*)(part + l15 * 256 + ct * 16 + 4 * g4) = oacc[ct];
        if (g4 == 0) { part[4096 + l15] = m_run; part[4096 + 16 + l15] = lsum; }
    }
}
__device__ __forceinline__ void sample_attn_seq(const Args& a, LAS unsigned char* lds, int s, int wv) {
    int z = 0; asm volatile("" : "+s"(z));
    int tid = TIDW(wv); asm volatile("" : "+v"(tid)); const int lane = tid & 63, wave = wv;
    unsigned char* ws = (unsigned char*)a.in[I_WS + z];
    const bf16* Qrow = (const bf16*)(ws + WS_Q) + (size_t)(MP + s) * QW;
    const bf16* BKV = (const bf16*)(ws + WS_BKV);
    __syncthreads();
    {
        LAS float* qs = (LAS float*)(lds + SA_KT);
        { const unsigned w = ((const unsigned*)Qrow)[tid]; qs[2 * tid] = bflo(w); qs[2 * tid + 1] = bfhi(w); }
        __syncthreads();
        const int r2 = (tid & 127) * 2, hg = tid >> 7;
#pragma unroll 1
        for (int hh = 0; hh < 4; ++hh) { const int hd = hg * 4 + hh; float a0 = 0.f, a1 = 0.f;
            unsigned wv_[64];
#pragma unroll
            for (int d = 0; d < 64; ++d) wv_[d] = *(const unsigned*)(BKV + (size_t)(hd * 64 + d) * KVL + r2);
#pragma unroll
            for (int d = 0; d < 64; ++d) { const float q = qs[hd * 64 + d]; a0 += q * bflo(wv_[d]); a1 += q * bfhi(wv_[d]); }
            *(LAS unsigned*)(lds + SA_QIMG + hd * SA_PITCH + r2 * 2) = pk2(a0, a1); }
        if ((tid & 31) < 16) { const int hd = tid >> 5, i = tid & 15;
          const float* cosT = (const float*)(ws + WS_ROPE); const float c = cosT[SEQ * 16 + i], sn = cosT[ROPE_TAB + SEQ * 16 + i];
          const float x1 = bf2f(Qrow[1024 + hd * 32 + i]), x2 = bf2f(Qrow[1024 + hd * 32 + 16 + i]);
          *(LAS bf16*)(lds + SA_QIMG + hd * SA_PITCH + (256 + i) * 2) = f2bf(x1 * c - x2 * sn);
          *(LAS bf16*)(lds + SA_QIMG + hd * SA_PITCH + (256 + 16 + i) * 2) = f2bf(x1 * sn + x2 * c); }
    }
    __syncthreads();
    const int g4 = lane >> 4, l15 = lane & 15;
    const LAS unsigned char* qfp = lds + SA_QIMG + l15 * SA_PITCH + 8 * g4 * 2;
    LAS unsigned char* kt = lds + SA_KT + wave * 9472;
    const unsigned ktb = (unsigned)(uintptr_t)kt;
    const int* pt = (const int*)a.in[I_PT + z] + s * NPAGES + wave * 8;
    const float* cckv = (const float*)a.in[I_CCKV + z]; const float* ckr = (const float*)a.in[I_CKR + z];
    float m_run = -1e30f, l_part = 0.f;
    f32x4 oacc[16];
#pragma unroll
    for (int i = 0; i < 16; ++i) oacc[i] = (f32x4){0.f, 0.f, 0.f, 0.f};
    f32x4 stA[18], stB[18];
#define SA_ISSUE(ST, tt) do { const int pid_ = pt[(tt) >> 3]; const float* kb_ = cckv + ((size_t)pid_ * PAGE + ((tt) & 7) * 16) * KVL; const float* rb_ = ckr + ((size_t)pid_ * PAGE + ((tt) & 7) * 16) * ROPE; \
        _Pragma("unroll") for (int i_ = 0; i_ < 16; ++i_) ST[i_] = __builtin_nontemporal_load((const f32x4*)(kb_ + i_ * KVL) + lane); \
        ST[16] = __builtin_nontemporal_load((const f32x4*)rb_ + lane); ST[17] = __builtin_nontemporal_load((const f32x4*)rb_ + 64 + lane); } while (0)
#define SA_TOLDS(ST) do { \
        _Pragma("unroll") for (int i = 0; i < 16; ++i) { u32x2 o; o.x = pk2(ST[i].x, ST[i].y); o.y = pk2(ST[i].z, ST[i].w); *(LAS u32x2*)(kt + i * SA_PITCH + lane * 8) = o; } \
        _Pragma("unroll") for (int k = 0; k < 2; ++k) { u32x2 o; o.x = pk2(ST[16 + k].x, ST[16 + k].y); o.y = pk2(ST[16 + k].z, ST[16 + k].w); *(LAS u32x2*)(kt + (8 * k + (lane >> 3)) * SA_PITCH + (256 + 4 * (lane & 7)) * 2) = o; } } while (0)
#define SA_TR4(base_) do { \
        asm volatile("ds_read_b64_tr_b16 %0, %4 offset:%5\n\tds_read_b64_tr_b16 %1, %4 offset:%6\n\tds_read_b64_tr_b16 %2, %4 offset:%7\n\tds_read_b64_tr_b16 %3, %4 offset:%8\n\ts_waitcnt lgkmcnt(0)" \
                     : "=&v"(vf[0]), "=&v"(vf[1]), "=&v"(vf[2]), "=&v"(vf[3]) \
                     : "v"(vaddr), "i"(((base_) + 0) * 32), "i"(((base_) + 1) * 32), "i"(((base_) + 2) * 32), "i"(((base_) + 3) * 32) : "memory"); \
        _Pragma("unroll") for (int c_ = 0; c_ < 4; ++c_) oacc[(base_) + c_] = __builtin_amdgcn_mfma_f32_16x16x16bf16_1k(vf[c_], pb, oacc[(base_) + c_], 0, 0, 0); } while (0)
#define SA_COMPUTE(SELF) do { \
        LDS_WAIT(); \
        f32x4 sacc = {0.f, 0.f, 0.f, 0.f}; \
        _Pragma("unroll") for (int j = 0; j < 9; ++j) { const bf16x8 kf = *(const LAS bf16x8*)(kt + l15 * SA_PITCH + (32 * j + 8 * g4) * 2); const bf16x8 qfj = *(const LAS bf16x8*)(qfp + 64 * j); sacc = __builtin_amdgcn_mfma_f32_16x16x32_bf16(kf, qfj, sacc, 0, 0, 0); } \
        if (SELF) { _Pragma("unroll") for (int i = 0; i < 4; ++i) if (4 * g4 + i >= 1) sacc[i] = -__builtin_inff(); } \
        float mx = fmaxf(fmaxf(sacc[0], sacc[1]), fmaxf(sacc[2], sacc[3])); \
        { auto r_ = __builtin_amdgcn_permlane16_swap(__float_as_uint(mx), __float_as_uint(mx), false, false); mx = fmaxf(__uint_as_float(r_[0]), __uint_as_float(r_[1])); } \
        { auto r_ = __builtin_amdgcn_permlane32_swap(__float_as_uint(mx), __float_as_uint(mx), false, false); mx = fmaxf(__uint_as_float(r_[0]), __uint_as_float(r_[1])); } \
        if (__builtin_expect(__any(mx > m_run + 8.f), 0)) { const float mn = fmaxf(m_run, mx), alpha = __builtin_amdgcn_exp2f(m_run - mn); m_run = mn; l_part *= alpha; \
            _Pragma("unroll") for (int ct = 0; ct < 16; ++ct) oacc[ct] = oacc[ct] * alpha; } \
        const float p0 = __builtin_amdgcn_exp2f(sacc[0] - m_run), p1 = __builtin_amdgcn_exp2f(sacc[1] - m_run), p2 = __builtin_amdgcn_exp2f(sacc[2] - m_run), p3 = __builtin_amdgcn_exp2f(sacc[3] - m_run); \
        l_part += (p0 + p1) + (p2 + p3); \
        u32x2 pw; pw.x = pk2(p0, p1); pw.y = pk2(p2, p3); \
        const s16x4 pb = __builtin_bit_cast(s16x4, pw); \
        const unsigned vaddr = ktb + (unsigned)((4 * g4 + (l15 >> 2)) * SA_PITCH + (l15 & 3) * 8); \
        s16x4 vf[4]; SA_TR4(0); SA_TR4(4); SA_TR4(8); SA_TR4(12); } while (0)
    SA_ISSUE(stA, 0); SA_ISSUE(stB, 1);
#pragma unroll 1
    for (int tt = 0; tt < 64; tt += 2) {
        if (tt + 1 < 64) asm volatile("s_waitcnt vmcnt(18)" ::: "memory"); else VM_WAIT();
        asm volatile("" : "+v"(stA[0]), "+v"(stA[1]), "+v"(stA[2]), "+v"(stA[3]), "+v"(stA[4]), "+v"(stA[5]), "+v"(stA[6]), "+v"(stA[7]), "+v"(stA[8]));
        asm volatile("" : "+v"(stA[9]), "+v"(stA[10]), "+v"(stA[11]), "+v"(stA[12]), "+v"(stA[13]), "+v"(stA[14]), "+v"(stA[15]), "+v"(stA[16]), "+v"(stA[17]));
        SA_TOLDS(stA);
        if (tt + 2 < 64) SA_ISSUE(stA, tt + 2);
        SA_COMPUTE(false);
        if (tt + 2 < 64) asm volatile("s_waitcnt vmcnt(18)" ::: "memory"); else VM_WAIT();
        asm volatile("" : "+v"(stB[0]), "+v"(stB[1]), "+v"(stB[2]), "+v"(stB[3]), "+v"(stB[4]), "+v"(stB[5]), "+v"(stB[6]), "+v"(stB[7]), "+v"(stB[8]));
        asm volatile("" : "+v"(stB[9]), "+v"(stB[10]), "+v"(stB[11]), "+v"(stB[12]), "+v"(stB[13]), "+v"(stB[14]), "+v"(stB[15]), "+v"(stB[16]), "+v"(stB[17]));
        SA_TOLDS(stB);
        if (tt + 3 < 64) SA_ISSUE(stB, tt + 3);
        SA_COMPUTE(false);
    }
    if (wave == 7) {
        const bf16* ck = (const bf16*)(ws + WS_CKV) + (size_t)(MP + s) * KVL; const bf16* kr = (const bf16*)(ws + WS_KR) + (size_t)(MP + s) * ROPE;
#pragma unroll
        for (int i = 0; i < 16; ++i) { u32x2 o = {0u, 0u}; if (i == 0) o = ((const u32x2*)ck)[lane]; *(LAS u32x2*)(kt + i * SA_PITCH + lane * 8) = o; }
        if (lane < 32) { *(LAS bf16*)(kt + (256 + lane) * 2) = kr[lane]; }
        else { const int d = lane - 32; for (int i = 1; i < 16; ++i) *(LAS bf16*)(kt + i * SA_PITCH + (256 + d) * 2) = 0; }
        SA_COMPUTE(true);
    }
#undef SA_ISSUE
#undef SA_TOLDS
#undef SA_COMPUTE
#undef SA_TR4
    LAS float* slots = (LAS float*)lds;
#pragma unroll 1
    for (int half = 4; half >= 1; half >>= 1) {
        __syncthreads();
        if (wave >= half && wave < 2 * half) { LAS float* sl = slots + (size_t)(wave - half) * (SA_SLOT / 4);
#pragma unroll
            for (int ct = 0; ct < 16; ++ct) { sl[(4 * ct + 0) * 64 + lane] = oacc[ct][0]; sl[(4 * ct + 1) * 64 + lane] = oacc[ct][1]; sl[(4 * ct + 2) * 64 + lane] = oacc[ct][2]; sl[(4 * ct + 3) * 64 + lane] = oacc[ct][3]; }
            sl[64 * 64 + lane] = m_run; sl[65 * 64 + lane] = l_part; }
        __syncthreads();
        if (wave < half) { const LAS float* sl = slots + (size_t)wave * (SA_SLOT / 4);
            const float m2 = sl[64 * 64 + lane], l2 = sl[65 * 64 + lane];
            const float mn = fmaxf(m_run, m2), a1 = __builtin_amdgcn_exp2f(m_run - mn), a2 = __builtin_amdgcn_exp2f(m2 - mn);
            m_run = mn; l_part = a1 * l_part + a2 * l2;
#pragma unroll
            for (int ct = 0; ct < 16; ++ct) { oacc[ct][0] = a1 * oacc[ct][0] + a2 * sl[(4 * ct + 0) * 64 + lane]; oacc[ct][1] = a1 * oacc[ct][1] + a2 * sl[(4 * ct + 1) * 64 + lane];
                                             oacc[ct][2] = a1 * oacc[ct][2] + a2 * sl[(4 * ct + 2) * 64 + lane]; oacc[ct][3] = a1 * oacc[ct][3] + a2 * sl[(4 * ct + 3) * 64 + lane]; } }
    }
    LAS float* olat = (LAS float*)(lds + SA_OLAT);
    if (wave == 0) {
        float lsum = l_part; lsum += __shfl_xor(lsum, 16); lsum += __shfl_xor(lsum, 32);
        const float il = 1.f / lsum;
#pragma unroll
        for (int ct = 0; ct < 16; ++ct) *(LAS f32x4*)(olat + l15 * 256 + ct * 16 + 4 * g4) = oacc[ct] * il;
    }
    __syncthreads();
    {
        const int hd = tid >> 5, v0 = (tid & 31) * 2;
        const bf16* B = BKV + (size_t)(1024 + hd * 64 + v0) * KVL;
        float a0 = 0.f, a1 = 0.f;
#pragma unroll 8
        for (int r = 0; r < 256; r += 8) { const u32x4 w0 = *(const u32x4*)(B + r), w1 = *(const u32x4*)(B + KVL + r);
            const f32x4 x0 = *(const LAS f32x4*)(olat + hd * 256 + r), x1 = *(const LAS f32x4*)(olat + hd * 256 + r + 4);
            a0 += x0.x * bflo(w0.x) + x0.y * bfhi(w0.x) + x0.z * bflo(w0.y) + x0.w * bfhi(w0.y) + x1.x * bflo(w0.z) + x1.y * bfhi(w0.z) + x1.z * bflo(w0.w) + x1.w * bfhi(w0.w);
            a1 += x0.x * bflo(w1.x) + x0.y * bfhi(w1.x) + x0.z * bflo(w1.y) + x0.w * bfhi(w1.y) + x1.x * bflo(w1.z) + x1.y * bfhi(w1.z) + x1.z * bflo(w1.w) + x1.w * bfhi(w1.w); }
        *(unsigned*)((bf16*)(ws + WS_OB) + (size_t)(MP + s) * DM + hd * 64 + v0) = pk2(a0, a1);
    }
}
__device__ __forceinline__ void sample_combine(const Args& a, LAS unsigned char* lds, int s, int wv) {
    int z = 0; asm volatile("" : "+s"(z));
    int tid = TIDW(wv); asm volatile("" : "+v"(tid));
    unsigned char* ws = (unsigned char*)a.in[I_WS + z];
    const float* part = (const float*)(ws + WS_PART) + (size_t)s * 2 * PART_STRIDE;
    LAS float* olat = (LAS float*)lds;
    __syncthreads();
    {
        const int hd = tid >> 5, cg = (tid & 31) * 8;
        const float m0 = part[4096 + hd], m1 = part[PART_STRIDE + 4096 + hd], mmax = fmaxf(m0, m1);
        const float w0 = __builtin_amdgcn_exp2f(m0 - mmax), w1 = __builtin_amdgcn_exp2f(m1 - mmax);
        const float il = 1.f / (w0 * part[4096 + 16 + hd] + w1 * part[PART_STRIDE + 4096 + 16 + hd]);
        const f32x4 o0 = (*(const f32x4*)(part + hd * 256 + cg) * w0 + *(const f32x4*)(part + PART_STRIDE + hd * 256 + cg) * w1) * il;
        const f32x4 o1 = (*(const f32x4*)(part + hd * 256 + cg + 4) * w0 + *(const f32x4*)(part + PART_STRIDE + hd * 256 + cg + 4) * w1) * il;
        *(LAS f32x4*)(olat + hd * 256 + cg) = o0; *(LAS f32x4*)(olat + hd * 256 + cg + 4) = o1;
    }
    __syncthreads();
    {
        const int hd = tid >> 5, v0 = (tid & 31) * 2;
        const bf16* B = (const bf16*)(ws + WS_BKV) + (size_t)(1024 + hd * 64 + v0) * KVL;
        float a0 = 0.f, a1 = 0.f;
#pragma unroll 8
        for (int r = 0; r < 256; r += 8) { const u32x4 w0 = *(const u32x4*)(B + r), w1 = *(const u32x4*)(B + KVL + r);
            const f32x4 x0 = *(const LAS f32x4*)(olat + hd * 256 + r), x1 = *(const LAS f32x4*)(olat + hd * 256 + r + 4);
            a0 += x0.x * bflo(w0.x) + x0.y * bfhi(w0.x) + x0.z * bflo(w0.y) + x0.w * bfhi(w0.y) + x1.x * bflo(w0.z) + x1.y * bfhi(w0.z) + x1.z * bflo(w0.w) + x1.w * bfhi(w0.w);
            a1 += x0.x * bflo(w1.x) + x0.y * bfhi(w1.x) + x0.z * bflo(w1.y) + x0.w * bfhi(w1.y) + x1.x * bflo(w1.z) + x1.y * bfhi(w1.z) + x1.z * bflo(w1.w) + x1.w * bfhi(w1.w); }
        *(unsigned*)((bf16*)(ws + WS_OB) + (size_t)(MP + s) * DM + hd * 64 + v0) = pk2(a0, a1);
    }
}

namespace pattn4 {
constexpr int NKS = 4, NVS = 4, KSLOT = 12288, VSLOT = 8192;
constexpr int LDS_K = 0, LDS_V = NKS * KSLOT, LDS_WS = LDS_V + NVS * VSLOT, LDS_OST = LDS_WS + 8 * 256, LDS_TOTAL = LDS_OST + 8 * 4096;
static_assert(LDS_TOTAL <= RING_BYTES, "attention LDS map");
constexpr float THR = 8.f;
#define SBAR() __builtin_amdgcn_sched_barrier(0)
#define SGB(mask, n) __builtin_amdgcn_sched_group_barrier(mask, n, 0)
#define WAIT_BAR(N) do { if constexpr (VAR & 4) asm volatile("s_waitcnt vmcnt(" #N ") lgkmcnt(0)" ::: "memory"); else asm volatile("s_waitcnt vmcnt(" #N ") lgkmcnt(0)\n\ts_barrier" ::: "memory"); } while (0)
__device__ __forceinline__ int crow(int r, int hi) { return (r & 3) + 8 * (r >> 2) + 4 * hi; }
__device__ __forceinline__ void mask_tile(f32x16& p0, f32x16& p1, int dq) {
    const float NEG = -__builtin_inff();
#pragma unroll
    for (int r = 0; r < 16; ++r) { const int c = (r & 3) + 8 * (r >> 2); if (dq - c < 0) p0[r] = NEG; if (dq - c - 32 < 0) p1[r] = NEG; }
}
template <int VAR> __device__ __forceinline__ void block(const bf16* Q, const bf16* KVB, const bf16* KR, const float* cosT, bf16* OB, LAS unsigned char* lds, int b, int h, int qb, int t0, int wv,
                                                   bool primed, bool has_next, int nb_, int nh_, int nqb_, bf16x8 (&qr)[6]) {
    int tid = TIDW(wv); asm volatile("" : "+v"(tid));
    const int wid = wv, lane = tid & 63, r32 = lane & 31, hi = lane >> 5;
    const int NT = 4 * (qb + 1);
    const int P0 = qb * 256, qlo = P0 + wid * 32, qm = qlo + r32 - 4 * hi;
    LAS float* wsf = (LAS float*)(lds + LDS_WS) + wid * 64; LAS float* li_l = wsf; LAS float* al_l = wsf + 32;
    const size_t rowbase = (size_t)b * SEQ;
    const bf16* ksrc = KVB + (rowbase + (wid & 3) * 16 + (lane & 15)) * KVW + h * 64 + ((wid >> 2) * 4 + (lane >> 4)) * 8;
    const bf16* rsrc = KR + (rowbase + (wid & 3) * 16 + (lane & 15)) * ROPE + (lane >> 4) * 8;
    const bf16* vsrc = KVB + (rowbase + 16 * (wid & 3) + (lane >> 2)) * KVW + 1024 + h * 64 + (wid >> 2) * 32 + (lane & 3) * 8;
    LAS unsigned char* kdst = lds + LDS_K + (wid & 3) * 3072 + (wid >> 2) * 1024; LAS unsigned char* rdst = lds + LDS_K + (wid & 3) * 3072 + 2048; LAS unsigned char* vdst = lds + LDS_V + wid * 1024;
#define TT(i_) (((i_) + t0 < NT) ? (i_) + t0 : (i_) + t0 - NT)
#define DMA_K(t, slot) do { if constexpr ((VAR & 16) != 0) break; __builtin_amdgcn_global_load_lds((const unsigned*)(ksrc + (size_t)TT(t) * 64 * KVW), (LAS unsigned*)(kdst + (slot) * KSLOT), 16, 0, 0); \
                            __builtin_amdgcn_global_load_lds((const unsigned*)(rsrc + (size_t)TT(t) * 64 * ROPE), (LAS unsigned*)(rdst + (slot) * KSLOT), 16, 0, 0); } while (0)
#define DMA_V(t, slot) do { if constexpr ((VAR & 16) == 0) __builtin_amdgcn_global_load_lds((const unsigned*)(vsrc + (size_t)TT(t) * 64 * KVW), (LAS unsigned*)(vdst + (slot) * VSLOT), 16, 0, 0); } while (0)
    const LAS unsigned char* kb0 = lds + LDS_K + (r32 >> 4) * 3072 + (r32 & 15) * 16 + hi * 256;
    const int vb0 = (int)(uintptr_t)(lds + LDS_V) + ((lane >> 4) & 1) * 32 + (lane & 3) * 8 + (4 * hi + ((lane & 15) >> 2)) * 64;
    float m_reg = 0.f, l_reg = 0.f; f32x16 o[2] = {}; f32x16 negm = f32x16{};
#define PRIME(bb_, hh_, qq_) do { const size_t rb_ = (size_t)(bb_) * SEQ; \
        const bf16* ks_ = KVB + (rb_ + (wid & 3) * 16 + (lane & 15)) * KVW + (hh_) * 64 + ((wid >> 2) * 4 + (lane >> 4)) * 8; \
        const bf16* rs_ = KR + (rb_ + (wid & 3) * 16 + (lane & 15)) * ROPE + (lane >> 4) * 8; \
        const bf16* vs_ = KVB + (rb_ + 16 * (wid & 3) + (lane >> 2)) * KVW + 1024 + (hh_) * 64 + (wid >> 2) * 32 + (lane & 3) * 8; \
        if constexpr ((VAR & 16) == 0) { _Pragma("unroll") for (int t_ = 0; t_ < 3; ++t_) { \
            __builtin_amdgcn_global_load_lds((const unsigned*)(ks_ + (size_t)t_ * 64 * KVW), (LAS unsigned*)(kdst + t_ * KSLOT), 16, 0, 0); \
            __builtin_amdgcn_global_load_lds((const unsigned*)(rs_ + (size_t)t_ * 64 * ROPE), (LAS unsigned*)(rdst + t_ * KSLOT), 16, 0, 0); \
            if (t_ < 2) __builtin_amdgcn_global_load_lds((const unsigned*)(vs_ + (size_t)t_ * 64 * KVW), (LAS unsigned*)(vdst + t_ * VSLOT), 16, 0, 0); } } \
        const bf16* qrow_ = Q + (rb_ + (qq_) * 256 + wid * 32 + r32) * QW; \
        _Pragma("unroll") for (int d0 = 0; d0 < 4; ++d0) qr[d0] = *(const bf16x8*)(qrow_ + (hh_) * 64 + d0 * 16 + hi * 8); \
        _Pragma("unroll") for (int d0 = 4; d0 < 6; ++d0) qr[d0] = *(const bf16x8*)(qrow_ + 1024 + (hh_) * 32 + (d0 - 4) * 16 + hi * 8); } while (0)
    if (!primed) PRIME(b, h, qb);
    bf16x8 kf[12];
#define KLOAD(slot) do { const LAS unsigned char* kb_ = kb0 + (slot) * KSLOT; _Pragma("unroll") for (int d0 = 0; d0 < 6; ++d0) { kf[2 * d0] = *(const LAS bf16x8*)(kb_ + d0 * 512); kf[2 * d0 + 1] = *(const LAS bf16x8*)(kb_ + d0 * 512 + 6144); } } while (0)
#define QK(P0_, P1_) do { if constexpr ((VAR & 32) != 0) { P0_ = negm; P1_ = negm; P0_[0] += __builtin_bit_cast(float, (int)kf[0][0] + (int)kf[11][1]); } else if constexpr ((VAR & 2) != 0) { P0_ = negm; P1_ = negm; _Pragma("unroll") for (int d0 = 0; d0 < 12; ++d0) { P0_[d0] += (float)kf[d0][0]; P1_[d0] += (float)kf[d0][1]; } } else { P0_ = __builtin_amdgcn_mfma_f32_32x32x16_bf16(kf[0], qr[0], negm, 0, 0, 0); P1_ = __builtin_amdgcn_mfma_f32_32x32x16_bf16(kf[1], qr[0], negm, 0, 0, 0); \
        _Pragma("unroll") for (int d0 = 1; d0 < 6; ++d0) { P0_ = __builtin_amdgcn_mfma_f32_32x32x16_bf16(kf[2 * d0], qr[d0], P0_, 0, 0, 0); P1_ = __builtin_amdgcn_mfma_f32_32x32x16_bf16(kf[2 * d0 + 1], qr[d0], P1_, 0, 0, 0); } } } while (0)
#define RESC(al) do { if (__any((al) < 1.f)) { if (hi == 0) al_l[r32] = (al); asm volatile("s_waitcnt lgkmcnt(0)" ::: "memory"); \
        _Pragma("unroll") for (int d_ = 0; d_ < 2; ++d_) _Pragma("unroll") for (int r = 0; r < 16; ++r) o[d_][r] *= al_l[crow(r, hi)]; } } while (0)
#define MASKT(P0_, P1_, t) do { const int kbm_ = TT(t) * 64; if (kbm_ + 63 > qlo) mask_tile(P0_, P1_, qm - kbm_); } while (0)
#define ROWMAX(P0_, P1_, pm_) do { float m0_ = fmaxf(P0_[0], P1_[0]), m1_ = fmaxf(P0_[1], P1_[1]), m2_ = fmaxf(P0_[2], P1_[2]), m3_ = fmaxf(P0_[3], P1_[3]); \
        _Pragma("unroll") for (int r = 4; r < 16; r += 4) { m0_ = fmaxf(fmaxf(m0_, P0_[r]), P1_[r]); m1_ = fmaxf(fmaxf(m1_, P0_[r + 1]), P1_[r + 1]); m2_ = fmaxf(fmaxf(m2_, P0_[r + 2]), P1_[r + 2]); m3_ = fmaxf(fmaxf(m3_, P0_[r + 3]), P1_[r + 3]); } \
        pm_ = fmaxf(fmaxf(m0_, m1_), fmaxf(m2_, m3_)); \
        auto rr_ = __builtin_amdgcn_permlane32_swap(__float_as_uint(pm_), __float_as_uint(pm_), false, false); pm_ = fmaxf(__uint_as_float(rr_[0]), __uint_as_float(rr_[1])); } while (0)
#define SHIFT(P0_, P1_, dl_) do { m_reg += (dl_); _Pragma("unroll") for (int r = 0; r < 16; ++r) { P0_[r] -= (dl_); P1_[r] -= (dl_); } _Pragma("unroll") for (int r = 0; r < 16; ++r) negm[r] = -m_reg; } while (0)
#define EXP16(P_) do { if constexpr ((VAR & 1) == 0) { _Pragma("unroll") for (int r = 0; r < 16; ++r) P_[r] = __builtin_amdgcn_exp2f(P_[r]); } } while (0)
#define PACKP(P0_, P1_) do { \
        { u32x4 w_ = {pk2(P0_[0], P0_[1]), pk2(P0_[2], P0_[3]), pk2(P0_[4], P0_[5]), pk2(P0_[6], P0_[7])}; pa0 = __builtin_bit_cast(bf16x8, w_); } \
        { u32x4 w_ = {pk2(P0_[8], P0_[9]), pk2(P0_[10], P0_[11]), pk2(P0_[12], P0_[13]), pk2(P0_[14], P0_[15])}; pa1 = __builtin_bit_cast(bf16x8, w_); } \
        { u32x4 w_ = {pk2(P1_[0], P1_[1]), pk2(P1_[2], P1_[3]), pk2(P1_[4], P1_[5]), pk2(P1_[6], P1_[7])}; pa2 = __builtin_bit_cast(bf16x8, w_); } \
        { u32x4 w_ = {pk2(P1_[8], P1_[9]), pk2(P1_[10], P1_[11]), pk2(P1_[12], P1_[13]), pk2(P1_[14], P1_[15])}; pa3 = __builtin_bit_cast(bf16x8, w_); } } while (0)
#define SOFTMAX2(P0_, P1_, al_) do { EXP16(P1_); float ps_ = 0.f; _Pragma("unroll") for (int r = 0; r < 16; ++r) ps_ += P0_[r] + P1_[r]; \
        auto rr_ = __builtin_amdgcn_permlane32_swap(__float_as_uint(ps_), __float_as_uint(ps_), false, false); ps_ = __uint_as_float(rr_[0]) + __uint_as_float(rr_[1]); \
        l_reg = l_reg * (al_) + ps_; PACKP(P0_, P1_); } while (0)
    s16x4 vl[8], vh[8];
#define TRRD(dst, off) asm volatile("ds_read_b64_tr_b16 %0, %1 offset:%2" : "=&v"(dst) : "v"(vb_), "i"(off) : "memory")
#define VREAD(slot) do { const int vb_ = vb0 + (slot) * VSLOT; \
        TRRD(vl[0], 0); TRRD(vh[0], 512); TRRD(vl[1], 1024); TRRD(vh[1], 1536); TRRD(vl[2], 2048); TRRD(vh[2], 2560); TRRD(vl[3], 3072); TRRD(vh[3], 3584); \
        TRRD(vl[4], 4096); TRRD(vh[4], 4608); TRRD(vl[5], 5120); TRRD(vh[5], 5632); TRRD(vl[6], 6144); TRRD(vh[6], 6656); TRRD(vl[7], 7168); TRRD(vh[7], 7680); } while (0)
#define VF(i) (bf16x8){vl[i][0], vl[i][1], vl[i][2], vl[i][3], vh[i][0], vh[i][1], vh[i][2], vh[i][3]}
#define PVALL() do { if constexpr ((VAR & 32) != 0) { o[0][0] += (float)vl[0][0] + (float)vh[7][1] + (float)pa0[0] + (float)pa3[1]; } else if constexpr ((VAR & 8) != 0) { PVH(0); PVH(1); } else { \
        o[0] = __builtin_amdgcn_mfma_f32_32x32x16_bf16(pa0, VF(0), o[0], 0, 0, 0); o[1] = __builtin_amdgcn_mfma_f32_32x32x16_bf16(pa0, VF(4), o[1], 0, 0, 0); \
        o[0] = __builtin_amdgcn_mfma_f32_32x32x16_bf16(pa1, VF(1), o[0], 0, 0, 0); o[1] = __builtin_amdgcn_mfma_f32_32x32x16_bf16(pa1, VF(5), o[1], 0, 0, 0); \
        o[0] = __builtin_amdgcn_mfma_f32_32x32x16_bf16(pa2, VF(2), o[0], 0, 0, 0); o[1] = __builtin_amdgcn_mfma_f32_32x32x16_bf16(pa2, VF(6), o[1], 0, 0, 0); \
        o[0] = __builtin_amdgcn_mfma_f32_32x32x16_bf16(pa3, VF(3), o[0], 0, 0, 0); o[1] = __builtin_amdgcn_mfma_f32_32x32x16_bf16(pa3, VF(7), o[1], 0, 0, 0); } } while (0)
#define PVH(d0) do { if constexpr ((VAR & 8) != 0) { _Pragma("unroll") for (int e_ = 0; e_ < 4; ++e_) { o[d0][e_] += (float)vl[4 * (d0) + e_][0] + (float)vh[4 * (d0) + e_][1] + (float)pa0[e_] + (float)pa1[e_] + (float)pa2[e_] + (float)pa3[e_]; } } else { o[d0] = __builtin_amdgcn_mfma_f32_32x32x16_bf16(pa0, VF(4 * (d0) + 0), o[d0], 0, 0, 0); o[d0] = __builtin_amdgcn_mfma_f32_32x32x16_bf16(pa1, VF(4 * (d0) + 1), o[d0], 0, 0, 0); \
        o[d0] = __builtin_amdgcn_mfma_f32_32x32x16_bf16(pa2, VF(4 * (d0) + 2), o[d0], 0, 0, 0); o[d0] = __builtin_amdgcn_mfma_f32_32x32x16_bf16(pa3, VF(4 * (d0) + 3), o[d0], 0, 0, 0); } } while (0)
    f32x16 px0, px1; bf16x8 pa0, pa1, pa2, pa3;
#define TILE_VALU(al_) bf16x8 pn0, pn1, pn2, pn3; do { EXP16(px0); EXP16(px1); float s0_ = px0[0] + px1[0], s1_ = px0[1] + px1[1], s2_ = px0[2] + px1[2], s3_ = px0[3] + px1[3]; \
        _Pragma("unroll") for (int r = 4; r < 16; r += 4) { s0_ += px0[r] + px1[r]; s1_ += px0[r + 1] + px1[r + 1]; s2_ += px0[r + 2] + px1[r + 2]; s3_ += px0[r + 3] + px1[r + 3]; } \
        float ps_ = (s0_ + s1_) + (s2_ + s3_); \
        auto rr_ = __builtin_amdgcn_permlane32_swap(__float_as_uint(ps_), __float_as_uint(ps_), false, false); ps_ = __uint_as_float(rr_[0]) + __uint_as_float(rr_[1]); \
        l_reg = l_reg * (al_) + ps_; \
        { u32x4 w_ = {pk2(px0[0], px0[1]), pk2(px0[2], px0[3]), pk2(px0[4], px0[5]), pk2(px0[6], px0[7])}; pn0 = __builtin_bit_cast(bf16x8, w_); } \
        { u32x4 w_ = {pk2(px0[8], px0[9]), pk2(px0[10], px0[11]), pk2(px0[12], px0[13]), pk2(px0[14], px0[15])}; pn1 = __builtin_bit_cast(bf16x8, w_); } \
        { u32x4 w_ = {pk2(px1[0], px1[1]), pk2(px1[2], px1[3]), pk2(px1[4], px1[5]), pk2(px1[6], px1[7])}; pn2 = __builtin_bit_cast(bf16x8, w_); } \
        { u32x4 w_ = {pk2(px1[8], px1[9]), pk2(px1[10], px1[11]), pk2(px1[12], px1[13]), pk2(px1[14], px1[15])}; pn3 = __builtin_bit_cast(bf16x8, w_); } } while (0)
    if (primed) { WAIT_BAR(4); } else { WAIT_BAR(0); }
    asm volatile("" : "+v"(qr[0]), "+v"(qr[1]), "+v"(qr[2]), "+v"(qr[3]), "+v"(qr[4]), "+v"(qr[5]));
    {
        const float* ct_ = cosT + (size_t)(P0 + wid * 32 + r32) * 16 + 8 * hi; const float* st_ = ct_ + ROPE_TAB;
        const f32x4 c0 = *(const f32x4*)ct_, c1 = *(const f32x4*)(ct_ + 4), s0 = *(const f32x4*)st_, s1 = *(const f32x4*)(st_ + 4);
        const u32x4 w1 = __builtin_bit_cast(u32x4, qr[4]), w2 = __builtin_bit_cast(u32x4, qr[5]);
        const f32x4 x1a = {bflo(w1.x), bfhi(w1.x), bflo(w1.y), bfhi(w1.y)}, x1b = {bflo(w1.z), bfhi(w1.z), bflo(w1.w), bfhi(w1.w)};
        const f32x4 x2a = {bflo(w2.x), bfhi(w2.x), bflo(w2.y), bfhi(w2.y)}, x2b = {bflo(w2.z), bfhi(w2.z), bflo(w2.w), bfhi(w2.w)};
        const f32x4 o1a = x1a * c0 - x2a * s0, o1b = x1b * c1 - x2b * s1, o2a = x1a * s0 + x2a * c0, o2b = x1b * s1 + x2b * c1;
        u32x4 r1 = {pk2(o1a.x, o1a.y), pk2(o1a.z, o1a.w), pk2(o1b.x, o1b.y), pk2(o1b.z, o1b.w)}, r2 = {pk2(o2a.x, o2a.y), pk2(o2a.z, o2a.w), pk2(o2b.x, o2b.y), pk2(o2b.z, o2b.w)};
        qr[4] = __builtin_bit_cast(bf16x8, r1); qr[5] = __builtin_bit_cast(bf16x8, r2); }
    const bool trail = wid >= 4;
#define PBAR_M(t) do { if ((t) + 3 < NT) { WAIT_BAR(6); } else { WAIT_BAR(0); } } while (0)
#define PBAR_V(t) do { if ((t) + 3 < NT) { WAIT_BAR(6); } else { WAIT_BAR(0); } } while (0)
    if (trail) WAIT_BAR(0);
    DMA_K(3, 3); DMA_V(2, 2);
    KLOAD(0); QK(px0, px1);
    PBAR_V(0);
    MASKT(px0, px1, 0);
    { float pm; ROWMAX(px0, px1, pm); SHIFT(px0, px1, pm); TILE_VALU(1.f); pa0 = pn0; pa1 = pn1; pa2 = pn2; pa3 = pn3; }
    int sk = 1, sv = 0;
#pragma unroll 1
    for (int t = 1; t < NT; ++t) {
        PBAR_M(t);
        { if (t + 3 < NT) DMA_K(t + 3, (sk + 3) & 3); if (t + 2 < NT) DMA_V(t + 2, (sk + 2) & 3); }
        SBAR();
        KLOAD(sk); VREAD(sv);
        SBAR();
        QK(px0, px1);
        SBAR(); asm volatile("s_waitcnt lgkmcnt(0)" ::: "memory"); SBAR();
        PVALL();
        PBAR_V(t);
        MASKT(px0, px1, t);
        float pm_, alX = 1.f; ROWMAX(px0, px1, pm_);
        if (__builtin_expect(__any(pm_ > THR), 0)) { const float dl_ = fmaxf(pm_, 0.f); SHIFT(px0, px1, dl_); alX = __builtin_amdgcn_exp2f(-dl_); }
        TILE_VALU(alX);
        pa0 = pn0; pa1 = pn1; pa2 = pn2; pa3 = pn3;
        RESC(alX);
        sk = (sk + 1) & 3; sv = (sv + 1) & 3;
    }
    WAIT_BAR(0);
    VREAD(sv); asm volatile("s_waitcnt lgkmcnt(0)" ::: "memory"); SBAR(); PVALL();
    if (!trail) WAIT_BAR(0);
    if (has_next) PRIME(nb_, nh_, nqb_);
#undef PBAR_M
#undef PBAR_V
    if (hi == 0) li_l[r32] = l_reg; asm volatile("s_waitcnt lgkmcnt(0)" ::: "memory");
    bf16* Ow = OB + (rowbase + P0 + wid * 32) * DM + h * 64;
    {
        LAS bf16* stg = (LAS bf16*)(lds + LDS_OST) + wid * 2048;
#pragma unroll
        for (int r = 0; r < 16; ++r) { const int orow = crow(r, hi); const float rl = __builtin_amdgcn_rcpf(li_l[orow]);
#pragma unroll
            for (int d0 = 0; d0 < 2; ++d0) stg[orow * 64 + d0 * 32 + r32] = f2bf(o[d0][r] * rl); }
        asm volatile("s_waitcnt lgkmcnt(0)" ::: "memory");
#pragma unroll
        for (int i4 = 0; i4 < 4; ++i4) { const int row = i4 * 8 + (lane >> 3), ch = lane & 7; const u32x4 v = *(const LAS u32x4*)(stg + row * 64 + ch * 8); *(u32x4*)(Ow + (size_t)row * DM + ch * 8) = v; }
    }
    if (!has_next) WAIT_BAR(0);
#undef PRIME
#undef TT
#undef DMA_K
#undef DMA_V
#undef KLOAD
#undef QK
#undef RESC
#undef MASKT
#undef ROWMAX
#undef SHIFT
#undef EXP16
#undef PACKP
#undef SOFTMAX2
#undef TILE_VALU
#undef TRRD
#undef VREAD
#undef VF
#undef PVH
#undef PVALL
#undef STEP
}
#undef SBAR
#undef SGB
#undef WAIT_BAR
}

#ifndef MK_PER_PHASE
#define MK_PER_PHASE 0
#endif
#ifndef REPEAT_MASK
#define REPEAT_MASK 0
#endif
#ifndef ATT_SHADOW
#define ATT_SHADOW -1
#endif
#ifndef P7_ONLY
#define P7_ONLY 0
#endif
__device__ __forceinline__ int q_grab(unsigned* que, LAS int* slot, int wv) {
    if (wv == 0) { if (lane_id() == 0) *slot = (int)__hip_atomic_fetch_add(que, 1u, __ATOMIC_RELAXED, __HIP_MEMORY_SCOPE_AGENT); }
    __syncthreads();
    const int r = __builtin_amdgcn_readfirstlane(*slot);
    __syncthreads();
    return r;
}
constexpr int N_PHASES = 17;
__global__ void __launch_bounds__(NWAVES * 64, 2) hybrid_fwd(Args args) {
    extern __shared__ __attribute__((aligned(16))) unsigned char lds_raw[];
    LAS unsigned char* lds = (LAS unsigned char*)lds_raw;
    const int wv0 = __builtin_amdgcn_readfirstlane(threadIdx.x >> 6);
    for (int u = threadIdx.x; u < (LDS_BYTES - LDSCTL_OFF) / 4; u += NWAVES * 64) ((LAS unsigned*)(lds + LDSCTL_OFF))[u] = 0u;
    __syncthreads();
    if (!MK_PER_PHASE) (void)xcd_barrier_post((unsigned*)((unsigned char*)args.in[I_WS] + WS_CTL) + CW_BAR, (volatile LAS unsigned*)(lds + MISC_OFF) + 8);
    const int lo = args.ph_lo, hi = args.ph_hi;
#define IN(k) (lo <= (k) && (k) < hi)
#define PH_BEGIN int z = 0; asm volatile("" : "+s"(z)); int tid = TIDW(wv0); asm volatile("" : "+v"(tid)); const int lane = tid & 63, wave = wv0; \
    const int G = gridDim.x; const int bx = blockIdx.x; const int vcu = (G % 8 == 0) ? (bx % 8) * (G / 8) + bx / 8 : bx; unsigned char* ws = (unsigned char*)args.in[I_WS + z]; \
    LAS unsigned char* ring = lds + RING_OFF; (void)lane; (void)wave; (void)vcu; (void)ws; (void)ring; (void)tid;
#define SEAM(k) do { if (IN(k) && IN((k) + 1)) { int zb = 0; asm volatile("" : "+s"(zb)); XcdBarrier bar; bar.bar = (unsigned*)((unsigned char*)args.in[I_WS + zb] + WS_CTL) + CW_BAR; bar.x = xb_xcc_id(); \
        bar.st = (volatile LAS unsigned*)(lds + MISC_OFF) + 8; bar.t0 = (TIDW(wv0) == 0); xcd_barrier(bar); } } while (0)
    typedef pg8::StaticOrder SO;
#define GBAR() do { int zb = 0; asm volatile("" : "+s"(zb)); XcdBarrier bar; bar.bar = (unsigned*)((unsigned char*)args.in[I_WS + zb] + WS_CTL) + CW_BAR; bar.x = xb_xcc_id(); \
        bar.st = (volatile LAS unsigned*)(lds + MISC_OFF) + 8; bar.t0 = (TIDW(wv0) == 0); xcd_barrier(bar); } while (0)
#define BAR_ARRIVE() do { int zb = 0; asm volatile("" : "+s"(zb)); XcdBarrier bar; bar.bar = (unsigned*)((unsigned char*)args.in[I_WS + zb] + WS_CTL) + CW_BAR; bar.x = xb_xcc_id(); \
        bar.st = (volatile LAS unsigned*)(lds + MISC_OFF) + 8; bar.t0 = (TIDW(wv0) == 0); xcd_barrier_arrive(bar); } while (0)
#define BAR_FINISH() do { int zb = 0; asm volatile("" : "+s"(zb)); XcdBarrier bar; bar.bar = (unsigned*)((unsigned char*)args.in[I_WS + zb] + WS_CTL) + CW_BAR; bar.x = xb_xcc_id(); \
        bar.st = (volatile LAS unsigned*)(lds + MISC_OFF) + 8; bar.t0 = (TIDW(wv0) == 0); xcd_barrier_finish(bar); } while (0)
#define PHASE(k, ...) if (IN(k)) { { constexpr int rep = 0; (void)rep; __VA_ARGS__ } if constexpr (((REPEAT_MASK) >> (k)) & 1) { GBAR(); { constexpr int rep = 1; (void)rep; __VA_ARGS__ } } }

    PHASE(0, { PH_BEGIN p0_prologue(args, lds, vcu, G, tid, lane, wave); })
    SEAM(0);
    PHASE(1, { PH_BEGIN pg8::Gemm g{(const bf16*)(ws + WS_XN), (const bf16*)(ws + WS_BUP1), MT, 2 * DFF, DM}; SO S; S.init(MT, 2 * DFF, G, bx);
        pg8::Epi<pg8::EM_SWIGLU> E{(bf16*)(ws + WS_H), DFF, nullptr, 0, nullptr, 0, 1.f};
        pg8::gemm_phase<pg8::Epi<pg8::EM_SWIGLU>, SO, true, true>(ring, g, S, E, wv0);
        if (rep == 0) convert_in_tail(args, lds, S.nwg, G, bx, CV_A, CV_B, wv0); })
    SEAM(1);
    PHASE(2, { PH_BEGIN
        auto pre = [&]() { sgemm_sample<pg8::EM_PLAIN, DFF>(lds + 32768, (const bf16*)(ws + WS_H), (const bf16*)(ws + WS_BDN1), DM, (bf16*)(ws + WS_F), DM, nullptr, 0, nullptr, 0, vcu, G, wv0, (unsigned*)(ws + WS_CTL) + CW_SN + 0 * 8 * 64); };
        pg8::Gemm g{(const bf16*)(ws + WS_H), (const bf16*)(ws + WS_BDN1), MP, DM, DFF}; SO S; S.init(MP, DM, G, bx);
        pg8::EpiNorm<1, 0> E{(const float*)args.in[I_XP + z], (bf16*)(ws + WS_XR), (bf16*)(ws + WS_XN), nullptr, (const float*)args.in[I_F1POST + z], (const float*)args.in[I_MIXPRE + z], 0.5f, (float*)(ws + WS_NSLOT) + (size_t)0 * 2 * 64 * 256 * 4, (unsigned*)(ws + WS_CTL) + CW_PN + 0 * 2 * 64 * 64, nullptr};
        pg8::gemm_phase<pg8::EpiNorm<1, 0>, SO, true, true, decltype(pre)>(ring, g, S, E, wv0, pre);
        sample_norm<1, 0>(args, (unsigned*)(ws + WS_CTL) + CW_SN + 0 * 8 * 64, (const bf16*)(ws + WS_F), 0.5f, I_F1POST, I_MIXPRE, G, vcu, wv0); })
    SEAM(3);
    PHASE(4, { PH_BEGIN pg8::Gemm g{(const bf16*)(ws + WS_XN), (const bf16*)(ws + WS_BIN), MT, ZW, DM}; SO S; S.init(MT, ZW, G, bx);
        pg8::Epi<pg8::EM_WIN> E{(bf16*)(ws + WS_Z), ZW, nullptr, 0, nullptr, 0, 1.f};
        pg8::gemm_phase<pg8::Epi<pg8::EM_WIN>, SO, true, true>(ring, g, S, E, wv0);
        if (rep == 0) convert_in_tail(args, lds, S.nwg, G, bx, CV_B, CV_N, wv0); })
    SEAM(4);
    PHASE(5, { PH_BEGIN
        for (int u = vcu; u < 256; u += G) lru_cu_unit<1>(args, lds, u, wv0);
        mla_prep(args, vcu, G, lane, wave);
    })
    SEAM(5);
    PHASE(6, {
        { PH_BEGIN for (int u = vcu; u < 256; u += G) lru_cu_unit<2>(args, lds, u, wv0); }
        __syncthreads();
        { PH_BEGIN sgemm_sample<pg8::EM_PLAIN, QL>(lds, (const bf16*)(ws + WS_CQ), (const bf16*)(ws + WS_BQ), QW, (bf16*)(ws + WS_Q), QW, nullptr, 0, nullptr, 0, vcu, G, wv0);
          sgemm_sample<pg8::EM_PLAIN, DPLE>(lds, (const bf16*)(ws + WS_PB), (const bf16*)(ws + WS_BPP), DM, (bf16*)(ws + WS_PPB), DM, nullptr, 0, nullptr, 0, vcu, G, wv0); }
    })
    SEAM(6);
    PHASE(7, {
        bool dec7;
        { PH_BEGIN const int nq = (G % 8 == 0) ? 8 : 1, q = (nq == 8) ? (bx & 7) : 0, ci = (nq == 8) ? (bx >> 3) : bx, cpq = G / nq, ndq = (NDEC / nq < cpq) ? NDEC / nq : cpq;
          const bool early = EARLY_DEC && (G == 256); dec7 = early && ci < ndq;
          if (!dec7) {
            const int Gp = early ? G - ndq * nq : G, cp = early ? (ci - ndq) * 8 + q : bx, vcup = early ? q * (cpq - ndq) + (ci - ndq) : vcu;
            sgemm_sample<pg8::EM_MULZ, DRNN>(lds, (const bf16*)(ws + WS_HG), (const bf16*)(ws + WS_BRNN), DM, (bf16*)(ws + WS_YAG), DM, (const bf16*)(ws + WS_Z) + Z_GA, ZW, nullptr, 0, vcup, Gp, wv0);
            { pg8::Gemm g{(const bf16*)(ws + WS_CQ), (const bf16*)(ws + WS_BQ), MP, QW, QL}; SO S; S.init(MP, QW, Gp, cp);
              pg8::Epi<pg8::EM_PLAIN> E{(bf16*)(ws + WS_Q), QW, nullptr, 0, nullptr, 0, 1.f};
              pg8::gemm_phase<pg8::Epi<pg8::EM_PLAIN>, SO, true, true>(ring, g, S, E, wv0); } } }
        if (!dec7) { PH_BEGIN const int nq = (G % 8 == 0) ? 8 : 1, q = (nq == 8) ? (bx & 7) : 0, ci = (nq == 8) ? (bx >> 3) : bx, cpq = G / nq, ndq = (NDEC / nq < cpq) ? NDEC / nq : cpq;
          const bool early = EARLY_DEC && (G == 256); const int Gp = early ? G - ndq * nq : G, cp = early ? (ci - ndq) * 8 + q : bx;
          pg8::Gemm g{(const bf16*)(ws + WS_CKV), (const bf16*)(ws + WS_BKV), MP, KVW, KVL}; SO S; S.init(MP, KVW, Gp, cp);
          pg8::Epi<pg8::EM_PLAIN> E{(bf16*)(ws + WS_KVB), KVW, nullptr, 0, nullptr, 0, 1.f};
          pg8::gemm_phase<pg8::Epi<pg8::EM_PLAIN>, SO, true, true>(ring, g, S, E, wv0); }
        BAR_ARRIVE();
        if (!dec7) BAR_FINISH();
    })
    PHASE(8, { PH_BEGIN
        const int nq = (G % 8 == 0) ? 8 : 1, q = (nq == 8) ? (bx & 7) : 0, ci = (nq == 8) ? (bx >> 3) : bx, cpq = G / nq;
        {
            const int ndq = (NDEC / nq < cpq) ? NDEC / nq : cpq, nd = ndq * nq;
            if (ci < ndq) {
                _Pragma("unroll 1") for (int sq = q * ndq + ci; sq < NS; sq += nd) {
                    sample_attn_seq(args, lds, sq, wv0);
                }
                __syncthreads();
                if (EARLY_DEC && G == 256) BAR_FINISH();
            }
        }
        {
            unsigned* que = (unsigned*)(ws + WS_CTL) + CW_QUE + 64 * q;
            LAS int* slot = (LAS int*)(lds + MISC_OFF) + 64;
            const int hq = 32 / nq, nblk = 32 * hq, npq = 64 / nq, ny = 4 * npq, ya0 = nblk - 10, nitem = nblk + ny;
            int cur = q_grab(que, slot, wv0), nxt = nitem; if (cur < nitem) nxt = q_grab(que, slot, wv0);
            _Pragma("unroll 1") while (cur < nitem) {
                if (cur >= ya0 && cur < ya0 + ny) {
                    const int t = cur - ya0;
                    pg8::Gemm g{(const bf16*)(ws + WS_HG), (const bf16*)(ws + WS_BRNN), MP, DM, DRNN}; pg8::OneUnit T; T.u.pm = q * npq + (t % npq); T.u.pn = t / npq;
                    pg8::Epi<pg8::EM_MULZ> E{(bf16*)(ws + WS_YAG), DM, (const bf16*)(ws + WS_Z) + Z_GA, ZW, nullptr, 0, 1.f};
                    pg8::gemm_phase<pg8::Epi<pg8::EM_MULZ>, pg8::OneUnit, true, true>(ring, g, T, E, wv0);
                    cur = nxt; if (cur < nitem) nxt = q_grab(que, slot, wv0);
                    continue;
                }
                bf16x8 qr[6]; bool primed = false, more;
                do {
                    const int kc = cur < ya0 ? cur : cur - ny, bh = hq * q + 2 * (kc >> 6) + (kc & 1), qb = 31 - ((kc & 63) >> 1);
                    more = nxt < nitem && !(nxt >= ya0 && nxt < ya0 + ny);
                    const int kn = more ? (nxt < ya0 ? nxt : nxt - ny) : 0, bhn = hq * q + 2 * (kn >> 6) + (kn & 1), qbn = 31 - ((kn & 63) >> 1);
                    pattn4::block<0>((const bf16*)(ws + WS_Q), (const bf16*)(ws + WS_KVB), (const bf16*)(ws + WS_KR), (const float*)(ws + WS_ROPE), (bf16*)(ws + WS_OB), lds, bh >> 4, bh & 15, qb, 0, wv0,
                                     primed, more, bhn >> 4, bhn & 15, qbn, qr);
                    primed = true; cur = nxt; if (cur < nitem) nxt = q_grab(que, slot, wv0);
                } while (more);
            }
        }
        __syncthreads();
#if ATT_SHADOW >= 0
        GBAR();
        { int z2 = 0; asm volatile("" : "+s"(z2)); unsigned char* ws2 = (unsigned char*)args.in[I_WS + z2];
          const int G2 = gridDim.x, bx2 = blockIdx.x, vcu2 = (G2 % 8 == 0) ? (bx2 % 8) * (G2 / 8) + bx2 / 8 : bx2;
          bf16x8 qrs[6];
          for (int L = vcu2; L < 512; L += G2) { const int bh = L >> 4, x = L & 15;
            pattn4::block<ATT_SHADOW>((const bf16*)(ws2 + WS_Q), (const bf16*)(ws2 + WS_KVB), (const bf16*)(ws2 + WS_KR), (const float*)(ws2 + WS_ROPE), (bf16*)(ws2 + WS_END), lds, bh >> 4, bh & 15, x, 0, wv0, false, false, 0, 0, 0, qrs);
            pattn4::block<ATT_SHADOW>((const bf16*)(ws2 + WS_Q), (const bf16*)(ws2 + WS_KVB), (const bf16*)(ws2 + WS_KR), (const float*)(ws2 + WS_ROPE), (bf16*)(ws2 + WS_END), lds, bh >> 4, bh & 15, 31 - x, 0, wv0, false, false, 0, 0, 0, qrs); } }
        __syncthreads();
#endif
    })
    SEAM(8);
    PHASE(9, { PH_BEGIN
        auto pre = [&]() { sgemm_sample<pg8::EM_FMAZ, DM>(lds + 32768, (const bf16*)(ws + WS_OB), (const bf16*)(ws + WS_BATT), DM, (bf16*)(ws + WS_MX), DM, (const bf16*)(ws + WS_Z) + Z_GB, ZW, (const bf16*)(ws + WS_YAG), DM, vcu, G, wv0); };
        pg8::Gemm g{(const bf16*)(ws + WS_OB), (const bf16*)(ws + WS_BATT), MP, DM, DM}; SO S; S.init(MP, DM, G, bx);
        pg8::Epi<pg8::EM_FMAZ> E{(bf16*)(ws + WS_MX), DM, (const bf16*)(ws + WS_Z) + Z_GB, ZW, (const bf16*)(ws + WS_YAG), DM, 1.f};
        pg8::gemm_phase<pg8::Epi<pg8::EM_FMAZ>, SO, true, true, decltype(pre)>(ring, g, S, E, wv0, pre); })
    SEAM(9);
    PHASE(10, { PH_BEGIN
        auto pre = [&]() { sgemm_sample<pg8::EM_PLAIN, DM>(lds + 32768, (const bf16*)(ws + WS_MX), (const bf16*)(ws + WS_BOUT), DM, (bf16*)(ws + WS_F), DM, nullptr, 0, nullptr, 0, vcu, G, wv0, (unsigned*)(ws + WS_CTL) + CW_SN + 1 * 8 * 64); };
        pg8::Gemm g{(const bf16*)(ws + WS_MX), (const bf16*)(ws + WS_BOUT), MP, DM, DM}; SO S; S.init(MP, DM, G, bx);
        pg8::EpiNorm<1, 1> E{nullptr, (bf16*)(ws + WS_XR), (bf16*)(ws + WS_XN), nullptr, (const float*)args.in[I_MIXPOST + z], (const float*)args.in[I_F2PRE + z], 1.0f, (float*)(ws + WS_NSLOT) + (size_t)1 * 2 * 64 * 256 * 4, (unsigned*)(ws + WS_CTL) + CW_PN + 1 * 2 * 64 * 64, nullptr};
        pg8::gemm_phase<pg8::EpiNorm<1, 1>, SO, true, true, decltype(pre)>(ring, g, S, E, wv0, pre);
        sample_norm<1, 1>(args, (unsigned*)(ws + WS_CTL) + CW_SN + 1 * 8 * 64, (const bf16*)(ws + WS_F), 1.0f, I_MIXPOST, I_F2PRE, G, vcu, wv0); })
    SEAM(11);
    PHASE(12, { PH_BEGIN pg8::Gemm g{(const bf16*)(ws + WS_XN), (const bf16*)(ws + WS_BUP2), MT, 2 * DFF, DM}; SO S; S.init(MT, 2 * DFF, G, bx);
        pg8::Epi<pg8::EM_SWIGLU> E{(bf16*)(ws + WS_H), DFF, nullptr, 0, nullptr, 0, 1.f};
        pg8::gemm_phase<pg8::Epi<pg8::EM_SWIGLU>, SO, true, true>(ring, g, S, E, wv0); }
        { PH_BEGIN const int nwg0 = (MT / 256) * (2 * DFF / 256), full = (nwg0 + G - 1) / G, nl = full * G - nwg0;
          if (nl == 0 || bx >= G - nl) { pg8::Gemm g2{(const bf16*)(ws + WS_PB), (const bf16*)(ws + WS_BPP), MP, DM, DPLE}; SO T; T.init(MP, DM, nl == 0 ? G : nl, nl == 0 ? bx : bx - (G - nl));
            pg8::Epi<pg8::EM_PLAIN> E2{(bf16*)(ws + WS_PPB), DM, nullptr, 0, nullptr, 0, 1.f};
            pg8::gemm_phase<pg8::Epi<pg8::EM_PLAIN>, SO, true, true>(ring, g2, T, E2, wv0); } } )
    SEAM(12);
    PHASE(13, { PH_BEGIN
        auto pre = [&]() { sgemm_sample<pg8::EM_PLAIN, DFF>(lds + 32768, (const bf16*)(ws + WS_H), (const bf16*)(ws + WS_BDN2), DM, (bf16*)(ws + WS_F), DM, nullptr, 0, nullptr, 0, vcu, G, wv0, (unsigned*)(ws + WS_CTL) + CW_SN + 2 * 8 * 64); };
        pg8::Gemm g{(const bf16*)(ws + WS_H), (const bf16*)(ws + WS_BDN2), MP, DM, DFF}; SO S; S.init(MP, DM, G, bx);
        pg8::EpiNorm<2, 1> E{nullptr, (bf16*)(ws + WS_XR), (bf16*)(ws + WS_XN), nullptr, (const float*)args.in[I_F2POST + z], nullptr, 0.5f, (float*)(ws + WS_NSLOT) + (size_t)2 * 2 * 64 * 256 * 4, (unsigned*)(ws + WS_CTL) + CW_PN + 2 * 2 * 64 * 64, nullptr};
        pg8::gemm_phase<pg8::EpiNorm<2, 1>, SO, true, true, decltype(pre)>(ring, g, S, E, wv0, pre);
        sample_norm<2, 1>(args, (unsigned*)(ws + WS_CTL) + CW_SN + 2 * 8 * 64, (const bf16*)(ws + WS_F), 0.5f, I_F2POST, I_F2POST, G, vcu, wv0); })
    SEAM(14);
    PHASE(15, { PH_BEGIN
        auto pre = [&]() { sgemm_sample<pg8::EM_SIGMUL, DM>(lds + 32768, (const bf16*)(ws + WS_XN), (const bf16*)(ws + WS_BPG), DM, (bf16*)(ws + WS_F), DM, (const bf16*)(ws + WS_PPB), DM, nullptr, 0, vcu, G, wv0, (unsigned*)(ws + WS_CTL) + CW_SN + 3 * 8 * 64); };
        pg8::Gemm g{(const bf16*)(ws + WS_XN), (const bf16*)(ws + WS_BPG), MP, DM, DM}; SO S; S.init(MP, DM, G, bx);
        pg8::EpiNorm<0, 2, 1> E{nullptr, nullptr, (bf16*)(ws + WS_XN), (float*)args.in[I_OUT + z] + O_Y, (const float*)args.in[I_PPOST + z], nullptr, 1.0f, (float*)(ws + WS_NSLOT) + (size_t)3 * 2 * 64 * 256 * 4, (unsigned*)(ws + WS_CTL) + CW_PN + 3 * 2 * 64 * 64, (const bf16*)(ws + WS_PPB)};
        pg8::gemm_phase<pg8::EpiNorm<0, 2, 1>, SO, true, true, decltype(pre)>(ring, g, S, E, wv0, pre);
        sample_norm<0, 2>(args, (unsigned*)(ws + WS_CTL) + CW_SN + 3 * 8 * 64, (const bf16*)(ws + WS_F), 1.0f, I_PPOST, I_PPOST, G, vcu, wv0); })
#undef IN
#undef SEAM
#undef PHASE
#undef GBAR
#undef PH_BEGIN
}

extern "C" void kernel_launch(void* const* d_in, const int* in_sizes, int n_in, void* d_out, int out_size, void* d_ws, size_t ws_size, hipStream_t stream) {
    static int grid = 0;
    if (grid == 0) {
        if (n_in != N_IN || (size_t)out_size != O_END || ws_size < WS_END) { fprintf(stderr, "kernel_launch: unexpected shapes (n_in %d, out %d, ws %zu)\n", n_in, out_size, ws_size); grid = -1; return; }
        int dev = 0, cus = 0, per_cu = 0;
        if (hipGetDevice(&dev) != hipSuccess || hipDeviceGetAttribute(&cus, hipDeviceAttributeMultiprocessorCount, dev) != hipSuccess) { grid = -1; return; }
        if (hipFuncSetAttribute((const void*)hybrid_fwd, hipFuncAttributeMaxDynamicSharedMemorySize, LDS_BYTES) != hipSuccess) { fprintf(stderr, "kernel_launch: hipFuncSetAttribute failed\n"); grid = -1; return; }
        if (hipOccupancyMaxActiveBlocksPerMultiprocessor(&per_cu, (const void*)hybrid_fwd, NWAVES * 64, LDS_BYTES) != hipSuccess || per_cu < 1) { fprintf(stderr, "kernel_launch: occupancy query says %d\n", per_cu); }
        (void)hipGetLastError();
        grid = cus;
    }
    if (grid < 0) return;
    (void)hipMemsetAsync((char*)d_ws + WS_CTL, 0, CTL_ZERO_BYTES, stream);
    Args a{};
    for (int i = 0; i < N_IN; ++i) a.in[i] = d_in[i];
    a.in[I_OUT] = d_out; a.in[I_WS] = d_ws; a.pad = 0;
#if MK_PER_PHASE
    for (int p = 0; p < N_PHASES; ++p) { a.ph_lo = p; a.ph_hi = p + 1; a.li = p; hipLaunchKernelGGL(hybrid_fwd, dim3(grid), dim3(NWAVES * 64), LDS_BYTES, stream, a); }
#else
    a.ph_lo = 0; a.ph_hi = N_PHASES; a.li = 0;
    hipLaunchKernelGGL(hybrid_fwd, dim3(grid), dim3(NWAVES * 64), LDS_BYTES, stream, a);
#endif
    const hipError_t le = hipPeekAtLastError();
    if (le != hipSuccess) fprintf(stderr, "kernel_launch: launch failed: %s\n", hipGetErrorName(le));
}
```
